# Optimizing an MI355X kernel written in HIP

```python
import jax
import jax.numpy as jnp
from jax import lax
import numpy as np

D_MODEL = 2048
BATCH = 2
SEQ = 16384
DEPTH = 2

GRID_W = 64
CTX_LEN = 256
N_EVEN = (DEPTH + 1) // 2
N_ODD = DEPTH // 2
NORM_EPS = 1e-6
ROPE_BASE = 10000.0
MASK_VALUE = -1e30

FOURIER_GROUPS = 4
FOURIER_GROUP_DIM = 256
FOURIER_WIDTH = FOURIER_GROUPS * FOURIER_GROUP_DIM
RET_HEADS = 8
RET_QK_DIM = 128
RET_V_DIM = 128
RET_CHUNK = 128
RET_QK_WIDTH = RET_HEADS * RET_QK_DIM
RET_V_WIDTH = RET_HEADS * RET_V_DIM
EVEN_IN_SIZES = (FOURIER_WIDTH, RET_QK_WIDTH, RET_QK_WIDTH, RET_V_WIDTH, RET_V_WIDTH, RET_V_WIDTH)
EVEN_IN_WIDTH = sum(EVEN_IN_SIZES)
EVEN_OUT_WIDTH = FOURIER_WIDTH + RET_V_WIDTH

SWA_Q_HEADS = 16
SWA_KV_HEADS = 2
SWA_GROUP = SWA_Q_HEADS // SWA_KV_HEADS
SWA_HEAD_DIM = 64
SWA_WINDOW = 128
SWA_BLOCK = 128
MLA_HEADS = 8
MLA_Q_RANK = 512
MLA_KV_RANK = 256
MLA_NOPE = 128
MLA_ROPE = 64
MLA_V = 128
MLA_QK_DIM = MLA_NOPE + MLA_ROPE
MLA_BLOCK = 128
ODD_IN_SIZES = (SWA_Q_HEADS * SWA_HEAD_DIM, SWA_KV_HEADS * SWA_HEAD_DIM, SWA_KV_HEADS * SWA_HEAD_DIM, MLA_Q_RANK, MLA_KV_RANK, MLA_ROPE)
ODD_IN_WIDTH = sum(ODD_IN_SIZES)
ODD_OUT_WIDTH = SWA_Q_HEADS * SWA_HEAD_DIM + MLA_HEADS * MLA_V

PEER_HEADS = 8
PEER_KEYS = 128
PEER_EXPERTS = PEER_KEYS * PEER_KEYS
PEER_TOPK = 16
PEER_QDIM = 256
PEER_TOKEN_BLOCK = 128

kernel_name = "hybrid_fourier_retention_swa_mla_peer_dit"


def _split(t, sizes):
    return jnp.split(t, [int(v) for v in np.cumsum(sizes)[:-1]], axis=-1)


def rms_norm(x, g):
    xf = x.astype(jnp.float32)
    y = xf * lax.rsqrt(jnp.mean(xf * xf, axis=-1, keepdims=True) + NORM_EPS)
    return (y * g.astype(jnp.float32)).astype(x.dtype)


def adaln(cond, w_mod, b_mod):
    m = jax.nn.silu(cond) @ w_mod + b_mod
    return jnp.split(m[..., None, :], 6, axis=-1)


def axial_rope_tables(rows, d_rot):
    d_axis = d_rot // 2
    inv = ROPE_BASE ** (-jnp.arange(0, d_axis, 2, dtype=jnp.float32) / d_axis)
    t = jnp.arange(rows * GRID_W)
    row = (t // GRID_W).astype(jnp.float32)
    col = (t % GRID_W).astype(jnp.float32)
    ar = row[:, None] * inv[None, :]
    ac = col[:, None] * inv[None, :]
    ang = jnp.concatenate([ar, ar, ac, ac], axis=-1)
    return jnp.cos(ang), jnp.sin(ang)


def apply_rope(t, cos, sin):
    r1, r2, c1, c2 = jnp.split(t, 4, axis=-1)
    rot = jnp.concatenate([-r2, r1, -c2, c1], axis=-1)
    return t * cos[:, None, :].astype(t.dtype) + rot * sin[:, None, :].astype(t.dtype)


def fourier_mix(u):
    b, l, _ = u.shape
    ug = u.reshape(b, l, FOURIER_GROUPS, FOURIER_GROUP_DIM).astype(jnp.float32)
    y = jnp.fft.fft2(ug, axes=(1, 3), norm="ortho").real
    return y.reshape(b, l, FOURIER_WIDTH).astype(u.dtype)


def retention_scan(q, k, v, log_gamma, state0):
    b, l, h, dk = k.shape
    dv = v.shape[-1]
    n = l // RET_CHUNK
    kc = k.reshape(b, n, RET_CHUNK, h, dk).astype(jnp.float32)
    vc = v.reshape(b, n, RET_CHUNK, h, dv).astype(jnp.float32)
    pos = jnp.arange(RET_CHUNK, dtype=jnp.float32)
    lg = log_gamma[:, None]
    zeta = jnp.exp(lg * (RET_CHUNK - 1.0 - pos)).T
    d_state = jnp.einsum('bnjhd,bnjhe->nbhde', kc, vc * zeta[:, :, None])
    chunk_decay = jnp.exp(log_gamma * RET_CHUNK)[None, :, None, None]

    def step(state, ds):
        return state * chunk_decay + ds, state

    final, prev = lax.scan(step, state0, d_state)
    if q is None:
        return None, final
    qc = q.reshape(b, n, RET_CHUNK, h, dk).astype(jnp.float32)
    diff = pos[:, None] - pos[None, :]
    decay = jnp.where(diff >= 0, jnp.exp(log_gamma[:, None, None] * jnp.maximum(diff, 0.0)), 0.0)
    scores = jnp.einsum('bnihd,bnjhd->bnhij', qc, kc) * decay
    inner = jnp.einsum('bnhij,bnjhe->bnihe', scores, vc)
    xi = jnp.exp(lg * (pos + 1.0)).T
    cross = jnp.einsum('bnihd,nbhde->bnihe', qc * xi[:, :, None], prev)
    return (inner + cross).reshape(b, l, h, dv), final


def head_norm(o, g):
    b, l, h, dv = o.shape
    y = o * lax.rsqrt(jnp.mean(o * o, axis=-1, keepdims=True) + NORM_EPS)
    return y.reshape(b, l, h * dv) * g.astype(jnp.float32)


def even_mixer(h_lat, h_ctx, w_in, ret_gn, w_out, rows, need_ctx):
    rope = axial_rope_tables(rows, RET_QK_DIM)
    log_gamma = jnp.log(1.0 - jnp.exp2(-5.0 - jnp.arange(RET_HEADS, dtype=jnp.float32)))

    def project(h, rotate):
        b, l, _ = h.shape
        f, q, k, v, gf, gb = _split(h @ w_in, EVEN_IN_SIZES)
        q = q.reshape(b, l, RET_HEADS, RET_QK_DIM)
        k = k.reshape(b, l, RET_HEADS, RET_QK_DIM) * RET_QK_DIM ** -0.5
        v = v.reshape(b, l, RET_HEADS, RET_V_DIM)
        if rotate:
            q = apply_rope(q, *rope)
            k = apply_rope(k, *rope)
        return f, q, k, v, gf, gb

    f_l, q_l, k_l, v_l, gf_l, gb_l = project(h_lat, True)
    f_c, q_c, k_c, v_c, gf_c, gb_c = project(h_ctx, False)
    rev = lambda t: t[:, ::-1]
    zero = jnp.zeros((h_lat.shape[0], RET_HEADS, RET_QK_DIM, RET_V_DIM), jnp.float32)
    o_cf, st_f = retention_scan(q_c if need_ctx else None, k_c, v_c, log_gamma, zero)
    o_cb, st_b = retention_scan(rev(q_c) if need_ctx else None, rev(k_c), rev(v_c), log_gamma, zero)
    o_lf, _ = retention_scan(q_l, k_l, v_l, log_gamma, st_f)
    o_lb, _ = retention_scan(rev(q_l), rev(k_l), rev(v_l), log_gamma, st_b)

    def merge(f, o_f, o_b_rev, gf, gb):
        ret = head_norm(o_f, ret_gn) * jax.nn.silu(gf) + head_norm(rev(o_b_rev), ret_gn) * jax.nn.silu(gb)
        return jnp.concatenate([fourier_mix(f), ret.astype(f.dtype)], axis=-1) @ w_out

    y_lat = merge(f_l, o_lf, o_lb, gf_l, gb_l)
    y_ctx = merge(f_c, o_cf, o_cb, gf_c, gb_c) if need_ctx else None
    return y_lat, y_ctx


def sink_softmax(s, sink):
    sk = sink.astype(jnp.float32)[:, :, None, None]
    m = jnp.maximum(jnp.max(s, axis=-1, keepdims=True), sk)
    e = jnp.exp(s - m)
    return e / (jnp.sum(e, axis=-1, keepdims=True) + jnp.exp(sk - m))


def window_attention(q, k, v, k_ctx, v_ctx, sink):
    b, l, hq, dh = q.shape
    nb = l // SWA_BLOCK
    n_ctx = k_ctx.shape[1]
    qb = jnp.moveaxis(q.reshape(b, nb, SWA_BLOCK, SWA_KV_HEADS, SWA_GROUP, dh), 1, 0)
    pad = jnp.zeros((b, SWA_BLOCK, SWA_KV_HEADS, dh), k.dtype)
    kp = jnp.concatenate([pad, k, pad], axis=1)
    vp = jnp.concatenate([pad, v, pad], axis=1)
    offs_q = jnp.arange(SWA_BLOCK)
    offs_k = jnp.arange(3 * SWA_BLOCK) - SWA_BLOCK

    def block(args):
        qi, i = args
        start = i * SWA_BLOCK
        ki = lax.dynamic_slice_in_dim(kp, start, 3 * SWA_BLOCK, axis=1)
        vi = lax.dynamic_slice_in_dim(vp, start, 3 * SWA_BLOCK, axis=1)
        qpos = start + offs_q
        kpos = start + offs_k
        valid = (jnp.abs(qpos[:, None] - kpos[None, :]) <= SWA_WINDOW) & (kpos >= 0)[None, :] & (kpos < l)[None, :]
        s_loc = jnp.where(valid, jnp.einsum('bqhgd,bkhd->bhgqk', qi, ki).astype(jnp.float32), MASK_VALUE)
        s_ctx = jnp.einsum('bqhgd,bkhd->bhgqk', qi, k_ctx).astype(jnp.float32)
        p = sink_softmax(jnp.concatenate([s_ctx, s_loc], axis=-1), sink).astype(v.dtype)
        o = jnp.einsum('bhgqk,bkhd->bqhgd', p[..., :n_ctx], v_ctx) + jnp.einsum('bhgqk,bkhd->bqhgd', p[..., n_ctx:], vi)
        return o.reshape(b, SWA_BLOCK, hq * dh)

    out = lax.map(block, (qb, jnp.arange(nb)))
    return jnp.moveaxis(out, 0, 1).reshape(b, l, hq * dh)


def context_window_heads(q, k, v, sink):
    b, l, hq, dh = q.shape
    qg = q.reshape(b, l, SWA_KV_HEADS, SWA_GROUP, dh)
    s = jnp.einsum('bqhgd,bkhd->bhgqk', qg, k).astype(jnp.float32)
    p = sink_softmax(s, sink).astype(v.dtype)
    return jnp.einsum('bhgqk,bkhd->bqhgd', p, v).reshape(b, l, hq * dh)


def dense_block_attention(q, k, v):
    b, l, h, dq = q.shape
    nb = l // MLA_BLOCK
    qb = jnp.moveaxis(q.reshape(b, nb, MLA_BLOCK, h, dq), 1, 0)

    def block(qi):
        p = jax.nn.softmax(jnp.einsum('bqhd,bkhd->bhqk', qi, k).astype(jnp.float32), axis=-1).astype(v.dtype)
        return jnp.einsum('bhqk,bkhd->bqhd', p, v).reshape(b, MLA_BLOCK, h * v.shape[-1])

    out = lax.map(block, qb)
    return jnp.moveaxis(out, 0, 1).reshape(b, l, h * v.shape[-1])


def odd_mixer(h_lat, h_ctx, w_in, sink, q_norm, kv_norm, w_uq, w_ukv, w_out, rows, need_ctx):
    rope_swa = axial_rope_tables(rows, SWA_HEAD_DIM)
    rope_mla = axial_rope_tables(rows, MLA_ROPE)

    def project(h, rotate, with_q):
        b, l, _ = h.shape
        sq, sk, sv, cq, ckv, kr = _split(h @ w_in, ODD_IN_SIZES)
        sk = sk.reshape(b, l, SWA_KV_HEADS, SWA_HEAD_DIM)
        sv = sv.reshape(b, l, SWA_KV_HEADS, SWA_HEAD_DIM)
        mkv = (rms_norm(ckv, kv_norm) @ w_ukv).reshape(b, l, MLA_HEADS, MLA_NOPE + MLA_V)
        k_nope, mv = jnp.split(mkv, [MLA_NOPE], axis=-1)
        kr = kr[:, :, None, :]
        if rotate:
            sk = apply_rope(sk, *rope_swa)
            kr = apply_rope(kr, *rope_mla)
        mk = jnp.concatenate([k_nope, jnp.broadcast_to(kr, (b, l, MLA_HEADS, MLA_ROPE))], axis=-1)
        if not with_q:
            return None, sk, sv, None, mk, mv
        sq = sq.reshape(b, l, SWA_Q_HEADS, SWA_HEAD_DIM) * SWA_HEAD_DIM ** -0.5
        mq = (rms_norm(cq, q_norm) @ w_uq).reshape(b, l, MLA_HEADS, MLA_QK_DIM)
        q_nope, q_rope = jnp.split(mq, [MLA_NOPE], axis=-1)
        if rotate:
            sq = apply_rope(sq, *rope_swa)
            q_rope = apply_rope(q_rope, *rope_mla)
        mq = jnp.concatenate([q_nope, q_rope], axis=-1) * MLA_QK_DIM ** -0.5
        return sq, sk, sv, mq, mk, mv

    sq_l, sk_l, sv_l, mq_l, mk_l, mv_l = project(h_lat, True, True)
    sq_c, sk_c, sv_c, mq_c, mk_c, mv_c = project(h_ctx, False, need_ctx)
    sink_g = sink.reshape(SWA_KV_HEADS, SWA_GROUP)
    swa_l = window_attention(sq_l, sk_l, sv_l, sk_c, sv_c, sink_g)
    mla_l = dense_block_attention(mq_l, jnp.concatenate([mk_c, mk_l], axis=1), jnp.concatenate([mv_c, mv_l], axis=1))
    y_lat = jnp.concatenate([swa_l, mla_l], axis=-1) @ w_out
    if not need_ctx:
        return y_lat, None
    swa_c = context_window_heads(sq_c, sk_c, sv_c, sink_g)
    mla_c = dense_block_attention(mq_c, mk_c, mv_c)
    y_ctx = jnp.concatenate([swa_c, mla_c], axis=-1) @ w_out
    return y_lat, y_ctx


def peer(h, w_q, sub_keys, u_tab, v_tab):
    n_tok, d = h.shape
    hb = h.reshape(n_tok // PEER_TOKEN_BLOCK, PEER_TOKEN_BLOCK, d)

    def block(x):
        t = x.shape[0]
        q = (x @ w_q).reshape(t, PEER_HEADS, 2, PEER_QDIM // 2)
        s = jnp.einsum('thpc,hpkc->thpk', q, sub_keys).astype(jnp.float32)
        top_s, top_i = lax.top_k(s, PEER_TOPK)
        cand_s = top_s[:, :, 0, :, None] + top_s[:, :, 1, None, :]
        cand_i = top_i[:, :, 0, :, None] * PEER_KEYS + top_i[:, :, 1, None, :]
        best_s, best_j = lax.top_k(cand_s.reshape(t, PEER_HEADS, -1), PEER_TOPK)
        idx = jnp.take_along_axis(cand_i.reshape(t, PEER_HEADS, -1), best_j, axis=-1)
        g = jax.nn.softmax(best_s, axis=-1)
        a = jnp.einsum('td,thkd->thk', x, u_tab[idx]).astype(jnp.float32)
        w = (g * jax.nn.gelu(a)).astype(x.dtype)
        return jnp.einsum('thk,thkd->td', w, v_tab[idx])

    return lax.map(block, hb).reshape(n_tok, d)


def setup_inputs(seed: int = 0) -> dict:
    key = jax.random.key(seed)
    ks = iter(jax.random.split(key, 32))
    nrm = lambda shape, scale: jax.random.normal(next(ks), shape, jnp.float32) * scale
    d = D_MODEL
    return {
        "x": nrm((BATCH, SEQ, d), 1.0),
        "c": nrm((BATCH, d), 1.0),
        "ctx": nrm((BATCH, CTX_LEN, d), 1.0),
        "c_ctx": nrm((d,), 1.0),
        "w_mod": nrm((DEPTH, d, 6 * d), 0.5 * d ** -0.5),
        "b_mod": nrm((DEPTH, 6 * d), 0.01),
        "norm1": 1.0 + nrm((DEPTH, d), 0.1),
        "norm2": 1.0 + nrm((DEPTH, d), 0.1),
        "even_w_in": nrm((N_EVEN, d, EVEN_IN_WIDTH), d ** -0.5),
        "even_ret_gn": 1.0 + nrm((N_EVEN, RET_V_WIDTH), 0.1),
        "even_w_out": nrm((N_EVEN, EVEN_OUT_WIDTH, d), EVEN_OUT_WIDTH ** -0.5),
        "odd_w_in": nrm((N_ODD, d, ODD_IN_WIDTH), d ** -0.5),
        "odd_sink": nrm((N_ODD, SWA_Q_HEADS), 1.0),
        "odd_mla_q_norm": 1.0 + nrm((N_ODD, MLA_Q_RANK), 0.1),
        "odd_mla_kv_norm": 1.0 + nrm((N_ODD, MLA_KV_RANK), 0.1),
        "odd_mla_w_uq": nrm((N_ODD, MLA_Q_RANK, MLA_HEADS * MLA_QK_DIM), MLA_Q_RANK ** -0.5),
        "odd_mla_w_ukv": nrm((N_ODD, MLA_KV_RANK, MLA_HEADS * (MLA_NOPE + MLA_V)), MLA_KV_RANK ** -0.5),
        "odd_w_out": nrm((N_ODD, ODD_OUT_WIDTH, d), ODD_OUT_WIDTH ** -0.5),
        "peer_w_q": nrm((DEPTH, d, PEER_HEADS * PEER_QDIM), d ** -0.5),
        "peer_sub_keys": nrm((DEPTH, PEER_HEADS, 2, PEER_KEYS, PEER_QDIM // 2), (PEER_QDIM // 2) ** -0.5),
        "peer_u": nrm((DEPTH, PEER_EXPERTS, d), d ** -0.5),
        "peer_v": nrm((DEPTH, PEER_EXPERTS, d), 1.0),
        "final_norm": 1.0 + nrm((d,), 0.1),
    }


def reference(x, c, ctx, c_ctx, w_mod, b_mod, norm1, norm2, even_w_in, even_ret_gn, even_w_out,
              odd_w_in, odd_sink, odd_mla_q_norm, odd_mla_kv_norm, odd_mla_w_uq, odd_mla_w_ukv, odd_w_out,
              peer_w_q, peer_sub_keys, peer_u, peer_v, final_norm):
    b, s_len, d = x.shape
    n_ctx = ctx.shape[1]
    rows = s_len // GRID_W
    x_lat, x_ctx = x, ctx
    for layer in range(DEPTH):
        need_ctx = layer < DEPTH - 1
        j = layer // 2
        sh1, sc1, g1, sh2, sc2, g2 = adaln(c, w_mod[layer], b_mod[layer])
        sh1c, sc1c, g1c, sh2c, sc2c, g2c = adaln(c_ctx, w_mod[layer], b_mod[layer])
        h_lat = rms_norm(x_lat, norm1[layer]) * (1.0 + sc1) + sh1
        h_ctx = rms_norm(x_ctx, norm1[layer]) * (1.0 + sc1c) + sh1c
        if layer % 2 == 0:
            y_lat, y_ctx = even_mixer(h_lat, h_ctx, even_w_in[j], even_ret_gn[j], even_w_out[j], rows, need_ctx)
        else:
            y_lat, y_ctx = odd_mixer(h_lat, h_ctx, odd_w_in[j], odd_sink[j], odd_mla_q_norm[j], odd_mla_kv_norm[j],
                                     odd_mla_w_uq[j], odd_mla_w_ukv[j], odd_w_out[j], rows, need_ctx)
        x_lat = x_lat + g1 * y_lat
        h2_lat = rms_norm(x_lat, norm2[layer]) * (1.0 + sc2) + sh2
        if need_ctx:
            x_ctx = x_ctx + g1c * y_ctx
            h2_ctx = rms_norm(x_ctx, norm2[layer]) * (1.0 + sc2c) + sh2c
            tokens = jnp.concatenate([h2_ctx.reshape(-1, d), h2_lat.reshape(-1, d)], axis=0)
            f = peer(tokens, peer_w_q[layer], peer_sub_keys[layer], peer_u[layer], peer_v[layer])
            x_ctx = x_ctx + g2c * f[: b * n_ctx].reshape(b, n_ctx, d)
            f_lat = f[b * n_ctx:].reshape(b, s_len, d)
        else:
            f_lat = peer(h2_lat.reshape(-1, d), peer_w_q[layer], peer_sub_keys[layer], peer_u[layer], peer_v[layer]).reshape(b, s_len, d)
        x_lat = x_lat + g2 * f_lat
    return rms_norm(x_lat, final_norm)
```

```cpp
#include <hip/hip_runtime.h>
#include <stdint.h>
#include <stdio.h>

#ifndef N_LAUNCHES
#define N_LAUNCHES 1
#endif
#ifndef DBG_SKIP_GATHER
#define DBG_SKIP_GATHER 0
#endif
#ifndef DBG_CAT_PART
#define DBG_CAT_PART 0

#endif
#ifndef PHASE_MASK
#define PHASE_MASK 0xFFFFFFu
#endif

#define LAS __attribute__((address_space(3)))
typedef unsigned short bf16_t;
typedef short bf16x8 __attribute__((ext_vector_type(8)));
typedef short s16x4 __attribute__((ext_vector_type(4)));
typedef float f32x2 __attribute__((ext_vector_type(2)));
typedef float f32x4 __attribute__((ext_vector_type(4)));
typedef float f32x16 __attribute__((ext_vector_type(16)));
typedef unsigned u32x2 __attribute__((ext_vector_type(2)));
typedef unsigned u32x4 __attribute__((ext_vector_type(4)));
typedef __bf16 bf16x2_t __attribute__((ext_vector_type(2)));

constexpr int D = 2048, NBATCH = 2, SEQ = 16384, NCTX = 256;
constexpr int TC = NBATCH * NCTX;
constexpr int TL = NBATCH * SEQ;
constexpr int TT = TC + TL;
constexpr int NCH = 130;
constexpr float EPS = 1e-6f;
constexpr float LOG2E = 1.4426950408889634f;
constexpr float U_SCALE = 90.5f, V_SCALE = 2.0f;

constexpr size_t MiB = 1ull << 20;
constexpr size_t WS_CTL = 0;
constexpr size_t WS_MODS = 1 * MiB;
constexpr size_t WS_MODP = 2 * MiB;
constexpr size_t WS_ROPE = 12 * MiB;
constexpr size_t WS_DFT = 13 * MiB;
constexpr size_t WS_SKB = 14 * MiB;
constexpr size_t WS_XCTX = 15 * MiB;
constexpr size_t WS_W = 19 * MiB;
constexpr size_t WS_WINE = WS_W;
constexpr size_t WS_WOUTE = WS_WINE + 24 * MiB;
constexpr size_t WS_WINO = WS_WOUTE + 8 * MiB;
constexpr size_t WS_WUQ = WS_WINO + 9 * MiB;
constexpr size_t WS_WUKV = WS_WUQ + 2 * MiB;
constexpr size_t WS_WOUTO = WS_WUKV + 1 * MiB;
constexpr size_t WS_WQ0 = WS_WOUTO + 8 * MiB;
constexpr size_t WS_WQ1 = WS_WQ0 + 8 * MiB;
constexpr size_t WS_TABU = 88 * MiB;
constexpr size_t WS_TABV = WS_TABU + 64 * MiB;
constexpr size_t WS_H = 216 * MiB;
constexpr size_t WS_A = 346 * MiB;
constexpr size_t WS_Q = 411 * MiB;
constexpr size_t WS_K = 476 * MiB;
constexpr size_t WS_V = 541 * MiB;
constexpr size_t WS_G = 606 * MiB;
constexpr size_t WS_CAT = 736 * MiB;
constexpr size_t WS_ST = 866 * MiB;
constexpr size_t WS_IDX = 998 * MiB;
constexpr size_t WS_GATE = 1015 * MiB;
constexpr size_t WS_END = 1032 * MiB;

constexpr int LDS_BYTES = 147456;
constexpr int NPH = 24;

#define XB_TMO      128
#define XB_XCNT(j)  (256  + 64 * (j))
#define XB_XSUB(j)  (1280 + 64 * (j))
#define XB_XGEN(j)  (2304 + 64 * (j))
#define XB_TOP      3328
#define XB_TOPGEN   3392
#define XCD_BAR_WORDS 3456
#define XB_SPIN_CAP (1u << 24)

__device__ __forceinline__ unsigned xb_ld(unsigned* p)              { return __hip_atomic_load(p, __ATOMIC_RELAXED, __HIP_MEMORY_SCOPE_AGENT); }
__device__ __forceinline__ unsigned xb_add(unsigned* p, unsigned v) { return __hip_atomic_fetch_add(p, v, __ATOMIC_RELAXED, __HIP_MEMORY_SCOPE_AGENT); }
__device__ __forceinline__ unsigned xb_xcc_id() { return (unsigned)__builtin_amdgcn_s_getreg((3 << 11) | 20) & 0xFu; }
#define XB_SPIN(cond, bar) do { unsigned _sp = 0; while (cond) { __builtin_amdgcn_s_sleep(1); \
    if ((++_sp & 255u) == 0u) { if (xb_ld(&(bar)[XB_TMO])) break; if (_sp > XB_SPIN_CAP) { atomicAdd(&(bar)[XB_TMO], 1u); break; } } } } while (0)

struct XcdBarrier { unsigned* bar; unsigned x; volatile LAS unsigned* st; };

__device__ __forceinline__ XcdBarrier xcd_barrier_post(unsigned* bar, volatile LAS unsigned* st) {
    XcdBarrier b; b.bar = bar; b.x = xb_xcc_id(); b.st = st;
    if (threadIdx.x == 0) (void)xb_add(&bar[XB_XCNT(b.x)], 1u);
    return b;
}
__device__ __forceinline__ void xcd_barrier_complete(unsigned* bar, unsigned x, unsigned& nloc, unsigned& nx) {
    const unsigned G = gridDim.x * gridDim.y * gridDim.z;
    unsigned sum, cnt, mine, sp = 0u;
    for (;;) {
        sum = 0u; cnt = 0u; mine = 0u;
#pragma unroll
        for (unsigned j = 0; j < 16; ++j) { const unsigned c = xb_ld(&bar[XB_XCNT(j)]); sum += c; cnt += (c > 0u) ? 1u : 0u; mine = (j == x) ? c : mine; }
        if (sum == G) break;
        __builtin_amdgcn_s_sleep(1);
        if ((++sp & 255u) == 0u) { if (xb_ld(&bar[XB_TMO])) break; if (sp > XB_SPIN_CAP) { atomicAdd(&bar[XB_TMO], 1u); break; } }
    }
    nloc = mine > 0u ? mine : 1u; nx = cnt > 0u ? cnt : 1u;
}
__device__ __forceinline__ void xcd_barrier(const XcdBarrier& b) {
    asm volatile("s_waitcnt vmcnt(0)" ::: "memory");
    __syncthreads();
    if (threadIdx.x == 0) {
        unsigned* bar = b.bar;
        __builtin_amdgcn_s_waitcnt(0);
        unsigned nloc = b.st[0], nx = b.st[1];
        if (nloc == 0u) { xcd_barrier_complete(bar, b.x, nloc, nx); b.st[0] = nloc; b.st[1] = nx; }
        const unsigned old = xb_add(&bar[XB_XSUB(b.x)], 1u);
        const unsigned gen = old / nloc;
        if (old + 1u == (gen + 1u) * nloc) {
            __builtin_amdgcn_fence(__ATOMIC_RELEASE, "agent");
            asm volatile("s_waitcnt vmcnt(0)" ::: "memory");
            const unsigned og = xb_add(&bar[XB_TOP], 1u);
            const unsigned tg = og / nx;
            if (og + 1u == (tg + 1u) * nx) xb_add(&bar[XB_TOPGEN], 1u);
            else XB_SPIN(xb_ld(&bar[XB_TOPGEN]) == tg, bar);
            __builtin_amdgcn_fence(__ATOMIC_ACQUIRE, "agent");
            xb_add(&bar[XB_XGEN(b.x)], 1u);
            asm volatile("s_waitcnt vmcnt(0)" ::: "memory");
        } else {
            XB_SPIN(xb_ld(&bar[XB_XGEN(b.x)]) == gen, bar);
            __builtin_amdgcn_fence(__ATOMIC_ACQUIRE, "agent");
            asm volatile("s_waitcnt vmcnt(0)" ::: "memory");
        }
    }
    __syncthreads();
}

__device__ __forceinline__ unsigned cvt_pk_bf16(float lo, float hi) { const f32x2 v = {lo, hi}; const bf16x2_t r = __builtin_convertvector(v, bf16x2_t); return __builtin_bit_cast(unsigned, r); }
__device__ __forceinline__ float bf_lo(unsigned u) { return __uint_as_float(u << 16); }
__device__ __forceinline__ float bf_hi(unsigned u) { return __uint_as_float(u & 0xffff0000u); }
__device__ __forceinline__ float bf2f(bf16_t b) { return __uint_as_float(((unsigned)b) << 16); }
__device__ __forceinline__ u32x2 pack4(f32x4 v) { u32x2 r; r.x = cvt_pk_bf16(v[0], v[1]); r.y = cvt_pk_bf16(v[2], v[3]); return r; }
__device__ __forceinline__ float fast_exp2(float x) { return __builtin_amdgcn_exp2f(x); }
__device__ __forceinline__ float fast_rcp(float x) { return __builtin_amdgcn_rcpf(x); }
__device__ __forceinline__ float silu_f(float x) { return x * fast_rcp(1.0f + fast_exp2(-x * LOG2E)); }
__device__ __forceinline__ float gelu_tanh(float x) {
    const float u = 0.7978845608028654f * (x + 0.044715f * x * x * x);
    return x * fast_rcp(1.0f + fast_exp2(-2.0f * LOG2E * u));
}
__device__ __forceinline__ float wave_sum(float v) {
#pragma unroll
    for (int o = 32; o >= 1; o >>= 1) v += __shfl_xor(v, o);
    return v;
}
__device__ __forceinline__ float cos_rev(float fr) { return __builtin_amdgcn_cosf(fr); }
__device__ __forceinline__ float sin_rev(float fr) { return __builtin_amdgcn_sinf(fr); }
__device__ __forceinline__ float log2_gamma(int h) {
    const float x = __uint_as_float((unsigned)(127 - 5 - h) << 23);
    float s = x * (1.0f + x * (0.5f + x * (0.33333334f + x * (0.25f + x * (0.2f + x * (0.16666667f + x * 0.14285715f))))));
    return -s * LOG2E;
}

__device__ __forceinline__ int tok_batch(int tok) { return tok < TC ? (tok >> 8) : ((tok - TC) >> 14); }

constexpr int GEMM_LDS = 73728;
template <bool TRANS, class AF, class BF>
__device__ __forceinline__ void gemm128(LAS unsigned char* lds, int K, const AF& arow, const BF& brow, f32x4 (&acc)[2][4]) {
    const int tid = threadIdx.x, lane = tid & 63, w = tid >> 6, wm = w >> 1, wn = w & 1;
    const int r0 = tid >> 3, ch = tid & 7;
    const bf16_t* pa0 = arow(r0) + ch * 8; const bf16_t* pa1 = arow(r0 + 64) + ch * 8;
    const bf16_t* pb0 = brow(r0) + ch * 8; const bf16_t* pb1 = brow(r0 + 64) + ch * 8;
    const int woff = r0 * 144 + ch * 16;
#pragma unroll
    for (int mb = 0; mb < 2; ++mb)
#pragma unroll
        for (int nb = 0; nb < 4; ++nb) acc[mb][nb] = (f32x4){0.f, 0.f, 0.f, 0.f};
    u32x4 ra0 = *(const u32x4*)pa0, ra1 = *(const u32x4*)pa1, rb0 = *(const u32x4*)pb0, rb1 = *(const u32x4*)pb1;
    *(LAS u32x4*)(lds + woff) = ra0; *(LAS u32x4*)(lds + woff + 9216) = ra1;
    *(LAS u32x4*)(lds + 36864 + woff) = rb0; *(LAS u32x4*)(lds + 36864 + woff + 9216) = rb1;
    __syncthreads();
    const int nk = K >> 6;
    const int aoff = (32 * wm + (lane & 15)) * 144 + (lane >> 4) * 16;
    const int boff = 36864 + (64 * wn + (lane & 15)) * 144 + (lane >> 4) * 16;
    for (int kt = 0; kt < nk; ++kt) {
        const int buf = (kt & 1) * 18432;
        if (kt + 1 < nk) {
            const int ko = (kt + 1) * 64;
            ra0 = *(const u32x4*)(pa0 + ko); ra1 = *(const u32x4*)(pa1 + ko); rb0 = *(const u32x4*)(pb0 + ko); rb1 = *(const u32x4*)(pb1 + ko);
        }
#pragma unroll
        for (int ks = 0; ks < 2; ++ks) {
            bf16x8 af[2], bfr[4];
#pragma unroll
            for (int mb = 0; mb < 2; ++mb) af[mb] = *(const LAS bf16x8*)(lds + buf + aoff + mb * 2304 + ks * 64);
#pragma unroll
            for (int nb = 0; nb < 4; ++nb) bfr[nb] = *(const LAS bf16x8*)(lds + buf + boff + nb * 2304 + ks * 64);
#pragma unroll
            for (int mb = 0; mb < 2; ++mb)
#pragma unroll
                for (int nb = 0; nb < 4; ++nb)
                    acc[mb][nb] = TRANS ? __builtin_amdgcn_mfma_f32_16x16x32_bf16(bfr[nb], af[mb], acc[mb][nb], 0, 0, 0)
                                        : __builtin_amdgcn_mfma_f32_16x16x32_bf16(af[mb], bfr[nb], acc[mb][nb], 0, 0, 0);
        }
        if (kt + 1 < nk) {
            const int nb2 = ((kt + 1) & 1) * 18432;
            *(LAS u32x4*)(lds + nb2 + woff) = ra0; *(LAS u32x4*)(lds + nb2 + woff + 9216) = ra1;
            *(LAS u32x4*)(lds + 36864 + nb2 + woff) = rb0; *(LAS u32x4*)(lds + 36864 + nb2 + woff + 9216) = rb1;
        }
        __syncthreads();
    }
}
template <bool TRANS, int K, class AF, class BF>
__device__ __forceinline__ void gemm128s(LAS unsigned char* lds, const AF& arow, const BF& brow, f32x4 (&acc)[2][4]) {
    constexpr int NK = K / 64, DEPTH = NK < 4 ? NK : 4;
    const int tid = threadIdx.x, lane = tid & 63, w = tid >> 6, wm = w >> 1, wn = w & 1;
    const int r0 = tid >> 3, ch = tid & 7;
    const bf16_t* pa0 = arow(r0) + ch * 8; const bf16_t* pa1 = arow(r0 + 64) + ch * 8;
    const bf16_t* pb0 = brow(r0) + ch * 8; const bf16_t* pb1 = brow(r0 + 64) + ch * 8;
    const int woff = r0 * 144 + ch * 16;
    u32x4 rg[DEPTH][4];
#pragma unroll
    for (int d = 0; d < DEPTH; ++d) {
        rg[d][0] = *(const u32x4*)(pa0 + d * 64); rg[d][1] = *(const u32x4*)(pa1 + d * 64);
        rg[d][2] = *(const u32x4*)(pb0 + d * 64); rg[d][3] = *(const u32x4*)(pb1 + d * 64);
    }
    __builtin_amdgcn_sched_barrier(0);
#pragma unroll
    for (int mb = 0; mb < 2; ++mb)
#pragma unroll
        for (int nb = 0; nb < 4; ++nb) acc[mb][nb] = (f32x4){0.f, 0.f, 0.f, 0.f};
    *(LAS u32x4*)(lds + woff) = rg[0][0]; *(LAS u32x4*)(lds + woff + 9216) = rg[0][1];
    *(LAS u32x4*)(lds + 36864 + woff) = rg[0][2]; *(LAS u32x4*)(lds + 36864 + woff + 9216) = rg[0][3];
    __syncthreads();
    const int aoff = (32 * wm + (lane & 15)) * 144 + (lane >> 4) * 16;
    const int boff = 36864 + (64 * wn + (lane & 15)) * 144 + (lane >> 4) * 16;
#pragma unroll
    for (int kt = 0; kt < NK; ++kt) {
        const int buf = (kt & 1) * 18432;
        if (kt + DEPTH < NK) {
            const int ko = (kt + DEPTH) * 64;
            rg[kt % DEPTH][0] = *(const u32x4*)(pa0 + ko); rg[kt % DEPTH][1] = *(const u32x4*)(pa1 + ko);
            rg[kt % DEPTH][2] = *(const u32x4*)(pb0 + ko); rg[kt % DEPTH][3] = *(const u32x4*)(pb1 + ko);
            __builtin_amdgcn_sched_barrier(0);
        }
#pragma unroll
        for (int ks = 0; ks < 2; ++ks) {
            bf16x8 af[2], bfr[4];
#pragma unroll
            for (int mb = 0; mb < 2; ++mb) af[mb] = *(const LAS bf16x8*)(lds + buf + aoff + mb * 2304 + ks * 64);
#pragma unroll
            for (int nb = 0; nb < 4; ++nb) bfr[nb] = *(const LAS bf16x8*)(lds + buf + boff + nb * 2304 + ks * 64);
#pragma unroll
            for (int mb = 0; mb < 2; ++mb)
#pragma unroll
                for (int nb = 0; nb < 4; ++nb)
                    acc[mb][nb] = TRANS ? __builtin_amdgcn_mfma_f32_16x16x32_bf16(bfr[nb], af[mb], acc[mb][nb], 0, 0, 0)
                                        : __builtin_amdgcn_mfma_f32_16x16x32_bf16(af[mb], bfr[nb], acc[mb][nb], 0, 0, 0);
        }
        if (kt + 1 < NK) {
            const int nb2 = ((kt + 1) & 1) * 18432; constexpr int dummy = 0; (void)dummy;
            const int s = (kt + 1) % DEPTH;
            *(LAS u32x4*)(lds + nb2 + woff) = rg[s][0]; *(LAS u32x4*)(lds + nb2 + woff + 9216) = rg[s][1];
            *(LAS u32x4*)(lds + 36864 + nb2 + woff) = rg[s][2]; *(LAS u32x4*)(lds + 36864 + nb2 + woff + 9216) = rg[s][3];
        }
        __syncthreads();
    }
}
template <bool TRANS, class AF, class BF>
__device__ __forceinline__ void gemm128r(LAS unsigned char* lds, int K, const AF& arow, const BF& brow, f32x4 (&acc)[2][4]) {
    const int tid = threadIdx.x, lane = tid & 63, w = tid >> 6, wm = w >> 1, wn = w & 1;
    const int r0 = tid >> 3, ch = tid & 7;
    const bf16_t* pa0 = arow(r0) + ch * 8; const bf16_t* pa1 = arow(r0 + 64) + ch * 8;
    const bf16_t* pb0 = brow(r0) + ch * 8; const bf16_t* pb1 = brow(r0 + 64) + ch * 8;
    const int woff = r0 * 144 + ch * 16;
    u32x4 rg[4][4];
#pragma unroll
    for (int d = 0; d < 4; ++d) {
        rg[d][0] = *(const u32x4*)(pa0 + d * 64); rg[d][1] = *(const u32x4*)(pa1 + d * 64);
        rg[d][2] = *(const u32x4*)(pb0 + d * 64); rg[d][3] = *(const u32x4*)(pb1 + d * 64);
    }
    __builtin_amdgcn_sched_barrier(0);
#pragma unroll
    for (int mb = 0; mb < 2; ++mb)
#pragma unroll
        for (int nb = 0; nb < 4; ++nb) acc[mb][nb] = (f32x4){0.f, 0.f, 0.f, 0.f};
    *(LAS u32x4*)(lds + woff) = rg[0][0]; *(LAS u32x4*)(lds + woff + 9216) = rg[0][1];
    *(LAS u32x4*)(lds + 36864 + woff) = rg[0][2]; *(LAS u32x4*)(lds + 36864 + woff + 9216) = rg[0][3];
    __syncthreads();
    const int nk = K >> 6;
    const int aoff = (32 * wm + (lane & 15)) * 144 + (lane >> 4) * 16;
    const int boff = 36864 + (64 * wn + (lane & 15)) * 144 + (lane >> 4) * 16;
#pragma unroll 1
    for (int kt0 = 0; kt0 < nk; kt0 += 4) {
#pragma unroll
        for (int j = 0; j < 4; ++j) {
            const int kt = kt0 + j, buf = (j & 1) * 18432;
            if (kt + 4 < nk) {
                const int ko = (kt + 4) * 64;
                rg[j][0] = *(const u32x4*)(pa0 + ko); rg[j][1] = *(const u32x4*)(pa1 + ko);
                rg[j][2] = *(const u32x4*)(pb0 + ko); rg[j][3] = *(const u32x4*)(pb1 + ko);
            }
            __builtin_amdgcn_sched_barrier(0);
#pragma unroll
            for (int ks = 0; ks < 2; ++ks) {
                bf16x8 af[2], bfr[4];
#pragma unroll
                for (int mb = 0; mb < 2; ++mb) af[mb] = *(const LAS bf16x8*)(lds + buf + aoff + mb * 2304 + ks * 64);
#pragma unroll
                for (int nb = 0; nb < 4; ++nb) bfr[nb] = *(const LAS bf16x8*)(lds + buf + boff + nb * 2304 + ks * 64);
#pragma unroll
                for (int mb = 0; mb < 2; ++mb)
#pragma unroll
                    for (int nb = 0; nb < 4; ++nb)
                        acc[mb][nb] = TRANS ? __builtin_amdgcn_mfma_f32_16x16x32_bf16(bfr[nb], af[mb], acc[mb][nb], 0, 0, 0)
                                            : __builtin_amdgcn_mfma_f32_16x16x32_bf16(af[mb], bfr[nb], acc[mb][nb], 0, 0, 0);
            }
            if (kt + 1 < nk) {
                const int nb2 = ((j + 1) & 1) * 18432, s = (j + 1) & 3;
                *(LAS u32x4*)(lds + nb2 + woff) = rg[s][0]; *(LAS u32x4*)(lds + nb2 + woff + 9216) = rg[s][1];
                *(LAS u32x4*)(lds + 36864 + nb2 + woff) = rg[s][2]; *(LAS u32x4*)(lds + 36864 + nb2 + woff + 9216) = rg[s][3];
            }
            __syncthreads();
        }
    }
}
__device__ __forceinline__ void tile_mn(int t, int MT, int NT, int& mt, int& nt) {
    const int per = 16 * NT; const int g = t / per; const int r = t - g * per; const int rem = MT - g * 16; const int gs = rem < 16 ? rem : 16;
    mt = g * 16 + r % gs; nt = r / gs;
}
struct RowLin { const bf16_t* base; size_t pitch; __device__ __forceinline__ const bf16_t* operator()(int r) const { return base + (size_t)r * pitch; } };

__device__ __forceinline__ s16x4 tr_read(LAS unsigned char* blk, int stride, int lane) {
    const int i = lane & 15;
    return __builtin_amdgcn_ds_read_tr16_b64_v4i16((LAS s16x4*)(blk + (i >> 2) * stride + (i & 3) * 8));
}
__device__ __forceinline__ bf16x8 cat8(s16x4 a, s16x4 b) { bf16x8 r; r[0] = a[0]; r[1] = a[1]; r[2] = a[2]; r[3] = a[3]; r[4] = b[0]; r[5] = b[1]; r[6] = b[2]; r[7] = b[3]; return r; }

namespace pg8 {
#define PG8_LAS __attribute__((address_space(3)))
constexpr int BM = 256, BK = 64, HALF = 128, HTB = HALF * BK * 2  , STAGE_BYTES = 8 * HTB, NXCD = 8, WGM = 8;

__host__ __device__ __forceinline__ int lds_byte(int r, int c) { const int st = (r >> 4) * 2 + (c >> 5), rr = r & 15, cc = c & 31, ob = rr * 64 + cc * 2; return st * 1024 + (ob ^ (((ob >> 9) & 1) << 5)); }
__host__ __device__ __forceinline__ void stage_rc(int b, int& R, int& C) { const int st = b / 1024, sb = b % 1024, swz = sb ^ (((sb >> 9) & 1) << 5); R = (st >> 1) * 16 + swz / 64; C = (st & 1) * 32 + (swz % 64) / 2; }
__host__ __device__ __forceinline__ int perm32(int rho) { const int n = rho >> 4, i = rho & 15; return 8 * (i >> 2) + 4 * n + (i & 3); }

struct Unit { int pm, pn; };
struct Gemm { const bf16_t* A; const bf16_t* Bt; int M, N, K; };

struct StaticOrder {
    int nM, nN, nwg, G, c;
    __host__ __device__ void init(int M, int N, int G_, int c_) { nM = M / BM; nN = N / BM; nwg = nM * nN; G = G_; c = c_; }
    __host__ __device__ bool next(int i, Unit& u) const {
        const long L = (long)i * G + c; if (L >= nwg) return false;
        int wgid = (int)L; { const int q = nwg / NXCD, r = nwg % NXCD, xcd = wgid % NXCD, off = wgid / NXCD; wgid = (xcd < r ? xcd * (q + 1) : r * (q + 1) + (xcd - r) * q) + off; }
        const int nig = WGM * nN, gid = wgid / nig, fm = gid * WGM, gsz = (nM - fm) < WGM ? (nM - fm) : WGM;
        u.pm = fm + ((wgid % nig) % gsz); u.pn = (wgid % nig) / gsz; return true;
    }
    __device__ __forceinline__ void a_ready(const Unit&) const {}
    __device__ __forceinline__ void done(const Unit&) const {}
};
template <class Epi, class Sched>
__device__ __forceinline__ void gemm_phase(PG8_LAS unsigned char* lds, const Gemm g, const Sched& S, const Epi& E) {
    const int tid = threadIdx.x, wid = __builtin_amdgcn_readfirstlane(tid >> 6), lane = tid & 63, wr = wid >> 2, wc = wid & 3, fr = lane & 15, fq = lane >> 4;
    const int K = g.K, nt = K / BK;
    unsigned voffA[2], voffB[2];
#pragma unroll
    for (int i = 0; i < 2; ++i) { int R, C; stage_rc(tid * 16 + i * 8192, R, C); const int Rb = Epi::PERM ? ((R & ~31) + perm32(R & 31)) : R;
        voffA[i] = (unsigned)(R * K + C) * 2u; voffB[i] = (unsigned)(Rb * K + C) * 2u; }
    const size_t kstep = (size_t)(BK * 2);
    const size_t hstep = (size_t)HALF * K * 2;
    const size_t tstep = 2 * hstep;
    const unsigned ldsw = (unsigned)wid * 1024u;
    const int aoff = lds_byte(wr * 64 + fr, fq * 8), boff = lds_byte(wc * 32 + fr, fq * 8);
#define PG8_SA(b, h) (((b) * 2 + (h)) * HTB)
#define PG8_SB(b, h) ((4 + (b) * 2 + (h)) * HTB)
#define PG8_STAGE(bufoff, gbase, voff) do { _Pragma("unroll") for (int _i = 0; _i < 2; ++_i) \
        __builtin_amdgcn_global_load_lds((const unsigned*)((const char*)(gbase) + (voff)[_i]), (PG8_LAS unsigned*)(lds + (bufoff) + ldsw + _i * 8192), 16, 0, 0); } while (0)
#define PG8_LDA(dst, b, h) do { _Pragma("unroll") for (int m = 0; m < 4; ++m) _Pragma("unroll") for (int k = 0; k < 2; ++k) dst[m][k] = *(const PG8_LAS bf16x8*)(lds + PG8_SA(b, h) + aoff + m * 2048 + k * 1024); } while (0)
#define PG8_LDB(dst, b, h) do { _Pragma("unroll") for (int n = 0; n < 2; ++n) _Pragma("unroll") for (int k = 0; k < 2; ++k) dst[n][k] = *(const PG8_LAS bf16x8*)(lds + PG8_SB(b, h) + boff + n * 2048 + k * 1024); } while (0)
#define PG8_MMA(ai, bj, At, Bt) do { __builtin_amdgcn_s_setprio(1); _Pragma("unroll") for (int m = 0; m < 4; ++m) _Pragma("unroll") for (int n = 0; n < 2; ++n) _Pragma("unroll") for (int k = 0; k < 2; ++k) \
        acc[ai][bj][m][n] = __builtin_amdgcn_mfma_f32_16x16x32_bf16(Bt[n][k], At[m][k], acc[ai][bj][m][n], 0, 0, 0); __builtin_amdgcn_s_setprio(0); } while (0)
#define PG8_WAIT_V(n) asm volatile("s_waitcnt vmcnt(" #n ")" ::: "memory")
#define PG8_WAIT_L(n) asm volatile("s_waitcnt lgkmcnt(" #n ")" ::: "memory")
#define PG8_BAR __builtin_amdgcn_s_barrier()
#define PG8_SCHED __builtin_amdgcn_sched_barrier(0)
    Unit cur, nxt; int ui = 0;
    if (!S.next(0, cur)) return;
    f32x4 acc[2][2][4][2];
#pragma unroll
    for (int a = 0; a < 2; ++a)
#pragma unroll
        for (int b = 0; b < 2; ++b)
#pragma unroll
            for (int m = 0; m < 4; ++m)
#pragma unroll
                for (int n = 0; n < 2; ++n) acc[a][b][m][n] = (f32x4){0.f, 0.f, 0.f, 0.f};
    bf16x8 At[4][2], B0[2][2], B1[2][2];
    const char* cA = (const char*)g.A + (size_t)cur.pm * tstep; const char* cB = (const char*)g.Bt + (size_t)cur.pn * tstep;
    S.a_ready(cur);
    PG8_STAGE(PG8_SB(0, 0), cB, voffB); PG8_STAGE(PG8_SA(0, 0), cA, voffA); PG8_STAGE(PG8_SB(0, 1), cB + hstep, voffB); PG8_STAGE(PG8_SA(0, 1), cA + hstep, voffA);
    if (wr == 1) PG8_BAR;
    PG8_WAIT_V(4); PG8_BAR;
    PG8_STAGE(PG8_SB(1, 0), cB + kstep, voffB); PG8_STAGE(PG8_SA(1, 0), cA + kstep, voffA); PG8_STAGE(PG8_SB(1, 1), cB + hstep + kstep, voffB);
    PG8_WAIT_V(6); PG8_BAR;
    for (;;) {
        const bool has_next = S.next(ui + 1, nxt);
        const char* nA = has_next ? (const char*)g.A + (size_t)nxt.pm * tstep : cA; const char* nB = has_next ? (const char*)g.Bt + (size_t)nxt.pn * tstep : cB;
        for (int t = 0; t < nt; t += 2) {
            const bool last = (t == nt - 2);
            const char* a1 = cA + (size_t)(t + 1) * kstep;
            const char* a2 = last ? nA : cA + (size_t)(t + 2) * kstep; const char* b2 = last ? nB : cB + (size_t)(t + 2) * kstep;
            const char* a3 = a2 + kstep; const char* b3 = b2 + kstep;
            if (last && has_next) S.a_ready(nxt);
            PG8_LDB(B0, 0, 0); PG8_SCHED; PG8_LDA(At, 0, 0); PG8_STAGE(PG8_SA(1, 1), a1 + hstep, voffA);
            PG8_WAIT_L(8); PG8_BAR; PG8_WAIT_L(0); PG8_MMA(0, 0, At, B0); PG8_BAR; PG8_SCHED;
            PG8_LDB(B1, 0, 1); PG8_STAGE(PG8_SB(0, 0), b2, voffB);
            PG8_BAR; PG8_WAIT_L(0); PG8_MMA(0, 1, At, B1); PG8_BAR;
            PG8_LDA(At, 0, 1); PG8_STAGE(PG8_SA(0, 0), a2, voffA);
            PG8_BAR; PG8_WAIT_L(0); PG8_MMA(1, 0, At, B0); PG8_BAR; PG8_SCHED;
            PG8_STAGE(PG8_SB(0, 1), b2 + hstep, voffB);
            PG8_WAIT_V(6); PG8_BAR; PG8_MMA(1, 1, At, B1); PG8_BAR;
            PG8_LDB(B0, 1, 0); PG8_SCHED; PG8_LDA(At, 1, 0); PG8_STAGE(PG8_SA(0, 1), a2 + hstep, voffA);
            PG8_WAIT_L(8); PG8_BAR; PG8_WAIT_L(0); PG8_MMA(0, 0, At, B0); PG8_BAR; PG8_SCHED;
            PG8_LDB(B1, 1, 1); PG8_STAGE(PG8_SB(1, 0), b3, voffB);
            PG8_BAR; PG8_WAIT_L(0); PG8_MMA(0, 1, At, B1); PG8_BAR;
            PG8_LDA(At, 1, 1); PG8_STAGE(PG8_SA(1, 0), a3, voffA);
            PG8_BAR; PG8_WAIT_L(0); PG8_MMA(1, 0, At, B0); PG8_BAR; PG8_SCHED;
            PG8_STAGE(PG8_SB(1, 1), b3 + hstep, voffB);
            PG8_WAIT_V(6); PG8_BAR; PG8_MMA(1, 1, At, B1); PG8_BAR;
        }
        if constexpr (!Epi::AFTER_DRAIN) { E(acc, cur, wr, wc, fr, fq); S.done(cur); }
        if (!has_next) break;
#pragma unroll
        for (int a = 0; a < 2; ++a)
#pragma unroll
            for (int b = 0; b < 2; ++b)
#pragma unroll
                for (int m = 0; m < 4; ++m)
#pragma unroll
                    for (int n = 0; n < 2; ++n) acc[a][b][m][n] = (f32x4){0.f, 0.f, 0.f, 0.f};
        cur = nxt; cA = nA; cB = nB; ++ui;
    }
    PG8_WAIT_V(0);
    if (wr == 0) PG8_BAR;
    PG8_BAR;
    if constexpr (Epi::AFTER_DRAIN) { E.fused(acc, cur, wr, wc, fr, fq, lds, wid, lane); S.done(cur); }
#undef PG8_SA
#undef PG8_SB
#undef PG8_STAGE
#undef PG8_LDA
#undef PG8_LDB
#undef PG8_MMA
#undef PG8_WAIT_V
#undef PG8_WAIT_L
#undef PG8_BAR
#undef PG8_SCHED
}
}


struct KArgs { const float* in[23]; float* out; unsigned char* ws; int ph_lo, ph_hi; };
struct Ctx {
    const float* in[23]; float* out; unsigned char* ws; LAS unsigned char* lds; int G, bid, tid, lane, w;
    __device__ __forceinline__ bf16_t* wb(size_t off) const { return (bf16_t*)(ws + off); }
    __device__ __forceinline__ float* wf(size_t off) const { return (float*)(ws + off); }
};

template <bool PERMQK = false>
__device__ __forceinline__ void tconv(const Ctx& c, const float* __restrict__ src, int K, int N, bf16_t* __restrict__ dst) {
    LAS float* tile = (LAS float*)c.lds;
    const int NT = N >> 6, total = (K >> 6) * NT, ngroups = (total + 3) >> 2;
    const int r = c.tid >> 4, c4 = (c.tid & 15) * 4, n = c.tid >> 3, kc = (c.tid & 7) * 8;
    for (int gidx = c.bid; gidx < ngroups; gidx += c.G) {
        f32x4 v[4][2];
#pragma unroll
        for (int q = 0; q < 4; ++q) {
            const int t = gidx * 4 + q;
            if (t < total) { const int kt = t / NT, nt = t - kt * NT;
#pragma unroll
                for (int i = 0; i < 2; ++i) v[q][i] = *(const f32x4*)(src + (size_t)(kt * 64 + r + 32 * i) * N + nt * 64 + c4); }
        }
#pragma unroll
        for (int q = 0; q < 4; ++q)
            if (gidx * 4 + q < total) {
#pragma unroll
                for (int i = 0; i < 2; ++i) { LAS float* p = tile + q * (64 * 65) + (r + 32 * i) * 65 + c4; p[0] = v[q][i][0]; p[1] = v[q][i][1]; p[2] = v[q][i][2]; p[3] = v[q][i][3]; }
            }
        __syncthreads();
#pragma unroll
        for (int q = 0; q < 4; ++q) {
            const int t = gidx * 4 + q;
            if (t < total) {
                const int kt = t / NT, nt = t - kt * NT;
                float f[8];
#pragma unroll
                for (int j = 0; j < 8; ++j) f[j] = tile[q * (64 * 65) + (kc + j) * 65 + n];
                u32x4 o; o.x = cvt_pk_bf16(f[0], f[1]); o.y = cvt_pk_bf16(f[2], f[3]); o.z = cvt_pk_bf16(f[4], f[5]); o.w = cvt_pk_bf16(f[6], f[7]);
                int drow = nt * 64 + n;
                if (PERMQK && drow >= 1024 && drow < 3072) { const int d = drow & 127; drow = (drow & ~127) + 32 * (2 * (d >> 6) + ((d >> 4) & 1)) + 16 * ((d >> 5) & 1) + (d & 15); }
                *(u32x4*)(dst + (size_t)drow * K + kt * 64 + kc) = o;
            }
        }
        __syncthreads();
    }
}
__device__ __forceinline__ void conv_bf16(const Ctx& c, const float* __restrict__ src, bf16_t* __restrict__ dst, size_t n) {
    const size_t nch = n >> 3;
    for (size_t i = (size_t)c.bid * 512 + c.tid; i < nch; i += (size_t)c.G * 512) {
        const f32x4 a = *(const f32x4*)(src + i * 8), b = *(const f32x4*)(src + i * 8 + 4);
        u32x4 o; o.x = cvt_pk_bf16(a[0], a[1]); o.y = cvt_pk_bf16(a[2], a[3]); o.z = cvt_pk_bf16(b[0], b[1]); o.w = cvt_pk_bf16(b[2], b[3]);
        *(u32x4*)(dst + i * 8) = o;
    }
}
__device__ __forceinline__ unsigned enc_fp6(float v) {
    const float a = fminf(fabsf(v), 7.5f);
    float q;
    if (a < 2.0f) q = rintf(a * 8.0f);
    else if (a < 4.0f) q = 16.0f + rintf((a - 2.0f) * 4.0f);
    else q = 24.0f + rintf((a - 4.0f) * 2.0f);
    unsigned c = (unsigned)q; c = c > 31u ? 31u : c;
    return c | (v < 0.f ? 32u : 0u);
}
__device__ __forceinline__ void conv_fp6(const Ctx& c, const float* __restrict__ src, unsigned char* __restrict__ dst, int rows, float scale) {
    const size_t ngroups = (size_t)rows * 64;
    for (size_t gi = (size_t)c.bid * 512 + c.tid; gi < ngroups; gi += (size_t)c.G * 512) {
        const size_t row = gi >> 6; const int l = (int)(gi & 63);
        const float* sp = src + row * 2048 + l * 32;
        unsigned w[6] = {0u, 0u, 0u, 0u, 0u, 0u};
#pragma unroll
        for (int q = 0; q < 8; ++q) {
            const f32x4 v = *(const f32x4*)(sp + q * 4);
#pragma unroll
            for (int e = 0; e < 4; ++e) {
                const int k = q * 4 + e, pos = 6 * k, d = pos >> 5, sh = pos & 31;
                const unsigned code = enc_fp6(v[e] * scale);
                w[d] |= code << sh;
                if (sh > 26) w[d + 1] |= code >> (32 - sh);
            }
        }
        unsigned char* dp = dst + row * 1536 + l * 8;
        *(u32x2*)(dp) = (u32x2){w[0], w[1]}; *(u32x2*)(dp + 512) = (u32x2){w[2], w[3]}; *(u32x2*)(dp + 1024) = (u32x2){w[4], w[5]};
    }
}
__device__ __forceinline__ unsigned enc_fp4(float v) {
    const float a = fabsf(v);
    unsigned c;
    if (a < 2.0f) c = (unsigned)rintf(a * 2.0f);
    else if (a < 4.0f) c = 4u + (unsigned)rintf((a - 2.0f));
    else c = a < 5.0f ? 6u : 7u;
    return c | (v < 0.f ? 8u : 0u);
}
__device__ __forceinline__ void conv_fp4(const Ctx& c, const float* __restrict__ src, unsigned char* __restrict__ dst, int rows, float scale, int part, int nparts) {
    for (int row = part * 8 + c.w; row < rows; row += nparts * 8) {
        const float* sp = src + (size_t)row * 2048 + c.lane * 8;
        f32x4 v[4][2];
#pragma unroll
        for (int q = 0; q < 4; ++q) { v[q][0] = *(const f32x4*)(sp + q * 512); v[q][1] = *(const f32x4*)(sp + q * 512 + 4); }
#pragma unroll
        for (int q = 0; q < 4; ++q) {
            unsigned h = 0u;
#pragma unroll
            for (int e = 0; e < 4; ++e) h |= (enc_fp4(v[q][0][e] * scale) << (4 * e)) | (enc_fp4(v[q][1][e] * scale) << (16 + 4 * e));
            *(unsigned*)(dst + (size_t)row * 1024 + q * 256 + c.lane * 4) = h;
        }
    }
}
__device__ __forceinline__ void conv_fp8(const Ctx& c, const float* __restrict__ src, unsigned char* __restrict__ dst, size_t n, float scale) {
    const size_t nch = n >> 4;
    for (size_t i = (size_t)c.bid * 512 + c.tid; i < nch; i += (size_t)c.G * 512) {
        u32x4 o;
#pragma unroll
        for (int q = 0; q < 4; ++q) {
            const f32x4 a = *(const f32x4*)(src + i * 16 + q * 4);
            int w = 0;
            w = __builtin_amdgcn_cvt_pk_fp8_f32(a[0] * scale, a[1] * scale, w, false);
            w = __builtin_amdgcn_cvt_pk_fp8_f32(a[2] * scale, a[3] * scale, w, true);
            o[q] = (unsigned)w;
        }
        *(u32x4*)(dst + i * 16) = o;
    }
}
__device__ __forceinline__ void phase_prologue(const Ctx& c) {
    tconv<true>(c, c.in[8], 2048, 6144, c.wb(WS_WINE));
    tconv(c, c.in[10], 2048, 2048, c.wb(WS_WOUTE));
    tconv(c, c.in[11], 2048, 2112, c.wb(WS_WINO));
    tconv(c, c.in[15], 512, 1536, c.wb(WS_WUQ));
    tconv(c, c.in[16], 256, 2048, c.wb(WS_WUKV));
    tconv(c, c.in[17], 2048, 2048, c.wb(WS_WOUTO));
    tconv(c, c.in[18], 2048, 2048, c.wb(WS_WQ0));
    tconv(c, c.in[18] + (size_t)2048 * 2048, 2048, 2048, c.wb(WS_WQ1));
    {
        u32x4* p = (u32x4*)(c.wb(WS_WINO) + (size_t)2112 * 2048);
        for (int i = c.bid * 512 + c.tid; i < 192 * 2048 / 8; i += c.G * 512) p[i] = (u32x4){0u, 0u, 0u, 0u};
    }
    conv_bf16(c, c.in[19], c.wb(WS_SKB), (size_t)2 * 16 * 128 * 128);
    {
        const int two = 2 * 32 * 6 - c.G; const bool split = two > 0 && two < c.G; const int r0 = split ? 12288 : 16384;
        conv_fp4(c, c.in[20], c.ws + WS_TABU, r0, U_SCALE, c.bid, c.G);
        conv_fp4(c, c.in[21], c.ws + WS_TABV, r0, V_SCALE, c.bid, c.G);
        if (split && c.bid >= two) {
            conv_fp4(c, c.in[20] + (size_t)r0 * 2048, c.ws + WS_TABU + (size_t)r0 * 1024, 16384 - r0, U_SCALE, c.bid - two, c.G - two);
            conv_fp4(c, c.in[21] + (size_t)r0 * 2048, c.ws + WS_TABV + (size_t)r0 * 1024, 16384 - r0, V_SCALE, c.bid - two, c.G - two);
        }
    }
    const int gt = c.bid * 512 + c.tid, gn = c.G * 512;
    {
        f32x2* r128 = (f32x2*)(c.ws + WS_ROPE); f32x2* r64 = (f32x2*)(c.ws + WS_ROPE + 131072);
        for (int i = gt; i < 256 * 32; i += gn) {
            const int pos = i >> 5, f = i & 31;
            const float inv = exp2f(-(float)f * (13.287712379549449f / 32.0f));
            const float rev = (float)pos * inv * 0.15915494309189535f; const float fr = rev - floorf(rev);
            r128[i] = (f32x2){cos_rev(fr), sin_rev(fr)};
        }
        for (int i = gt; i < 256 * 16; i += gn) {
            const int pos = i >> 4, f = i & 15;
            const float inv = exp2f(-(float)f * (13.287712379549449f / 16.0f));
            const float rev = (float)pos * inv * 0.15915494309189535f; const float fr = rev - floorf(rev);
            r64[i] = (f32x2){cos_rev(fr), sin_rev(fr)};
        }
    }
    {
        bf16_t* MC = c.wb(WS_DFT); bf16_t* M1 = c.wb(WS_DFT + 262144); bf16_t* M2 = c.wb(WS_DFT + 393216); bf16_t* MCX = c.wb(WS_DFT + 458752);
        for (int i = gt; i < 512 * 256; i += gn) {
            const int n = i >> 8, k = i & 255, m = n & 255; const float fr = (float)((m * k) & 255) * (1.0f / 256.0f);
            const float v = (n < 256 ? cos_rev(fr) : -sin_rev(fr)) * 0.0625f;
            MC[i] = (bf16_t)(cvt_pk_bf16(v, 0.f) & 0xffffu);
        }
        for (int i = gt; i < 256 * 256; i += gn) {
            const int j = i >> 8, kk = i & 255, ka = j >> 1, ro = j & 1, ri = kk >> 7, nh = kk & 127;
            const float fr = (float)((ka * nh) & 127) * (1.0f / 128.0f); const float cc = cos_rev(fr), ss = sin_rev(fr);
            const float v = (ro == ri ? cc : (ro == 0 ? ss : -ss)) * 0.08838834764831845f;
            M1[i] = (bf16_t)(cvt_pk_bf16(v, 0.f) & 0xffffu);
        }
        for (int i = gt; i < 128 * 256; i += gn) {
            const int kb = i >> 8, kk = i & 255, ri = kk >> 7, nl = kk & 127;
            const float fr = (float)((kb * nl) & 127) * (1.0f / 128.0f);
            const float v = (ri == 0 ? cos_rev(fr) : sin_rev(fr)) * 0.08838834764831845f;
            M2[i] = (bf16_t)(cvt_pk_bf16(v, 0.f) & 0xffffu);
        }
        for (int i = gt; i < 256 * 512; i += gn) {
            const int k = i >> 9, kk = i & 511, ri = kk >> 8, n = kk & 255;
            const float fr = (float)((k * n) & 255) * (1.0f / 256.0f);
            const float v = (ri == 0 ? cos_rev(fr) : sin_rev(fr)) * 0.0625f;
            MCX[i] = (bf16_t)(cvt_pk_bf16(v, 0.f) & 0xffffu);
        }
    }
    {
        const float* cvec = c.in[1]; const float* cctx = c.in[3]; const float* wmod = c.in[4];
        float* modp = c.wf(WS_MODP);
        for (int u = c.bid; u < 2 * 32 * 6; u += c.G) {
            const int l = u / 192, r = u - l * 192, kc = r / 6, nb = r - kc * 6;
            const int n = nb * 2048 + c.tid * 4;
            f32x4 a0 = {0.f, 0.f, 0.f, 0.f}, a1 = a0, a2 = a0;
            const float* wp = wmod + ((size_t)l * 2048 + kc * 64) * 12288 + n;
#pragma unroll 8
            for (int k = 0; k < 64; ++k) {
                const int kk = kc * 64 + k;
                const f32x4 wv = *(const f32x4*)(wp + (size_t)k * 12288);
                const float s0 = silu_f(cvec[kk]), s1 = silu_f(cvec[2048 + kk]), s2 = silu_f(cctx[kk]);
                a0 += wv * s0; a1 += wv * s1; a2 += wv * s2;
            }
            float* o = modp + ((size_t)(kc * 2 + l) * 3) * 12288 + n;
            *(f32x4*)(o) = a0; *(f32x4*)(o + 12288) = a1; *(f32x4*)(o + 2 * 12288) = a2;
        }
    }
}
__device__ __forceinline__ void phase_mods(const Ctx& c) {
    const float* modp = c.wf(WS_MODP); float* mods = c.wf(WS_MODS); const float* bmod = c.in[5];
    for (int i = c.bid * 512 + c.tid; i < 2 * 3 * 12288; i += c.G * 512) {
        const int l = i / 36864, r = i - l * 36864, n = r % 12288;
        float s = bmod[l * 12288 + n];
        for (int kc = 0; kc < 32; ++kc) s += modp[(size_t)(kc * 2 + l) * 36864 + r];
        mods[i] = s;
    }
}
__device__ __forceinline__ void phase_modnorm(const Ctx& c, int layer, int which, const float* __restrict__ xlat, const float* __restrict__ xctx, int tok_lo, bf16_t* __restrict__ H) {
    const float* mods = c.wf(WS_MODS); const float* nw = c.in[6 + which] + layer * D;
    for (int tok = tok_lo + c.bid * 8 + c.w; tok < TT; tok += c.G * 8) {
        const float* src = tok < TC ? xctx + (size_t)tok * D : xlat + (size_t)(tok - TC) * D;
        const int mw = tok < TC ? 2 : ((tok - TC) >> 14);
        const float* mb = mods + (size_t)(layer * 3 + mw) * 12288 + which * 3 * 2048;
        f32x4 v[8]; float ss = 0.f;
#pragma unroll
        for (int i = 0; i < 8; ++i) { v[i] = *(const f32x4*)(src + i * 256 + c.lane * 4); ss += v[i][0] * v[i][0] + v[i][1] * v[i][1] + v[i][2] * v[i][2] + v[i][3] * v[i][3]; }
        ss = wave_sum(ss);
        const float rstd = rsqrtf(ss * (1.0f / D) + EPS);
#pragma unroll
        for (int i = 0; i < 8; ++i) {
            const int col = i * 256 + c.lane * 4;
            const f32x4 g = *(const f32x4*)(nw + col), sh = *(const f32x4*)(mb + col), sc = *(const f32x4*)(mb + 2048 + col);
            f32x4 o;
#pragma unroll
            for (int j = 0; j < 4; ++j) o[j] = v[i][j] * rstd * g[j] * (1.0f + sc[j]) + sh[j];
            *(u32x2*)(H + (size_t)tok * D + col) = pack4(o);
        }
    }
}

__device__ __forceinline__ void phase_even_proj(const Ctx& c) {
    const bf16_t* H = c.wb(WS_H); const bf16_t* W = c.wb(WS_WINE);
    bf16_t* F = c.wb(WS_A); bf16_t* Q = c.wb(WS_Q); bf16_t* Kb = c.wb(WS_K); bf16_t* V = c.wb(WS_V); bf16_t* Gt = c.wb(WS_G);
    const f32x2* r128 = (const f32x2*)(c.ws + WS_ROPE);
    const int MT = TT / 128, NT = 6144 / 128;
    const int g = c.lane >> 4, wm = c.w >> 1, wn = c.w & 1;
    for (int t = c.bid; t < MT * NT; t += c.G) {
        int mt, nt; tile_mn(t, MT, NT, mt, nt);
        f32x4 acc[2][4];
        gemm128<true>(c.lds, 2048, RowLin{H + (size_t)mt * 128 * D, (size_t)D}, RowLin{W + (size_t)nt * 128 * 2048, 2048}, acc);
        const int region = nt >> 3, cr0 = (nt & 7) * 128 + 64 * wn + 4 * g;
#pragma unroll
        for (int mb = 0; mb < 2; ++mb) {
            const int tok = mt * 128 + 32 * wm + 16 * mb + (c.lane & 15);
            if (region == 0) {
#pragma unroll
                for (int nb = 0; nb < 4; ++nb) *(u32x2*)(F + (size_t)tok * 1024 + cr0 + 16 * nb) = pack4(acc[mb][nb]);
            } else if (region == 1 || region == 2) {
                bf16_t* dst = (region == 1 ? Q : Kb) + (size_t)tok * 1024 + cr0;
                const float sc = region == 2 ? 0.08838834764831845f : 1.0f;
                if (tok >= TC) {
                    const int s = (tok - TC) & (SEQ - 1); const int pos = wn == 0 ? (s >> 6) : (s & 63);
#pragma unroll
                    for (int nb = 0; nb < 2; ++nb) {
                        f32x4 o1, o2;
#pragma unroll
                        for (int r = 0; r < 4; ++r) {
                            const f32x2 cs = r128[pos * 32 + 16 * nb + 4 * g + r];
                            const float a = acc[mb][nb][r] * sc, b = acc[mb][nb + 2][r] * sc;
                            o1[r] = a * cs.x - b * cs.y; o2[r] = b * cs.x + a * cs.y;
                        }
                        *(u32x2*)(dst + 16 * nb) = pack4(o1); *(u32x2*)(dst + 16 * (nb + 2)) = pack4(o2);
                    }
                } else {
#pragma unroll
                    for (int nb = 0; nb < 4; ++nb) *(u32x2*)(dst + 16 * nb) = pack4(acc[mb][nb] * sc);
                }
            } else if (region == 3) {
#pragma unroll
                for (int nb = 0; nb < 4; ++nb) *(u32x2*)(V + (size_t)tok * 1024 + cr0 + 16 * nb) = pack4(acc[mb][nb]);
            } else {
#pragma unroll
                for (int nb = 0; nb < 4; ++nb) {
                    f32x4 o;
#pragma unroll
                    for (int r = 0; r < 4; ++r) o[r] = silu_f(acc[mb][nb][r]);
                    *(u32x2*)(Gt + (size_t)tok * 2048 + (region - 4) * 1024 + cr0 + 16 * nb) = pack4(o);
                }
            }
        }
    }
}
constexpr int FS = 528, F_B = 128 * FS;
template <class RF>
__device__ __forceinline__ void ftile_issue(u32x4 (&r)[8], const RF& row, int tid) {
#pragma unroll
    for (int i = 0; i < 8; ++i) r[i] = *(const u32x4*)(row((tid >> 5) + 16 * i) + (tid & 31) * 8);
}
__device__ __forceinline__ void ftile_write(LAS unsigned char* dst, const u32x4 (&r)[8], int tid) {
#pragma unroll
    for (int i = 0; i < 8; ++i) *(LAS u32x4*)(dst + ((tid >> 5) + 16 * i) * FS + (tid & 31) * 16) = r[i];
}
__device__ __forceinline__ void ftile_mma(LAS unsigned char* lds, f32x4 (&acc)[2][4], int lane, int wm, int wn) {
#pragma unroll
    for (int mb = 0; mb < 2; ++mb)
#pragma unroll
        for (int nb = 0; nb < 4; ++nb) acc[mb][nb] = (f32x4){0.f, 0.f, 0.f, 0.f};
    const int aoff = (32 * wm + (lane & 15)) * FS + (lane >> 4) * 16;
    const int boff = F_B + (64 * wn + (lane & 15)) * FS + (lane >> 4) * 16;
#pragma unroll
    for (int ks = 0; ks < 8; ++ks) {
        bf16x8 af[2], bfr[4];
#pragma unroll
        for (int mb = 0; mb < 2; ++mb) af[mb] = *(const LAS bf16x8*)(lds + aoff + mb * (16 * FS) + ks * 64);
#pragma unroll
        for (int nb = 0; nb < 4; ++nb) bfr[nb] = *(const LAS bf16x8*)(lds + boff + nb * (16 * FS) + ks * 64);
#pragma unroll
        for (int mb = 0; mb < 2; ++mb)
#pragma unroll
            for (int nb = 0; nb < 4; ++nb) acc[mb][nb] = __builtin_amdgcn_mfma_f32_16x16x32_bf16(af[mb], bfr[nb], acc[mb][nb], 0, 0, 0);
    }
}
struct RowStr { const bf16_t* base; size_t pitch; __device__ __forceinline__ const bf16_t* operator()(int r) const { return base + (size_t)r * pitch; } };
__device__ __forceinline__ void phase_chan_dft(const Ctx& c) {
    const bf16_t* F = c.wb(WS_A); const bf16_t* MC = c.wb(WS_DFT);
    bf16_t* Zt = c.wb(WS_ST); bf16_t* Ztc = c.wb(WS_ST + 128 * MiB);
    const int g4 = c.lane >> 4, wm = c.w >> 1, wn = c.w & 1;
    LAS unsigned char* la = c.lds; LAS unsigned char* lb = c.lds + F_B;
    constexpr int NUL = 2 * 4 * 128;
    u32x4 ra[8], rb[8];
    if (c.bid < NUL) {
        const int grp = c.bid & 3, nlo = (c.bid >> 2) & 127, b = c.bid >> 9;
        ftile_issue(ra, RowStr{F + ((size_t)(TC + b * SEQ + nlo)) * 1024 + grp * 256, (size_t)128 * 1024}, c.tid);
        ftile_issue(rb, RowLin{MC, 256}, c.tid);
        ftile_write(la, ra, c.tid); ftile_write(lb, rb, c.tid);
    }
    __syncthreads();
    for (int u = c.bid; u < NUL; u += c.G) {
        const int grp = u & 3, nlo = (u >> 2) & 127, b = u >> 9;
        const bool nxu = u + c.G < NUL;
#pragma unroll 1
        for (int nt = 0; nt < 4; ++nt) {
            if (nt < 3) ftile_issue(rb, RowLin{MC + (size_t)(nt + 1) * 128 * 256, 256}, c.tid);
            else if (nxu) {
                const int un = u + c.G, gn = un & 3, nn = (un >> 2) & 127, bn = un >> 9;
                ftile_issue(ra, RowStr{F + ((size_t)(TC + bn * SEQ + nn)) * 1024 + gn * 256, (size_t)128 * 1024}, c.tid);
                ftile_issue(rb, RowLin{MC, 256}, c.tid);
            }
            __builtin_amdgcn_sched_barrier(0);
            f32x4 acc[2][4];
            ftile_mma(c.lds, acc, c.lane, wm, wn);
#pragma unroll
            for (int mb = 0; mb < 2; ++mb)
#pragma unroll
                for (int nb = 0; nb < 4; ++nb) {
                    const int n = nt * 128 + 64 * wn + 16 * nb + (c.lane & 15), reim = n >> 8, m = n & 255, nhi = 32 * wm + 16 * mb + 4 * g4;
                    *(u32x2*)(Zt + ((((size_t)(b * 4 + grp) * 256 + m) * 128 + nlo) * 2 + reim) * 128 + nhi) = pack4(acc[mb][nb]);
                }
            __syncthreads();
            if (nt < 3) ftile_write(lb, rb, c.tid);
            else if (nxu) { ftile_write(la, ra, c.tid); ftile_write(lb, rb, c.tid); }
            __syncthreads();
        }
    }
    for (int v = c.bid; v < 64; v += c.G) {
        f32x4 acc[2][4];
        const int nt = v & 3, rt = (v >> 2) & 1, grp = (v >> 3) & 3, b = v >> 5;
        gemm128s<false, 256>(c.lds, RowLin{F + ((size_t)(b * NCTX + rt * 128)) * 1024 + grp * 256, 1024}, RowLin{MC + (size_t)nt * 128 * 256, 256}, acc);
#pragma unroll
        for (int mb = 0; mb < 2; ++mb)
#pragma unroll
            for (int nb = 0; nb < 4; ++nb) {
                const int n = nt * 128 + 64 * wn + 16 * nb + (c.lane & 15), reim = n >> 8, m = n & 255, nn = rt * 128 + 32 * wm + 16 * mb + 4 * g4;
                *(u32x2*)(Ztc + (((size_t)(b * 4 + grp) * 256 + m) * 2 + reim) * 256 + nn) = pack4(acc[mb][nb]);
            }
    }
}
__device__ __forceinline__ void phase_dft_stage1(const Ctx& c) {
    const bf16_t* Zt = c.wb(WS_ST); const bf16_t* Ztc = c.wb(WS_ST + 128 * MiB);
    const bf16_t* M1 = c.wb(WS_DFT + 262144); const bf16_t* MCX = c.wb(WS_DFT + 458752);
    bf16_t* Tp = c.wb(WS_H); bf16_t* CAT = c.wb(WS_CAT);
    const int g4 = c.lane >> 4, wm = c.w >> 1, wn = c.w & 1;
    LAS unsigned char* la = c.lds; LAS unsigned char* lb = c.lds + F_B;
    constexpr int NUL = 2048;
    u32x4 ra[8], rb[8];
    if (c.bid < NUL) {
        ftile_issue(ra, RowLin{Zt + (size_t)c.bid * 128 * 256, 256}, c.tid); ftile_issue(rb, RowLin{M1, 256}, c.tid);
        ftile_write(la, ra, c.tid); ftile_write(lb, rb, c.tid);
    }
    __syncthreads();
    for (int rt = c.bid; rt < NUL; rt += c.G) {
        const int bg = rt >> 8, m = rt & 255;
        const bool nxu = rt + c.G < NUL;
#pragma unroll 1
        for (int nt = 0; nt < 2; ++nt) {
            if (nt < 1) ftile_issue(rb, RowLin{M1 + (size_t)(nt + 1) * 128 * 256, 256}, c.tid);
            else if (nxu) { ftile_issue(ra, RowLin{Zt + (size_t)(rt + c.G) * 128 * 256, 256}, c.tid); ftile_issue(rb, RowLin{M1, 256}, c.tid); }
            __builtin_amdgcn_sched_barrier(0);
            f32x4 acc[2][4];
            ftile_mma(c.lds, acc, c.lane, wm, wn);
#pragma unroll
            for (int mb = 0; mb < 2; ++mb)
#pragma unroll
                for (int nb = 0; nb < 4; ++nb) {
                    const int j = nt * 128 + 64 * wn + 16 * nb + (c.lane & 15), ka = j >> 1, ro = j & 1, nlo0 = 32 * wm + 16 * mb + 4 * g4;
                    f32x4 o;
#pragma unroll
                    for (int r = 0; r < 4; ++r) {
                        const float mine = acc[mb][nb][r], other = __shfl_xor(mine, 1);
                        const float fr = (float)((ka * (nlo0 + r)) & 16383) * (1.0f / 16384.0f);
                        const float cc = cos_rev(fr), ss = sin_rev(fr);
                        o[r] = ro == 0 ? (mine * cc + other * ss) : (mine * cc - other * ss);
                    }
                    *(u32x2*)(Tp + ((((size_t)bg * 128 + ka) * 256 + m) * 2 + ro) * 128 + nlo0) = pack4(o);
                }
            __syncthreads();
            if (nt < 1) ftile_write(lb, rb, c.tid);
            else if (nxu) { ftile_write(la, ra, c.tid); ftile_write(lb, rb, c.tid); }
            __syncthreads();
        }
    }
    for (int v = c.bid; v < 32; v += c.G) {
        f32x4 acc[2][4];
        const int nt = v & 1, rt = v >> 1;
        gemm128s<false, 512>(c.lds, RowLin{Ztc + (size_t)rt * 128 * 512, 512}, RowLin{MCX + (size_t)nt * 128 * 512, 512}, acc);
        const int bg = rt >> 1, b = bg >> 2, grp = bg & 3, mh = rt & 1;
#pragma unroll
        for (int mb = 0; mb < 2; ++mb)
#pragma unroll
            for (int nb = 0; nb < 4; ++nb) {
                const int k = nt * 128 + 64 * wn + 16 * nb + (c.lane & 15), m0 = mh * 128 + 32 * wm + 16 * mb + 4 * g4;
                *(u32x2*)(CAT + (size_t)(b * NCTX + k) * 2048 + grp * 256 + m0) = pack4(acc[mb][nb]);
            }
    }
}
__device__ __forceinline__ void phase_dft_stage2(const Ctx& c) {
    const bf16_t* Tp = c.wb(WS_H); const bf16_t* M2 = c.wb(WS_DFT + 393216); bf16_t* CAT = c.wb(WS_CAT);
    const int g4 = c.lane >> 4, wm = c.w >> 1, wn = c.w & 1;
    LAS unsigned char* la = c.lds; LAS unsigned char* lb = c.lds + F_B;
    u32x4 ra[8];
    if (c.bid < 2048) {
        ftile_issue(ra, RowLin{M2, 256}, c.tid);
        ftile_write(lb, ra, c.tid);
        ftile_issue(ra, RowLin{Tp + (size_t)c.bid * 128 * 256, 256}, c.tid);
        ftile_write(la, ra, c.tid);
    }
    __syncthreads();
    for (int u = c.bid; u < 2048; u += c.G) {
        const bool nxu = u + c.G < 2048;
        if (nxu) ftile_issue(ra, RowLin{Tp + (size_t)(u + c.G) * 128 * 256, 256}, c.tid);
        __builtin_amdgcn_sched_barrier(0);
        f32x4 acc[2][4];
        ftile_mma(c.lds, acc, c.lane, wm, wn);
        const int mh = u & 1, ka = (u >> 1) & 127, bg = u >> 8, b = bg >> 2, grp = bg & 3;
#pragma unroll
        for (int mb = 0; mb < 2; ++mb)
#pragma unroll
            for (int nb = 0; nb < 4; ++nb) {
                const int kb = 64 * wn + 16 * nb + (c.lane & 15), m0 = mh * 128 + 32 * wm + 16 * mb + 4 * g4;
                *(u32x2*)(CAT + (size_t)(TC + b * SEQ + ka + 128 * kb) * 2048 + grp * 256 + m0) = pack4(acc[mb][nb]);
            }
        __syncthreads();
        if (nxu) ftile_write(la, ra, c.tid);
        __syncthreads();
    }
}

constexpr int TS = 272;
constexpr int TILE_B = 128 * TS;
constexpr int TSV = 288;
constexpr int TILE_BV = 128 * TSV;
__device__ __forceinline__ int chunk_tok0(int b, int cch) { return cch < 2 ? b * NCTX + cch * 128 : TC + b * SEQ + (cch - 2) * 128; }
template <int STRIDE = TS>
__device__ __forceinline__ void load_tile128(const Ctx& c, LAS unsigned char* dst, const bf16_t* src  , size_t pitch) {
#pragma unroll
    for (int i = 0; i < 4; ++i) {
        const int id = c.tid + 512 * i, row = id >> 4, ch = id & 15;
        *(LAS u32x4*)(dst + row * STRIDE + ch * 16) = *(const u32x4*)(src + (size_t)row * pitch + ch * 8);
    }
}
__device__ __forceinline__ void phase_ret_ds(const Ctx& c) {
    const bf16_t* Kb = c.wb(WS_K); const bf16_t* V = c.wb(WS_V); bf16_t* ST = c.wb(WS_ST);
    LAS unsigned char* kt = c.lds; LAS unsigned char* vf = c.lds + TILE_BV; LAS unsigned char* vb = c.lds + 2 * TILE_BV;
    const int g = c.lane >> 4, wm = c.w >> 1, wn = c.w & 1, d0 = 32 * wm, e0 = 64 * wn;
    u32x4 rk[4], rv[4];
    if (c.bid < NBATCH * 8 * NCH) {
        const int cch = c.bid % NCH, bh = c.bid / NCH; const size_t g0 = (size_t)chunk_tok0(bh >> 3, cch) * 1024 + (bh & 7) * 128;
#pragma unroll
        for (int i = 0; i < 4; ++i) { const int id = c.tid + 512 * i; const size_t go = g0 + (size_t)(id >> 4) * 1024 + (id & 15) * 8; rk[i] = *(const u32x4*)(Kb + go); rv[i] = *(const u32x4*)(V + go); }
    }
    for (int u = c.bid; u < NBATCH * 8 * NCH; u += c.G) {
        const int cch = u % NCH, bh = u / NCH, h = bh & 7, b = bh >> 3;
        const float lg = log2_gamma(h);
#pragma unroll
        for (int i = 0; i < 4; ++i) {
            const int id = c.tid + 512 * i, row = id >> 4, ch = id & 15;
            *(LAS u32x4*)(kt + row * TSV + ch * 16) = rk[i];
            const u32x4 v = rv[i];
            const float zf = fast_exp2(lg * (float)(127 - row)), zb = fast_exp2(lg * (float)row);
            u32x4 of, ob;
            of.x = cvt_pk_bf16(bf_lo(v.x) * zf, bf_hi(v.x) * zf); of.y = cvt_pk_bf16(bf_lo(v.y) * zf, bf_hi(v.y) * zf);
            of.z = cvt_pk_bf16(bf_lo(v.z) * zf, bf_hi(v.z) * zf); of.w = cvt_pk_bf16(bf_lo(v.w) * zf, bf_hi(v.w) * zf);
            ob.x = cvt_pk_bf16(bf_lo(v.x) * zb, bf_hi(v.x) * zb); ob.y = cvt_pk_bf16(bf_lo(v.y) * zb, bf_hi(v.y) * zb);
            ob.z = cvt_pk_bf16(bf_lo(v.z) * zb, bf_hi(v.z) * zb); ob.w = cvt_pk_bf16(bf_lo(v.w) * zb, bf_hi(v.w) * zb);
            *(LAS u32x4*)(vf + row * TSV + ch * 16) = of; *(LAS u32x4*)(vb + row * TSV + ch * 16) = ob;
        }
        __syncthreads();
        if (u + c.G < NBATCH * 8 * NCH) {
            const int un = u + c.G, cn = un % NCH, bn = un / NCH; const size_t g0 = (size_t)chunk_tok0(bn >> 3, cn) * 1024 + (bn & 7) * 128;
#pragma unroll
            for (int i = 0; i < 4; ++i) { const int id = c.tid + 512 * i; const size_t go = g0 + (size_t)(id >> 4) * 1024 + (id & 15) * 8; rk[i] = *(const u32x4*)(Kb + go); rv[i] = *(const u32x4*)(V + go); }
        }
        __builtin_amdgcn_sched_barrier(0);
        f32x4 accf[2][4], accb[2][4];
#pragma unroll
        for (int mb = 0; mb < 2; ++mb)
#pragma unroll
            for (int nb = 0; nb < 4; ++nb) { accf[mb][nb] = (f32x4){0.f, 0.f, 0.f, 0.f}; accb[mb][nb] = (f32x4){0.f, 0.f, 0.f, 0.f}; }
#pragma unroll
        for (int ks = 0; ks < 4; ++ks) {
            const int j0 = 32 * ks + 8 * g;
            bf16x8 af[2];
#pragma unroll
            for (int mb = 0; mb < 2; ++mb)
                af[mb] = cat8(tr_read(kt + j0 * TSV + (d0 + 16 * mb) * 2, TSV, c.lane), tr_read(kt + (j0 + 4) * TSV + (d0 + 16 * mb) * 2, TSV, c.lane));
#pragma unroll
            for (int nb = 0; nb < 4; ++nb) {
                const bf16x8 bf = cat8(tr_read(vf + j0 * TSV + (e0 + 16 * nb) * 2, TSV, c.lane), tr_read(vf + (j0 + 4) * TSV + (e0 + 16 * nb) * 2, TSV, c.lane));
                const bf16x8 bb = cat8(tr_read(vb + j0 * TSV + (e0 + 16 * nb) * 2, TSV, c.lane), tr_read(vb + (j0 + 4) * TSV + (e0 + 16 * nb) * 2, TSV, c.lane));
#pragma unroll
                for (int mb = 0; mb < 2; ++mb) {
                    accf[mb][nb] = __builtin_amdgcn_mfma_f32_16x16x32_bf16(af[mb], bf, accf[mb][nb], 0, 0, 0);
                    accb[mb][nb] = __builtin_amdgcn_mfma_f32_16x16x32_bf16(af[mb], bb, accb[mb][nb], 0, 0, 0);
                }
            }
        }
        bf16_t* sf = ST + ((size_t)((0 * 2 + b) * 8 + h) * NCH + cch) * 16384;
        bf16_t* sb = ST + ((size_t)((1 * 2 + b) * 8 + h) * NCH + cch) * 16384;
#pragma unroll
        for (int mb = 0; mb < 2; ++mb)
#pragma unroll
            for (int nb = 0; nb < 4; ++nb) {
                const int e = e0 + 16 * nb + (c.lane & 15), d = d0 + 16 * mb + 4 * g;
                *(u32x2*)(sf + e * 128 + d) = pack4(accf[mb][nb]);
                *(u32x2*)(sb + e * 128 + d) = pack4(accb[mb][nb]);
            }
        __syncthreads();
    }
}
__device__ __forceinline__ void phase_ret_scan(const Ctx& c) {
    bf16_t* ST = c.wb(WS_ST);
    for (int gid = c.bid * 512 + c.tid; gid < 2 * 16 * 2048; gid += c.G * 512) {
        const int dir = gid >> 15, rem = gid & 32767, bh = rem >> 11, e8 = rem & 2047, h = bh & 7;
        bf16_t* base = ST + (size_t)(dir * 16 + bh) * NCH * 16384 + e8 * 8;
        const float decay = fast_exp2(log2_gamma(h) * 128.0f);
        float st[8];
#pragma unroll
        for (int j = 0; j < 8; ++j) st[j] = 0.f;
        for (int s0 = 0; s0 < NCH; s0 += 26) {
            u32x4 ds[26];
#pragma unroll
            for (int i = 0; i < 26; ++i) {
                const int s = s0 + i; const int cch = dir == 0 ? s : (s < 2 ? 1 - s : 131 - s);
                ds[i] = *(const u32x4*)(base + (size_t)cch * 16384);
            }
            __builtin_amdgcn_sched_barrier(0);
#pragma unroll
            for (int i = 0; i < 26; ++i) {
                const int s = s0 + i; const int cch = dir == 0 ? s : (s < 2 ? 1 - s : 131 - s);
                u32x4 o; o.x = cvt_pk_bf16(st[0], st[1]); o.y = cvt_pk_bf16(st[2], st[3]); o.z = cvt_pk_bf16(st[4], st[5]); o.w = cvt_pk_bf16(st[6], st[7]);
                *(u32x4*)(base + (size_t)cch * 16384) = o;
                st[0] = st[0] * decay + bf_lo(ds[i].x); st[1] = st[1] * decay + bf_hi(ds[i].x);
                st[2] = st[2] * decay + bf_lo(ds[i].y); st[3] = st[3] * decay + bf_hi(ds[i].y);
                st[4] = st[4] * decay + bf_lo(ds[i].z); st[5] = st[5] * decay + bf_hi(ds[i].z);
                st[6] = st[6] * decay + bf_lo(ds[i].w); st[7] = st[7] * decay + bf_hi(ds[i].w);
            }
        }
    }
}
__device__ __forceinline__ void phase_ret_out(const Ctx& c) {
    const bf16_t* Q = c.wb(WS_Q); const bf16_t* Kb = c.wb(WS_K); const bf16_t* V = c.wb(WS_V); const bf16_t* Gt = c.wb(WS_G);
    const bf16_t* ST = c.wb(WS_ST); bf16_t* CAT = c.wb(WS_CAT); const float* gn = c.in[9];
    LAS unsigned char* qt = c.lds; LAS unsigned char* kt = c.lds + TILE_B; LAS unsigned char* vt = c.lds + 2 * TILE_B;
    LAS unsigned char* pw = c.lds + 2 * TILE_B + TILE_BV + c.w * (16 * TS);
    LAS float* gws = (LAS float*)(c.lds + 2 * TILE_B + TILE_BV + 8 * (16 * TS));
    const int g = c.lane >> 4, il = c.lane & 15, i0 = 16 * c.w;
    for (int u = c.bid; u < NBATCH * 8 * NCH; u += c.G) {
        const int cch = u % NCH, bh = u / NCH, h = bh & 7, b = bh >> 3;
        const int tok0 = chunk_tok0(b, cch);
        const float lg = log2_gamma(h);
        const bf16_t* st0 = ST + ((size_t)((0 * 2 + b) * 8 + h) * NCH + cch) * 16384;
        u32x4 rq[4], rk[4], rv[4], rs[4];
#pragma unroll
        for (int i = 0; i < 4; ++i) {
            const int id = c.tid + 512 * i, row = id >> 4, ch = id & 15;
            const size_t go = (size_t)(tok0 + row) * 1024 + h * 128 + ch * 8;
            rq[i] = *(const u32x4*)(Q + go); rk[i] = *(const u32x4*)(Kb + go); rv[i] = *(const u32x4*)(V + go);
            rs[i] = *(const u32x4*)(st0 + row * 128 + ch * 8);
        }
        const float gwv = gn[h * 128 + (c.tid & 127)];
        __builtin_amdgcn_sched_barrier(0);
#pragma unroll
        for (int i = 0; i < 4; ++i) {
            const int id = c.tid + 512 * i, row = id >> 4, ch = id & 15;
            *(LAS u32x4*)(qt + row * TS + ch * 16) = rq[i]; *(LAS u32x4*)(kt + row * TS + ch * 16) = rk[i];
            *(LAS u32x4*)(vt + row * TSV + ch * 16) = rv[i];
        }
        if (c.tid < 128) gws[c.tid] = gwv;
        __syncthreads();
        f32x4 sT[8];
#pragma unroll
        for (int jb = 0; jb < 8; ++jb) sT[jb] = (f32x4){0.f, 0.f, 0.f, 0.f};
#pragma unroll 1
        for (int ks = 0; ks < 4; ++ks) {
            const bf16x8 qk = *(const LAS bf16x8*)(qt + (i0 + il) * TS + (32 * ks + 8 * g) * 2);
#pragma unroll
            for (int jb = 0; jb < 8; ++jb) {
                const bf16x8 kf = *(const LAS bf16x8*)(kt + (16 * jb + il) * TS + (32 * ks + 8 * g) * 2);
                sT[jb] = __builtin_amdgcn_mfma_f32_16x16x32_bf16(kf, qk, sT[jb], 0, 0, 0);
            }
        }
        __syncthreads();
        f32x4 ret[8];
#pragma unroll
        for (int eb = 0; eb < 8; ++eb) ret[eb] = (f32x4){0.f, 0.f, 0.f, 0.f};
        const int ii = i0 + il;
        const int tok = tok0 + ii;
#pragma unroll 1
        for (int dir = 0; dir < 2; ++dir) {
#pragma unroll
            for (int i = 0; i < 4; ++i) {
                const int id = c.tid + 512 * i, row = id >> 4, ch = id & 15;
                *(LAS u32x4*)(kt + row * TS + ch * 16) = rs[i];
            }
            if (dir == 0) {
                const bf16_t* st1 = ST + ((size_t)((1 * 2 + b) * 8 + h) * NCH + cch) * 16384;
#pragma unroll
                for (int i = 0; i < 4; ++i) {
                    const int id = c.tid + 512 * i, row = id >> 4, ch = id & 15;
                    rs[i] = *(const u32x4*)(st1 + row * 128 + ch * 8);
                }
            }
            u32x2 gg[8];
#pragma unroll
            for (int eb = 0; eb < 8; ++eb) gg[eb] = *(const u32x2*)(Gt + (size_t)tok * 2048 + dir * 1024 + h * 128 + 16 * eb + 4 * g);
            __builtin_amdgcn_sched_barrier(0);
#pragma unroll
            for (int jb = 0; jb < 8; ++jb) {
                f32x4 p;
#pragma unroll
                for (int r = 0; r < 4; ++r) {
                    const int j = 16 * jb + 4 * g + r; const int dl = dir == 0 ? ii - j : j - ii;
                    p[r] = dl >= 0 ? sT[jb][r] * fast_exp2(lg * (float)dl) : 0.f;
                }
                *(LAS u32x2*)(pw + il * TS + (16 * jb + 4 * g) * 2) = pack4(p);
            }
            __syncthreads();
            f32x4 o[8];
#pragma unroll
            for (int eb = 0; eb < 8; ++eb) o[eb] = (f32x4){0.f, 0.f, 0.f, 0.f};
#pragma unroll 1
            for (int ks = 0; ks < 4; ++ks) {
                const bf16x8 qk = *(const LAS bf16x8*)(qt + (i0 + il) * TS + (32 * ks + 8 * g) * 2);
#pragma unroll
                for (int eb = 0; eb < 8; ++eb) {
                    const bf16x8 sfr = *(const LAS bf16x8*)(kt + (16 * eb + il) * TS + (32 * ks + 8 * g) * 2);
                    o[eb] = __builtin_amdgcn_mfma_f32_16x16x32_bf16(sfr, qk, o[eb], 0, 0, 0);
                }
            }
            const float xi = dir == 0 ? fast_exp2(lg * (float)(ii + 1)) : fast_exp2(lg * (float)(128 - ii));
#pragma unroll
            for (int eb = 0; eb < 8; ++eb) o[eb] = o[eb] * xi;
#pragma unroll 1
            for (int ks = 0; ks < 4; ++ks) {
                const bf16x8 pf = *(const LAS bf16x8*)(pw + il * TS + (32 * ks + 8 * g) * 2);
                const int j0 = 32 * ks + 8 * g;
#pragma unroll
                for (int eb = 0; eb < 8; ++eb) {
                    const bf16x8 vfr = cat8(tr_read(vt + j0 * TSV + (16 * eb) * 2, TSV, c.lane), tr_read(vt + (j0 + 4) * TSV + (16 * eb) * 2, TSV, c.lane));
                    o[eb] = __builtin_amdgcn_mfma_f32_16x16x32_bf16(vfr, pf, o[eb], 0, 0, 0);
                }
            }
            float ss = 0.f;
#pragma unroll
            for (int eb = 0; eb < 8; ++eb) ss += o[eb][0] * o[eb][0] + o[eb][1] * o[eb][1] + o[eb][2] * o[eb][2] + o[eb][3] * o[eb][3];
            ss += __shfl_xor(ss, 16); ss += __shfl_xor(ss, 32);
            const float rstd = rsqrtf(ss * (1.0f / 128.0f) + EPS);
#pragma unroll
            for (int eb = 0; eb < 8; ++eb) {
                const f32x4 gw = *(const LAS f32x4*)(gws + 16 * eb + 4 * g);
                ret[eb][0] += o[eb][0] * rstd * gw[0] * bf_lo(gg[eb].x); ret[eb][1] += o[eb][1] * rstd * gw[1] * bf_hi(gg[eb].x);
                ret[eb][2] += o[eb][2] * rstd * gw[2] * bf_lo(gg[eb].y); ret[eb][3] += o[eb][3] * rstd * gw[3] * bf_hi(gg[eb].y);
            }
            __syncthreads();
        }
#pragma unroll
        for (int eb = 0; eb < 8; ++eb) *(u32x2*)(CAT + (size_t)tok * 2048 + 1024 + h * 128 + 16 * eb + 4 * g) = pack4(ret[eb]);
    }
}
__device__ __forceinline__ void phase_wout(const Ctx& c, const bf16_t* W, int layer, const float* xlat_old, const float* xctx_old, int mt_lo, int MTn) {
    const bf16_t* CAT = c.wb(WS_CAT); const float* mods = c.wf(WS_MODS); float* xctx_new = c.wf(WS_XCTX);
    const int NT = 16;
    const int g = c.lane >> 4, wm = c.w >> 1, wn = c.w & 1;
    for (int t = c.bid; t < MTn * NT; t += c.G) {
        int mt, nt; tile_mn(t, MTn, NT, mt, nt); mt += mt_lo;
        f32x4 acc[2][4];
#if DBG_CAT_PART == 0
        gemm128r<true>(c.lds, 2048, RowLin{CAT + (size_t)mt * 128 * 2048, 2048}, RowLin{W + (size_t)nt * 128 * 2048, 2048}, acc);
#else
        gemm128<true>(c.lds, 1024, RowLin{CAT + (size_t)mt * 128 * 2048 + (DBG_CAT_PART - 1) * 1024, 2048}, RowLin{W + (size_t)nt * 128 * 2048 + (DBG_CAT_PART - 1) * 1024, 2048}, acc);
#endif
#pragma unroll
        for (int mb = 0; mb < 2; ++mb) {
            const int tok = mt * 128 + 32 * wm + 16 * mb + (c.lane & 15);
            const int mw = tok < TC ? 2 : ((tok - TC) >> 14);
            const float* g1 = mods + (size_t)(layer * 3 + mw) * 12288 + 2 * 2048;
            const float* xo = tok < TC ? xctx_old + (size_t)tok * D : xlat_old + (size_t)(tok - TC) * D;
            float* xn = tok < TC ? xctx_new + (size_t)tok * D : c.out + (size_t)(tok - TC) * D;
#pragma unroll
            for (int nb = 0; nb < 4; ++nb) {
                const int col = nt * 128 + 64 * wn + 16 * nb + 4 * g;
                const f32x4 gv = *(const f32x4*)(g1 + col), xv = *(const f32x4*)(xo + col);
                *(f32x4*)(xn + col) = xv + gv * acc[mb][nb];
            }
        }
    }
}
__device__ __forceinline__ void phase_peer_q(const Ctx& c, const bf16_t* W, int mt_lo, int MTn) {
    const bf16_t* H = c.wb(WS_H); bf16_t* Qp = c.wb(WS_G);
    const int NT = 16;
    const int g = c.lane >> 4, wm = c.w >> 1, wn = c.w & 1;
    for (int t = c.bid; t < MTn * NT; t += c.G) {
        int mt, nt; tile_mn(t, MTn, NT, mt, nt); mt += mt_lo;
        f32x4 acc[2][4];
        gemm128r<true>(c.lds, 2048, RowLin{H + (size_t)mt * 128 * 2048, 2048}, RowLin{W + (size_t)nt * 128 * 2048, 2048}, acc);
#pragma unroll
        for (int mb = 0; mb < 2; ++mb) {
            const int tok = mt * 128 + 32 * wm + 16 * mb + (c.lane & 15);
#pragma unroll
            for (int nb = 0; nb < 4; ++nb) *(u32x2*)(Qp + (size_t)tok * 2048 + nt * 128 + 64 * wn + 16 * nb + 4 * g) = pack4(acc[mb][nb]);
        }
    }
}

__device__ __forceinline__ unsigned enc_key(float v) { const unsigned u = __float_as_uint(v); return (u & 0x80000000u) ? ~u : (u | 0x80000000u); }
__device__ __forceinline__ float dec_key(unsigned k) { return __uint_as_float((k & 0x80000000u) ? (k & 0x7fffffffu) : ~k); }
__device__ __forceinline__ void ins16(unsigned (&L)[16], unsigned x) {
#pragma unroll
    for (int i = 0; i < 16; ++i) { const unsigned hi = L[i] > x ? L[i] : x; x = L[i] > x ? x : L[i]; L[i] = hi; }
}
__device__ __forceinline__ void merge16(unsigned (&A)[16], const unsigned (&B)[16]) {
#pragma unroll
    for (int i = 0; i < 16; ++i) A[i] = A[i] > B[15 - i] ? A[i] : B[15 - i];
#pragma unroll
    for (int s = 8; s >= 1; s >>= 1) {
#pragma unroll
        for (int i = 0; i < 16; ++i)
            if ((i & s) == 0) { const unsigned x = A[i], y = A[i + s]; A[i] = x > y ? x : y; A[i + s] = x > y ? y : x; }
    }
}
__device__ __forceinline__ void sort16(unsigned (&A)[16]) {
#pragma unroll
    for (int k = 2; k <= 16; k <<= 1) {
#pragma unroll
        for (int j = k >> 1; j > 0; j >>= 1) {
#pragma unroll
            for (int i = 0; i < 16; ++i) {
                const int l = i ^ j;
                if (l > i) {
                    const unsigned x = A[i], y = A[l]; const unsigned hi = x > y ? x : y, lo = x > y ? y : x;
                    if ((i & k) == 0) { A[i] = hi; A[l] = lo; } else { A[i] = lo; A[l] = hi; }
                }
            }
        }
    }
}
__device__ __forceinline__ unsigned sel16(const unsigned (&L)[16], int a) {
    unsigned r = L[0];
#pragma unroll
    for (int i = 1; i < 16; ++i) r = (a == i) ? L[i] : r;
    return r;
}
__device__ __forceinline__ void topk_issue(const Ctx& c, u32x4 (&ra)[2][2][2], u32x4 (&rb)[2][2][2], const bf16_t* qbase, const bf16_t* kbase) {
    const int r0 = c.tid >> 3, ch = c.tid & 7;
#pragma unroll
    for (int p = 0; p < 2; ++p)
#pragma unroll
        for (int kt = 0; kt < 2; ++kt)
#pragma unroll
            for (int hf = 0; hf < 2; ++hf) {
                ra[p][kt][hf] = *(const u32x4*)(qbase + (size_t)(r0 + 64 * hf) * 2048 + p * 128 + kt * 64 + ch * 8);
                rb[p][kt][hf] = *(const u32x4*)(kbase + (size_t)p * 128 * 128 + (r0 + 64 * hf) * 128 + kt * 64 + ch * 8);
            }
}
__device__ __forceinline__ void topk_scores_pair(const Ctx& c, LAS float* S0, LAS float* S1, const u32x4 (&ra)[2][2][2], const u32x4 (&rb)[2][2][2]) {
    const int lane = c.lane, g = lane >> 4, wm = c.w >> 1, wn = c.w & 1;
    const int r0 = c.tid >> 3, ch = c.tid & 7, woff = r0 * 144 + ch * 16;
    const int aoff = (32 * wm + (lane & 15)) * 144 + (lane >> 4) * 16;
    const int boff = 36864 + (64 * wn + (lane & 15)) * 144 + (lane >> 4) * 16;
#pragma unroll
    for (int p = 0; p < 2; ++p) {
        if (p == 1) __syncthreads();
#pragma unroll
        for (int kt = 0; kt < 2; ++kt)
#pragma unroll
            for (int hf = 0; hf < 2; ++hf) {
                *(LAS u32x4*)(c.lds + kt * 18432 + woff + hf * 9216) = ra[p][kt][hf];
                *(LAS u32x4*)(c.lds + 36864 + kt * 18432 + woff + hf * 9216) = rb[p][kt][hf];
            }
        __syncthreads();
        f32x4 acc[2][4];
#pragma unroll
        for (int mb = 0; mb < 2; ++mb)
#pragma unroll
            for (int nb = 0; nb < 4; ++nb) acc[mb][nb] = (f32x4){0.f, 0.f, 0.f, 0.f};
#pragma unroll
        for (int kt = 0; kt < 2; ++kt)
#pragma unroll
            for (int ks = 0; ks < 2; ++ks) {
                bf16x8 af[2], bfr[4];
#pragma unroll
                for (int mb = 0; mb < 2; ++mb) af[mb] = *(const LAS bf16x8*)(c.lds + kt * 18432 + aoff + mb * 2304 + ks * 64);
#pragma unroll
                for (int nb = 0; nb < 4; ++nb) bfr[nb] = *(const LAS bf16x8*)(c.lds + kt * 18432 + boff + nb * 2304 + ks * 64);
#pragma unroll
                for (int mb = 0; mb < 2; ++mb)
#pragma unroll
                    for (int nb = 0; nb < 4; ++nb) acc[mb][nb] = __builtin_amdgcn_mfma_f32_16x16x32_bf16(af[mb], bfr[nb], acc[mb][nb], 0, 0, 0);
            }
        if (p == 1) __syncthreads();
        LAS float* S = p == 0 ? S0 : S1;
#pragma unroll
        for (int mb = 0; mb < 2; ++mb)
#pragma unroll
            for (int nb = 0; nb < 4; ++nb)
#pragma unroll
                for (int r = 0; r < 4; ++r) S[(32 * wm + 16 * mb + 4 * g + r) * 129 + 64 * wn + 16 * nb + (lane & 15)] = acc[mb][nb][r];
    }
}
__device__ __forceinline__ void phase_peer_topk(const Ctx& c, int layer, int mt_lo) {
    const bf16_t* Qp = c.wb(WS_G); const bf16_t* SK = c.wb(WS_SKB) + (size_t)layer * 16 * 128 * 128;
    int* IDX = (int*)(c.ws + WS_IDX); float* GATE = c.wf(WS_GATE);
    LAS float* S0 = (LAS float*)(c.lds + GEMM_LDS);
    LAS float* S1 = (LAS float*)c.lds;
    const int MT = TT / 128, NU = (MT - mt_lo) * 8;
    u32x4 ra[2][2][2], rb[2][2][2];
    if (c.bid < NU) topk_issue(c, ra, rb, Qp + (size_t)(mt_lo + (c.bid >> 3)) * 128 * 2048 + ((c.bid & 7) * 2) * 128, SK + (size_t)((c.bid & 7) * 2) * 128 * 128);
    for (int u = c.bid; u < NU; u += c.G) {
        const int mt = mt_lo + (u >> 3), h = u & 7;
        topk_scores_pair(c, S0, S1, ra, rb);
        if (u + c.G < NU) {
            const int un = u + c.G;
            topk_issue(c, ra, rb, Qp + (size_t)(mt_lo + (un >> 3)) * 128 * 2048 + ((un & 7) * 2) * 128, SK + (size_t)((un & 7) * 2) * 128 * 128);
        }
        __builtin_amdgcn_sched_barrier(0);
        __syncthreads();
        unsigned La[16], Lb[16];
#pragma unroll
        for (int i = 0; i < 16; ++i) { La[i] = 0u; Lb[i] = 0u; }
        if (c.tid < 256) {
            LAS float* row = (c.tid < 128 ? S0 : S1) + (c.tid & 127) * 129;
#pragma unroll
            for (int i = 0; i < 16; ++i) La[i] = (enc_key(row[i]) & ~127u) | (unsigned)i;
            sort16(La);
#pragma unroll 1
            for (int j0 = 16; j0 < 128; j0 += 16) {
#pragma unroll
                for (int i = 0; i < 16; ++i) Lb[i] = (enc_key(row[j0 + i]) & ~127u) | (unsigned)(j0 + i);
                sort16(Lb);
                merge16(La, Lb);
            }
        }
        __syncthreads();
        if (c.tid >= 128 && c.tid < 256) { LAS unsigned* lst = (LAS unsigned*)S1 + (c.tid - 128) * 129;
#pragma unroll
            for (int i = 0; i < 16; ++i) lst[i] = La[i]; }
        __syncthreads();
        if (c.tid < 128) {
            LAS unsigned* l1 = (LAS unsigned*)S1 + c.tid * 129;
#pragma unroll
            for (int i = 0; i < 16; ++i) Lb[i] = l1[i];
            unsigned M[16], T[16];
#define CK(a, b) ((enc_key(dec_key(La[a] & ~127u) + dec_key(Lb[b] & ~127u)) & ~255u) | (unsigned)(255 - ((a) * 16 + (b))))
#pragma unroll
            for (int b = 0; b < 16; ++b) M[b] = CK(0, b);
#pragma unroll
            for (int a = 1; a < 8; ++a) {
#pragma unroll
                for (int b = 0; b < 16; ++b) T[b] = ((a + 1) * (b + 1) <= 16) ? CK(a, b) : 0u;
                merge16(M, T);
            }
#pragma unroll
            for (int a = 8; a < 16; ++a) T[a - 8] = CK(a, 0);
#pragma unroll
            for (int i = 8; i < 16; ++i) T[i] = 0u;
            merge16(M, T);
#undef CK
            const int tok = mt * 128 + c.tid;
            float sv[16]; const float smax = dec_key(M[0] & ~255u); float sum = 0.f;
#pragma unroll
            for (int k = 0; k < 16; ++k) { sv[k] = fast_exp2((dec_key(M[k] & ~255u) - smax) * LOG2E); sum += sv[k]; }
            const float inv = 1.0f / sum;
            int* ip = IDX + ((size_t)tok * 8 + h) * 16; float* gp = GATE + ((size_t)tok * 8 + h) * 16;
            LAS unsigned* lst = (LAS unsigned*)S0 + c.tid * 129;
#pragma unroll
            for (int i = 0; i < 16; ++i) { lst[i] = La[i]; lst[16 + i] = Lb[i]; }
#pragma unroll
            for (int k = 0; k < 16; ++k) {
                const int ab = 255 - (int)(M[k] & 255u), a = ab >> 4, b = ab & 15;
                const int i0 = (int)(lst[a] & 127u), i1 = (int)(lst[16 + b] & 127u);
                ip[k] = i0 * 128 + i1; gp[k] = sv[k] * inv;
            }
        }
        __syncthreads();
    }
}
typedef unsigned u32x6 __attribute__((ext_vector_type(6)));
typedef float f32x32 __attribute__((ext_vector_type(32)));
__device__ __forceinline__ void gather_experts(const Ctx& c, int layer, const unsigned char* TU, const unsigned char* TV, const float (&xf)[32], int idA, int idB, float gA, float gB,
                                               int e_lo, int e_hi, float (&acc)[32]) {
    for (int e = e_lo; e < (((DBG_SKIP_GATHER >> layer) & 1) ? 0 : e_hi); e += 4) {
        const int sl = e & 63;
        int rr[4]; float gg[4];
#pragma unroll
        for (int k = 0; k < 4; ++k) { rr[k] = __shfl(e < 64 ? idA : idB, sl + k); gg[k] = __shfl(e < 64 ? gA : gB, sl + k); }
        u32x4 uu[4]; u32x4 vv[4];
#pragma unroll
        for (int k = 0; k < 4; ++k) {
            uu[k] = *(const u32x4*)(TU + (size_t)rr[k] * 1024 + c.lane * 16);
            vv[k] = *(const u32x4*)(TV + (size_t)rr[k] * 1024 + c.lane * 16);
        }
        __builtin_amdgcn_sched_barrier(0);
        float dd[4];
#pragma unroll
        for (int k = 0; k < 4; ++k) {
            float d0 = 0.f, d1 = 0.f;
#pragma unroll
            for (int q = 0; q < 4; ++q) {
                const f32x2 f0 = __builtin_amdgcn_cvt_scalef32_pk_f32_fp4(uu[k][q], 1.0f, 0), f1 = __builtin_amdgcn_cvt_scalef32_pk_f32_fp4(uu[k][q], 1.0f, 1);
                const f32x2 f2 = __builtin_amdgcn_cvt_scalef32_pk_f32_fp4(uu[k][q], 1.0f, 2), f3 = __builtin_amdgcn_cvt_scalef32_pk_f32_fp4(uu[k][q], 1.0f, 3);
                d0 += f0.x * xf[q * 8 + 0] + f1.x * xf[q * 8 + 2] + f2.x * xf[q * 8 + 4] + f3.x * xf[q * 8 + 6];
                d1 += f0.y * xf[q * 8 + 1] + f1.y * xf[q * 8 + 3] + f2.y * xf[q * 8 + 5] + f3.y * xf[q * 8 + 7];
            }
            dd[k] = d0 + d1;
        }
#pragma unroll
        for (int o = 32; o >= 1; o >>= 1) {
#pragma unroll
            for (int k = 0; k < 4; ++k) dd[k] += __shfl_xor(dd[k], o);
        }
#pragma unroll
        for (int k = 0; k < 4; ++k) {
            const float w = gg[k] * gelu_tanh(dd[k] * (1.0f / U_SCALE)) * (1.0f / V_SCALE);
#pragma unroll
            for (int q = 0; q < 4; ++q) {
                const f32x2 f0 = __builtin_amdgcn_cvt_scalef32_pk_f32_fp4(vv[k][q], 1.0f, 0), f1 = __builtin_amdgcn_cvt_scalef32_pk_f32_fp4(vv[k][q], 1.0f, 1);
                const f32x2 f2 = __builtin_amdgcn_cvt_scalef32_pk_f32_fp4(vv[k][q], 1.0f, 2), f3 = __builtin_amdgcn_cvt_scalef32_pk_f32_fp4(vv[k][q], 1.0f, 3);
                acc[q * 8 + 0] += w * f0.x; acc[q * 8 + 1] += w * f0.y; acc[q * 8 + 2] += w * f1.x; acc[q * 8 + 3] += w * f1.y;
                acc[q * 8 + 4] += w * f2.x; acc[q * 8 + 5] += w * f2.y; acc[q * 8 + 6] += w * f3.x; acc[q * 8 + 7] += w * f3.y;
            }
        }
    }
}
__device__ __forceinline__ void gather_load_x(const Ctx& c, const bf16_t* H, int tok, float (&xf)[32]) {
#pragma unroll
    for (int q = 0; q < 4; ++q) {
        const u32x4 v = *(const u32x4*)(H + (size_t)tok * D + c.lane * 32 + q * 8);
#pragma unroll
        for (int e = 0; e < 4; ++e) { xf[q * 8 + e * 2] = bf_lo(v[e]); xf[q * 8 + e * 2 + 1] = bf_hi(v[e]); }
    }
}
template <bool FINAL>
__device__ __forceinline__ void gather_epilogue(const Ctx& c, int layer, int tok, float (&acc)[32]) {
    const float* mods = c.wf(WS_MODS); float* xctx = c.wf(WS_XCTX); const float* fnorm = c.in[22];
    const int mw = tok < TC ? 2 : ((tok - TC) >> 14);
    const float* g2 = mods + (size_t)(layer * 3 + mw) * 12288 + 5 * 2048;
    float* xp = tok < TC ? xctx + (size_t)tok * D : c.out + (size_t)(tok - TC) * D;
    float ss = 0.f;
    f32x4 xa[8], ga[8];
#pragma unroll
    for (int q = 0; q < 8; ++q) { xa[q] = *(const f32x4*)(xp + c.lane * 32 + q * 4); ga[q] = *(const f32x4*)(g2 + c.lane * 32 + q * 4); }
    __builtin_amdgcn_sched_barrier(0);
#pragma unroll
    for (int q = 0; q < 8; ++q) {
        const int col = c.lane * 32 + q * 4;
        const f32x4 xv = xa[q], gv = ga[q];
        f32x4 o;
#pragma unroll
        for (int j = 0; j < 4; ++j) { o[j] = xv[j] + gv[j] * acc[q * 4 + j]; ss += o[j] * o[j]; }
        if (!FINAL) *(f32x4*)(xp + col) = o;
        else { acc[q * 4 + 0] = o[0]; acc[q * 4 + 1] = o[1]; acc[q * 4 + 2] = o[2]; acc[q * 4 + 3] = o[3]; }
    }
    if (FINAL) {
        f32x4 fwa[8];
#pragma unroll
        for (int q = 0; q < 8; ++q) fwa[q] = *(const f32x4*)(fnorm + c.lane * 32 + q * 4);
        __builtin_amdgcn_sched_barrier(0);
        ss = wave_sum(ss);
        const float rstd = rsqrtf(ss * (1.0f / D) + EPS);
#pragma unroll
        for (int q = 0; q < 8; ++q) {
            const int col = c.lane * 32 + q * 4;
            const f32x4 fw = fwa[q];
            f32x4 o;
#pragma unroll
            for (int j = 0; j < 4; ++j) o[j] = acc[q * 4 + j] * rstd * fw[j];
#if defined(DBG_ATTN_CHECK) || defined(DBG_TOPK_CHECK) || defined(DBG_TSEL) || defined(DBG_FOURIER_CHECK) || defined(DBG_RET_CHECK)
            for (int j = 0; j < 4; ++j) o[j] += 10000.0f * (float)(*(volatile unsigned*)(c.ws + WS_CTL + 32768));
#endif
            *(f32x4*)(xp + col) = o;
        }
    }
}
template <bool FINAL>
__device__ __forceinline__ void phase_peer_gather(const Ctx& c, int layer, int tok_lo) {
    const bf16_t* H = c.wb(WS_H); const unsigned char* TU = c.ws + WS_TABU + (size_t)layer * (32 * MiB); const unsigned char* TV = c.ws + WS_TABV + (size_t)layer * (32 * MiB);
    const int* IDX = (const int*)(c.ws + WS_IDX); const float* GATE = c.wf(WS_GATE);
    const int W = c.G * 8, nTok = TT - tok_lo, R = nTok / W, rem = nTok - R * W;
    u32x4 xr[4]; int idA = 0, idB = 0; float gA = 0.f, gB = 0.f;
    if (R > 0) {
        const int tok = tok_lo + c.bid * 8 + c.w;
#pragma unroll
        for (int q = 0; q < 4; ++q) xr[q] = *(const u32x4*)(H + (size_t)tok * D + c.lane * 32 + q * 8);
        idA = IDX[(size_t)tok * 128 + c.lane]; idB = IDX[(size_t)tok * 128 + 64 + c.lane];
        gA = GATE[(size_t)tok * 128 + c.lane]; gB = GATE[(size_t)tok * 128 + 64 + c.lane];
    }
    for (int r = 0; r < R; ++r) {
        const int tok = tok_lo + r * W + c.bid * 8 + c.w;
        float xf[32];
#pragma unroll
        for (int q = 0; q < 4; ++q)
#pragma unroll
            for (int e = 0; e < 4; ++e) { xf[q * 8 + e * 2] = bf_lo(xr[q][e]); xf[q * 8 + e * 2 + 1] = bf_hi(xr[q][e]); }
        const int cA = idA, cB = idB; const float cgA = gA, cgB = gB;
        if (r + 1 < R) {
            const int tn = tok + W;
#pragma unroll
            for (int q = 0; q < 4; ++q) xr[q] = *(const u32x4*)(H + (size_t)tn * D + c.lane * 32 + q * 8);
            idA = IDX[(size_t)tn * 128 + c.lane]; idB = IDX[(size_t)tn * 128 + 64 + c.lane];
            gA = GATE[(size_t)tn * 128 + c.lane]; gB = GATE[(size_t)tn * 128 + 64 + c.lane];
        }
        __builtin_amdgcn_sched_barrier(0);
        float acc[32];
#pragma unroll
        for (int j = 0; j < 32; ++j) acc[j] = 0.f;
        gather_experts(c, layer, TU, TV, xf, cA, cB, cgA, cgB, 0, 128, acc);
        gather_epilogue<FINAL>(c, layer, tok, acc);
    }
    if (rem > 0) {
        int S = 1; if (W % rem == 0) { const int q = W / rem; S = q >= 8 ? 8 : (q >= 4 ? 4 : (q >= 2 ? 2 : 1)); }
        const int per = 8 / S, ti = c.bid * per + c.w / S, part = c.w % S, ne = 128 / S;
        const bool act = ti < rem; const int tok = tok_lo + R * W + (act ? ti : 0);
        float acc[32];
#pragma unroll
        for (int j = 0; j < 32; ++j) acc[j] = 0.f;
        if (act) {
            float xf[32];
            gather_load_x(c, H, tok, xf);
            const int idA = IDX[(size_t)tok * 128 + c.lane], idB = IDX[(size_t)tok * 128 + 64 + c.lane];
            const float gA = GATE[(size_t)tok * 128 + c.lane], gB = GATE[(size_t)tok * 128 + 64 + c.lane];
            gather_experts(c, layer, TU, TV, xf, idA, idB, gA, gB, part * ne, part * ne + ne, acc);
        }
        if (S > 1) {
            LAS float* red = (LAS float*)c.lds;
            __syncthreads();
#pragma unroll
            for (int j = 0; j < 32; ++j) red[(c.w * 32 + j) * 64 + c.lane] = acc[j];
            __syncthreads();
            if (act && part == 0)
                for (int p = 1; p < S; ++p) {
#pragma unroll
                    for (int j = 0; j < 32; ++j) acc[j] += red[((c.w + p) * 32 + j) * 64 + c.lane];
                }
        }
        if (act && part == 0) gather_epilogue<FINAL>(c, layer, tok, acc);
    }
}

__device__ __forceinline__ void rope64_store(const f32x4 (&a)[4], bool rotate, int s, int g, float sc, const f32x2* r64, bf16_t* dst) {
    if (rotate) {
        const int prow = s >> 6, pcol = s & 63;
#pragma unroll
        for (int hlf = 0; hlf < 2; ++hlf) {
            const int pos = hlf == 0 ? prow : pcol;
            f32x4 o1, o2;
#pragma unroll
            for (int r = 0; r < 4; ++r) {
                const f32x2 cs = r64[pos * 16 + 4 * g + r];
                const float x1 = a[2 * hlf][r] * sc, x2 = a[2 * hlf + 1][r] * sc;
                o1[r] = x1 * cs.x - x2 * cs.y; o2[r] = x2 * cs.x + x1 * cs.y;
            }
            *(u32x2*)(dst + 32 * hlf) = pack4(o1); *(u32x2*)(dst + 32 * hlf + 16) = pack4(o2);
        }
    } else {
#pragma unroll
        for (int nb = 0; nb < 4; ++nb) *(u32x2*)(dst + 16 * nb) = pack4(a[nb] * sc);
    }
}
__device__ __forceinline__ void phase_odd_proj(const Ctx& c) {
    const bf16_t* H = c.wb(WS_H); const bf16_t* W = c.wb(WS_WINO);
    bf16_t* SQ = c.wb(WS_A); bf16_t* SK = c.wb(WS_Q); bf16_t* SV = c.wb(WS_Q + 9 * MiB); bf16_t* CQ = c.wb(WS_Q + 18 * MiB);
    bf16_t* CKV = c.wb(WS_K); bf16_t* KR = c.wb(WS_K + 17 * MiB);
    const f32x2* r64 = (const f32x2*)(c.ws + WS_ROPE + 131072);
    const int MT = TT / 128, NT = 17;
    const int g = c.lane >> 4, wm = c.w >> 1, wn = c.w & 1;
    for (int t = c.bid; t < MT * NT; t += c.G) {
        int mt, nt; tile_mn(t, MT, NT, mt, nt);
        f32x4 acc[2][4];
        gemm128<true>(c.lds, 2048, RowLin{H + (size_t)mt * 128 * D, (size_t)D}, RowLin{W + (size_t)nt * 128 * 2048, 2048}, acc);
#pragma unroll
        for (int mb = 0; mb < 2; ++mb) {
            const int tok = mt * 128 + 32 * wm + 16 * mb + (c.lane & 15);
            const bool lat = tok >= TC; const int s = (tok - TC) & (SEQ - 1);
            const int cw = 64 * wn + 4 * g;
            if (nt < 8) rope64_store(acc[mb], lat, s, g, 0.125f, r64, SQ + (size_t)tok * 1024 + nt * 128 + cw);
            else if (nt == 8) rope64_store(acc[mb], lat, s, g, 1.0f, r64, SK + (size_t)tok * 128 + cw);
            else if (nt == 9) rope64_store(acc[mb], false, s, g, 1.0f, r64, SV + (size_t)tok * 128 + cw);
            else if (nt < 14) rope64_store(acc[mb], false, s, g, 1.0f, r64, CQ + (size_t)tok * 512 + (nt - 10) * 128 + cw);
            else if (nt < 16) rope64_store(acc[mb], false, s, g, 1.0f, r64, CKV + (size_t)tok * 256 + (nt - 14) * 128 + cw);
            else if (wn == 0) rope64_store(acc[mb], lat, s, g, 1.0f, r64, KR + (size_t)tok * 64 + 4 * g);
        }
    }
}
__device__ __forceinline__ void phase_odd_local(const Ctx& c) {
    bf16_t* CQ = c.wb(WS_Q + 18 * MiB); bf16_t* CKV = c.wb(WS_K); const bf16_t* KR = c.wb(WS_K + 17 * MiB); bf16_t* MK = c.wb(WS_ST);
    const float* qn = c.in[13]; const float* kvn = c.in[14];
    const int l32 = c.lane & 31, hh = c.lane >> 3, part = c.lane & 7, W = c.G * 8;
    const f32x4 qw0 = *(const f32x4*)(qn + c.lane * 8), qw1 = *(const f32x4*)(qn + c.lane * 8 + 4);
    const f32x4 kw0 = *(const f32x4*)(kvn + l32 * 8), kw1 = *(const f32x4*)(kvn + l32 * 8 + 4);
    for (int t0 = c.bid * 8 + c.w; t0 < TT; t0 += 4 * W) {
        u32x4 vq[4], vk[4], vr[4];
#pragma unroll
        for (int k = 0; k < 4; ++k) {
            const int tok = t0 + k * W;
            if (tok < TT) {
                vq[k] = *(const u32x4*)(CQ + (size_t)tok * 512 + c.lane * 8);
                vk[k] = *(const u32x4*)(CKV + (size_t)tok * 256 + l32 * 8);
                vr[k] = *(const u32x4*)(KR + (size_t)tok * 64 + part * 8);
            }
        }
        __builtin_amdgcn_sched_barrier(0);
#pragma unroll
        for (int k = 0; k < 4; ++k) {
            const int tok = t0 + k * W;
            if (tok < TT) {
                {
                    const u32x4 v = vq[k];
                    float f[8] = {bf_lo(v.x), bf_hi(v.x), bf_lo(v.y), bf_hi(v.y), bf_lo(v.z), bf_hi(v.z), bf_lo(v.w), bf_hi(v.w)};
                    float ss = 0.f;
#pragma unroll
                    for (int j = 0; j < 8; ++j) ss += f[j] * f[j];
                    ss = wave_sum(ss);
                    const float rstd = rsqrtf(ss * (1.0f / 512.0f) + EPS);
                    u32x4 o; o.x = cvt_pk_bf16(f[0] * rstd * qw0[0], f[1] * rstd * qw0[1]); o.y = cvt_pk_bf16(f[2] * rstd * qw0[2], f[3] * rstd * qw0[3]);
                    o.z = cvt_pk_bf16(f[4] * rstd * qw1[0], f[5] * rstd * qw1[1]); o.w = cvt_pk_bf16(f[6] * rstd * qw1[2], f[7] * rstd * qw1[3]);
                    *(u32x4*)(CQ + (size_t)tok * 512 + c.lane * 8) = o;
                }
                {
                    const u32x4 v = vk[k];
                    float f[8] = {bf_lo(v.x), bf_hi(v.x), bf_lo(v.y), bf_hi(v.y), bf_lo(v.z), bf_hi(v.z), bf_lo(v.w), bf_hi(v.w)};
                    float ss = 0.f;
#pragma unroll
                    for (int j = 0; j < 8; ++j) ss += f[j] * f[j];
                    ss = wave_sum(ss) * 0.5f;
                    const float rstd = rsqrtf(ss * (1.0f / 256.0f) + EPS);
                    u32x4 o; o.x = cvt_pk_bf16(f[0] * rstd * kw0[0], f[1] * rstd * kw0[1]); o.y = cvt_pk_bf16(f[2] * rstd * kw0[2], f[3] * rstd * kw0[3]);
                    o.z = cvt_pk_bf16(f[4] * rstd * kw1[0], f[5] * rstd * kw1[1]); o.w = cvt_pk_bf16(f[6] * rstd * kw1[2], f[7] * rstd * kw1[3]);
                    if (c.lane < 32) *(u32x4*)(CKV + (size_t)tok * 256 + l32 * 8) = o;
                }
                *(u32x4*)(MK + ((size_t)tok * 8 + hh) * 192 + 128 + part * 8) = vr[k];
            }
        }
    }
}
__device__ __forceinline__ void phase_mla_up(const Ctx& c) {
    const bf16_t* CQ = c.wb(WS_Q + 18 * MiB); const bf16_t* CKV = c.wb(WS_K);
    const bf16_t* Wuq = c.wb(WS_WUQ); const bf16_t* Wukv = c.wb(WS_WUKV);
    bf16_t* MQ = c.wb(WS_G); bf16_t* MK = c.wb(WS_ST); bf16_t* MV = c.wb(WS_V);
    const f32x2* r64 = (const f32x2*)(c.ws + WS_ROPE + 131072);
    const int g = c.lane >> 4, wm = c.w >> 1, wn = c.w & 1;
    const int NUQ = 256 * 12, NUKV = 260 * 16;
    for (int u = c.bid; u < NUQ + NUKV; u += c.G) {
        f32x4 acc[2][4];
        if (u < NUQ) {
            int mt, nt; tile_mn(u, 256, 12, mt, nt); mt += 4;
            gemm128<true>(c.lds, 512, RowLin{CQ + (size_t)mt * 128 * 512, 512}, RowLin{Wuq + (size_t)nt * 128 * 512, 512}, acc);
            const int rr = nt * 2 + wn, part = rr % 3;
#pragma unroll
            for (int mb = 0; mb < 2; ++mb) {
                const int tok = mt * 128 + 32 * wm + 16 * mb + (c.lane & 15); const int s = (tok - TC) & (SEQ - 1);
                rope64_store(acc[mb], part == 2, s, g, 0.07216878364870322f, r64, MQ + (size_t)tok * 1536 + rr * 64 + 4 * g);
            }
        } else {
            int mt, nt; tile_mn(u - NUQ, 260, 16, mt, nt);
            gemm128<true>(c.lds, 256, RowLin{CKV + (size_t)mt * 128 * 256, 256}, RowLin{Wukv + (size_t)nt * 128 * 256, 256}, acc);
            const int head = nt >> 1;
#pragma unroll
            for (int mb = 0; mb < 2; ++mb) {
                const int tok = mt * 128 + 32 * wm + 16 * mb + (c.lane & 15);
                bf16_t* dst = (nt & 1) ? MV + ((size_t)tok * 8 + head) * 128 + 64 * wn + 4 * g : MK + ((size_t)tok * 8 + head) * 192 + 64 * wn + 4 * g;
#pragma unroll
                for (int nb = 0; nb < 4; ++nb) *(u32x2*)(dst + 16 * nb) = pack4(acc[mb][nb]);
            }
        }
    }
}

__device__ __forceinline__ int fresh_lane() { int l = __builtin_amdgcn_mbcnt_hi(~0u, __builtin_amdgcn_mbcnt_lo(~0u, 0u)); asm volatile("" : "+v"(l)); return l; }
__device__ __forceinline__ void half_pair(float v, float& a, float& b) {
    const auto rr = __builtin_amdgcn_permlane32_swap(__float_as_uint(v), __float_as_uint(v), false, false);
    a = __uint_as_float(rr[0]); b = __uint_as_float(rr[1]);
}
template <int DQK, int DV, bool SWA, bool YOUNG>
__device__ __forceinline__ void attn_body(const Ctx& c0, const bf16_t* __restrict__ qptr, int qpitch, const bf16_t* __restrict__ kptr, int kpitch,
                                          const bf16_t* __restrict__ vptr, int vpitch, bf16_t* __restrict__ optr, int opitch, int b, int q0, float sink) {
    constexpr int KS = DQK * 2 + 16, VS = DV * 2 + (DV == 128 ? 32 : 16);
    constexpr int KCPR = DQK / 8, VCPR = DV / 8, KPT = DQK / 64, VPT = DV / 64, NKS = DQK / 16, NDB = DV / 32;
    constexpr int KB = 64 * KS;
    const int lane = fresh_lane(), tid = c0.w * 64 + lane;
    LAS unsigned char* kbuf = c0.lds; LAS unsigned char* vt = c0.lds + 2 * KB;
    const int hh = lane >> 5, l31 = lane & 31, blk = (lane >> 4) & 1;
    int ntiles, kt_lo = 0;
    if (SWA) { kt_lo = (q0 - 128) >> 6; if (kt_lo < 0) kt_lo = 0; int kt_hi = (q0 + 255 + 128) >> 6; if (kt_hi > 255) kt_hi = 255; ntiles = 4 + kt_hi - kt_lo + 1; }
    else ntiles = 4 + 256;
    bf16x8 qf[NKS];
    {
        const bf16_t* qr = qptr + (size_t)(32 * c0.w + l31) * qpitch + 8 * hh;
#pragma unroll
        for (int ks = 0; ks < NKS; ++ks) qf[ks] = *(const bf16x8*)(qr + 16 * ks);
    }
    f32x16 o[NDB];
#pragma unroll
    for (int db = 0; db < NDB; ++db)
#pragma unroll
        for (int r = 0; r < 16; ++r) o[db][r] = 0.f;
    float m = SWA ? sink : -INFINITY, l = (SWA && hh == 0) ? 1.0f : 0.0f;
    const int qpos = q0 + 32 * c0.w + l31;
    u32x4 kr[KPT], vr[VPT];
#define ATT_TK(tt) ((tt) < 4 ? b * NCTX + 64 * (tt) : TC + b * SEQ + 64 * (kt_lo + (tt) - 4))
#define ATT_LOADK(tt) do { const char* _kb = (const char*)(kptr + (size_t)ATT_TK(tt) * kpitch); \
        _Pragma("unroll") for (int i = 0; i < KPT; ++i) { const int id = tid + 512 * i, row = id / KCPR, ch = id % KCPR; kr[i] = *(const u32x4*)(_kb + (unsigned)((row * kpitch + ch * 8) * 2)); } } while (0)
#define ATT_LOADV(tt) do { const char* _vb = (const char*)(vptr + (size_t)ATT_TK(tt) * vpitch); \
        _Pragma("unroll") for (int i = 0; i < VPT; ++i) { const int id = tid + 512 * i, row = id / VCPR, ch = id % VCPR; vr[i] = *(const u32x4*)(_vb + (unsigned)((row * vpitch + ch * 8) * 2)); } } while (0)
#define ATT_WRITE_K(buf) do { _Pragma("unroll") for (int i = 0; i < KPT; ++i) { const int id = tid + 512 * i, row = id / KCPR, ch = id % KCPR; *(LAS u32x4*)(kbuf + (buf) * KB + row * KS + ch * 16) = kr[i]; } } while (0)
#define ATT_WRITE_V() do { _Pragma("unroll") for (int i = 0; i < VPT; ++i) { const int id = tid + 512 * i, row = id / VCPR, ch = id % VCPR; *(LAS u32x4*)(vt + row * VS + ch * 16) = vr[i]; } } while (0)
#define ATT_QK(buf) do { _Pragma("unroll") for (int kb = 0; kb < 2; ++kb) _Pragma("unroll") for (int r = 0; r < 16; ++r) s[kb][r] = 0.f; \
        _Pragma("unroll") for (int ks = 0; ks < NKS; ++ks) _Pragma("unroll") for (int kb = 0; kb < 2; ++kb) { \
            const bf16x8 kf = *(const LAS bf16x8*)(kbuf + (buf) * KB + (32 * kb + l31) * KS + (16 * ks + 8 * hh) * 2); \
            s[kb] = __builtin_amdgcn_mfma_f32_32x32x16_bf16(kf, qf[ks], s[kb], 0, 0, 0); } } while (0)
    f32x16 s[2];
    ATT_LOADK(0); ATT_WRITE_K(0); ATT_LOADV(0);
    if (ntiles > 1) ATT_LOADK(1);
    __syncthreads();
    if (YOUNG) ATT_QK(0);
    for (int t = 0; t < ntiles; ++t) {
        __syncthreads();
        ATT_WRITE_V();
        if (t + 1 < ntiles) ATT_WRITE_K((t + 1) & 1);
        __syncthreads();
        if (t + 1 < ntiles) ATT_LOADV(t + 1);
        if (t + 2 < ntiles) ATT_LOADK(t + 2);
        if (!YOUNG) ATT_QK(t & 1);
        if (SWA && t >= 4) {
            const int kpos0 = 64 * (kt_lo + t - 4);
#pragma unroll
            for (int kb = 0; kb < 2; ++kb)
#pragma unroll
                for (int r = 0; r < 16; ++r) {
                    const int kpos = kpos0 + 32 * kb + (r & 3) + 8 * (r >> 2) + 4 * hh; const int dd = qpos - kpos;
                    if (dd > 128 || dd < -128) s[kb][r] = -INFINITY;
                }
        }
        float tm = s[0][0];
#pragma unroll
        for (int kb = 0; kb < 2; ++kb)
#pragma unroll
            for (int r = 0; r < 16; ++r) tm = fmaxf(tm, s[kb][r]);
        { float ta, tb; half_pair(tm, ta, tb); tm = fmaxf(ta, tb); }
        const float mr = fmaxf(m, tm);
        const bool upd = (mr - m) * LOG2E > 8.0f;
        const float mn = upd ? mr : m;
        const float alpha = upd ? fast_exp2((m - mn) * LOG2E) : 1.0f;
        m = mn;
        const float mnl = mn * LOG2E;
        f32x2 ps2 = {0.f, 0.f};
        const f32x2 sc2 = {LOG2E, LOG2E}, mn2 = {-mnl, -mnl};
#pragma unroll
        for (int kb = 0; kb < 2; ++kb)
#pragma unroll
            for (int r = 0; r < 16; r += 2) {
                f32x2 x = {s[kb][r], s[kb][r + 1]};
                x = __builtin_elementwise_fma(x, sc2, mn2);
                const f32x2 p = {fast_exp2(x.x), fast_exp2(x.y)};
                s[kb][r] = p.x; s[kb][r + 1] = p.y; ps2 += p;
            }
        const float ps = ps2.x + ps2.y;
        l = l * alpha + ps;
        if (!__all(alpha == 1.0f)) {
#pragma unroll
            for (int db = 0; db < NDB; ++db)
#pragma unroll
                for (int r = 0; r < 16; ++r) o[db][r] *= alpha;
        }
#pragma unroll
        for (int kb = 0; kb < 2; ++kb)
#pragma unroll
            for (int s2 = 0; s2 < 2; ++s2) {
                u32x4 pk;
                pk.x = cvt_pk_bf16(s[kb][8 * s2 + 0], s[kb][8 * s2 + 1]); pk.y = cvt_pk_bf16(s[kb][8 * s2 + 2], s[kb][8 * s2 + 3]);
                pk.z = cvt_pk_bf16(s[kb][8 * s2 + 4], s[kb][8 * s2 + 5]); pk.w = cvt_pk_bf16(s[kb][8 * s2 + 6], s[kb][8 * s2 + 7]);
                const bf16x8 pf = __builtin_bit_cast(bf16x8, pk);
                const int r0 = 32 * kb + 16 * s2 + 4 * hh;
#pragma unroll
                for (int db = 0; db < NDB; ++db) {
                    const bf16x8 vf = cat8(tr_read(vt + r0 * VS + (32 * db + 16 * blk) * 2, VS, lane), tr_read(vt + (r0 + 8) * VS + (32 * db + 16 * blk) * 2, VS, lane));
                    o[db] = __builtin_amdgcn_mfma_f32_32x32x16_bf16(vf, pf, o[db], 0, 0, 0);
                }
            }
        if (YOUNG && t + 1 < ntiles) ATT_QK((t + 1) & 1);
    }
#undef ATT_TK
#undef ATT_LOADK
#undef ATT_LOADV
#undef ATT_WRITE_K
#undef ATT_WRITE_V
#undef ATT_QK
    { float la, lb; half_pair(l, la, lb); l = la + lb; }
    const float inv = 1.0f / l;
    const int le = fresh_lane();
    bf16_t* orow = optr + (size_t)(32 * c0.w + (le & 31)) * opitch + 4 * (le >> 5);
#pragma unroll
    for (int db = 0; db < NDB; ++db)
#pragma unroll
        for (int rg = 0; rg < 4; ++rg) {
            f32x4 v = {o[db][4 * rg] * inv, o[db][4 * rg + 1] * inv, o[db][4 * rg + 2] * inv, o[db][4 * rg + 3] * inv};
            *(u32x2*)(orow + 32 * db + 8 * rg) = pack4(v);
        }
    __syncthreads();
}
template <int DQK, int DV, bool SWA>
__device__ __forceinline__ void attn_unit(const Ctx& c, const bf16_t* __restrict__ qptr, int qpitch, const bf16_t* __restrict__ kptr, int kpitch,
                                          const bf16_t* __restrict__ vptr, int vpitch, bf16_t* __restrict__ optr, int opitch, int b, int q0, float sink) {
    if (c.w < 4) attn_body<DQK, DV, SWA, false>(c, qptr, qpitch, kptr, kpitch, vptr, vpitch, optr, opitch, b, q0, sink);
    else attn_body<DQK, DV, SWA, true>(c, qptr, qpitch, kptr, kpitch, vptr, vpitch, optr, opitch, b, q0, sink);
}
__device__ __forceinline__ void phase_attention(const Ctx& c) {
    const bf16_t* MQ = c.wb(WS_G); const bf16_t* MK = c.wb(WS_ST); const bf16_t* MV = c.wb(WS_V);
    const bf16_t* SQ = c.wb(WS_A); const bf16_t* SK = c.wb(WS_Q); const bf16_t* SV = c.wb(WS_Q + 9 * MiB);
    bf16_t* CAT = c.wb(WS_CAT); const float* sink = c.in[12];
    for (int u = c.bid; u < 1024; u += c.G) {
        const int b = u >> 9, h = (u >> 6) & 7, qb = u & 63; const size_t tok0 = (size_t)TC + (size_t)b * SEQ + qb * 256;
        attn_unit<192, 128, false>(c, MQ + tok0 * 1536 + h * 192, 1536, MK + h * 192, 1536, MV + h * 128, 1024, CAT + tok0 * 2048 + 1024 + h * 128, 2048, b, qb * 256, 0.f);
    }
    for (int u = c.bid; u < 2048; u += c.G) {
        const int b = u >> 10, hq = (u >> 6) & 15, qb = u & 63; const size_t tok0 = (size_t)TC + (size_t)b * SEQ + qb * 256;
        attn_unit<64, 64, true>(c, SQ + tok0 * 1024 + hq * 64, 1024, SK + (hq >> 3) * 64, 128, SV + (hq >> 3) * 64, 128, CAT + tok0 * 2048 + hq * 64, 2048, b, qb * 256, sink[hq]);
    }
}


#ifdef DBG_TOPK_CHECK

__device__ __forceinline__ void dbg_gather_save(const Ctx& c) {
    if (c.bid >= 64) return;
    const int tok = 512 + 509 * c.bid + (c.bid & 1 ? 0 : 7);
    float* sv = (float*)(c.ws + WS_CTL + 65536) + (size_t)c.bid * 2048;
    for (int i = c.tid; i < 2048; i += 512) sv[i] = c.out[(size_t)(tok - TC) * D + i];
}
__device__ __forceinline__ void dbg_gather_check(const Ctx& c) {
    if (c.bid >= 64) return;
    const int tok = 512 + 509 * c.bid + (c.bid & 1 ? 0 : 7);
    const bf16_t* H = c.wb(WS_H); const bf16_t* TU = c.wb(WS_TABU); const bf16_t* TV = c.wb(WS_TABV);
    const int* IDX = (const int*)(c.ws + WS_IDX); const float* GATE = c.wf(WS_GATE);
    const float* sv = (const float*)(c.ws + WS_CTL + 65536) + (size_t)c.bid * 2048;
    const float* g2 = c.wf(WS_MODS) + (size_t)(0 * 3 + ((tok - TC) >> 14)) * 12288 + 5 * 2048;
    LAS float* red = (LAS float*)c.lds;
    float f0 = 0.f, f1 = 0.f, f2 = 0.f, f3 = 0.f;
    const int d0 = c.tid * 4;
    for (int e = 0; e < 128; ++e) {
        const int id = IDX[(size_t)tok * 128 + e]; const float gt = GATE[(size_t)tok * 128 + e];
        float p = 0.f;
        for (int j = 0; j < 4; ++j) p += bf2f(H[(size_t)tok * D + d0 + j]) * bf2f(TU[(size_t)id * D + d0 + j]);
        p = wave_sum(p);
        __syncthreads();
        if (c.lane == 0) red[c.w] = p;
        __syncthreads();
        float a = 0.f; for (int w = 0; w < 8; ++w) a += red[w];
        const float wgt = gt * gelu_tanh(a);
        f0 += wgt * bf2f(TV[(size_t)id * D + d0]); f1 += wgt * bf2f(TV[(size_t)id * D + d0 + 1]); f2 += wgt * bf2f(TV[(size_t)id * D + d0 + 2]); f3 += wgt * bf2f(TV[(size_t)id * D + d0 + 3]);
    }
    const float* xo = c.out + (size_t)(tok - TC) * D + d0;
    int bad = 0;
    if (fabsf(sv[d0] + g2[d0] * f0 - xo[0]) > 0.02f) bad = 16;
    if (fabsf(sv[d0 + 1] + g2[d0 + 1] * f1 - xo[1]) > 0.02f) bad = 16;
    if (fabsf(sv[d0 + 2] + g2[d0 + 2] * f2 - xo[2]) > 0.02f) bad = 16;
    if (fabsf(sv[d0 + 3] + g2[d0 + 3] * f3 - xo[3]) > 0.02f) bad = 16;
    if (bad) atomicOr((unsigned*)(c.ws + WS_CTL + 32768), (unsigned)bad);
}
__device__ __forceinline__ void dbg_topk_check(const Ctx& c) {
    const bf16_t* Qp = c.wb(WS_G); const bf16_t* SK = c.wb(WS_SKB);
    const int* IDX = (const int*)(c.ws + WS_IDX); const float* GATE = c.wf(WS_GATE);
    LAS float* sc = (LAS float*)c.lds;
    LAS int* cnt = (LAS int*)(c.lds + 2048);
    if (c.bid >= 64) return;
    const int tok = 512 + 509 * c.bid + (c.bid & 1 ? 0 : 7);
    int bad = 0;
    for (int h = 0; h < 8; ++h) {
        if (c.tid < 256) {
            const int p = c.tid >> 7, key = c.tid & 127, hp = h * 2 + p;
            float s = 0.f;
            for (int cc = 0; cc < 128; ++cc) s += bf2f(Qp[(size_t)tok * 2048 + hp * 128 + cc]) * bf2f(SK[((size_t)hp * 128 + key) * 128 + cc]);
            sc[p * 128 + key] = s;
        }
        if (c.tid == 0) cnt[0] = 0;
        __syncthreads();
        LAS float* ls = (LAS float*)(c.lds + 4096);
        if (c.tid < 16) { const int id = IDX[((size_t)tok * 8 + h) * 16 + c.tid]; ls[c.tid] = sc[(id >> 7) & 127] + sc[128 + (id & 127)]; if (id < 0 || id >= 16384) bad |= 1; }
        __syncthreads();
        float smin = 1e30f, smax = -1e30f;
        for (int k = 0; k < 16; ++k) { smin = fminf(smin, ls[k]); smax = fmaxf(smax, ls[k]); }
        for (int k = 0; k < 16; ++k) for (int k2 = k + 1; k2 < 16; ++k2) if (IDX[((size_t)tok * 8 + h) * 16 + k] == IDX[((size_t)tok * 8 + h) * 16 + k2]) bad |= 2;
        int n = 0;
        for (int i = c.tid; i < 16384; i += 512) { const float v = sc[i >> 7] + sc[128 + (i & 127)]; if (v > smin + 2e-2f) ++n; }
        atomicAdd((int*)cnt, n);
        __syncthreads();
        if (cnt[0] > 15) bad |= 4;
        float den = 0.f; for (int k = 0; k < 16; ++k) den += fast_exp2((ls[k] - smax) * LOG2E);
        for (int k = 0; k < 16; ++k) { const float gref = fast_exp2((ls[k] - smax) * LOG2E) / den; if (fabsf(gref - GATE[((size_t)tok * 8 + h) * 16 + k]) > 2e-2f) bad |= 8; }
        __syncthreads();
    }
    if (bad && c.tid == 0) atomicOr((unsigned*)(c.ws + WS_CTL + 32768), (unsigned)bad);
}
#endif

#ifdef DBG_ATTN_CHECK
__device__ __forceinline__ void dbg_attn_check(const Ctx& c) {
    if (c.bid >= 64) return;
    LAS float* sc = (LAS float*)c.lds;
    LAS float* red = (LAS float*)(c.lds + 80000);
    const bf16_t* CAT = c.wb(WS_CAT);
    int bad = 0;
    if (c.bid < 32) {
        const bf16_t* MQ = c.wb(WS_G); const bf16_t* MK = c.wb(WS_ST); const bf16_t* MV = c.wb(WS_V);
        const int b = c.bid & 1, h = (c.bid >> 1) & 7, s = (c.bid * 523 + 77) & 16383;
        const size_t tok = (size_t)TC + (size_t)b * SEQ + s;
        float lmax = -1e30f;
        for (int k = c.tid; k < 16640; k += 512) {
            const size_t kt = k < 256 ? (size_t)b * 256 + k : (size_t)TC + (size_t)b * SEQ + (k - 256);
            float a = 0.f;
            for (int d = 0; d < 192; ++d) a += bf2f(MQ[tok * 1536 + h * 192 + d]) * bf2f(MK[(kt * 8 + h) * 192 + d]);
            sc[k] = a; lmax = fmaxf(lmax, a);
        }
#pragma unroll
        for (int o = 32; o >= 1; o >>= 1) lmax = fmaxf(lmax, __shfl_xor(lmax, o));
        if (c.lane == 0) red[c.w] = lmax;
        __syncthreads();
        float mx = red[0]; for (int w = 1; w < 8; ++w) mx = fmaxf(mx, red[w]);
        __syncthreads();
        float ls = 0.f;
        for (int k = c.tid; k < 16640; k += 512) { float p = fast_exp2((sc[k] - mx) * LOG2E);
#if defined(DBG_ATTN_MODE) && DBG_ATTN_MODE == 1
            p = 1.f;
#endif
            sc[k] = p; ls += p; }
        ls = wave_sum(ls);
        if (c.lane == 0) red[c.w] = ls;
        __syncthreads();
        float den = 0.f; for (int w = 0; w < 8; ++w) den += red[w];
        if (c.tid < 128) {
            float o = 0.f;
            for (int k = 0; k < 16640; ++k) { const size_t kt = k < 256 ? (size_t)b * 256 + k : (size_t)TC + (size_t)b * SEQ + (k - 256);
#ifdef DBG_ATTN_SYNV
                o += sc[k] * (float)((((int)kt) * 3 + c.tid) & 31);
#else
                o += sc[k] * bf2f(MV[(kt * 8 + h) * 128 + c.tid]);
#endif
            }
            o /= den;
            const float got = bf2f(CAT[tok * 2048 + 1024 + h * 128 + c.tid]);
            if (fabsf(got - o) > 0.002f + 0.03f * fabsf(o)) bad = 1;

        }
    } else {
        const bf16_t* SQ = c.wb(WS_A); const bf16_t* SK = c.wb(WS_Q); const bf16_t* SV = c.wb(WS_Q + 9 * MiB);
        const int i = c.bid - 32; const int b = i & 1, hq = (i >> 1) & 15;
        const int s = i < 4 ? (i == 0 ? 0 : (i == 1 ? 16383 : (i == 2 ? 100 : 16300))) : ((i * 1021 + 333) & 16383);
        const size_t tok = (size_t)TC + (size_t)b * SEQ + s; const int hk = hq >> 3;
        const float sink = c.in[12][hq];
        const int lo = s - 128 < 0 ? 0 : s - 128, hi = s + 128 > 16383 ? 16383 : s + 128, nk = 256 + hi - lo + 1;
        float lmax = sink;
        for (int k = c.tid; k < nk; k += 512) {
            const size_t kt = k < 256 ? (size_t)b * 256 + k : (size_t)TC + (size_t)b * SEQ + lo + (k - 256);
            float a = 0.f;
            for (int d = 0; d < 64; ++d) a += bf2f(SQ[tok * 1024 + hq * 64 + d]) * bf2f(SK[kt * 128 + hk * 64 + d]);
            sc[k] = a; lmax = fmaxf(lmax, a);
        }
#pragma unroll
        for (int o = 32; o >= 1; o >>= 1) lmax = fmaxf(lmax, __shfl_xor(lmax, o));
        if (c.lane == 0) red[c.w] = lmax;
        __syncthreads();
        float mx = red[0]; for (int w = 1; w < 8; ++w) mx = fmaxf(mx, red[w]);
        __syncthreads();
        float ls = 0.f;
        for (int k = c.tid; k < nk; k += 512) { float p = fast_exp2((sc[k] - mx) * LOG2E);
#if defined(DBG_ATTN_MODE) && DBG_ATTN_MODE == 1
            p = 1.f;
#endif
            sc[k] = p; ls += p; }
        ls = wave_sum(ls);
        if (c.lane == 0) red[c.w] = ls;
        __syncthreads();
#if defined(DBG_ATTN_MODE) && DBG_ATTN_MODE == 1
        float den = 1.f;
#else
        float den = fast_exp2((sink - mx) * LOG2E);
#endif
        for (int w = 0; w < 8; ++w) den += red[w];
        if (c.tid < 64) {
            float o = 0.f;
            for (int k = 0; k < nk; ++k) { const size_t kt = k < 256 ? (size_t)b * 256 + k : (size_t)TC + (size_t)b * SEQ + lo + (k - 256); o += sc[k] * bf2f(SV[kt * 128 + hk * 64 + c.tid]); }
            o /= den;
            const float got = bf2f(CAT[tok * 2048 + hq * 64 + c.tid]);
            if (fabsf(got - o) > 0.002f + 0.03f * fabsf(o)) bad = 2;

        }
    }
    if (bad) atomicOr((unsigned*)(c.ws + WS_CTL + 32768), (unsigned)bad);
    __syncthreads();
}
#endif

typedef const f32x4 (&Acc8)[2][2][4][2];
__device__ __forceinline__ void rope64_pair(const f32x4 a, const f32x4 b, bool rotate, const f32x4 (&cs)[2], float sc, bf16_t* dst) {
    if (rotate) {
        f32x4 o1, o2;
#pragma unroll
        for (int r = 0; r < 4; ++r) { const float cx = cs[r >> 1][(r & 1) * 2], sx = cs[r >> 1][(r & 1) * 2 + 1]; const float x1 = a[r] * sc, x2 = b[r] * sc; o1[r] = x1 * cx - x2 * sx; o2[r] = x2 * cx + x1 * sx; }
        *(u32x2*)dst = pack4(o1); *(u32x2*)(dst + 16) = pack4(o2);
    } else { *(u32x2*)dst = pack4(a * sc); *(u32x2*)(dst + 16) = pack4(b * sc); }
}
__device__ __forceinline__ void rope64_load(f32x4 (&cs)[2], const f32x2* r64, int tok, int wc, int fq) {
    const int s = (tok - TC) & (SEQ - 1), pos = (wc & 1) == 0 ? (s >> 6) : (s & 63);
    const f32x4* p = (const f32x4*)(r64 + pos * 16 + 4 * fq);
    if (tok >= TC) { cs[0] = p[0]; cs[1] = p[1]; }
}
struct EpiEvenProj {
    static constexpr bool PERM = false, AFTER_DRAIN = false;
    bf16_t* F; bf16_t* Q; bf16_t* Kb; bf16_t* V; bf16_t* Gt; const f32x2* r128;
    __device__ __forceinline__ void ld_cs(f32x4 (&cs)[2], int tok, int wc, int fq) const {
        const int s = (tok - TC) & (SEQ - 1), pos = (wc >> 1) == 0 ? (s >> 6) : (s & 63);
        const f32x4* p = (const f32x4*)(r128 + pos * 32 + 16 * (wc & 1) + 4 * fq);
        if (tok >= TC) { cs[0] = p[0]; cs[1] = p[1]; }
    }
    __device__ __forceinline__ void operator()(Acc8 acc, const pg8::Unit& u, int wr, int wc, int fr, int fq) const {
        const int region = u.pn >> 2, ct = (u.pn & 3) * 256;
        const bool qk = region == 1 || region == 2;
        const int tok0 = u.pm * 256 + wr * 64 + fr;
        f32x4 cur[2], nxt[2];
        if (qk) ld_cs(cur, tok0, wc, fq);
#pragma unroll
        for (int ai = 0; ai < 2; ++ai)
#pragma unroll
            for (int m = 0; m < 4; ++m) {
                const int tok = tok0 + ai * 128 + m * 16, gi = ai * 4 + m;
                if (qk && gi + 1 < 8) ld_cs(nxt, tok0 + ((gi + 1) >> 2) * 128 + ((gi + 1) & 3) * 16, wc, fq);
#pragma unroll
                for (int bj = 0; bj < 2; ++bj) {
                    const int col = ct + bj * 128 + wc * 32 + 4 * fq;
                    if (region == 0) { *(u32x2*)(F + (size_t)tok * 1024 + col) = pack4(acc[ai][bj][m][0]); *(u32x2*)(F + (size_t)tok * 1024 + col + 16) = pack4(acc[ai][bj][m][1]); }
                    else if (region == 3) { *(u32x2*)(V + (size_t)tok * 1024 + col) = pack4(acc[ai][bj][m][0]); *(u32x2*)(V + (size_t)tok * 1024 + col + 16) = pack4(acc[ai][bj][m][1]); }
                    else if (region >= 4) {
#pragma unroll
                        for (int n = 0; n < 2; ++n) { f32x4 o;
#pragma unroll
                            for (int r = 0; r < 4; ++r) o[r] = silu_f(acc[ai][bj][m][n][r]);
                            *(u32x2*)(Gt + (size_t)tok * 2048 + (region - 4) * 1024 + col + 16 * n) = pack4(o); }
                    } else {
                        const int head = (u.pn & 3) * 2 + bj, d0 = 64 * (wc >> 1) + 16 * (wc & 1) + 4 * fq;
                        bf16_t* dst = (region == 1 ? Q : Kb) + (size_t)tok * 1024 + head * 128 + d0;
                        const float sc = region == 2 ? 0.08838834764831845f : 1.0f;
                        if (tok >= TC) {
                            f32x4 o1, o2;
#pragma unroll
                            for (int r = 0; r < 4; ++r) { const float cx = cur[r >> 1][(r & 1) * 2], sx = cur[r >> 1][(r & 1) * 2 + 1]; const float a = acc[ai][bj][m][0][r] * sc, b = acc[ai][bj][m][1][r] * sc; o1[r] = a * cx - b * sx; o2[r] = b * cx + a * sx; }
                            *(u32x2*)dst = pack4(o1); *(u32x2*)(dst + 32) = pack4(o2);
                        } else { *(u32x2*)dst = pack4(acc[ai][bj][m][0] * sc); *(u32x2*)(dst + 32) = pack4(acc[ai][bj][m][1] * sc); }
                    }
                }
                if (qk && gi + 1 < 8) { cur[0] = nxt[0]; cur[1] = nxt[1]; }
            }
    }
};
struct EpiOddProj {
    static constexpr bool PERM = false, AFTER_DRAIN = false;
    bf16_t* SQ; bf16_t* SK; bf16_t* SV; bf16_t* CQ; bf16_t* CKV; bf16_t* KR; const f32x2* r64;
    __device__ __forceinline__ void operator()(Acc8 acc, const pg8::Unit& u, int wr, int wc, int fr, int fq) const {
        const bool rot = u.pn <= 4 || u.pn == 8;
        const int tok0 = u.pm * 256 + wr * 64 + fr;
        f32x4 cur[2], nxt[2];
        if (rot) rope64_load(cur, r64, tok0, wc, fq);
#pragma unroll
        for (int ai = 0; ai < 2; ++ai)
#pragma unroll
            for (int m = 0; m < 4; ++m) {
                const int tok = tok0 + ai * 128 + m * 16, gi = ai * 4 + m;
                if (rot && gi + 1 < 8) rope64_load(nxt, r64, tok0 + ((gi + 1) >> 2) * 128 + ((gi + 1) & 3) * 16, wc, fq);
                const bool lat = tok >= TC;
#pragma unroll
                for (int bj = 0; bj < 2; ++bj) {
                    const int c0 = u.pn * 256 + bj * 128 + wc * 32 + 4 * fq;
                    const f32x4 a = acc[ai][bj][m][0], b = acc[ai][bj][m][1];
                    if (u.pn < 4) rope64_pair(a, b, lat, cur, 0.125f, SQ + (size_t)tok * 1024 + c0);
                    else if (u.pn == 4) { if (bj == 0) rope64_pair(a, b, lat, cur, 1.0f, SK + (size_t)tok * 128 + (c0 - 1024)); else rope64_pair(a, b, false, cur, 1.0f, SV + (size_t)tok * 128 + (c0 - 1152)); }
                    else if (u.pn < 7) rope64_pair(a, b, false, cur, 1.0f, CQ + (size_t)tok * 512 + (c0 - 1280));
                    else if (u.pn == 7) rope64_pair(a, b, false, cur, 1.0f, CKV + (size_t)tok * 256 + (c0 - 1792));
                    else if (bj == 0 && wc < 2) rope64_pair(a, b, lat, cur, 1.0f, KR + (size_t)tok * 64 + (c0 - 2048));
                }
                if (rot && gi + 1 < 8) { cur[0] = nxt[0]; cur[1] = nxt[1]; }
            }
    }
};
struct EpiMlaQ {
    static constexpr bool PERM = false, AFTER_DRAIN = false;
    bf16_t* MQ; const f32x2* r64;
    __device__ __forceinline__ void operator()(Acc8 acc, const pg8::Unit& u, int wr, int wc, int fr, int fq) const {
        const int tok0 = TC + u.pm * 256 + wr * 64 + fr;
        f32x4 cur[2], nxt[2];
        rope64_load(cur, r64, tok0, wc, fq);
#pragma unroll
        for (int ai = 0; ai < 2; ++ai)
#pragma unroll
            for (int m = 0; m < 4; ++m) {
                const int tok = tok0 + ai * 128 + m * 16, gi = ai * 4 + m;
                if (gi + 1 < 8) rope64_load(nxt, r64, tok0 + ((gi + 1) >> 2) * 128 + ((gi + 1) & 3) * 16, wc, fq);
#pragma unroll
                for (int bj = 0; bj < 2; ++bj) {
                    const int c0 = u.pn * 256 + bj * 128 + wc * 32 + 4 * fq; const int rr = c0 >> 6;
                    rope64_pair(acc[ai][bj][m][0], acc[ai][bj][m][1], (rr % 3) == 2, cur, 0.07216878364870322f, MQ + (size_t)tok * 1536 + c0);
                }
                if (gi + 1 < 8) { cur[0] = nxt[0]; cur[1] = nxt[1]; }
            }
    }
};
struct EpiMlaKV {
    static constexpr bool PERM = false, AFTER_DRAIN = false;
    bf16_t* MK; bf16_t* MV;
    __device__ __forceinline__ void operator()(Acc8 acc, const pg8::Unit& u, int wr, int wc, int fr, int fq) const {
#pragma unroll
        for (int ai = 0; ai < 2; ++ai)
#pragma unroll
            for (int m = 0; m < 4; ++m) {
                const int tok = u.pm * 256 + ai * 128 + wr * 64 + m * 16 + fr;
                bf16_t* k = MK + ((size_t)tok * 8 + u.pn) * 192 + wc * 32 + 4 * fq; bf16_t* v = MV + ((size_t)tok * 8 + u.pn) * 128 + wc * 32 + 4 * fq;
                *(u32x2*)k = pack4(acc[ai][0][m][0]); *(u32x2*)(k + 16) = pack4(acc[ai][0][m][1]);
                *(u32x2*)v = pack4(acc[ai][1][m][0]); *(u32x2*)(v + 16) = pack4(acc[ai][1][m][1]);
            }
    }
};
struct EpiWout {
    static constexpr bool PERM = false, AFTER_DRAIN = false;
    const float* mods; const float* xlat_old; const float* xctx_old; float* out; float* xctx_new; int layer, tok_off;
    struct Grp { f32x4 gv[2][2], xv[2][2]; float* xn; };
    __device__ __forceinline__ void load_grp(Grp& G, const pg8::Unit& u, int ai, int m, int wr, int wc, int fr, int fq) const {
        const int tok = tok_off + u.pm * 256 + ai * 128 + wr * 64 + m * 16 + fr;
        const int mw = tok < TC ? 2 : ((tok - TC) >> 14);
        const float* g1 = mods + (size_t)(layer * 3 + mw) * 12288 + 2 * 2048;
        const float* xo = tok < TC ? xctx_old + (size_t)tok * D : xlat_old + (size_t)(tok - TC) * D;
        G.xn = tok < TC ? xctx_new + (size_t)tok * D : out + (size_t)(tok - TC) * D;
#pragma unroll
        for (int bj = 0; bj < 2; ++bj)
#pragma unroll
            for (int n = 0; n < 2; ++n) {
                const int col = u.pn * 256 + bj * 128 + wc * 32 + n * 16 + 4 * fq;
                G.gv[bj][n] = *(const f32x4*)(g1 + col); G.xv[bj][n] = *(const f32x4*)(xo + col);
            }
    }
    __device__ __forceinline__ void operator()(Acc8 acc, const pg8::Unit& u, int wr, int wc, int fr, int fq) const {
        Grp cur, nxt;
        load_grp(cur, u, 0, 0, wr, wc, fr, fq);
#pragma unroll
        for (int ai = 0; ai < 2; ++ai)
#pragma unroll
            for (int m = 0; m < 4; ++m) {
                const int gi = ai * 4 + m;
                if (gi + 1 < 8) load_grp(nxt, u, (gi + 1) >> 2, (gi + 1) & 3, wr, wc, fr, fq);
#pragma unroll
                for (int bj = 0; bj < 2; ++bj)
#pragma unroll
                    for (int n = 0; n < 2; ++n) {
                        const int col = u.pn * 256 + bj * 128 + wc * 32 + n * 16 + 4 * fq;
                        *(f32x4*)(cur.xn + col) = cur.xv[bj][n] + cur.gv[bj][n] * acc[ai][bj][m][n];
                    }
                if (gi + 1 < 8) cur = nxt;
            }
    }
};
struct EpiStoreBf16 {
    static constexpr bool PERM = false, AFTER_DRAIN = false;
    bf16_t* O; int ldc;
    __device__ __forceinline__ void operator()(Acc8 acc, const pg8::Unit& u, int wr, int wc, int fr, int fq) const {
#pragma unroll
        for (int ai = 0; ai < 2; ++ai)
#pragma unroll
            for (int m = 0; m < 4; ++m) {
                bf16_t* rp = O + (size_t)(u.pm * 256 + ai * 128 + wr * 64 + m * 16 + fr) * ldc + u.pn * 256 + wc * 32 + 4 * fq;
#pragma unroll
                for (int bj = 0; bj < 2; ++bj)
#pragma unroll
                    for (int n = 0; n < 2; ++n) *(u32x2*)(rp + bj * 128 + n * 16) = pack4(acc[ai][bj][m][n]);
            }
    }
};
template <class Epi>
__device__ __forceinline__ void big_gemm(const Ctx& c, const bf16_t* A, const bf16_t* Bt, int M, int N, int K, const Epi& E) {
    pg8::Gemm g{A, Bt, M, N, K}; pg8::StaticOrder S; S.init(M, N, c.G, c.bid);
    pg8::gemm_phase<Epi, pg8::StaticOrder>((PG8_LAS unsigned char*)c.lds, g, S, E);
}
__device__ __forceinline__ void phase_even_proj2(const Ctx& c) {
    EpiEvenProj E{c.wb(WS_A), c.wb(WS_Q), c.wb(WS_K), c.wb(WS_V), c.wb(WS_G), (const f32x2*)(c.ws + WS_ROPE)};
    big_gemm(c, c.wb(WS_H), c.wb(WS_WINE), TT, 6144, 2048, E);
    const int busy = (TT / 256) * 24 - 12 * c.G;
    if (busy > 0 && busy < c.G && c.bid >= busy) {
        conv_fp4(c, c.in[20] + (size_t)16384 * 2048, c.ws + WS_TABU + 32 * MiB, 16384, U_SCALE, c.bid - busy, c.G - busy);
        conv_fp4(c, c.in[21] + (size_t)16384 * 2048, c.ws + WS_TABV + 32 * MiB, 16384, V_SCALE, c.bid - busy, c.G - busy);
    } else if (!(busy > 0 && busy < c.G)) {
        conv_fp4(c, c.in[20] + (size_t)16384 * 2048, c.ws + WS_TABU + 32 * MiB, 16384, U_SCALE, c.bid, c.G);
        conv_fp4(c, c.in[21] + (size_t)16384 * 2048, c.ws + WS_TABV + 32 * MiB, 16384, V_SCALE, c.bid, c.G);
    }
}
__device__ __forceinline__ void phase_odd_proj2(const Ctx& c) {
    EpiOddProj E{c.wb(WS_A), c.wb(WS_Q), c.wb(WS_Q + 9 * MiB), c.wb(WS_Q + 18 * MiB), c.wb(WS_K), c.wb(WS_K + 17 * MiB), (const f32x2*)(c.ws + WS_ROPE + 131072)};
    big_gemm(c, c.wb(WS_H), c.wb(WS_WINO), TT, 2304, 2048, E);
}
__device__ __forceinline__ void phase_mla_up2(const Ctx& c) {
    EpiMlaQ EQ{c.wb(WS_G), (const f32x2*)(c.ws + WS_ROPE + 131072)};
    big_gemm(c, c.wb(WS_Q + 18 * MiB) + (size_t)TC * 512, c.wb(WS_WUQ), TL, 1536, 512, EQ);
    EpiMlaKV EK{c.wb(WS_ST), c.wb(WS_V)};
    big_gemm(c, c.wb(WS_K), c.wb(WS_WUKV), TT, 2048, 256, EK);
}
__device__ __forceinline__ void phase_wout2(const Ctx& c, const bf16_t* W, int layer, const float* xlat_old, const float* xctx_old, int tok_off) {
    EpiWout E{c.wf(WS_MODS), xlat_old, xctx_old, c.out, c.wf(WS_XCTX), layer, tok_off};
    big_gemm(c, c.wb(WS_CAT) + (size_t)tok_off * 2048, W, TT - tok_off, 2048, 2048, E);
}
__device__ __forceinline__ void phase_peer_q2(const Ctx& c, const bf16_t* W, int tok_off) {
    EpiStoreBf16 E{c.wb(WS_G) + (size_t)tok_off * 2048, 2048};
    big_gemm(c, c.wb(WS_H) + (size_t)tok_off * 2048, W, TT - tok_off, 2048, 2048, E);
}

#ifdef DBG_FOURIER_CHECK
__device__ __forceinline__ void dbg_fourier_check(const Ctx& c) {
    if (c.bid >= 48) return;
    const bf16_t* F = c.wb(WS_A); const bf16_t* CAT = c.wb(WS_CAT);
    LAS float* red = (LAS float*)c.lds;
    const int i = c.bid;
    const bool lat = i >= 32;
    const int b = i & 1, g = (i >> 1) & 3, m = (i * 53 + 7) & 255;
    const int L = lat ? 16384 : 256;
    const int k = lat ? ((i * 2731 + 11) & 16383) : ((i * 37 + 3) & 255);
    const size_t tok0 = lat ? (size_t)TC + (size_t)b * SEQ : (size_t)b * NCTX;
    float acc = 0.f;
    for (int n = c.tid; n < L; n += 512) {
        const float fa = (float)(((long long)k * n) % L) / (float)L;
        float rs = 0.f;
        for (int cc = 0; cc < 256; ++cc) {
            const float fb = (float)((m * cc) & 255) * (1.0f / 256.0f);
            float fr = fa + fb; fr = fr - floorf(fr);
            rs += bf2f(F[(tok0 + n) * 1024 + g * 256 + cc]) * cos_rev(fr);
        }
        acc += rs;
    }
    acc = wave_sum(acc);
    if (c.lane == 0) red[c.w] = acc;
    __syncthreads();
    float tot = 0.f; for (int w = 0; w < 8; ++w) tot += red[w];
    tot *= lat ? (1.0f / 2048.0f) : (1.0f / 256.0f);
    const float got = bf2f(CAT[(tok0 + k) * 2048 + g * 256 + m]);
    if (c.tid == 0 && fabsf(got - tot) > 0.03f + 0.03f * fabsf(tot)) atomicOr((unsigned*)(c.ws + WS_CTL + 32768), lat ? 2u : 1u);
    __syncthreads();
}
#endif
#ifdef DBG_RET_CHECK
__device__ __forceinline__ void dbg_ret_check(const Ctx& c) {
    if (c.bid >= 32) return;
    const bf16_t* Q = c.wb(WS_Q); const bf16_t* Kb = c.wb(WS_K); const bf16_t* V = c.wb(WS_V); const bf16_t* Gt = c.wb(WS_G); const bf16_t* CAT = c.wb(WS_CAT);
    const float* gn = c.in[9];
    LAS float* wgt = (LAS float*)c.lds;
    LAS float* red = (LAS float*)(c.lds + 80000);
    const int i = c.bid, b = i & 1, h = (i >> 1) & 7;
    const bool isctx = i >= 26;
    const int pos = isctx ? (i == 26 ? 5 : (i == 27 ? 130 : (i == 28 ? 255 : (i == 29 ? 0 : (i * 41) & 255))))
                          : (i == 0 ? 0 : (i == 1 ? 16383 : (i == 2 ? 127 : (i == 3 ? 128 : (i * 1637 + 29) & 16383))));
    const size_t tokT = isctx ? (size_t)b * NCTX + pos : (size_t)TC + (size_t)b * SEQ + pos;
    const float lg = log2_gamma(h);
    float yacc = 0.f;
    for (int dir = 0; dir < 2; ++dir) {
        const int nkeys = isctx ? 256 : 256 + 16384;
        for (int j = c.tid; j < nkeys; j += 512) {
            const bool kc = j < 256; const int kp = kc ? j : j - 256;
            const size_t tokK = kc ? (size_t)b * NCTX + kp : (size_t)TC + (size_t)b * SEQ + kp;
            int dist;
            if (isctx) dist = dir == 0 ? pos - kp : kp - pos;
            else if (kc) dist = dir == 0 ? 256 + pos - kp : 16384 - pos + kp;
            else dist = dir == 0 ? pos - kp : kp - pos;
            float w = 0.f;
            if (dist >= 0) {
                float d = 0.f;
                for (int x = 0; x < 128; ++x) d += bf2f(Q[tokT * 1024 + h * 128 + x]) * bf2f(Kb[tokK * 1024 + h * 128 + x]);
                w = d * fast_exp2(lg * (float)dist);
            }
            wgt[j] = w;
        }
        __syncthreads();
        float o = 0.f;
        if (c.tid < 128) {
            for (int j = 0; j < nkeys; ++j) {
                const float w = wgt[j];
                if (w != 0.f) { const bool kc = j < 256; const int kp = kc ? j : j - 256; const size_t tokK = kc ? (size_t)b * NCTX + kp : (size_t)TC + (size_t)b * SEQ + kp;
                    o += w * bf2f(V[tokK * 1024 + h * 128 + c.tid]); }
            }
        }
        float ss = (c.tid < 128) ? o * o : 0.f;
        ss = wave_sum(ss);
        if (c.lane == 0) red[c.w] = ss;
        __syncthreads();
        const float tot = red[0] + red[1];
        const float rstd = rsqrtf(tot * (1.0f / 128.0f) + EPS);
        if (c.tid < 128) yacc += o * rstd * gn[h * 128 + c.tid] * bf2f(Gt[tokT * 2048 + dir * 1024 + h * 128 + c.tid]);
        __syncthreads();
    }
    if (c.tid < 128) {
        const float got = bf2f(CAT[tokT * 2048 + 1024 + h * 128 + c.tid]);
        if (fabsf(got - yacc) > 0.04f + 0.05f * fabsf(yacc)) atomicOr((unsigned*)(c.ws + WS_CTL + 32768), isctx ? 8u : 4u);
    }
    __syncthreads();
}
#endif
__global__ void __launch_bounds__(512, 2) fwd_kernel(KArgs a) {
    extern __shared__ __attribute__((aligned(16))) unsigned char shm[];
    Ctx c;
#pragma unroll
    for (int i = 0; i < 23; ++i) c.in[i] = a.in[i];
    c.out = a.out; c.ws = a.ws; c.lds = (LAS unsigned char*)shm; c.G = gridDim.x; c.bid = blockIdx.x; c.tid = threadIdx.x; c.lane = threadIdx.x & 63;
    c.w = __builtin_amdgcn_readfirstlane(threadIdx.x >> 6);
    const int lo = a.ph_lo, hi = a.ph_hi;
    volatile LAS unsigned* bw = (volatile LAS unsigned*)(c.lds + LDS_BYTES - 16);
    XcdBarrier bar; bar.bar = (unsigned*)(a.ws + WS_CTL); bar.x = 0; bar.st = bw;
    if (hi - lo > 1) {
        if (threadIdx.x == 0) { bw[0] = 0u; bw[1] = 0u; bw[2] = 0u; bw[3] = 0u; }
        __syncthreads();
        bar = xcd_barrier_post((unsigned*)(a.ws + WS_CTL), bw);
    }
#define IN(k) (((PHASE_MASK >> (k)) & 1u) && lo <= (k) && (k) < hi)
#define SEAM(k) do { if (IN(k) && IN((k) + 1)) xcd_barrier(bar); } while (0)
    float* XCTX = c.wf(WS_XCTX); bf16_t* H = c.wb(WS_H);
    if (IN(0)) phase_prologue(c);
    SEAM(0);
    if (IN(1)) phase_mods(c);
    SEAM(1);
    if (IN(2)) phase_modnorm(c, 0, 0, c.in[0], c.in[2], 0, H);
    SEAM(2);
    if (IN(3)) phase_even_proj2(c);
    SEAM(3);
    if (IN(4)) phase_chan_dft(c);
    SEAM(4);
    if (IN(5)) phase_dft_stage1(c);
    SEAM(5);
    if (IN(6)) { phase_dft_stage2(c); phase_ret_ds(c); }
    SEAM(6);
    if (IN(7)) phase_ret_scan(c);
    SEAM(7);
    if (IN(8)) phase_ret_out(c);
    SEAM(8);
#ifdef DBG_FOURIER_CHECK
    if (IN(9)) dbg_fourier_check(c);
#endif
#ifdef DBG_RET_CHECK
    if (IN(9)) dbg_ret_check(c);
#endif
    if (IN(9)) { phase_wout2(c, c.wb(WS_WOUTE), 0, c.in[0], c.in[2], TC); phase_wout(c, c.wb(WS_WOUTE), 0, c.in[0], c.in[2], 0, TC / 128); }
    SEAM(9);
    if (IN(10)) phase_modnorm(c, 0, 1, c.out, XCTX, 0, H);
    SEAM(10);
    if (IN(11)) { phase_peer_q2(c, c.wb(WS_WQ0), TC); phase_peer_q(c, c.wb(WS_WQ0), 0, TC / 128); }
    SEAM(11);
    if (IN(12)) phase_peer_topk(c, 0, 0);
    SEAM(12);
#ifdef DBG_TOPK_CHECK
    if (lo == 12) dbg_gather_save(c);
#endif
    if (IN(13)) phase_peer_gather<false>(c, 0, 0);
    SEAM(13);
#ifdef DBG_TOPK_CHECK
    if (lo == 13) dbg_topk_check(c);
    if (lo == 14) dbg_gather_check(c);
#endif
    if (IN(14)) {
        phase_modnorm(c, 1, 0, c.out, XCTX, 0, H);
    }
    SEAM(14);
    if (IN(15)) phase_odd_proj2(c);
    SEAM(15);
    if (IN(16)) phase_odd_local(c);
    SEAM(16);
    if (IN(17)) phase_mla_up2(c);
    SEAM(17);
    if (IN(18)) phase_attention(c);
    SEAM(18);
#ifdef DBG_ATTN_CHECK
    if (IN(19)) dbg_attn_check(c);
#endif
    if (IN(19)) phase_wout2(c, c.wb(WS_WOUTO), 1, c.out, XCTX, TC);
    SEAM(19);
    if (IN(20)) phase_modnorm(c, 1, 1, c.out, XCTX, TC, H);
    SEAM(20);
    if (IN(21)) phase_peer_q2(c, c.wb(WS_WQ1), TC);
    SEAM(21);
    if (IN(22)) phase_peer_topk(c, 1, 4);
    SEAM(22);
    if (IN(23)) phase_peer_gather<true>(c, 1, TC);
#ifdef DUMP_OFF
    if (lo == NPH - 1) { const bf16_t* src = c.wb(DUMP_OFF); for (size_t i = (size_t)c.bid * 512 + c.tid; i < (size_t)TL * D; i += (size_t)c.G * 512) { float v = bf2f(src[i]); c.out[i] = (v == v && fabsf(v) < 1e30f) ? v : 777.0f; } }
#endif
#undef IN
#undef SEAM
}

extern "C" void kernel_launch(void* const* d_in, const int* in_sizes, int n_in, void* d_out, int out_size, void* d_ws, size_t ws_size, hipStream_t stream) {
    static int grid = 0;
    if (grid == 0) {
        if (n_in != 23 || ws_size < WS_END) { fprintf(stderr, "kernel_launch: unexpected n_in %d / ws %zu\n", n_in, ws_size); grid = -1; return; }
        int dev = 0, cus = 0, per_cu = 0;
        hipGetDevice(&dev);
        hipDeviceGetAttribute(&cus, hipDeviceAttributeMultiprocessorCount, dev);
        if (hipFuncSetAttribute((const void*)fwd_kernel, hipFuncAttributeMaxDynamicSharedMemorySize, LDS_BYTES) != hipSuccess) { fprintf(stderr, "hipFuncSetAttribute failed\n"); grid = -1; return; }
        if (hipOccupancyMaxActiveBlocksPerMultiprocessor(&per_cu, (const void*)fwd_kernel, 512, LDS_BYTES) != hipSuccess || per_cu < 1) { fprintf(stderr, "occupancy query: %d\n", per_cu); }
        (void)hipGetLastError();
        grid = cus > 0 ? cus : 256;
    }
    if (grid < 0) return;
    hipMemsetAsync((char*)d_ws + WS_CTL, 0, 65536, stream);
    KArgs a{};
    for (int i = 0; i < 23; ++i) a.in[i] = (const float*)d_in[i];
    a.out = (float*)d_out; a.ws = (unsigned char*)d_ws;
#if N_LAUNCHES == 1
    a.ph_lo = 0; a.ph_hi = NPH;
    hipLaunchKernelGGL(fwd_kernel, dim3(grid), dim3(512), LDS_BYTES, stream, a);
#else
    { static const int order[NPH] = {0,1,2,3,4,5,6,7,8,9,10,11,12,13,14,15,16,17,18,19,20,21,22,23};
      for (int i = 0; i < NPH; ++i) { const int k = order[i]; a.ph_lo = k; a.ph_hi = k + 1; hipLaunchKernelGGL(fwd_kernel, dim3(grid), dim3(512), LDS_BYTES, stream, a); } }
#endif
}
```

```cpp
#include <hip/hip_runtime.h>
#include <stdint.h>
#include <stdio.h>

#ifndef N_LAUNCHES
#define N_LAUNCHES 1
#endif
#ifndef DBG_SKIP_GATHER
#define DBG_SKIP_GATHER 0
#endif
#ifndef DBG_CAT_PART
#define DBG_CAT_PART 0

#endif
#ifndef PHASE_MASK
#define PHASE_MASK 0xFFFFFFu
#endif

#define LAS __attribute__((address_space(3)))
typedef unsigned short bf16_t;
typedef short bf16x8 __attribute__((ext_vector_type(8)));
typedef short s16x4 __attribute__((ext_vector_type(4)));
typedef float f32x2 __attribute__((ext_vector_type(2)));
typedef float f32x4 __attribute__((ext_vector_type(4)));
typedef float f32x16 __attribute__((ext_vector_type(16)));
typedef unsigned u32x2 __attribute__((ext_vector_type(2)));
typedef unsigned u32x4 __attribute__((ext_vector_type(4)));
typedef __bf16 bf16x2_t __attribute__((ext_vector_type(2)));

constexpr int D = 2048, NBATCH = 2, SEQ = 16384, NCTX = 256;
constexpr int TC = NBATCH * NCTX;
constexpr int TL = NBATCH * SEQ;
constexpr int TT = TC + TL;
constexpr int NCH = 130;
constexpr float EPS = 1e-6f;
constexpr float LOG2E = 1.4426950408889634f;
constexpr float U_SCALE = 90.5f, V_SCALE = 2.0f;

constexpr size_t MiB = 1ull << 20;
constexpr size_t WS_CTL = 0;
constexpr size_t WS_MODS = 1 * MiB;
constexpr size_t WS_MODP = 2 * MiB;
constexpr size_t WS_ROPE = 12 * MiB;
constexpr size_t WS_DFT = 13 * MiB;
constexpr size_t WS_SKB = 14 * MiB;
constexpr size_t WS_XCTX = 15 * MiB;
constexpr size_t WS_W = 19 * MiB;
constexpr size_t WS_WINE = WS_W;
constexpr size_t WS_WOUTE = WS_WINE + 24 * MiB;
constexpr size_t WS_WINO = WS_WOUTE + 8 * MiB;
constexpr size_t WS_WUQ = WS_WINO + 9 * MiB;
constexpr size_t WS_WUKV = WS_WUQ + 2 * MiB;
constexpr size_t WS_WOUTO = WS_WUKV + 1 * MiB;
constexpr size_t WS_WQ0 = WS_WOUTO + 8 * MiB;
constexpr size_t WS_WQ1 = WS_WQ0 + 8 * MiB;
constexpr size_t WS_TABU = 88 * MiB;
constexpr size_t WS_TABV = WS_TABU + 64 * MiB;
constexpr size_t WS_H = 216 * MiB;
constexpr size_t WS_A = 346 * MiB;
constexpr size_t WS_Q = 411 * MiB;
constexpr size_t WS_K = 476 * MiB;
constexpr size_t WS_V = 541 * MiB;
constexpr size_t WS_G = 606 * MiB;
constexpr size_t WS_CAT = 736 * MiB;
constexpr size_t WS_ST = 866 * MiB;
constexpr size_t WS_IDX = 998 * MiB;
constexpr size_t WS_GATE = 1015 * MiB;
constexpr size_t WS_END = 1032 * MiB;

constexpr int LDS_BYTES = 147456;
constexpr int NPH = 24;

#define XB_TMO      128
#define XB_XCNT(j)  (256  + 64 * (j))
#define XB_XSUB(j)  (1280 + 64 * (j))
#define XB_XGEN(j)  (2304 + 64 * (j))
#define XB_TOP      3328
#define XB_TOPGEN   3392
#define XCD_BAR_WORDS 3456
#define XB_SPIN_CAP (1u << 24)

__device__ __forceinline__ unsigned xb_ld(unsigned* p)              { return __hip_atomic_load(p, __ATOMIC_RELAXED, __HIP_MEMORY_SCOPE_AGENT); }
__device__ __forceinline__ unsigned xb_add(unsigned* p, unsigned v) { return __hip_atomic_fetch_add(p, v, __ATOMIC_RELAXED, __HIP_MEMORY_SCOPE_AGENT); }
__device__ __forceinline__ unsigned xb_xcc_id() { return (unsigned)__builtin_amdgcn_s_getreg((3 << 11) | 20) & 0xFu; }
#define XB_SPIN(cond, bar) do { unsigned _sp = 0; while (cond) { __builtin_amdgcn_s_sleep(1); \
    if ((++_sp & 255u) == 0u) { if (xb_ld(&(bar)[XB_TMO])) break; if (_sp > XB_SPIN_CAP) { atomicAdd(&(bar)[XB_TMO], 1u); break; } } } } while (0)

struct XcdBarrier { unsigned* bar; unsigned x; volatile LAS unsigned* st; };

__device__ __forceinline__ XcdBarrier xcd_barrier_post(unsigned* bar, volatile LAS unsigned* st) {
    XcdBarrier b; b.bar = bar; b.x = xb_xcc_id(); b.st = st;
    if (threadIdx.x == 0) (void)xb_add(&bar[XB_XCNT(b.x)], 1u);
    return b;
}
__device__ __forceinline__ void xcd_barrier_complete(unsigned* bar, unsigned x, unsigned& nloc, unsigned& nx) {
    const unsigned G = gridDim.x * gridDim.y * gridDim.z;
    unsigned sum, cnt, mine, sp = 0u;
    for (;;) {
        sum = 0u; cnt = 0u; mine = 0u;
#pragma unroll
        for (unsigned j = 0; j < 16; ++j) { const unsigned c = xb_ld(&bar[XB_XCNT(j)]); sum += c; cnt += (c > 0u) ? 1u : 0u; mine = (j == x) ? c : mine; }
        if (sum == G) break;
        __builtin_amdgcn_s_sleep(1);
        if ((++sp & 255u) == 0u) { if (xb_ld(&bar[XB_TMO])) break; if (sp > XB_SPIN_CAP) { atomicAdd(&bar[XB_TMO], 1u); break; } }
    }
    nloc = mine > 0u ? mine : 1u; nx = cnt > 0u ? cnt : 1u;
}
__device__ __forceinline__ void xcd_barrier(const XcdBarrier& b) {
    asm volatile("s_waitcnt vmcnt(0)" ::: "memory");
    __syncthreads();
    if (threadIdx.x == 0) {
        unsigned* bar = b.bar;
        __builtin_amdgcn_s_waitcnt(0);
        unsigned nloc = b.st[0], nx = b.st[1];
        if (nloc == 0u) { xcd_barrier_complete(bar, b.x, nloc, nx); b.st[0] = nloc; b.st[1] = nx; }
        const unsigned old = xb_add(&bar[XB_XSUB(b.x)], 1u);
        const unsigned gen = old / nloc;
        if (old + 1u == (gen + 1u) * nloc) {
            __builtin_amdgcn_fence(__ATOMIC_RELEASE, "agent");
            asm volatile("s_waitcnt vmcnt(0)" ::: "memory");
            const unsigned og = xb_add(&bar[XB_TOP], 1u);
            const unsigned tg = og / nx;
            if (og + 1u == (tg + 1u) * nx) xb_add(&bar[XB_TOPGEN], 1u);
            else XB_SPIN(xb_ld(&bar[XB_TOPGEN]) == tg, bar);
            __builtin_amdgcn_fence(__ATOMIC_ACQUIRE, "agent");
            xb_add(&bar[XB_XGEN(b.x)], 1u);
            asm volatile("s_waitcnt vmcnt(0)" ::: "memory");
        } else {
            XB_SPIN(xb_ld(&bar[XB_XGEN(b.x)]) == gen, bar);
            __builtin_amdgcn_fence(__ATOMIC_ACQUIRE, "agent");
            asm volatile("s_waitcnt vmcnt(0)" ::: "memory");
        }
    }
    __syncthreads();
}

__device__ __forceinline__ unsigned cvt_pk_bf16(float lo, float hi) { const f32x2 v = {lo, hi}; const bf16x2_t r = __builtin_convertvector(v, bf16x2_t); return __builtin_bit_cast(unsigned, r); }
__device__ __forceinline__ float bf_lo(unsigned u) { return __uint_as_float(u << 16); }
__device__ __forceinline__ float bf_hi(unsigned u) { return __uint_as_float(u & 0xffff0000u); }
__device__ __forceinline__ float bf2f(bf16_t b) { return __uint_as_float(((unsigned)b) << 16); }
__device__ __forceinline__ u32x2 pack4(f32x4 v) { u32x2 r; r.x = cvt_pk_bf16(v[0], v[1]); r.y = cvt_pk_bf16(v[2], v[3]); return r; }
__device__ __forceinline__ float fast_exp2(float x) { return __builtin_amdgcn_exp2f(x); }
__device__ __forceinline__ float fast_rcp(float x) { return __builtin_amdgcn_rcpf(x); }
__device__ __forceinline__ float silu_f(float x) { return x * fast_rcp(1.0f + fast_exp2(-x * LOG2E)); }
__device__ __forceinline__ float gelu_tanh(float x) {
    const float u = 0.7978845608028654f * (x + 0.044715f * x * x * x);
    return x * fast_rcp(1.0f + fast_exp2(-2.0f * LOG2E * u));
}
__device__ __forceinline__ float wave_sum(float v) {
#pragma unroll
    for (int o = 32; o >= 1; o >>= 1) v += __shfl_xor(v, o);
    return v;
}
__device__ __forceinline__ float cos_rev(float fr) { return __builtin_amdgcn_cosf(fr); }
__device__ __forceinline__ float sin_rev(float fr) { return __builtin_amdgcn_sinf(fr); }
__device__ __forceinline__ float log2_gamma(int h) {
    const float x = __uint_as_float((unsigned)(127 - 5 - h) << 23);
    float s = x * (1.0f + x * (0.5f + x * (0.33333334f + x * (0.25f + x * (0.2f + x * (0.16666667f + x * 0.14285715f))))));
    return -s * LOG2E;
}

__device__ __forceinline__ int tok_batch(int tok) { return tok < TC ? (tok >> 8) : ((tok - TC) >> 14); }

constexpr int GEMM_LDS = 73728;
template <bool TRANS, class AF, class BF>
__device__ __forceinline__ void gemm128(LAS unsigned char* lds, int K, const AF& arow, const BF& brow, f32x4 (&acc)[2][4]) {
    const int tid = threadIdx.x, lane = tid & 63, w = tid >> 6, wm = w >> 1, wn = w & 1;
    const int r0 = tid >> 3, ch = tid & 7;
    const bf16_t* pa0 = arow(r0) + ch * 8; const bf16_t* pa1 = arow(r0 + 64) + ch * 8;
    const bf16_t* pb0 = brow(r0) + ch * 8; const bf16_t* pb1 = brow(r0 + 64) + ch * 8;
    const int woff = r0 * 144 + ch * 16;
#pragma unroll
    for (int mb = 0; mb < 2; ++mb)
#pragma unroll
        for (int nb = 0; nb < 4; ++nb) acc[mb][nb] = (f32x4){0.f, 0.f, 0.f, 0.f};
    u32x4 ra0 = *(const u32x4*)pa0, ra1 = *(const u32x4*)pa1, rb0 = *(const u32x4*)pb0, rb1 = *(const u32x4*)pb1;
    *(LAS u32x4*)(lds + woff) = ra0; *(LAS u32x4*)(lds + woff + 9216) = ra1;
    *(LAS u32x4*)(lds + 36864 + woff) = rb0; *(LAS u32x4*)(lds + 36864 + woff + 9216) = rb1;
    __syncthreads();
    const int nk = K >> 6;
    const int aoff = (32 * wm + (lane & 15)) * 144 + (lane >> 4) * 16;
    const int boff = 36864 + (64 * wn + (lane & 15)) * 144 + (lane >> 4) * 16;
    for (int kt = 0; kt < nk; ++kt) {
        const int buf = (kt & 1) * 18432;
        if (kt + 1 < nk) {
            const int ko = (kt + 1) * 64;
            ra0 = *(const u32x4*)(pa0 + ko); ra1 = *(const u32x4*)(pa1 + ko); rb0 = *(const u32x4*)(pb0 + ko); rb1 = *(const u32x4*)(pb1 + ko);
        }
#pragma unroll
        for (int ks = 0; ks < 2; ++ks) {
            bf16x8 af[2], bfr[4];
#pragma unroll
            for (int mb = 0; mb < 2; ++mb) af[mb] = *(const LAS bf16x8*)(lds + buf + aoff + mb * 2304 + ks * 64);
#pragma unroll
            for (int nb = 0; nb < 4; ++nb) bfr[nb] = *(const LAS bf16x8*)(lds + buf + boff + nb * 2304 + ks * 64);
#pragma unroll
            for (int mb = 0; mb < 2; ++mb)
#pragma unroll
                for (int nb = 0; nb < 4; ++nb)
                    acc[mb][nb] = TRANS ? __builtin_amdgcn_mfma_f32_16x16x32_bf16(bfr[nb], af[mb], acc[mb][nb], 0, 0, 0)
                                        : __builtin_amdgcn_mfma_f32_16x16x32_bf16(af[mb], bfr[nb], acc[mb][nb], 0, 0, 0);
        }
        if (kt + 1 < nk) {
            const int nb2 = ((kt + 1) & 1) * 18432;
            *(LAS u32x4*)(lds + nb2 + woff) = ra0; *(LAS u32x4*)(lds + nb2 + woff + 9216) = ra1;
            *(LAS u32x4*)(lds + 36864 + nb2 + woff) = rb0; *(LAS u32x4*)(lds + 36864 + nb2 + woff + 9216) = rb1;
        }
        __syncthreads();
    }
}
template <bool TRANS, int K, class AF, class BF>
__device__ __forceinline__ void gemm128s(LAS unsigned char* lds, const AF& arow, const BF& brow, f32x4 (&acc)[2][4]) {
    constexpr int NK = K / 64, DEPTH = NK < 4 ? NK : 4;
    const int tid = threadIdx.x, lane = tid & 63, w = tid >> 6, wm = w >> 1, wn = w & 1;
    const int r0 = tid >> 3, ch = tid & 7;
    const bf16_t* pa0 = arow(r0) + ch * 8; const bf16_t* pa1 = arow(r0 + 64) + ch * 8;
    const bf16_t* pb0 = brow(r0) + ch * 8; const bf16_t* pb1 = brow(r0 + 64) + ch * 8;
    const int woff = r0 * 144 + ch * 16;
    u32x4 rg[DEPTH][4];
#pragma unroll
    for (int d = 0; d < DEPTH; ++d) {
        rg[d][0] = *(const u32x4*)(pa0 + d * 64); rg[d][1] = *(const u32x4*)(pa1 + d * 64);
        rg[d][2] = *(const u32x4*)(pb0 + d * 64); rg[d][3] = *(const u32x4*)(pb1 + d * 64);
    }
    __builtin_amdgcn_sched_barrier(0);
#pragma unroll
    for (int mb = 0; mb < 2; ++mb)
#pragma unroll
        for (int nb = 0; nb < 4; ++nb) acc[mb][nb] = (f32x4){0.f, 0.f, 0.f, 0.f};
    *(LAS u32x4*)(lds + woff) = rg[0][0]; *(LAS u32x4*)(lds + woff + 9216) = rg[0][1];
    *(LAS u32x4*)(lds + 36864 + woff) = rg[0][2]; *(LAS u32x4*)(lds + 36864 + woff + 9216) = rg[0][3];
    __syncthreads();
    const int aoff = (32 * wm + (lane & 15)) * 144 + (lane >> 4) * 16;
    const int boff = 36864 + (64 * wn + (lane & 15)) * 144 + (lane >> 4) * 16;
#pragma unroll
    for (int kt = 0; kt < NK; ++kt) {
        const int buf = (kt & 1) * 18432;
        if (kt + DEPTH < NK) {
            const int ko = (kt + DEPTH) * 64;
            rg[kt % DEPTH][0] = *(const u32x4*)(pa0 + ko); rg[kt % DEPTH][1] = *(const u32x4*)(pa1 + ko);
            rg[kt % DEPTH][2] = *(const u32x4*)(pb0 + ko); rg[kt % DEPTH][3] = *(const u32x4*)(pb1 + ko);
            __builtin_amdgcn_sched_barrier(0);
        }
#pragma unroll
        for (int ks = 0; ks < 2; ++ks) {
            bf16x8 af[2], bfr[4];
#pragma unroll
            for (int mb = 0; mb < 2; ++mb) af[mb] = *(const LAS bf16x8*)(lds + buf + aoff + mb * 2304 + ks * 64);
#pragma unroll
            for (int nb = 0; nb < 4; ++nb) bfr[nb] = *(const LAS bf16x8*)(lds + buf + boff + nb * 2304 + ks * 64);
#pragma unroll
            for (int mb = 0; mb < 2; ++mb)
#pragma unroll
                for (int nb = 0; nb < 4; ++nb)
                    acc[mb][nb] = TRANS ? __builtin_amdgcn_mfma_f32_16x16x32_bf16(bfr[nb], af[mb], acc[mb][nb], 0, 0, 0)
                                        : __builtin_amdgcn_mfma_f32_16x16x32_bf16(af[mb], bfr[nb], acc[mb][nb], 0, 0, 0);
        }
        if (kt + 1 < NK) {
            const int nb2 = ((kt + 1) & 1) * 18432; constexpr int dummy = 0; (void)dummy;
            const int s = (kt + 1) % DEPTH;
            *(LAS u32x4*)(lds + nb2 + woff) = rg[s][0]; *(LAS u32x4*)(lds + nb2 + woff + 9216) = rg[s][1];
            *(LAS u32x4*)(lds + 36864 + nb2 + woff) = rg[s][2]; *(LAS u32x4*)(lds + 36864 + nb2 + woff + 9216) = rg[s][3];
        }
        __syncthreads();
    }
}
template <bool TRANS, class AF, class BF>
__device__ __forceinline__ void gemm128r(LAS unsigned char* lds, int K, const AF& arow, const BF& brow, f32x4 (&acc)[2][4]) {
    const int tid = threadIdx.x, lane = tid & 63, w = tid >> 6, wm = w >> 1, wn = w & 1;
    const int r0 = tid >> 3, ch = tid & 7;
    const bf16_t* pa0 = arow(r0) + ch * 8; const bf16_t* pa1 = arow(r0 + 64) + ch * 8;
    const bf16_t* pb0 = brow(r0) + ch * 8; const bf16_t* pb1 = brow(r0 + 64) + ch * 8;
    const int woff = r0 * 144 + ch * 16;
    u32x4 rg[4][4];
#pragma unroll
    for (int d = 0; d < 4; ++d) {
        rg[d][0] = *(const u32x4*)(pa0 + d * 64); rg[d][1] = *(const u32x4*)(pa1 + d * 64);
        rg[d][2] = *(const u32x4*)(pb0 + d * 64); rg[d][3] = *(const u32x4*)(pb1 + d * 64);
    }
    __builtin_amdgcn_sched_barrier(0);
#pragma unroll
    for (int mb = 0; mb < 2; ++mb)
#pragma unroll
        for (int nb = 0; nb < 4; ++nb) acc[mb][nb] = (f32x4){0.f, 0.f, 0.f, 0.f};
    *(LAS u32x4*)(lds + woff) = rg[0][0]; *(LAS u32x4*)(lds + woff + 9216) = rg[0][1];
    *(LAS u32x4*)(lds + 36864 + woff) = rg[0][2]; *(LAS u32x4*)(lds + 36864 + woff + 9216) = rg[0][3];
    __syncthreads();
    const int nk = K >> 6;
    const int aoff = (32 * wm + (lane & 15)) * 144 + (lane >> 4) * 16;
    const int boff = 36864 + (64 * wn + (lane & 15)) * 144 + (lane >> 4) * 16;
#pragma unroll 1
    for (int kt0 = 0; kt0 < nk; kt0 += 4) {
#pragma unroll
        for (int j = 0; j < 4; ++j) {
            const int kt = kt0 + j, buf = (j & 1) * 18432;
            if (kt + 4 < nk) {
                const int ko = (kt + 4) * 64;
                rg[j][0] = *(const u32x4*)(pa0 + ko); rg[j][1] = *(const u32x4*)(pa1 + ko);
                rg[j][2] = *(const u32x4*)(pb0 + ko); rg[j][3] = *(const u32x4*)(pb1 + ko);
            }
            __builtin_amdgcn_sched_barrier(0);
#pragma unroll
            for (int ks = 0; ks < 2; ++ks) {
                bf16x8 af[2], bfr[4];
#pragma unroll
                for (int mb = 0; mb < 2; ++mb) af[mb] = *(const LAS bf16x8*)(lds + buf + aoff + mb * 2304 + ks * 64);
#pragma unroll
                for (int nb = 0; nb < 4; ++nb) bfr[nb] = *(const LAS bf16x8*)(lds + buf + boff + nb * 2304 + ks * 64);
#pragma unroll
                for (int mb = 0; mb < 2; ++mb)
#pragma unroll
                    for (int nb = 0; nb < 4; ++nb)
                        acc[mb][nb] = TRANS ? __builtin_amdgcn_mfma_f32_16x16x32_bf16(bfr[nb], af[mb], acc[mb][nb], 0, 0, 0)
                                            : __builtin_amdgcn_mfma_f32_16x16x32_bf16(af[mb], bfr[nb], acc[mb][nb], 0, 0, 0);
            }
            if (kt + 1 < nk) {
                const int nb2 = ((j + 1) & 1) * 18432, s = (j + 1) & 3;
                *(LAS u32x4*)(lds + nb2 + woff) = rg[s][0]; *(LAS u32x4*)(lds + nb2 + woff + 9216) = rg[s][1];
                *(LAS u32x4*)(lds + 36864 + nb2 + woff) = rg[s][2]; *(LAS u32x4*)(lds + 36864 + nb2 + woff + 9216) = rg[s][3];
            }
            __syncthreads();
        }
    }
}
__device__ __forceinline__ void tile_mn(int t, int MT, int NT, int& mt, int& nt) {
    const int per = 16 * NT; const int g = t / per; const int r = t - g * per; const int rem = MT - g * 16; const int gs = rem < 16 ? rem : 16;
    mt = g * 16 + r % gs; nt = r / gs;
}
struct RowLin { const bf16_t* base; size_t pitch; __device__ __forceinline__ const bf16_t* operator()(int r) const { return base + (size_t)r * pitch; } };

__device__ __forceinline__ s16x4 tr_read(LAS unsigned char* blk, int stride, int lane) {
    const int i = lane & 15;
    return __builtin_amdgcn_ds_read_tr16_b64_v4i16((LAS s16x4*)(blk + (i >> 2) * stride + (i & 3) * 8));
}
__device__ __forceinline__ bf16x8 cat8(s16x4 a, s16x4 b) { bf16x8 r; r[0] = a[0]; r[1] = a[1]; r[2] = a[2]; r[3] = a[3]; r[4] = b[0]; r[5] = b[1]; r[6] = b[2]; r[7] = b[3]; return r; }

namespace pg8 {
#define PG8_LAS __attribute__((address_space(3)))
constexpr int BM = 256, BK = 64, HALF = 128, HTB = HALF * BK * 2  , STAGE_BYTES = 8 * HTB, NXCD = 8, WGM = 8;

__host__ __device__ __forceinline__ int lds_byte(int r, int c) { const int st = (r >> 4) * 2 + (c >> 5), rr = r & 15, cc = c & 31, ob = rr * 64 + cc * 2; return st * 1024 + (ob ^ (((ob >> 9) & 1) << 5)); }
__host__ __device__ __forceinline__ void stage_rc(int b, int& R, int& C) { const int st = b / 1024, sb = b % 1024, swz = sb ^ (((sb >> 9) & 1) << 5); R = (st >> 1) * 16 + swz / 64; C = (st & 1) * 32 + (swz % 64) / 2; }
__host__ __device__ __forceinline__ int perm32(int rho) { const int n = rho >> 4, i = rho & 15; return 8 * (i >> 2) + 4 * n + (i & 3); }

struct Unit { int pm, pn; };
struct Gemm { const bf16_t* A; const bf16_t* Bt; int M, N, K; };

struct StaticOrder {
    int nM, nN, nwg, G, c;
    __host__ __device__ void init(int M, int N, int G_, int c_) { nM = M / BM; nN = N / BM; nwg = nM * nN; G = G_; c = c_; }
    __host__ __device__ bool next(int i, Unit& u) const {
        const long L = (long)i * G + c; if (L >= nwg) return false;
        int wgid = (int)L; { const int q = nwg / NXCD, r = nwg % NXCD, xcd = wgid % NXCD, off = wgid / NXCD; wgid = (xcd < r ? xcd * (q + 1) : r * (q + 1) + (xcd - r) * q) + off; }
        const int nig = WGM * nN, gid = wgid / nig, fm = gid * WGM, gsz = (nM - fm) < WGM ? (nM - fm) : WGM;
        u.pm = fm + ((wgid % nig) % gsz); u.pn = (wgid % nig) / gsz; return true;
    }
    __device__ __forceinline__ void a_ready(const Unit&) const {}
    __device__ __forceinline__ void done(const Unit&) const {}
};
template <class Epi, class Sched>
__device__ __forceinline__ void gemm_phase(PG8_LAS unsigned char* lds, const Gemm g, const Sched& S, const Epi& E) {
    const int tid = threadIdx.x, wid = __builtin_amdgcn_readfirstlane(tid >> 6), lane = tid & 63, wr = wid >> 2, wc = wid & 3, fr = lane & 15, fq = lane >> 4;
    const int K = g.K, nt = K / BK;
    unsigned voffA[2], voffB[2];
#pragma unroll
    for (int i = 0; i < 2; ++i) { int R, C; stage_rc(tid * 16 + i * 8192, R, C); const int Rb = Epi::PERM ? ((R & ~31) + perm32(R & 31)) : R;
        voffA[i] = (unsigned)(R * K + C) * 2u; voffB[i] = (unsigned)(Rb * K + C) * 2u; }
    const size_t kstep = (size_t)(BK * 2);
    const size_t hstep = (size_t)HALF * K * 2;
    const size_t tstep = 2 * hstep;
    const unsigned ldsw = (unsigned)wid * 1024u;
    const int aoff = lds_byte(wr * 64 + fr, fq * 8), boff = lds_byte(wc * 32 + fr, fq * 8);
#define PG8_SA(b, h) (((b) * 2 + (h)) * HTB)
#define PG8_SB(b, h) ((4 + (b) * 2 + (h)) * HTB)
#define PG8_STAGE(bufoff, gbase, voff) do { _Pragma("unroll") for (int _i = 0; _i < 2; ++_i) \
        __builtin_amdgcn_global_load_lds((const unsigned*)((const char*)(gbase) + (voff)[_i]), (PG8_LAS unsigned*)(lds + (bufoff) + ldsw + _i * 8192), 16, 0, 0); } while (0)
#define PG8_LDA(dst, b, h) do { _Pragma("unroll") for (int m = 0; m < 4; ++m) _Pragma("unroll") for (int k = 0; k < 2; ++k) dst[m][k] = *(const PG8_LAS bf16x8*)(lds + PG8_SA(b, h) + aoff + m * 2048 + k * 1024); } while (0)
#define PG8_LDB(dst, b, h) do { _Pragma("unroll") for (int n = 0; n < 2; ++n) _Pragma("unroll") for (int k = 0; k < 2; ++k) dst[n][k] = *(const PG8_LAS bf16x8*)(lds + PG8_SB(b, h) + boff + n * 2048 + k * 1024); } while (0)
#define PG8_MMA(ai, bj, At, Bt) do { __builtin_amdgcn_s_setprio(1); _Pragma("unroll") for (int m = 0; m < 4; ++m) _Pragma("unroll") for (int n = 0; n < 2; ++n) _Pragma("unroll") for (int k = 0; k < 2; ++k) \
        acc[ai][bj][m][n] = __builtin_amdgcn_mfma_f32_16x16x32_bf16(Bt[n][k], At[m][k], acc[ai][bj][m][n], 0, 0, 0); __builtin_amdgcn_s_setprio(0); } while (0)
#define PG8_WAIT_V(n) asm volatile("s_waitcnt vmcnt(" #n ")" ::: "memory")
#define PG8_WAIT_L(n) asm volatile("s_waitcnt lgkmcnt(" #n ")" ::: "memory")
#define PG8_BAR __builtin_amdgcn_s_barrier()
#define PG8_SCHED __builtin_amdgcn_sched_barrier(0)
    Unit cur, nxt; int ui = 0;
    if (!S.next(0, cur)) return;
    f32x4 acc[2][2][4][2];
#pragma unroll
    for (int a = 0; a < 2; ++a)
#pragma unroll
        for (int b = 0; b < 2; ++b)
#pragma unroll
            for (int m = 0; m < 4; ++m)
#pragma unroll
                for (int n = 0; n < 2; ++n) acc[a][b][m][n] = (f32x4){0.f, 0.f, 0.f, 0.f};
    bf16x8 At[4][2], B0[2][2], B1[2][2];
    const char* cA = (const char*)g.A + (size_t)cur.pm * tstep; const char* cB = (const char*)g.Bt + (size_t)cur.pn * tstep;
    S.a_ready(cur);
    PG8_STAGE(PG8_SB(0, 0), cB, voffB); PG8_STAGE(PG8_SA(0, 0), cA, voffA); PG8_STAGE(PG8_SB(0, 1), cB + hstep, voffB); PG8_STAGE(PG8_SA(0, 1), cA + hstep, voffA);
    if (wr == 1) PG8_BAR;
    PG8_WAIT_V(4); PG8_BAR;
    PG8_STAGE(PG8_SB(1, 0), cB + kstep, voffB); PG8_STAGE(PG8_SA(1, 0), cA + kstep, voffA); PG8_STAGE(PG8_SB(1, 1), cB + hstep + kstep, voffB);
    PG8_WAIT_V(6); PG8_BAR;
    for (;;) {
        const bool has_next = S.next(ui + 1, nxt);
        const char* nA = has_next ? (const char*)g.A + (size_t)nxt.pm * tstep : cA; const char* nB = has_next ? (const char*)g.Bt + (size_t)nxt.pn * tstep : cB;
        for (int t = 0; t < nt; t += 2) {
            const bool last = (t == nt - 2);
            const char* a1 = cA + (size_t)(t + 1) * kstep;
            const char* a2 = last ? nA : cA + (size_t)(t + 2) * kstep; const char* b2 = last ? nB : cB + (size_t)(t + 2) * kstep;
            const char* a3 = a2 + kstep; const char* b3 = b2 + kstep;
            if (last && has_next) S.a_ready(nxt);
            PG8_LDB(B0, 0, 0); PG8_SCHED; PG8_LDA(At, 0, 0); PG8_STAGE(PG8_SA(1, 1), a1 + hstep, voffA);
            PG8_WAIT_L(8); PG8_BAR; PG8_WAIT_L(0); PG8_MMA(0, 0, At, B0); PG8_BAR; PG8_SCHED;
            PG8_LDB(B1, 0, 1); PG8_STAGE(PG8_SB(0, 0), b2, voffB);
            PG8_BAR; PG8_WAIT_L(0); PG8_MMA(0, 1, At, B1); PG8_BAR;
            PG8_LDA(At, 0, 1); PG8_STAGE(PG8_SA(0, 0), a2, voffA);
            PG8_BAR; PG8_WAIT_L(0); PG8_MMA(1, 0, At, B0); PG8_BAR; PG8_SCHED;
            PG8_STAGE(PG8_SB(0, 1), b2 + hstep, voffB);
            PG8_WAIT_V(6); PG8_BAR; PG8_MMA(1, 1, At, B1); PG8_BAR;
            PG8_LDB(B0, 1, 0); PG8_SCHED; PG8_LDA(At, 1, 0); PG8_STAGE(PG8_SA(0, 1), a2 + hstep, voffA);
            PG8_WAIT_L(8); PG8_BAR; PG8_WAIT_L(0); PG8_MMA(0, 0, At, B0); PG8_BAR; PG8_SCHED;
            PG8_LDB(B1, 1, 1); PG8_STAGE(PG8_SB(1, 0), b3, voffB);
            PG8_BAR; PG8_WAIT_L(0); PG8_MMA(0, 1, At, B1); PG8_BAR;
            PG8_LDA(At, 1, 1); PG8_STAGE(PG8_SA(1, 0), a3, voffA);
            PG8_BAR; PG8_WAIT_L(0); PG8_MMA(1, 0, At, B0); PG8_BAR; PG8_SCHED;
            PG8_STAGE(PG8_SB(1, 1), b3 + hstep, voffB);
            PG8_WAIT_V(6); PG8_BAR; PG8_MMA(1, 1, At, B1); PG8_BAR;
        }
        if constexpr (!Epi::AFTER_DRAIN) { E(acc, cur, wr, wc, fr, fq); S.done(cur); }
        if (!has_next) break;
#pragma unroll
        for (int a = 0; a < 2; ++a)
#pragma unroll
            for (int b = 0; b < 2; ++b)
#pragma unroll
                for (int m = 0; m < 4; ++m)
#pragma unroll
                    for (int n = 0; n < 2; ++n) acc[a][b][m][n] = (f32x4){0.f, 0.f, 0.f, 0.f};
        cur = nxt; cA = nA; cB = nB; ++ui;
    }
    PG8_WAIT_V(0);
    if (wr == 0) PG8_BAR;
    PG8_BAR;
    if constexpr (Epi::AFTER_DRAIN) { E.fused(acc, cur, wr, wc, fr, fq, lds, wid, lane); S.done(cur); }
#undef PG8_SA
#undef PG8_SB
#undef PG8_STAGE
#undef PG8_LDA
#undef PG8_LDB
#undef PG8_MMA
#undef PG8_WAIT_V
#undef PG8_WAIT_L
#undef PG8_BAR
#undef PG8_SCHED
}
}


struct KArgs { const float* in[23]; float* out; unsigned char* ws; int ph_lo, ph_hi; };
struct Ctx {
    const float* in[23]; float* out; unsigned char* ws; LAS unsigned char* lds; int G, bid, tid, lane, w;
    __device__ __forceinline__ bf16_t* wb(size_t off) const { return (bf16_t*)(ws + off); }
    __device__ __forceinline__ float* wf(size_t off) const { return (float*)(ws + off); }
};

template <bool PERMQK = false>
__device__ __forceinline__ void tconv(const Ctx& c, const float* __restrict__ src, int K, int N, bf16_t* __restrict__ dst) {
    LAS float* tile = (LAS float*)c.lds;
    const int NT = N >> 6, total = (K >> 6) * NT, ngroups = (total + 3) >> 2;
    const int r = c.tid >> 4, c4 = (c.tid & 15) * 4, n = c.tid >> 3, kc = (c.tid & 7) * 8;
    for (int gidx = c.bid; gidx < ngroups; gidx += c.G) {
        f32x4 v[4][2];
#pragma unroll
        for (int q = 0; q < 4; ++q) {
            const int t = gidx * 4 + q;
            if (t < total) { const int kt = t / NT, nt = t - kt * NT;
#pragma unroll
                for (int i = 0; i < 2; ++i) v[q][i] = *(const f32x4*)(src + (size_t)(kt * 64 + r + 32 * i) * N + nt * 64 + c4); }
        }
#pragma unroll
        for (int q = 0; q < 4; ++q)
            if (gidx * 4 + q < total) {
#pragma unroll
                for (int i = 0; i < 2; ++i) { LAS float* p = tile + q * (64 * 65) + (r + 32 * i) * 65 + c4; p[0] = v[q][i][0]; p[1] = v[q][i][1]; p[2] = v[q][i][2]; p[3] = v[q][i][3]; }
            }
        __syncthreads();
#pragma unroll
        for (int q = 0; q < 4; ++q) {
            const int t = gidx * 4 + q;
            if (t < total) {
                const int kt = t / NT, nt = t - kt * NT;
                float f[8];
#pragma unroll
                for (int j = 0; j < 8; ++j) f[j] = tile[q * (64 * 65) + (kc + j) * 65 + n];
                u32x4 o; o.x = cvt_pk_bf16(f[0], f[1]); o.y = cvt_pk_bf16(f[2], f[3]); o.z = cvt_pk_bf16(f[4], f[5]); o.w = cvt_pk_bf16(f[6], f[7]);
                int drow = nt * 64 + n;
                if (PERMQK && drow >= 1024 && drow < 3072) { const int d = drow & 127; drow = (drow & ~127) + 32 * (2 * (d >> 6) + ((d >> 4) & 1)) + 16 * ((d >> 5) & 1) + (d & 15); }
                *(u32x4*)(dst + (size_t)drow * K + kt * 64 + kc) = o;
            }
        }
        __syncthreads();
    }
}
__device__ __forceinline__ void conv_bf16(const Ctx& c, const float* __restrict__ src, bf16_t* __restrict__ dst, size_t n) {
    const size_t nch = n >> 3;
    for (size_t i = (size_t)c.bid * 512 + c.tid; i < nch; i += (size_t)c.G * 512) {
        const f32x4 a = *(const f32x4*)(src + i * 8), b = *(const f32x4*)(src + i * 8 + 4);
        u32x4 o; o.x = cvt_pk_bf16(a[0], a[1]); o.y = cvt_pk_bf16(a[2], a[3]); o.z = cvt_pk_bf16(b[0], b[1]); o.w = cvt_pk_bf16(b[2], b[3]);
        *(u32x4*)(dst + i * 8) = o;
    }
}
__device__ __forceinline__ unsigned enc_fp6(float v) {
    const float a = fminf(fabsf(v), 7.5f);
    float q;
    if (a < 2.0f) q = rintf(a * 8.0f);
    else if (a < 4.0f) q = 16.0f + rintf((a - 2.0f) * 4.0f);
    else q = 24.0f + rintf((a - 4.0f) * 2.0f);
    unsigned c = (unsigned)q; c = c > 31u ? 31u : c;
    return c | (v < 0.f ? 32u : 0u);
}
__device__ __forceinline__ void conv_fp6(const Ctx& c, const float* __restrict__ src, unsigned char* __restrict__ dst, int rows, float scale) {
    const size_t ngroups = (size_t)rows * 64;
    for (size_t gi = (size_t)c.bid * 512 + c.tid; gi < ngroups; gi += (size_t)c.G * 512) {
        const size_t row = gi >> 6; const int l = (int)(gi & 63);
        const float* sp = src + row * 2048 + l * 32;
        unsigned w[6] = {0u, 0u, 0u, 0u, 0u, 0u};
#pragma unroll
        for (int q = 0; q < 8; ++q) {
            const f32x4 v = *(const f32x4*)(sp + q * 4);
#pragma unroll
            for (int e = 0; e < 4; ++e) {
                const int k = q * 4 + e, pos = 6 * k, d = pos >> 5, sh = pos & 31;
                const unsigned code = enc_fp6(v[e] * scale);
                w[d] |= code << sh;
                if (sh > 26) w[d + 1] |= code >> (32 - sh);
            }
        }
        unsigned char* dp = dst + row * 1536 + l * 8;
        *(u32x2*)(dp) = (u32x2){w[0], w[1]}; *(u32x2*)(dp + 512) = (u32x2){w[2], w[3]}; *(u32x2*)(dp + 1024) = (u32x2){w[4], w[5]};
    }
}
__device__ __forceinline__ unsigned enc_fp4(float v) {
    const float a = fabsf(v);
    unsigned c;
    if (a < 2.0f) c = (unsigned)rintf(a * 2.0f);
    else if (a < 4.0f) c = 4u + (unsigned)rintf((a - 2.0f));
    else c = a < 5.0f ? 6u : 7u;
    return c | (v < 0.f ? 8u : 0u);
}
__device__ __forceinline__ void conv_fp4(const Ctx& c, const float* __restrict__ src, unsigned char* __restrict__ dst, int rows, float scale, int part, int nparts) {
    for (int row = part * 8 + c.w; row < rows; row += nparts * 8) {
        const float* sp = src + (size_t)row * 2048 + c.lane * 8;
        f32x4 v[4][2];
#pragma unroll
        for (int q = 0; q < 4; ++q) { v[q][0] = *(const f32x4*)(sp + q * 512); v[q][1] = *(const f32x4*)(sp + q * 512 + 4); }
#pragma unroll
        for (int q = 0; q < 4; ++q) {
            unsigned h = 0u;
#pragma unroll
            for (int e = 0; e < 4; ++e) h |= (enc_fp4(v[q][0][e] * scale) << (4 * e)) | (enc_fp4(v[q][1][e] * scale) << (16 + 4 * e));
            *(unsigned*)(dst + (size_t)row * 1024 + q * 256 + c.lane * 4) = h;
        }
    }
}
__device__ __forceinline__ void conv_fp8(const Ctx& c, const float* __restrict__ src, unsigned char* __restrict__ dst, size_t n, float scale) {
    const size_t nch = n >> 4;
    for (size_t i = (size_t)c.bid * 512 + c.tid; i < nch; i += (size_t)c.G * 512) {
        u32x4 o;
#pragma unroll
        for (int q = 0; q < 4; ++q) {
            const f32x4 a = *(const f32x4*)(src + i * 16 + q * 4);
            int w = 0;
            w = __builtin_amdgcn_cvt_pk_fp8_f32(a[0] * scale, a[1] * scale, w, false);
            w = __builtin_amdgcn_cvt_pk_fp8_f32(a[2] * scale, a[3] * scale, w, true);
            o[q] = (unsigned)w;
        }
        *(u32x4*)(dst + i * 16) = o;
    }
}
__device__ __forceinline__ void phase_prologue(const Ctx& c) {
    tconv<true>(c, c.in[8], 2048, 6144, c.wb(WS_WINE));
    tconv(c, c.in[10], 2048, 2048, c.wb(WS_WOUTE));
    tconv(c, c.in[11], 2048, 2112, c.wb(WS_WINO));
    tconv(c, c.in[15], 512, 1536, c.wb(WS_WUQ));
    tconv(c, c.in[16], 256, 2048, c.wb(WS_WUKV));
    tconv(c, c.in[17], 2048, 2048, c.wb(WS_WOUTO));
    tconv(c, c.in[18], 2048, 2048, c.wb(WS_WQ0));
    tconv(c, c.in[18] + (size_t)2048 * 2048, 2048, 2048, c.wb(WS_WQ1));
    {
        u32x4* p = (u32x4*)(c.wb(WS_WINO) + (size_t)2112 * 2048);
        for (int i = c.bid * 512 + c.tid; i < 192 * 2048 / 8; i += c.G * 512) p[i] = (u32x4){0u, 0u, 0u, 0u};
    }
    conv_bf16(c, c.in[19], c.wb(WS_SKB), (size_t)2 * 16 * 128 * 128);
    {
        const int two = 2 * 32 * 6 - c.G; const bool split = two > 0 && two < c.G; const int r0 = split ? 12288 : 16384;
        conv_fp4(c, c.in[20], c.ws + WS_TABU, r0, U_SCALE, c.bid, c.G);
        conv_fp4(c, c.in[21], c.ws + WS_TABV, r0, V_SCALE, c.bid, c.G);
        if (split && c.bid >= two) {
            conv_fp4(c, c.in[20] + (size_t)r0 * 2048, c.ws + WS_TABU + (size_t)r0 * 1024, 16384 - r0, U_SCALE, c.bid - two, c.G - two);
            conv_fp4(c, c.in[21] + (size_t)r0 * 2048, c.ws + WS_TABV + (size_t)r0 * 1024, 16384 - r0, V_SCALE, c.bid - two, c.G - two);
        }
    }
    const int gt = c.bid * 512 + c.tid, gn = c.G * 512;
    {
        f32x2* r128 = (f32x2*)(c.ws + WS_ROPE); f32x2* r64 = (f32x2*)(c.ws + WS_ROPE + 131072);
        for (int i = gt; i < 256 * 32; i += gn) {
            const int pos = i >> 5, f = i & 31;
            const float inv = exp2f(-(float)f * (13.287712379549449f / 32.0f));
            const float rev = (float)pos * inv * 0.15915494309189535f; const float fr = rev - floorf(rev);
            r128[i] = (f32x2){cos_rev(fr), sin_rev(fr)};
        }
        for (int i = gt; i < 256 * 16; i += gn) {
            const int pos = i >> 4, f = i & 15;
            const float inv = exp2f(-(float)f * (13.287712379549449f / 16.0f));
            const float rev = (float)pos * inv * 0.15915494309189535f; const float fr = rev - floorf(rev);
            r64[i] = (f32x2){cos_rev(fr), sin_rev(fr)};
        }
    }
    {
        bf16_t* MC = c.wb(WS_DFT); bf16_t* M1 = c.wb(WS_DFT + 262144); bf16_t* M2 = c.wb(WS_DFT + 393216); bf16_t* MCX = c.wb(WS_DFT + 458752);
        for (int i = gt; i < 512 * 256; i += gn) {
            const int n = i >> 8, k = i & 255, m = n & 255; const float fr = (float)((m * k) & 255) * (1.0f / 256.0f);
            const float v = (n < 256 ? cos_rev(fr) : -sin_rev(fr)) * 0.0625f;
            MC[i] = (bf16_t)(cvt_pk_bf16(v, 0.f) & 0xffffu);
        }
        for (int i = gt; i < 256 * 256; i += gn) {
            const int j = i >> 8, kk = i & 255, ka = j >> 1, ro = j & 1, ri = kk >> 7, nh = kk & 127;
            const float fr = (float)((ka * nh) & 127) * (1.0f / 128.0f); const float cc = cos_rev(fr), ss = sin_rev(fr);
            const float v = (ro == ri ? cc : (ro == 0 ? ss : -ss)) * 0.08838834764831845f;
            M1[i] = (bf16_t)(cvt_pk_bf16(v, 0.f) & 0xffffu);
        }
        for (int i = gt; i < 128 * 256; i += gn) {
            const int kb = i >> 8, kk = i & 255, ri = kk >> 7, nl = kk & 127;
            const float fr = (float)((kb * nl) & 127) * (1.0f / 128.0f);
            const float v = (ri == 0 ? cos_rev(fr) : sin_rev(fr)) * 0.08838834764831845f;
            M2[i] = (bf16_t)(cvt_pk_bf16(v, 0.f) & 0xffffu);
        }
        for (int i = gt; i < 256 * 512; i += gn) {
            const int k = i >> 9, kk = i & 511, ri = kk >> 8, n = kk & 255;
            const float fr = (float)((k * n) & 255) * (1.0f / 256.0f);
            const float v = (ri == 0 ? cos_rev(fr) : sin_rev(fr)) * 0.0625f;
            MCX[i] = (bf16_t)(cvt_pk_bf16(v, 0.f) & 0xffffu);
        }
    }
    {
        const float* cvec = c.in[1]; const float* cctx = c.in[3]; const float* wmod = c.in[4];
        float* modp = c.wf(WS_MODP);
        for (int u = c.bid; u < 2 * 32 * 6; u += c.G) {
            const int l = u / 192, r = u - l * 192, kc = r / 6, nb = r - kc * 6;
            const int n = nb * 2048 + c.tid * 4;
            f32x4 a0 = {0.f, 0.f, 0.f, 0.f}, a1 = a0, a2 = a0;
            const float* wp = wmod + ((size_t)l * 2048 + kc * 64) * 12288 + n;
#pragma unroll 8
            for (int k = 0; k < 64; ++k) {
                const int kk = kc * 64 + k;
                const f32x4 wv = *(const f32x4*)(wp + (size_t)k * 12288);
                const float s0 = silu_f(cvec[kk]), s1 = silu_f(cvec[2048 + kk]), s2 = silu_f(cctx[kk]);
                a0 += wv * s0; a1 += wv * s1; a2 += wv * s2;
            }
            float* o = modp + ((size_t)(kc * 2 + l) * 3) * 12288 + n;
            *(f32x4*)(o) = a0; *(f32x4*)(o + 12288) = a1; *(f32x4*)(o + 2 * 12288) = a2;
        }
    }
}
__device__ __forceinline__ void phase_mods(const Ctx& c) {
    const float* modp = c.wf(WS_MODP); float* mods = c.wf(WS_MODS); const float* bmod = c.in[5];
    for (int i = c.bid * 512 + c.tid; i < 2 * 3 * 12288; i += c.G * 512) {
        const int l = i / 36864, r = i - l * 36864, n = r % 12288;
        float s = bmod[l * 12288 + n];
        for (int kc = 0; kc < 32; ++kc) s += modp[(size_t)(kc * 2 + l) * 36864 + r];
        mods[i] = s;
    }
}
__device__ __forceinline__ void phase_modnorm(const Ctx& c, int layer, int which, const float* __restrict__ xlat, const float* __restrict__ xctx, int tok_lo, bf16_t* __restrict__ H) {
    const float* mods = c.wf(WS_MODS); const float* nw = c.in[6 + which] + layer * D;
    for (int tok = tok_lo + c.bid * 8 + c.w; tok < TT; tok += c.G * 8) {
        const float* src = tok < TC ? xctx + (size_t)tok * D : xlat + (size_t)(tok - TC) * D;
        const int mw = tok < TC ? 2 : ((tok - TC) >> 14);
        const float* mb = mods + (size_t)(layer * 3 + mw) * 12288 + which * 3 * 2048;
        f32x4 v[8]; float ss = 0.f;
#pragma unroll
        for (int i = 0; i < 8; ++i) { v[i] = *(const f32x4*)(src + i * 256 + c.lane * 4); ss += v[i][0] * v[i][0] + v[i][1] * v[i][1] + v[i][2] * v[i][2] + v[i][3] * v[i][3]; }
        ss = wave_sum(ss);
        const float rstd = rsqrtf(ss * (1.0f / D) + EPS);
#pragma unroll
        for (int i = 0; i < 8; ++i) {
            const int col = i * 256 + c.lane * 4;
            const f32x4 g = *(const f32x4*)(nw + col), sh = *(const f32x4*)(mb + col), sc = *(const f32x4*)(mb + 2048 + col);
            f32x4 o;
#pragma unroll
            for (int j = 0; j < 4; ++j) o[j] = v[i][j] * rstd * g[j] * (1.0f + sc[j]) + sh[j];
            *(u32x2*)(H + (size_t)tok * D + col) = pack4(o);
        }
    }
}

__device__ __forceinline__ void phase_even_proj(const Ctx& c) {
    const bf16_t* H = c.wb(WS_H); const bf16_t* W = c.wb(WS_WINE);
    bf16_t* F = c.wb(WS_A); bf16_t* Q = c.wb(WS_Q); bf16_t* Kb = c.wb(WS_K); bf16_t* V = c.wb(WS_V); bf16_t* Gt = c.wb(WS_G);
    const f32x2* r128 = (const f32x2*)(c.ws + WS_ROPE);
    const int MT = TT / 128, NT = 6144 / 128;
    const int g = c.lane >> 4, wm = c.w >> 1, wn = c.w & 1;
    for (int t = c.bid; t < MT * NT; t += c.G) {
        int mt, nt; tile_mn(t, MT, NT, mt, nt);
        f32x4 acc[2][4];
        gemm128<true>(c.lds, 2048, RowLin{H + (size_t)mt * 128 * D, (size_t)D}, RowLin{W + (size_t)nt * 128 * 2048, 2048}, acc);
        const int region = nt >> 3, cr0 = (nt & 7) * 128 + 64 * wn + 4 * g;
#pragma unroll
        for (int mb = 0; mb < 2; ++mb) {
            const int tok = mt * 128 + 32 * wm + 16 * mb + (c.lane & 15);
            if (region == 0) {
#pragma unroll
                for (int nb = 0; nb < 4; ++nb) *(u32x2*)(F + (size_t)tok * 1024 + cr0 + 16 * nb) = pack4(acc[mb][nb]);
            } else if (region == 1 || region == 2) {
                bf16_t* dst = (region == 1 ? Q : Kb) + (size_t)tok * 1024 + cr0;
                const float sc = region == 2 ? 0.08838834764831845f : 1.0f;
                if (tok >= TC) {
                    const int s = (tok - TC) & (SEQ - 1); const int pos = wn == 0 ? (s >> 6) : (s & 63);
#pragma unroll
                    for (int nb = 0; nb < 2; ++nb) {
                        f32x4 o1, o2;
#pragma unroll
                        for (int r = 0; r < 4; ++r) {
                            const f32x2 cs = r128[pos * 32 + 16 * nb + 4 * g + r];
                            const float a = acc[mb][nb][r] * sc, b = acc[mb][nb + 2][r] * sc;
                            o1[r] = a * cs.x - b * cs.y; o2[r] = b * cs.x + a * cs.y;
                        }
                        *(u32x2*)(dst + 16 * nb) = pack4(o1); *(u32x2*)(dst + 16 * (nb + 2)) = pack4(o2);
                    }
                } else {
#pragma unroll
                    for (int nb = 0; nb < 4; ++nb) *(u32x2*)(dst + 16 * nb) = pack4(acc[mb][nb] * sc);
                }
            } else if (region == 3) {
#pragma unroll
                for (int nb = 0; nb < 4; ++nb) *(u32x2*)(V + (size_t)tok * 1024 + cr0 + 16 * nb) = pack4(acc[mb][nb]);
            } else {
#pragma unroll
                for (int nb = 0; nb < 4; ++nb) {
                    f32x4 o;
#pragma unroll
                    for (int r = 0; r < 4; ++r) o[r] = silu_f(acc[mb][nb][r]);
                    *(u32x2*)(Gt + (size_t)tok * 2048 + (region - 4) * 1024 + cr0 + 16 * nb) = pack4(o);
                }
            }
        }
    }
}
constexpr int FS = 528, F_B = 128 * FS;
template <class RF>
__device__ __forceinline__ void ftile_issue(u32x4 (&r)[8], const RF& row, int tid) {
#pragma unroll
    for (int i = 0; i < 8; ++i) r[i] = *(const u32x4*)(row((tid >> 5) + 16 * i) + (tid & 31) * 8);
}
__device__ __forceinline__ void ftile_write(LAS unsigned char* dst, const u32x4 (&r)[8], int tid) {
#pragma unroll
    for (int i = 0; i < 8; ++i) *(LAS u32x4*)(dst + ((tid >> 5) + 16 * i) * FS + (tid & 31) * 16) = r[i];
}
__device__ __forceinline__ void ftile_mma(LAS unsigned char* lds, f32x4 (&acc)[2][4], int lane, int wm, int wn) {
#pragma unroll
    for (int mb = 0; mb < 2; ++mb)
#pragma unroll
        for (int nb = 0; nb < 4; ++nb) acc[mb][nb] = (f32x4){0.f, 0.f, 0.f, 0.f};
    const int aoff = (32 * wm + (lane & 15)) * FS + (lane >> 4) * 16;
    const int boff = F_B + (64 * wn + (lane & 15)) * FS + (lane >> 4) * 16;
#pragma unroll
    for (int ks = 0; ks < 8; ++ks) {
        bf16x8 af[2], bfr[4];
#pragma unroll
        for (int mb = 0; mb < 2; ++mb) af[mb] = *(const LAS bf16x8*)(lds + aoff + mb * (16 * FS) + ks * 64);
#pragma unroll
        for (int nb = 0; nb < 4; ++nb) bfr[nb] = *(const LAS bf16x8*)(lds + boff + nb * (16 * FS) + ks * 64);
#pragma unroll
        for (int mb = 0; mb < 2; ++mb)
#pragma unroll
            for (int nb = 0; nb < 4; ++nb) acc[mb][nb] = __builtin_amdgcn_mfma_f32_16x16x32_bf16(af[mb], bfr[nb], acc[mb][nb], 0, 0, 0);
    }
}
struct RowStr { const bf16_t* base; size_t pitch; __device__ __forceinline__ const bf16_t* operator()(int r) const { return base + (size_t)r * pitch; } };
__device__ __forceinline__ void phase_chan_dft(const Ctx& c) {
    const bf16_t* F = c.wb(WS_A); const bf16_t* MC = c.wb(WS_DFT);
    bf16_t* Zt = c.wb(WS_ST); bf16_t* Ztc = c.wb(WS_ST + 128 * MiB);
    const int g4 = c.lane >> 4, wm = c.w >> 1, wn = c.w & 1;
    LAS unsigned char* la = c.lds; LAS unsigned char* lb = c.lds + F_B;
    constexpr int NUL = 2 * 4 * 128;
    u32x4 ra[8], rb[8];
    if (c.bid < NUL) {
        const int grp = c.bid & 3, nlo = (c.bid >> 2) & 127, b = c.bid >> 9;
        ftile_issue(ra, RowStr{F + ((size_t)(TC + b * SEQ + nlo)) * 1024 + grp * 256, (size_t)128 * 1024}, c.tid);
        ftile_issue(rb, RowLin{MC, 256}, c.tid);
        ftile_write(la, ra, c.tid); ftile_write(lb, rb, c.tid);
    }
    __syncthreads();
    for (int u = c.bid; u < NUL; u += c.G) {
        const int grp = u & 3, nlo = (u >> 2) & 127, b = u >> 9;
        const bool nxu = u + c.G < NUL;
#pragma unroll 1
        for (int nt = 0; nt < 4; ++nt) {
            if (nt < 3) ftile_issue(rb, RowLin{MC + (size_t)(nt + 1) * 128 * 256, 256}, c.tid);
            else if (nxu) {
                const int un = u + c.G, gn = un & 3, nn = (un >> 2) & 127, bn = un >> 9;
                ftile_issue(ra, RowStr{F + ((size_t)(TC + bn * SEQ + nn)) * 1024 + gn * 256, (size_t)128 * 1024}, c.tid);
                ftile_issue(rb, RowLin{MC, 256}, c.tid);
            }
            __builtin_amdgcn_sched_barrier(0);
            f32x4 acc[2][4];
            ftile_mma(c.lds, acc, c.lane, wm, wn);
#pragma unroll
            for (int mb = 0; mb < 2; ++mb)
#pragma unroll
                for (int nb = 0; nb < 4; ++nb) {
                    const int n = nt * 128 + 64 * wn + 16 * nb + (c.lane & 15), reim = n >> 8, m = n & 255, nhi = 32 * wm + 16 * mb + 4 * g4;
                    *(u32x2*)(Zt + ((((size_t)(b * 4 + grp) * 256 + m) * 128 + nlo) * 2 + reim) * 128 + nhi) = pack4(acc[mb][nb]);
                }
            __syncthreads();
            if (nt < 3) ftile_write(lb, rb, c.tid);
            else if (nxu) { ftile_write(la, ra, c.tid); ftile_write(lb, rb, c.tid); }
            __syncthreads();
        }
    }
    for (int v = c.bid; v < 64; v += c.G) {
        f32x4 acc[2][4];
        const int nt = v & 3, rt = (v >> 2) & 1, grp = (v >> 3) & 3, b = v >> 5;
        gemm128s<false, 256>(c.lds, RowLin{F + ((size_t)(b * NCTX + rt * 128)) * 1024 + grp * 256, 1024}, RowLin{MC + (size_t)nt * 128 * 256, 256}, acc);
#pragma unroll
        for (int mb = 0; mb < 2; ++mb)
#pragma unroll
            for (int nb = 0; nb < 4; ++nb) {
                const int n = nt * 128 + 64 * wn + 16 * nb + (c.lane & 15), reim = n >> 8, m = n & 255, nn = rt * 128 + 32 * wm + 16 * mb + 4 * g4;
                *(u32x2*)(Ztc + (((size_t)(b * 4 + grp) * 256 + m) * 2 + reim) * 256 + nn) = pack4(acc[mb][nb]);
            }
    }
}
__device__ __forceinline__ void phase_dft_stage1(const Ctx& c) {
    const bf16_t* Zt = c.wb(WS_ST); const bf16_t* Ztc = c.wb(WS_ST + 128 * MiB);
    const bf16_t* M1 = c.wb(WS_DFT + 262144); const bf16_t* MCX = c.wb(WS_DFT + 458752);
    bf16_t* Tp = c.wb(WS_H); bf16_t* CAT = c.wb(WS_CAT);
    const int g4 = c.lane >> 4, wm = c.w >> 1, wn = c.w & 1;
    LAS unsigned char* la = c.lds; LAS unsigned char* lb = c.lds + F_B;
    constexpr int NUL = 2048;
    u32x4 ra[8], rb[8];
    if (c.bid < NUL) {
        ftile_issue(ra, RowLin{Zt + (size_t)c.bid * 128 * 256, 256}, c.tid); ftile_issue(rb, RowLin{M1, 256}, c.tid);
        ftile_write(la, ra, c.tid); ftile_write(lb, rb, c.tid);
    }
    __syncthreads();
    for (int rt = c.bid; rt < NUL; rt += c.G) {
        const int bg = rt >> 8, m = rt & 255;
        const bool nxu = rt + c.G < NUL;
#pragma unroll 1
        for (int nt = 0; nt < 2; ++nt) {
            if (nt < 1) ftile_issue(rb, RowLin{M1 + (size_t)(nt + 1) * 128 * 256, 256}, c.tid);
            else if (nxu) { ftile_issue(ra, RowLin{Zt + (size_t)(rt + c.G) * 128 * 256, 256}, c.tid); ftile_issue(rb, RowLin{M1, 256}, c.tid); }
            __builtin_amdgcn_sched_barrier(0);
            f32x4 acc[2][4];
            ftile_mma(c.lds, acc, c.lane, wm, wn);
#pragma unroll
            for (int mb = 0; mb < 2; ++mb)
#pragma unroll
                for (int nb = 0; nb < 4; ++nb) {
                    const int j = nt * 128 + 64 * wn + 16 * nb + (c.lane & 15), ka = j >> 1, ro = j & 1, nlo0 = 32 * wm + 16 * mb + 4 * g4;
                    f32x4 o;
#pragma unroll
                    for (int r = 0; r < 4; ++r) {
                        const float mine = acc[mb][nb][r], other = __shfl_xor(mine, 1);
                        const float fr = (float)((ka * (nlo0 + r)) & 16383) * (1.0f / 16384.0f);
                        const float cc = cos_rev(fr), ss = sin_rev(fr);
                        o[r] = ro == 0 ? (mine * cc + other * ss) : (mine * cc - other * ss);
                    }
                    *(u32x2*)(Tp + ((((size_t)bg * 128 + ka) * 256 + m) * 2 + ro) * 128 + nlo0) = pack4(o);
                }
            __syncthreads();
            if (nt < 1) ftile_write(lb, rb, c.tid);
            else if (nxu) { ftile_write(la, ra, c.tid); ftile_write(lb, rb, c.tid); }
            __syncthreads();
        }
    }
    for (int v = c.bid; v < 32; v += c.G) {
        f32x4 acc[2][4];
        const int nt = v & 1, rt = v >> 1;
        gemm128s<false, 512>(c.lds, RowLin{Ztc + (size_t)rt * 128 * 512, 512}, RowLin{MCX + (size_t)nt * 128 * 512, 512}, acc);
        const int bg = rt >> 1, b = bg >> 2, grp = bg & 3, mh = rt & 1;
#pragma unroll
        for (int mb = 0; mb < 2; ++mb)
#pragma unroll
            for (int nb = 0; nb < 4; ++nb) {
                const int k = nt * 128 + 64 * wn + 16 * nb + (c.lane & 15), m0 = mh * 128 + 32 * wm + 16 * mb + 4 * g4;
                *(u32x2*)(CAT + (size_t)(b * NCTX + k) * 2048 + grp * 256 + m0) = pack4(acc[mb][nb]);
            }
    }
}
__device__ __forceinline__ void phase_dft_stage2(const Ctx& c) {
    const bf16_t* Tp = c.wb(WS_H); const bf16_t* M2 = c.wb(WS_DFT + 393216); bf16_t* CAT = c.wb(WS_CAT);
    const int g4 = c.lane >> 4, wm = c.w >> 1, wn = c.w & 1;
    LAS unsigned char* la = c.lds; LAS unsigned char* lb = c.lds + F_B;
    u32x4 ra[8];
    if (c.bid < 2048) {
        ftile_issue(ra, RowLin{M2, 256}, c.tid);
        ftile_write(lb, ra, c.tid);
        ftile_issue(ra, RowLin{Tp + (size_t)c.bid * 128 * 256, 256}, c.tid);
        ftile_write(la, ra, c.tid);
    }
    __syncthreads();
    for (int u = c.bid; u < 2048; u += c.G) {
        const bool nxu = u + c.G < 2048;
        if (nxu) ftile_issue(ra, RowLin{Tp + (size_t)(u + c.G) * 128 * 256, 256}, c.tid);
        __builtin_amdgcn_sched_barrier(0);
        f32x4 acc[2][4];
        ftile_mma(c.lds, acc, c.lane, wm, wn);
        const int mh = u & 1, ka = (u >> 1) & 127, bg = u >> 8, b = bg >> 2, grp = bg & 3;
#pragma unroll
        for (int mb = 0; mb < 2; ++mb)
#pragma unroll
            for (int nb = 0; nb < 4; ++nb) {
                const int kb = 64 * wn + 16 * nb + (c.lane & 15), m0 = mh * 128 + 32 * wm + 16 * mb + 4 * g4;
                *(u32x2*)(CAT + (size_t)(TC + b * SEQ + ka + 128 * kb) * 2048 + grp * 256 + m0) = pack4(acc[mb][nb]);
            }
        __syncthreads();
        if (nxu) ftile_write(la, ra, c.tid);
        __syncthreads();
    }
}

constexpr int TS = 272;
constexpr int TILE_B = 128 * TS;
constexpr int TSV = 288;
constexpr int TILE_BV = 128 * TSV;
__device__ __forceinline__ int chunk_tok0(int b, int cch) { return cch < 2 ? b * NCTX + cch * 128 : TC + b * SEQ + (cch - 2) * 128; }
template <int STRIDE = TS>
__device__ __forceinline__ void load_tile128(const Ctx& c, LAS unsigned char* dst, const bf16_t* src  , size_t pitch) {
#pragma unroll
    for (int i = 0; i < 4; ++i) {
        const int id = c.tid + 512 * i, row = id >> 4, ch = id & 15;
        *(LAS u32x4*)(dst + row * STRIDE + ch * 16) = *(const u32x4*)(src + (size_t)row * pitch + ch * 8);
    }
}
__device__ __forceinline__ void phase_ret_ds(const Ctx& c) {
    const bf16_t* Kb = c.wb(WS_K); const bf16_t* V = c.wb(WS_V); bf16_t* ST = c.wb(WS_ST);
    LAS unsigned char* kt = c.lds; LAS unsigned char* vf = c.lds + TILE_BV; LAS unsigned char* vb = c.lds + 2 * TILE_BV;
    const int g = c.lane >> 4, wm = c.w >> 1, wn = c.w & 1, d0 = 32 * wm, e0 = 64 * wn;
    u32x4 rk[4], rv[4];
    if (c.bid < NBATCH * 8 * NCH) {
        const int cch = c.bid % NCH, bh = c.bid / NCH; const size_t g0 = (size_t)chunk_tok0(bh >> 3, cch) * 1024 + (bh & 7) * 128;
#pragma unroll
        for (int i = 0; i < 4; ++i) { const int id = c.tid + 512 * i; const size_t go = g0 + (size_t)(id >> 4) * 1024 + (id & 15) * 8; rk[i] = *(const u32x4*)(Kb + go); rv[i] = *(const u32x4*)(V + go); }
    }
    for (int u = c.bid; u < NBATCH * 8 * NCH; u += c.G) {
        const int cch = u % NCH, bh = u / NCH, h = bh & 7, b = bh >> 3;
        const float lg = log2_gamma(h);
#pragma unroll
        for (int i = 0; i < 4; ++i) {
            const int id = c.tid + 512 * i, row = id >> 4, ch = id & 15;
            *(LAS u32x4*)(kt + row * TSV + ch * 16) = rk[i];
            const u32x4 v = rv[i];
            const float zf = fast_exp2(lg * (float)(127 - row)), zb = fast_exp2(lg * (float)row);
            u32x4 of, ob;
            of.x = cvt_pk_bf16(bf_lo(v.x) * zf, bf_hi(v.x) * zf); of.y = cvt_pk_bf16(bf_lo(v.y) * zf, bf_hi(v.y) * zf);
            of.z = cvt_pk_bf16(bf_lo(v.z) * zf, bf_hi(v.z) * zf); of.w = cvt_pk_bf16(bf_lo(v.w) * zf, bf_hi(v.w) * zf);
            ob.x = cvt_pk_bf16(bf_lo(v.x) * zb, bf_hi(v.x) * zb); ob.y = cvt_pk_bf16(bf_lo(v.y) * zb, bf_hi(v.y) * zb);
            ob.z = cvt_pk_bf16(bf_lo(v.z) * zb, bf_hi(v.z) * zb); ob.w = cvt_pk_bf16(bf_lo(v.w) * zb, bf_hi(v.w) * zb);
            *(LAS u32x4*)(vf + row * TSV + ch * 16) = of; *(LAS u32x4*)(vb + row * TSV + ch * 16) = ob;
        }
        __syncthreads();
        if (u + c.G < NBATCH * 8 * NCH) {
            const int un = u + c.G, cn = un % NCH, bn = un / NCH; const size_t g0 = (size_t)chunk_tok0(bn >> 3, cn) * 1024 + (bn & 7) * 128;
#pragma unroll
            for (int i = 0; i < 4; ++i) { const int id = c.tid + 512 * i; const size_t go = g0 + (size_t)(id >> 4) * 1024 + (id & 15) * 8; rk[i] = *(const u32x4*)(Kb + go); rv[i] = *(const u32x4*)(V + go); }
        }
        __builtin_amdgcn_sched_barrier(0);
        f32x4 accf[2][4], accb[2][4];
#pragma unroll
        for (int mb = 0; mb < 2; ++mb)
#pragma unroll
            for (int nb = 0; nb < 4; ++nb) { accf[mb][nb] = (f32x4){0.f, 0.f, 0.f, 0.f}; accb[mb][nb] = (f32x4){0.f, 0.f, 0.f, 0.f}; }
#pragma unroll
        for (int ks = 0; ks < 4; ++ks) {
            const int j0 = 32 * ks + 8 * g;
            bf16x8 af[2];
#pragma unroll
            for (int mb = 0; mb < 2; ++mb)
                af[mb] = cat8(tr_read(kt + j0 * TSV + (d0 + 16 * mb) * 2, TSV, c.lane), tr_read(kt + (j0 + 4) * TSV + (d0 + 16 * mb) * 2, TSV, c.lane));
#pragma unroll
            for (int nb = 0; nb < 4; ++nb) {
                const bf16x8 bf = cat8(tr_read(vf + j0 * TSV + (e0 + 16 * nb) * 2, TSV, c.lane), tr_read(vf + (j0 + 4) * TSV + (e0 + 16 * nb) * 2, TSV, c.lane));
                const bf16x8 bb = cat8(tr_read(vb + j0 * TSV + (e0 + 16 * nb) * 2, TSV, c.lane), tr_read(vb + (j0 + 4) * TSV + (e0 + 16 * nb) * 2, TSV, c.lane));
#pragma unroll
                for (int mb = 0; mb < 2; ++mb) {
                    accf[mb][nb] = __builtin_amdgcn_mfma_f32_16x16x32_bf16(af[mb], bf, accf[mb][nb], 0, 0, 0);
                    accb[mb][nb] = __builtin_amdgcn_mfma_f32_16x16x32_bf16(af[mb], bb, accb[mb][nb], 0, 0, 0);
                }
            }
        }
        bf16_t* sf = ST + ((size_t)((0 * 2 + b) * 8 + h) * NCH + cch) * 16384;
        bf16_t* sb = ST + ((size_t)((1 * 2 + b) * 8 + h) * NCH + cch) * 16384;
#pragma unroll
        for (int mb = 0; mb < 2; ++mb)
#pragma unroll
            for (int nb = 0; nb < 4; ++nb) {
                const int e = e0 + 16 * nb + (c.lane & 15), d = d0 + 16 * mb + 4 * g;
                *(u32x2*)(sf + e * 128 + d) = pack4(accf[mb][nb]);
                *(u32x2*)(sb + e * 128 + d) = pack4(accb[mb][nb]);
            }
        __syncthreads();
    }
}
__device__ __forceinline__ void phase_ret_scan(const Ctx& c) {
    bf16_t* ST = c.wb(WS_ST);
    for (int gid = c.bid * 512 + c.tid; gid < 2 * 16 * 2048; gid += c.G * 512) {
        const int dir = gid >> 15, rem = gid & 32767, bh = rem >> 11, e8 = rem & 2047, h = bh & 7;
        bf16_t* base = ST + (size_t)(dir * 16 + bh) * NCH * 16384 + e8 * 8;
        const float decay = fast_exp2(log2_gamma(h) * 128.0f);
        float st[8];
#pragma unroll
        for (int j = 0; j < 8; ++j) st[j] = 0.f;
        for (int s0 = 0; s0 < NCH; s0 += 26) {
            u32x4 ds[26];
#pragma unroll
            for (int i = 0; i < 26; ++i) {
                const int s = s0 + i; const int cch = dir == 0 ? s : (s < 2 ? 1 - s : 131 - s);
                ds[i] = *(const u32x4*)(base + (size_t)cch * 16384);
            }
            __builtin_amdgcn_sched_barrier(0);
#pragma unroll
            for (int i = 0; i < 26; ++i) {
                const int s = s0 + i; const int cch = dir == 0 ? s : (s < 2 ? 1 - s : 131 - s);
                u32x4 o; o.x = cvt_pk_bf16(st[0], st[1]); o.y = cvt_pk_bf16(st[2], st[3]); o.z = cvt_pk_bf16(st[4], st[5]); o.w = cvt_pk_bf16(st[6], st[7]);
                *(u32x4*)(base + (size_t)cch * 16384) = o;
                st[0] = st[0] * decay + bf_lo(ds[i].x); st[1] = st[1] * decay + bf_hi(ds[i].x);
                st[2] = st[2] * decay + bf_lo(ds[i].y); st[3] = st[3] * decay + bf_hi(ds[i].y);
                st[4] = st[4] * decay + bf_lo(ds[i].z); st[5] = st[5] * decay + bf_hi(ds[i].z);
                st[6] = st[6] * decay + bf_lo(ds[i].w); st[7] = st[7] * decay + bf_hi(ds[i].w);
            }
        }
    }
}
__device__ __forceinline__ void phase_ret_out(const Ctx& c) {
    const bf16_t* Q = c.wb(WS_Q); const bf16_t* Kb = c.wb(WS_K); const bf16_t* V = c.wb(WS_V); const bf16_t* Gt = c.wb(WS_G);
    const bf16_t* ST = c.wb(WS_ST); bf16_t* CAT = c.wb(WS_CAT); const float* gn = c.in[9];
    LAS unsigned char* qt = c.lds; LAS unsigned char* kt = c.lds + TILE_B; LAS unsigned char* vt = c.lds + 2 * TILE_B;
    LAS unsigned char* pw = c.lds + 2 * TILE_B + TILE_BV + c.w * (16 * TS);
    LAS float* gws = (LAS float*)(c.lds + 2 * TILE_B + TILE_BV + 8 * (16 * TS));
    const int g = c.lane >> 4, il = c.lane & 15, i0 = 16 * c.w;
    for (int u = c.bid; u < NBATCH * 8 * NCH; u += c.G) {
        const int cch = u % NCH, bh = u / NCH, h = bh & 7, b = bh >> 3;
        const int tok0 = chunk_tok0(b, cch);
        const float lg = log2_gamma(h);
        const bf16_t* st0 = ST + ((size_t)((0 * 2 + b) * 8 + h) * NCH + cch) * 16384;
        u32x4 rq[4], rk[4], rv[4], rs[4];
#pragma unroll
        for (int i = 0; i < 4; ++i) {
            const int id = c.tid + 512 * i, row = id >> 4, ch = id & 15;
            const size_t go = (size_t)(tok0 + row) * 1024 + h * 128 + ch * 8;
            rq[i] = *(const u32x4*)(Q + go); rk[i] = *(const u32x4*)(Kb + go); rv[i] = *(const u32x4*)(V + go);
            rs[i] = *(const u32x4*)(st0 + row * 128 + ch * 8);
        }
        const float gwv = gn[h * 128 + (c.tid & 127)];
        __builtin_amdgcn_sched_barrier(0);
#pragma unroll
        for (int i = 0; i < 4; ++i) {
            const int id = c.tid + 512 * i, row = id >> 4, ch = id & 15;
            *(LAS u32x4*)(qt + row * TS + ch * 16) = rq[i]; *(LAS u32x4*)(kt + row * TS + ch * 16) = rk[i];
            *(LAS u32x4*)(vt + row * TSV + ch * 16) = rv[i];
        }
        if (c.tid < 128) gws[c.tid] = gwv;
        __syncthreads();
        f32x4 sT[8];
#pragma unroll
        for (int jb = 0; jb < 8; ++jb) sT[jb] = (f32x4){0.f, 0.f, 0.f, 0.f};
#pragma unroll 1
        for (int ks = 0; ks < 4; ++ks) {
            const bf16x8 qk = *(const LAS bf16x8*)(qt + (i0 + il) * TS + (32 * ks + 8 * g) * 2);
#pragma unroll
            for (int jb = 0; jb < 8; ++jb) {
                const bf16x8 kf = *(const LAS bf16x8*)(kt + (16 * jb + il) * TS + (32 * ks + 8 * g) * 2);
                sT[jb] = __builtin_amdgcn_mfma_f32_16x16x32_bf16(kf, qk, sT[jb], 0, 0, 0);
            }
        }
        __syncthreads();
        f32x4 ret[8];
#pragma unroll
        for (int eb = 0; eb < 8; ++eb) ret[eb] = (f32x4){0.f, 0.f, 0.f, 0.f};
        const int ii = i0 + il;
        const int tok = tok0 + ii;
#pragma unroll 1
        for (int dir = 0; dir < 2; ++dir) {
#pragma unroll
            for (int i = 0; i < 4; ++i) {
                const int id = c.tid + 512 * i, row = id >> 4, ch = id & 15;
                *(LAS u32x4*)(kt + row * TS + ch * 16) = rs[i];
            }
            if (dir == 0) {
                const bf16_t* st1 = ST + ((size_t)((1 * 2 + b) * 8 + h) * NCH + cch) * 16384;
#pragma unroll
                for (int i = 0; i < 4; ++i) {
                    const int id = c.tid + 512 * i, row = id >> 4, ch = id & 15;
                    rs[i] = *(const u32x4*)(st1 + row * 128 + ch * 8);
                }
            }
            u32x2 gg[8];
#pragma unroll
            for (int eb = 0; eb < 8; ++eb) gg[eb] = *(const u32x2*)(Gt + (size_t)tok * 2048 + dir * 1024 + h * 128 + 16 * eb + 4 * g);
            __builtin_amdgcn_sched_barrier(0);
#pragma unroll
            for (int jb = 0; jb < 8; ++jb) {
                f32x4 p;
#pragma unroll
                for (int r = 0; r < 4; ++r) {
                    const int j = 16 * jb + 4 * g + r; const int dl = dir == 0 ? ii - j : j - ii;
                    p[r] = dl >= 0 ? sT[jb][r] * fast_exp2(lg * (float)dl) : 0.f;
                }
                *(LAS u32x2*)(pw + il * TS + (16 * jb + 4 * g) * 2) = pack4(p);
            }
            __syncthreads();
            f32x4 o[8];
#pragma unroll
            for (int eb = 0; eb < 8; ++eb) o[eb] = (f32x4){0.f, 0.f, 0.f, 0.f};
#pragma unroll 1
            for (int ks = 0; ks < 4; ++ks) {
                const bf16x8 qk = *(const LAS bf16x8*)(qt + (i0 + il) * TS + (32 * ks + 8 * g) * 2);
#pragma unroll
                for (int eb = 0; eb < 8; ++eb) {
                    const bf16x8 sfr = *(const LAS bf16x8*)(kt + (16 * eb + il) * TS + (32 * ks + 8 * g) * 2);
                    o[eb] = __builtin_amdgcn_mfma_f32_16x16x32_bf16(sfr, qk, o[eb], 0, 0, 0);
                }
            }
            const float xi = dir == 0 ? fast_exp2(lg * (float)(ii + 1)) : fast_exp2(lg * (float)(128 - ii));
#pragma unroll
            for (int eb = 0; eb < 8; ++eb) o[eb] = o[eb] * xi;
#pragma unroll 1
            for (int ks = 0; ks < 4; ++ks) {
                const bf16x8 pf = *(const LAS bf16x8*)(pw + il * TS + (32 * ks + 8 * g) * 2);
                const int j0 = 32 * ks + 8 * g;
#pragma unroll
                for (int eb = 0; eb < 8; ++eb) {
                    const bf16x8 vfr = cat8(tr_read(vt + j0 * TSV + (16 * eb) * 2, TSV, c.lane), tr_read(vt + (j0 + 4) * TSV + (16 * eb) * 2, TSV, c.lane));
                    o[eb] = __builtin_amdgcn_mfma_f32_16x16x32_bf16(vfr, pf, o[eb], 0, 0, 0);
                }
            }
            float ss = 0.f;
#pragma unroll
            for (int eb = 0; eb < 8; ++eb) ss += o[eb][0] * o[eb][0] + o[eb][1] * o[eb][1] + o[eb][2] * o[eb][2] + o[eb][3] * o[eb][3];
            ss += __shfl_xor(ss, 16); ss += __shfl_xor(ss, 32);
            const float rstd = rsqrtf(ss * (1.0f / 128.0f) + EPS);
#pragma unroll
            for (int eb = 0; eb < 8; ++eb) {
                const f32x4 gw = *(const LAS f32x4*)(gws + 16 * eb + 4 * g);
                ret[eb][0] += o[eb][0] * rstd * gw[0] * bf_lo(gg[eb].x); ret[eb][1] += o[eb][1] * rstd * gw[1] * bf_hi(gg[eb].x);
                ret[eb][2] += o[eb][2] * rstd * gw[2] * bf_lo(gg[eb].y); ret[eb][3] += o[eb][3] * rstd * gw[3] * bf_hi(gg[eb].y);
            }
            __syncthreads();
        }
#pragma unroll
        for (int eb = 0; eb < 8; ++eb) *(u32x2*)(CAT + (size_t)tok * 2048 + 1024 + h * 128 + 16 * eb + 4 * g) = pack4(ret[eb]);
    }
}
__device__ __forceinline__ void phase_wout(const Ctx& c, const bf16_t* W, int layer, const float* xlat_old, const float* xctx_old, int mt_lo, int MTn) {
    const bf16_t* CAT = c.wb(WS_CAT); const float* mods = c.wf(WS_MODS); float* xctx_new = c.wf(WS_XCTX);
    const int NT = 16;
    const int g = c.lane >> 4, wm = c.w >> 1, wn = c.w & 1;
    for (int t = c.bid; t < MTn * NT; t += c.G) {
        int mt, nt; tile_mn(t, MTn, NT, mt, nt); mt += mt_lo;
        f32x4 acc[2][4];
#if DBG_CAT_PART == 0
        gemm128r<true>(c.lds, 2048, RowLin{CAT + (size_t)mt * 128 * 2048, 2048}, RowLin{W + (size_t)nt * 128 * 2048, 2048}, acc);
#else
        gemm128<true>(c.lds, 1024, RowLin{CAT + (size_t)mt * 128 * 2048 + (DBG_CAT_PART - 1) * 1024, 2048}, RowLin{W + (size_t)nt * 128 * 2048 + (DBG_CAT_PART - 1) * 1024, 2048}, acc);
#endif
#pragma unroll
        for (int mb = 0; mb < 2; ++mb) {
            const int tok = mt * 128 + 32 * wm + 16 * mb + (c.lane & 15);
            const int mw = tok < TC ? 2 : ((tok - TC) >> 14);
            const float* g1 = mods + (size_t)(layer * 3 + mw) * 12288 + 2 * 2048;
            const float* xo = tok < TC ? xctx_old + (size_t)tok * D : xlat_old + (size_t)(tok - TC) * D;
            float* xn = tok < TC ? xctx_new + (size_t)tok * D : c.out + (size_t)(tok - TC) * D;
#pragma unroll
            for (int nb = 0; nb < 4; ++nb) {
                const int col = nt * 128 + 64 * wn + 16 * nb + 4 * g;
                const f32x4 gv = *(const f32x4*)(g1 + col), xv = *(const f32x4*)(xo + col);
                *(f32x4*)(xn + col) = xv + gv * acc[mb][nb];
            }
        }
    }
}
__device__ __forceinline__ void phase_peer_q(const Ctx& c, const bf16_t* W, int mt_lo, int MTn) {
    const bf16_t* H = c.wb(WS_H); bf16_t* Qp = c.wb(WS_G);
    const int NT = 16;
    const int g = c.lane >> 4, wm = c.w >> 1, wn = c.w & 1;
    for (int t = c.bid; t < MTn * NT; t += c.G) {
        int mt, nt; tile_mn(t, MTn, NT, mt, nt); mt += mt_lo;
        f32x4 acc[2][4];
        gemm128r<true>(c.lds, 2048, RowLin{H + (size_t)mt * 128 * 2048, 2048}, RowLin{W + (size_t)nt * 128 * 2048, 2048}, acc);
#pragma unroll
        for (int mb = 0; mb < 2; ++mb) {
            const int tok = mt * 128 + 32 * wm + 16 * mb + (c.lane & 15);
#pragma unroll
            for (int nb = 0; nb < 4; ++nb) *(u32x2*)(Qp + (size_t)tok * 2048 + nt * 128 + 64 * wn + 16 * nb + 4 * g) = pack4(acc[mb][nb]);
        }
    }
}

__device__ __forceinline__ unsigned enc_key(float v) { const unsigned u = __float_as_uint(v); return (u & 0x80000000u) ? ~u : (u | 0x80000000u); }
__device__ __forceinline__ float dec_key(unsigned k) { return __uint_as_float((k & 0x80000000u) ? (k & 0x7fffffffu) : ~k); }
__device__ __forceinline__ void ins16(unsigned (&L)[16], unsigned x) {
#pragma unroll
    for (int i = 0; i < 16; ++i) { const unsigned hi = L[i] > x ? L[i] : x; x = L[i] > x ? x : L[i]; L[i] = hi; }
}
__device__ __forceinline__ void merge16(unsigned (&A)[16], const unsigned (&B)[16]) {
#pragma unroll
    for (int i = 0; i < 16; ++i) A[i] = A[i] > B[15 - i] ? A[i] : B[15 - i];
#pragma unroll
    for (int s = 8; s >= 1; s >>= 1) {
#pragma unroll
        for (int i = 0; i < 16; ++i)
            if ((i & s) == 0) { const unsigned x = A[i], y = A[i + s]; A[i] = x > y ? x : y; A[i + s] = x > y ? y : x; }
    }
}
__device__ __forceinline__ void sort16(unsigned (&A)[16]) {
#pragma unroll
    for (int k = 2; k <= 16; k <<= 1) {
#pragma unroll
        for (int j = k >> 1; j > 0; j >>= 1) {
#pragma unroll
            for (int i = 0; i < 16; ++i) {
                const int l = i ^ j;
                if (l > i) {
                    const unsigned x = A[i], y = A[l]; const unsigned hi = x > y ? x : y, lo = x > y ? y : x;
                    if ((i & k) == 0) { A[i] = hi; A[l] = lo; } else { A[i] = lo; A[l] = hi; }
                }
            }
        }
    }
}
__device__ __forceinline__ unsigned sel16(const unsigned (&L)[16], int a) {
    unsigned r = L[0];
#pragma unroll
    for (int i = 1; i < 16; ++i) r = (a == i) ? L[i] : r;
    return r;
}
__device__ __forceinline__ void topk_issue(const Ctx& c, u32x4 (&ra)[2][2][2], u32x4 (&rb)[2][2][2], const bf16_t* qbase, const bf16_t* kbase) {
    const int r0 = c.tid >> 3, ch = c.tid & 7;
#pragma unroll
    for (int p = 0; p < 2; ++p)
#pragma unroll
        for (int kt = 0; kt < 2; ++kt)
#pragma unroll
            for (int hf = 0; hf < 2; ++hf) {
                ra[p][kt][hf] = *(const u32x4*)(qbase + (size_t)(r0 + 64 * hf) * 2048 + p * 128 + kt * 64 + ch * 8);
                rb[p][kt][hf] = *(const u32x4*)(kbase + (size_t)p * 128 * 128 + (r0 + 64 * hf) * 128 + kt * 64 + ch * 8);
            }
}
__device__ __forceinline__ void topk_scores_pair(const Ctx& c, LAS float* S0, LAS float* S1, const u32x4 (&ra)[2][2][2], const u32x4 (&rb)[2][2][2]) {
    const int lane = c.lane, g = lane >> 4, wm = c.w >> 1, wn = c.w & 1;
    const int r0 = c.tid >> 3, ch = c.tid & 7, woff = r0 * 144 + ch * 16;
    const int aoff = (32 * wm + (lane & 15)) * 144 + (lane >> 4) * 16;
    const int boff = 36864 + (64 * wn + (lane & 15)) * 144 + (lane >> 4) * 16;
#pragma unroll
    for (int p = 0; p < 2; ++p) {
        if (p == 1) __syncthreads();
#pragma unroll
        for (int kt = 0; kt < 2; ++kt)
#pragma unroll
            for (int hf = 0; hf < 2; ++hf) {
                *(LAS u32x4*)(c.lds + kt * 18432 + woff + hf * 9216) = ra[p][kt][hf];
                *(LAS u32x4*)(c.lds + 36864 + kt * 18432 + woff + hf * 9216) = rb[p][kt][hf];
            }
        __syncthreads();
        f32x4 acc[2][4];
#pragma unroll
        for (int mb = 0; mb < 2; ++mb)
#pragma unroll
            for (int nb = 0; nb < 4; ++nb) acc[mb][nb] = (f32x4){0.f, 0.f, 0.f, 0.f};
#pragma unroll
        for (int kt = 0; kt < 2; ++kt)
#pragma unroll
            for (int ks = 0; ks < 2; ++ks) {
                bf16x8 af[2], bfr[4];
#pragma unroll
                for (int mb = 0; mb < 2; ++mb) af[mb] = *(const LAS bf16x8*)(c.lds + kt * 18432 + aoff + mb * 2304 + ks * 64);
#pragma unroll
                for (int nb = 0; nb < 4; ++nb) bfr[nb] = *(const LAS bf16x8*)(c.lds + kt * 18432 + boff + nb * 2304 + ks * 64);
#pragma unroll
                for (int mb = 0; mb < 2; ++mb)
#pragma unroll
                    for (int nb = 0; nb < 4; ++nb) acc[mb][nb] = __builtin_amdgcn_mfma_f32_16x16x32_bf16(af[mb], bfr[nb], acc[mb][nb], 0, 0, 0);
            }
        if (p == 1) __syncthreads();
        LAS float* S = p == 0 ? S0 : S1;
#pragma unroll
        for (int mb = 0; mb < 2; ++mb)
#pragma unroll
            for (int nb = 0; nb < 4; ++nb)
#pragma unroll
                for (int r = 0; r < 4; ++r) S[(32 * wm + 16 * mb + 4 * g + r) * 129 + 64 * wn + 16 * nb + (lane & 15)] = acc[mb][nb][r];
    }
}
__device__ __forceinline__ void phase_peer_topk(const Ctx& c, int layer, int mt_lo) {
    const bf16_t* Qp = c.wb(WS_G); const bf16_t* SK = c.wb(WS_SKB) + (size_t)layer * 16 * 128 * 128;
    int* IDX = (int*)(c.ws + WS_IDX); float* GATE = c.wf(WS_GATE);
    LAS float* S0 = (LAS float*)(c.lds + GEMM_LDS);
    LAS float* S1 = (LAS float*)c.lds;
    const int MT = TT / 128, NU = (MT - mt_lo) * 8;
    u32x4 ra[2][2][2], rb[2][2][2];
    if (c.bid < NU) topk_issue(c, ra, rb, Qp + (size_t)(mt_lo + (c.bid >> 3)) * 128 * 2048 + ((c.bid & 7) * 2) * 128, SK + (size_t)((c.bid & 7) * 2) * 128 * 128);
    for (int u = c.bid; u < NU; u += c.G) {
        const int mt = mt_lo + (u >> 3), h = u & 7;
        topk_scores_pair(c, S0, S1, ra, rb);
        if (u + c.G < NU) {
            const int un = u + c.G;
            topk_issue(c, ra, rb, Qp + (size_t)(mt_lo + (un >> 3)) * 128 * 2048 + ((un & 7) * 2) * 128, SK + (size_t)((un & 7) * 2) * 128 * 128);
        }
        __builtin_amdgcn_sched_barrier(0);
        __syncthreads();
        unsigned La[16], Lb[16];
#pragma unroll
        for (int i = 0; i < 16; ++i) { La[i] = 0u; Lb[i] = 0u; }
        if (c.tid < 256) {
            LAS float* row = (c.tid < 128 ? S0 : S1) + (c.tid & 127) * 129;
#pragma unroll
            for (int i = 0; i < 16; ++i) La[i] = (enc_key(row[i]) & ~127u) | (unsigned)i;
            sort16(La);
#pragma unroll 1
            for (int j0 = 16; j0 < 128; j0 += 16) {
#pragma unroll
                for (int i = 0; i < 16; ++i) Lb[i] = (enc_key(row[j0 + i]) & ~127u) | (unsigned)(j0 + i);
                sort16(Lb);
                merge16(La, Lb);
            }
        }
        __syncthreads();
        if (c.tid >= 128 && c.tid < 256) { LAS unsigned* lst = (LAS unsigned*)S1 + (c.tid - 128) * 129;
#pragma unroll
            for (int i = 0; i < 16; ++i) lst[i] = La[i]; }
        __syncthreads();
        if (c.tid < 128) {
            LAS unsigned* l1 = (LAS unsigned*)S1 + c.tid * 129;
#pragma unroll
            for (int i = 0; i < 16; ++i) Lb[i] = l1[i];
            unsigned M[16], T[16];
#define CK(a, b) ((enc_key(dec_key(La[a] & ~127u) + dec_key(Lb[b] & ~127u)) & ~255u) | (unsigned)(255 - ((a) * 16 + (b))))
#pragma unroll
            for (int b = 0; b < 16; ++b) M[b] = CK(0, b);
#pragma unroll
            for (int a = 1; a < 8; ++a) {
#pragma unroll
                for (int b = 0; b < 16; ++b) T[b] = ((a + 1) * (b + 1) <= 16) ? CK(a, b) : 0u;
                merge16(M, T);
            }
#pragma unroll
            for (int a = 8; a < 16; ++a) T[a - 8] = CK(a, 0);
#pragma unroll
            for (int i = 8; i < 16; ++i) T[i] = 0u;
            merge16(M, T);
#undef CK
            const int tok = mt * 128 + c.tid;
            float sv[16]; const float smax = dec_key(M[0] & ~255u); float sum = 0.f;
#pragma unroll
            for (int k = 0; k < 16; ++k) { sv[k] = fast_exp2((dec_key(M[k] & ~255u) - smax) * LOG2E); sum += sv[k]; }
            const float inv = 1.0f / sum;
            int* ip = IDX + ((size_t)tok * 8 + h) * 16; float* gp = GATE + ((size_t)tok * 8 + h) * 16;
            LAS unsigned* lst = (LAS unsigned*)S0 + c.tid * 129;
#pragma unroll
            for (int i = 0; i < 16; ++i) { lst[i] = La[i]; lst[16 + i] = Lb[i]; }
#pragma unroll
            for (int k = 0; k < 16; ++k) {
                const int ab = 255 - (int)(M[k] & 255u), a = ab >> 4, b = ab & 15;
                const int i0 = (int)(lst[a] & 127u), i1 = (int)(lst[16 + b] & 127u);
                ip[k] = i0 * 128 + i1; gp[k] = sv[k] * inv;
            }
        }
        __syncthreads();
    }
}
typedef unsigned u32x6 __attribute__((ext_vector_type(6)));
typedef float f32x32 __attribute__((ext_vector_type(32)));
__device__ __forceinline__ void gather_experts(const Ctx& c, int layer, const unsigned char* TU, const unsigned char* TV, const float (&xf)[32], int idA, int idB, float gA, float gB,
                                               int e_lo, int e_hi, float (&acc)[32]) {
    for (int e = e_lo; e < (((DBG_SKIP_GATHER >> layer) & 1) ? 0 : e_hi); e += 4) {
        const int sl = e & 63;
        int rr[4]; float gg[4];
#pragma unroll
        for (int k = 0; k < 4; ++k) { rr[k] = __shfl(e < 64 ? idA : idB, sl + k); gg[k] = __shfl(e < 64 ? gA : gB, sl + k); }
        u32x4 uu[4]; u32x4 vv[4];
#pragma unroll
        for (int k = 0; k < 4; ++k) {
            uu[k] = *(const u32x4*)(TU + (size_t)rr[k] * 1024 + c.lane * 16);
            vv[k] = *(const u32x4*)(TV + (size_t)rr[k] * 1024 + c.lane * 16);
        }
        __builtin_amdgcn_sched_barrier(0);
        float dd[4];
#pragma unroll
        for (int k = 0; k < 4; ++k) {
            float d0 = 0.f, d1 = 0.f;
#pragma unroll
            for (int q = 0; q < 4; ++q) {
                const f32x2 f0 = __builtin_amdgcn_cvt_scalef32_pk_f32_fp4(uu[k][q], 1.0f, 0), f1 = __builtin_amdgcn_cvt_scalef32_pk_f32_fp4(uu[k][q], 1.0f, 1);
                const f32x2 f2 = __builtin_amdgcn_cvt_scalef32_pk_f32_fp4(uu[k][q], 1.0f, 2), f3 = __builtin_amdgcn_cvt_scalef32_pk_f32_fp4(uu[k][q], 1.0f, 3);
                d0 += f0.x * xf[q * 8 + 0] + f1.x * xf[q * 8 + 2] + f2.x * xf[q * 8 + 4] + f3.x * xf[q * 8 + 6];
                d1 += f0.y * xf[q * 8 + 1] + f1.y * xf[q * 8 + 3] + f2.y * xf[q * 8 + 5] + f3.y * xf[q * 8 + 7];
            }
            dd[k] = d0 + d1;
        }
#pragma unroll
        for (int o = 32; o >= 1; o >>= 1) {
#pragma unroll
            for (int k = 0; k < 4; ++k) dd[k] += __shfl_xor(dd[k], o);
        }
#pragma unroll
        for (int k = 0; k < 4; ++k) {
            const float w = gg[k] * gelu_tanh(dd[k] * (1.0f / U_SCALE)) * (1.0f / V_SCALE);
#pragma unroll
            for (int q = 0; q < 4; ++q) {
                const f32x2 f0 = __builtin_amdgcn_cvt_scalef32_pk_f32_fp4(vv[k][q], 1.0f, 0), f1 = __builtin_amdgcn_cvt_scalef32_pk_f32_fp4(vv[k][q], 1.0f, 1);
                const f32x2 f2 = __builtin_amdgcn_cvt_scalef32_pk_f32_fp4(vv[k][q], 1.0f, 2), f3 = __builtin_amdgcn_cvt_scalef32_pk_f32_fp4(vv[k][q], 1.0f, 3);
                acc[q * 8 + 0] += w * f0.x; acc[q * 8 + 1] += w * f0.y; acc[q * 8 + 2] += w * f1.x; acc[q * 8 + 3] += w * f1.y;
                acc[q * 8 + 4] += w * f2.x; acc[q * 8 + 5] += w * f2.y; acc[q * 8 + 6] += w * f3.x; acc[q * 8 + 7] += w * f3.y;
            }
        }
    }
}
__device__ __forceinline__ void gather_load_x(const Ctx& c, const bf16_t* H, int tok, float (&xf)[32]) {
#pragma unroll
    for (int q = 0; q < 4; ++q) {
        const u32x4 v = *(const u32x4*)(H + (size_t)tok * D + c.lane * 32 + q * 8);
#pragma unroll
        for (int e = 0; e < 4; ++e) { xf[q * 8 + e * 2] = bf_lo(v[e]); xf[q * 8 + e * 2 + 1] = bf_hi(v[e]); }
    }
}
template <bool FINAL>
__device__ __forceinline__ void gather_epilogue(const Ctx& c, int layer, int tok, float (&acc)[32]) {
    const float* mods = c.wf(WS_MODS); float* xctx = c.wf(WS_XCTX); const float* fnorm = c.in[22];
    const int mw = tok < TC ? 2 : ((tok - TC) >> 14);
    const float* g2 = mods + (size_t)(layer * 3 + mw) * 12288 + 5 * 2048;
    float* xp = tok < TC ? xctx + (size_t)tok * D : c.out + (size_t)(tok - TC) * D;
    float ss = 0.f;
    f32x4 xa[8], ga[8];
#pragma unroll
    for (int q = 0; q < 8; ++q) { xa[q] = *(const f32x4*)(xp + c.lane * 32 + q * 4); ga[q] = *(const f32x4*)(g2 + c.lane * 32 + q * 4); }
    __builtin_amdgcn_sched_barrier(0);
#pragma unroll
    for (int q = 0; q < 8; ++q) {
        const int col = c.lane * 32 + q * 4;
        const f32x4 xv = xa[q], gv = ga[q];
        f32x4 o;
#pragma unroll
        for (int j = 0; j < 4; ++j) { o[j] = xv[j] + gv[j] * acc[q * 4 + j]; ss += o[j] * o[j]; }
        if (!FINAL) *(f32x4*)(xp + col) = o;
        else { acc[q * 4 + 0] = o[0]; acc[q * 4 + 1] = o[1]; acc[q * 4 + 2] = o[2]; acc[q * 4 + 3] = o[3]; }
    }
    if (FINAL) {
        f32x4 fwa[8];
#pragma unroll
        for (int q = 0; q < 8; ++q) fwa[q] = *(const f32x4*)(fnorm + c.lane * 32 + q * 4);
        __builtin_amdgcn_sched_barrier(0);
        ss = wave_sum(ss);
        const float rstd = rsqrtf(ss * (1.0f / D) + EPS);
#pragma unroll
        for (int q = 0; q < 8; ++q) {
            const int col = c.lane * 32 + q * 4;
            const f32x4 fw = fwa[q];
            f32x4 o;
#pragma unroll
            for (int j = 0; j < 4; ++j) o[j] = acc[q * 4 + j] * rstd * fw[j];
#if defined(DBG_ATTN_CHECK) || defined(DBG_TOPK_CHECK) || defined(DBG_TSEL) || defined(DBG_FOURIER_CHECK) || defined(DBG_RET_CHECK)
            for (int j = 0; j < 4; ++j) o[j] += 10000.0f * (float)(*(volatile unsigned*)(c.ws + WS_CTL + 32768));
#endif
            *(f32x4*)(xp + col) = o;
        }
    }
}
template <bool FINAL>
__device__ __forceinline__ void phase_peer_gather(const Ctx& c, int layer, int tok_lo) {
    const bf16_t* H = c.wb(WS_H); const unsigned char* TU = c.ws + WS_TABU + (size_t)layer * (32 * MiB); const unsigned char* TV = c.ws + WS_TABV + (size_t)layer * (32 * MiB);
    const int* IDX = (const int*)(c.ws + WS_IDX); const float* GATE = c.wf(WS_GATE);
    const int W = c.G * 8, nTok = TT - tok_lo, R = nTok / W, rem = nTok - R * W;
    u32x4 xr[4]; int idA = 0, idB = 0; float gA = 0.f, gB = 0.f;
    if (R > 0) {
        const int tok = tok_lo + c.bid * 8 + c.w;
#pragma unroll
        for (int q = 0; q < 4; ++q) xr[q] = *(const u32x4*)(H + (size_t)tok * D + c.lane * 32 + q * 8);
        idA = IDX[(size_t)tok * 128 + c.lane]; idB = IDX[(size_t)tok * 128 + 64 + c.lane];
        gA = GATE[(size_t)tok * 128 + c.lane]; gB = GATE[(size_t)tok * 128 + 64 + c.lane];
    }
    for (int r = 0; r < R; ++r) {
        const int tok = tok_lo + r * W + c.bid * 8 + c.w;
        float xf[32];
#pragma unroll
        for (int q = 0; q < 4; ++q)
#pragma unroll
            for (int e = 0; e < 4; ++e) { xf[q * 8 + e * 2] = bf_lo(xr[q][e]); xf[q * 8 + e * 2 + 1] = bf_hi(xr[q][e]); }
        const int cA = idA, cB = idB; const float cgA = gA, cgB = gB;
        if (r + 1 < R) {
            const int tn = tok + W;
#pragma unroll
            for (int q = 0; q < 4; ++q) xr[q] = *(const u32x4*)(H + (size_t)tn * D + c.lane * 32 + q * 8);
            idA = IDX[(size_t)tn * 128 + c.lane]; idB = IDX[(size_t)tn * 128 + 64 + c.lane];
            gA = GATE[(size_t)tn * 128 + c.lane]; gB = GATE[(size_t)tn * 128 + 64 + c.lane];
        }
        __builtin_amdgcn_sched_barrier(0);
        float acc[32];
#pragma unroll
        for (int j = 0; j < 32; ++j) acc[j] = 0.f;
        gather_experts(c, layer, TU, TV, xf, cA, cB, cgA, cgB, 0, 128, acc);
        gather_epilogue<FINAL>(c, layer, tok, acc);
    }
    if (rem > 0) {
        int S = 1; if (W % rem == 0) { const int q = W / rem; S = q >= 8 ? 8 : (q >= 4 ? 4 : (q >= 2 ? 2 : 1)); }
        const int per = 8 / S, ti = c.bid * per + c.w / S, part = c.w % S, ne = 128 / S;
        const bool act = ti < rem; const int tok = tok_lo + R * W + (act ? ti : 0);
        float acc[32];
#pragma unroll
        for (int j = 0; j < 32; ++j) acc[j] = 0.f;
        if (act) {
            float xf[32];
            gather_load_x(c, H, tok, xf);
            const int idA = IDX[(size_t)tok * 128 + c.lane], idB = IDX[(size_t)tok * 128 + 64 + c.lane];
            const float gA = GATE[(size_t)tok * 128 + c.lane], gB = GATE[(size_t)tok * 128 + 64 + c.lane];
            gather_experts(c, layer, TU, TV, xf, idA, idB, gA, gB, part * ne, part * ne + ne, acc);
        }
        if (S > 1) {
            LAS float* red = (LAS float*)c.lds;
            __syncthreads();
#pragma unroll
            for (int j = 0; j < 32; ++j) red[(c.w * 32 + j) * 64 + c.lane] = acc[j];
            __syncthreads();
            if (act && part == 0)
                for (int p = 1; p < S; ++p) {
#pragma unroll
                    for (int j = 0; j < 32; ++j) acc[j] += red[((c.w + p) * 32 + j) * 64 + c.lane];
                }
        }
        if (act && part == 0) gather_epilogue<FINAL>(c, layer, tok, acc);
    }
}

__device__ __forceinline__ void rope64_store(const f32x4 (&a)[4], bool rotate, int s, int g, float sc, const f32x2* r64, bf16_t* dst) {
    if (rotate) {
        const int prow = s >> 6, pcol = s & 63;
#pragma unroll
        for (int hlf = 0; hlf < 2; ++hlf) {
            const int pos = hlf == 0 ? prow : pcol;
            f32x4 o1, o2;
#pragma unroll
            for (int r = 0; r < 4; ++r) {
                const f32x2 cs = r64[pos * 16 + 4 * g + r];
                const float x1 = a[2 * hlf][r] * sc, x2 = a[2 * hlf + 1][r] * sc;
                o1[r] = x1 * cs.x - x2 * cs.y; o2[r] = x2 * cs.x + x1 * cs.y;
            }
            *(u32x2*)(dst + 32 * hlf) = pack4(o1); *(u32x2*)(dst + 32 * hlf + 16) = pack4(o2);
        }
    } else {
#pragma unroll
        for (int nb = 0; nb < 4; ++nb) *(u32x2*)(dst + 16 * nb) = pack4(a[nb] * sc);
    }
}
__device__ __forceinline__ void phase_odd_proj(const Ctx& c) {
    const bf16_t* H = c.wb(WS_H); const bf16_t* W = c.wb(WS_WINO);
    bf16_t* SQ = c.wb(WS_A); bf16_t* SK = c.wb(WS_Q); bf16_t* SV = c.wb(WS_Q + 9 * MiB); bf16_t* CQ = c.wb(WS_Q + 18 * MiB);
    bf16_t* CKV = c.wb(WS_K); bf16_t* KR = c.wb(WS_K + 17 * MiB);
    const f32x2* r64 = (const f32x2*)(c.ws + WS_ROPE + 131072);
    const int MT = TT / 128, NT = 17;
    const int g = c.lane >> 4, wm = c.w >> 1, wn = c.w & 1;
    for (int t = c.bid; t < MT * NT; t += c.G) {
        int mt, nt; tile_mn(t, MT, NT, mt, nt);
        f32x4 acc[2][4];
        gemm128<true>(c.lds, 2048, RowLin{H + (size_t)mt * 128 * D, (size_t)D}, RowLin{W + (size_t)nt * 128 * 2048, 2048}, acc);
#pragma unroll
        for (int mb = 0; mb < 2; ++mb) {
            const int tok = mt * 128 + 32 * wm + 16 * mb + (c.lane & 15);
            const bool lat = tok >= TC; const int s = (tok - TC) & (SEQ - 1);
            const int cw = 64 * wn + 4 * g;
            if (nt < 8) rope64_store(acc[mb], lat, s, g, 0.125f, r64, SQ + (size_t)tok * 1024 + nt * 128 + cw);
            else if (nt == 8) rope64_store(acc[mb], lat, s, g, 1.0f, r64, SK + (size_t)tok * 128 + cw);
            else if (nt == 9) rope64_store(acc[mb], false, s, g, 1.0f, r64, SV + (size_t)tok * 128 + cw);
            else if (nt < 14) rope64_store(acc[mb], false, s, g, 1.0f, r64, CQ + (size_t)tok * 512 + (nt - 10) * 128 + cw);
            else if (nt < 16) rope64_store(acc[mb], false, s, g, 1.0f, r64, CKV + (size_t)tok * 256 + (nt - 14) * 128 + cw);
            else if (wn == 0) rope64_store(acc[mb], lat, s, g, 1.0f, r64, KR + (size_t)tok * 64 + 4 * g);
        }
    }
}
__device__ __forceinline__ void phase_odd_local(const Ctx& c) {
    bf16_t* CQ = c.wb(WS_Q + 18 * MiB); bf16_t* CKV = c.wb(WS_K); const bf16_t* KR = c.wb(WS_K + 17 * MiB); bf16_t* MK = c.wb(WS_ST);
    const float* qn = c.in[13]; const float* kvn = c.in[14];
    const int l32 = c.lane & 31, hh = c.lane >> 3, part = c.lane & 7, W = c.G * 8;
    const f32x4 qw0 = *(const f32x4*)(qn + c.lane * 8), qw1 = *(const f32x4*)(qn + c.lane * 8 + 4);
    const f32x4 kw0 = *(const f32x4*)(kvn + l32 * 8), kw1 = *(const f32x4*)(kvn + l32 * 8 + 4);
    for (int t0 = c.bid * 8 + c.w; t0 < TT; t0 += 4 * W) {
        u32x4 vq[4], vk[4], vr[4];
#pragma unroll
        for (int k = 0; k < 4; ++k) {
            const int tok = t0 + k * W;
            if (tok < TT) {
                vq[k] = *(const u32x4*)(CQ + (size_t)tok * 512 + c.lane * 8);
                vk[k] = *(const u32x4*)(CKV + (size_t)tok * 256 + l32 * 8);
                vr[k] = *(const u32x4*)(KR + (size_t)tok * 64 + part * 8);
            }
        }
        __builtin_amdgcn_sched_barrier(0);
#pragma unroll
        for (int k = 0; k < 4; ++k) {
            const int tok = t0 + k * W;
            if (tok < TT) {
                {
                    const u32x4 v = vq[k];
                    float f[8] = {bf_lo(v.x), bf_hi(v.x), bf_lo(v.y), bf_hi(v.y), bf_lo(v.z), bf_hi(v.z), bf_lo(v.w), bf_hi(v.w)};
                    float ss = 0.f;
#pragma unroll
                    for (int j = 0; j < 8; ++j) ss += f[j] * f[j];
                    ss = wave_sum(ss);
                    const float rstd = rsqrtf(ss * (1.0f / 512.0f) + EPS);
                    u32x4 o; o.x = cvt_pk_bf16(f[0] * rstd * qw0[0], f[1] * rstd * qw0[1]); o.y = cvt_pk_bf16(f[2] * rstd * qw0[2], f[3] * rstd * qw0[3]);
                    o.z = cvt_pk_bf16(f[4] * rstd * qw1[0], f[5] * rstd * qw1[1]); o.w = cvt_pk_bf16(f[6] * rstd * qw1[2], f[7] * rstd * qw1[3]);
                    *(u32x4*)(CQ + (size_t)tok * 512 + c.lane * 8) = o;
                }
                {
                    const u32x4 v = vk[k];
                    float f[8] = {bf_lo(v.x), bf_hi(v.x), bf_lo(v.y), bf_hi(v.y), bf_lo(v.z), bf_hi(v.z), bf_lo(v.w), bf_hi(v.w)};
                    float ss = 0.f;
#pragma unroll
                    for (int j = 0; j < 8; ++j) ss += f[j] * f[j];
                    ss = wave_sum(ss) * 0.5f;
                    const float rstd = rsqrtf(ss * (1.0f / 256.0f) + EPS);
                    u32x4 o; o.x = cvt_pk_bf16(f[0] * rstd * kw0[0], f[1] * rstd * kw0[1]); o.y = cvt_pk_bf16(f[2] * rstd * kw0[2], f[3] * rstd * kw0[3]);
                    o.z = cvt_pk_bf16(f[4] * rstd * kw1[0], f[5] * rstd * kw1[1]); o.w = cvt_pk_bf16(f[6] * rstd * kw1[2], f[7] * rstd * kw1[3]);
                    if (c.lane < 32) *(u32x4*)(CKV + (size_t)tok * 256 + l32 * 8) = o;
                }
                *(u32x4*)(MK + ((size_t)tok * 8 + hh) * 192 + 128 + part * 8) = vr[k];
            }
        }
    }
}
__device__ __forceinline__ void phase_mla_up(const Ctx& c) {
    const bf16_t* CQ = c.wb(WS_Q + 18 * MiB); const bf16_t* CKV = c.wb(WS_K);
    const bf16_t* Wuq = c.wb(WS_WUQ); const bf16_t* Wukv = c.wb(WS_WUKV);
    bf16_t* MQ = c.wb(WS_G); bf16_t* MK = c.wb(WS_ST); bf16_t* MV = c.wb(WS_V);
    const f32x2* r64 = (const f32x2*)(c.ws + WS_ROPE + 131072);
    const int g = c.lane >> 4, wm = c.w >> 1, wn = c.w & 1;
    const int NUQ = 256 * 12, NUKV = 260 * 16;
    for (int u = c.bid; u < NUQ + NUKV; u += c.G) {
        f32x4 acc[2][4];
        if (u < NUQ) {
            int mt, nt; tile_mn(u, 256, 12, mt, nt); mt += 4;
            gemm128<true>(c.lds, 512, RowLin{CQ + (size_t)mt * 128 * 512, 512}, RowLin{Wuq + (size_t)nt * 128 * 512, 512}, acc);
            const int rr = nt * 2 + wn, part = rr % 3;
#pragma unroll
            for (int mb = 0; mb < 2; ++mb) {
                const int tok = mt * 128 + 32 * wm + 16 * mb + (c.lane & 15); const int s = (tok - TC) & (SEQ - 1);
                rope64_store(acc[mb], part == 2, s, g, 0.07216878364870322f, r64, MQ + (size_t)tok * 1536 + rr * 64 + 4 * g);
            }
        } else {
            int mt, nt; tile_mn(u - NUQ, 260, 16, mt, nt);
            gemm128<true>(c.lds, 256, RowLin{CKV + (size_t)mt * 128 * 256, 256}, RowLin{Wukv + (size_t)nt * 128 * 256, 256}, acc);
            const int head = nt >> 1;
#pragma unroll
            for (int mb = 0; mb < 2; ++mb) {
                const int tok = mt * 128 + 32 * wm + 16 * mb + (c.lane & 15);
                bf16_t* dst = (nt & 1) ? MV + ((size_t)tok * 8 + head) * 128 + 64 * wn + 4 * g : MK + ((size_t)tok * 8 + head) * 192 + 64 * wn + 4 * g;
#pragma unroll
                for (int nb = 0; nb < 4; ++nb) *(u32x2*)(dst + 16 * nb) = pack4(acc[mb][nb]);
            }
        }
    }
}

__device__ __forceinline__ int fresh_lane() { int l = __builtin_amdgcn_mbcnt_hi(~0u, __builtin_amdgcn_mbcnt_lo(~0u, 0u)); asm volatile("" : "+v"(l)); return l; }
__device__ __forceinline__ void half_pair(float v, float& a, float& b) {
    const auto rr = __builtin_amdgcn_permlane32_swap(__float_as_uint(v), __float_as_uint(v), false, false);
    a = __uint_as_float(rr[0]); b = __uint_as_float(rr[1]);
}
template <int DQK, int DV, bool SWA, bool YOUNG>
__device__ __forceinline__ void attn_body(const Ctx& c0, const bf16_t* __restrict__ qptr, int qpitch, const bf16_t* __restrict__ kptr, int kpitch,
                                          const bf16_t* __restrict__ vptr, int vpitch, bf16_t* __restrict__ optr, int opitch, int b, int q0, float sink) {
    constexpr int KS = DQK * 2 + 16, VS = DV * 2 + (DV == 128 ? 32 : 16);
    constexpr int KCPR = DQK / 8, VCPR = DV / 8, KPT = DQK / 64, VPT = DV / 64, NKS = DQK / 16, NDB = DV / 32;
    constexpr int KB = 64 * KS;
    const int lane = fresh_lane(), tid = c0.w * 64 + lane;
    LAS unsigned char* kbuf = c0.lds; LAS unsigned char* vt = c0.lds + 2 * KB;
    const int hh = lane >> 5, l31 = lane & 31, blk = (lane >> 4) & 1;
    int ntiles, kt_lo = 0;
    if (SWA) { kt_lo = (q0 - 128) >> 6; if (kt_lo < 0) kt_lo = 0; int kt_hi = (q0 + 255 + 128) >> 6; if (kt_hi > 255) kt_hi = 255; ntiles = 4 + kt_hi - kt_lo + 1; }
    else ntiles = 4 + 256;
    bf16x8 qf[NKS];
    {
        const bf16_t* qr = qptr + (size_t)(32 * c0.w + l31) * qpitch + 8 * hh;
#pragma unroll
        for (int ks = 0; ks < NKS; ++ks) qf[ks] = *(const bf16x8*)(qr + 16 * ks);
    }
    f32x16 o[NDB];
#pragma unroll
    for (int db = 0; db < NDB; ++db)
#pragma unroll
        for (int r = 0; r < 16; ++r) o[db][r] = 0.f;
    float m = SWA ? sink * LOG2E : 0.0f, l = (SWA && hh == 0) ? 1.0f : 0.0f;

    const int qpos = q0 + 32 * c0.w + l31;
    u32x4 kr[KPT], vr[VPT];
#define ATT_TK(tt) ((tt) < 4 ? b * NCTX + 64 * (tt) : TC + b * SEQ + 64 * (kt_lo + (tt) - 4))
#define ATT_LOADK(tt) do { const char* _kb = (const char*)(kptr + (size_t)ATT_TK(tt) * kpitch); \
        _Pragma("unroll") for (int i = 0; i < KPT; ++i) { const int id = tid + 512 * i, row = id / KCPR, ch = id % KCPR; kr[i] = *(const u32x4*)(_kb + (unsigned)((row * kpitch + ch * 8) * 2)); } } while (0)
#define ATT_LOADV(tt) do { const char* _vb = (const char*)(vptr + (size_t)ATT_TK(tt) * vpitch); \
        _Pragma("unroll") for (int i = 0; i < VPT; ++i) { const int id = tid + 512 * i, row = id / VCPR, ch = id % VCPR; vr[i] = *(const u32x4*)(_vb + (unsigned)((row * vpitch + ch * 8) * 2)); } } while (0)
#define ATT_WRITE_K(buf) do { _Pragma("unroll") for (int i = 0; i < KPT; ++i) { const int id = tid + 512 * i, row = id / KCPR, ch = id % KCPR; *(LAS u32x4*)(kbuf + (buf) * KB + row * KS + ch * 16) = kr[i]; } } while (0)
#define ATT_WRITE_V() do { _Pragma("unroll") for (int i = 0; i < VPT; ++i) { const int id = tid + 512 * i, row = id / VCPR, ch = id % VCPR; *(LAS u32x4*)(vt + row * VS + ch * 16) = vr[i]; } } while (0)
#define ATT_QK(buf) do { f32x16 negm; _Pragma("unroll") for (int r = 0; r < 16; ++r) negm[r] = -m; \
        _Pragma("unroll") for (int ks = 0; ks < NKS; ++ks) _Pragma("unroll") for (int kb = 0; kb < 2; ++kb) { \
            const bf16x8 kf = *(const LAS bf16x8*)(kbuf + (buf) * KB + (32 * kb + l31) * KS + (16 * ks + 8 * hh) * 2); \
            s[kb] = __builtin_amdgcn_mfma_f32_32x32x16_bf16(kf, qf[ks], ks == 0 ? negm : s[kb], 0, 0, 0); } } while (0)
    f32x16 s[2];
    ATT_LOADK(0); ATT_WRITE_K(0); ATT_LOADV(0);
    if (ntiles > 1) ATT_LOADK(1);
    __syncthreads();
    if (YOUNG) ATT_QK(0);
    for (int t = 0; t < ntiles; ++t) {
        __syncthreads();
        ATT_WRITE_V();
        if (t + 1 < ntiles) ATT_WRITE_K((t + 1) & 1);
        __syncthreads();
        if (t + 1 < ntiles) ATT_LOADV(t + 1);
        if (t + 2 < ntiles) ATT_LOADK(t + 2);
        if (!YOUNG) ATT_QK(t & 1);
        if (SWA && t >= 4) {
            const int kpos0 = 64 * (kt_lo + t - 4);
#pragma unroll
            for (int kb = 0; kb < 2; ++kb)
#pragma unroll
                for (int r = 0; r < 16; ++r) {
                    const int kpos = kpos0 + 32 * kb + (r & 3) + 8 * (r >> 2) + 4 * hh; const int dd = qpos - kpos;
                    if (dd > 128 || dd < -128) s[kb][r] = -INFINITY;
                }
        }
        float tm = s[0][0];
#pragma unroll
        for (int kb = 0; kb < 2; ++kb)
#pragma unroll
            for (int r = 0; r < 16; ++r) tm = fmaxf(tm, s[kb][r]);
        { float ta, tb; half_pair(tm, ta, tb); tm = fmaxf(ta, tb); }
        const bool upd = tm > 8.0f || (!SWA && t == 0);
        if (!__all(!upd)) {
            const float d = upd ? tm : 0.f;
#pragma unroll
            for (int kb = 0; kb < 2; ++kb)
#pragma unroll
                for (int r = 0; r < 16; ++r) s[kb][r] -= d;
            m += d;
            const float alpha = d > 0.f ? fast_exp2(-d) : 1.0f;
            l *= alpha;
#pragma unroll
            for (int db = 0; db < NDB; ++db)
#pragma unroll
                for (int r = 0; r < 16; ++r) o[db][r] *= alpha;
        }
        float ps = 0.f;
#pragma unroll
        for (int kb = 0; kb < 2; ++kb)
#pragma unroll
            for (int r = 0; r < 16; ++r) { const float p = fast_exp2(s[kb][r]); s[kb][r] = p; ps += p; }
        l += ps;
#pragma unroll
        for (int kb = 0; kb < 2; ++kb)
#pragma unroll
            for (int s2 = 0; s2 < 2; ++s2) {
                u32x4 pk;
                pk.x = cvt_pk_bf16(s[kb][8 * s2 + 0], s[kb][8 * s2 + 1]); pk.y = cvt_pk_bf16(s[kb][8 * s2 + 2], s[kb][8 * s2 + 3]);
                pk.z = cvt_pk_bf16(s[kb][8 * s2 + 4], s[kb][8 * s2 + 5]); pk.w = cvt_pk_bf16(s[kb][8 * s2 + 6], s[kb][8 * s2 + 7]);
                const bf16x8 pf = __builtin_bit_cast(bf16x8, pk);
                const int r0 = 32 * kb + 16 * s2 + 4 * hh;
#pragma unroll
                for (int db = 0; db < NDB; ++db) {
                    const bf16x8 vf = cat8(tr_read(vt + r0 * VS + (32 * db + 16 * blk) * 2, VS, lane), tr_read(vt + (r0 + 8) * VS + (32 * db + 16 * blk) * 2, VS, lane));
                    o[db] = __builtin_amdgcn_mfma_f32_32x32x16_bf16(vf, pf, o[db], 0, 0, 0);
                }
            }
        if (YOUNG && t + 1 < ntiles) ATT_QK((t + 1) & 1);
    }
#undef ATT_TK
#undef ATT_LOADK
#undef ATT_LOADV
#undef ATT_WRITE_K
#undef ATT_WRITE_V
#undef ATT_QK
    { float la, lb; half_pair(l, la, lb); l = la + lb; }
    const float inv = 1.0f / l;
    const int le = fresh_lane();
    bf16_t* orow = optr + (size_t)(32 * c0.w + (le & 31)) * opitch + 4 * (le >> 5);
#pragma unroll
    for (int db = 0; db < NDB; ++db)
#pragma unroll
        for (int rg = 0; rg < 4; ++rg) {
            f32x4 v = {o[db][4 * rg] * inv, o[db][4 * rg + 1] * inv, o[db][4 * rg + 2] * inv, o[db][4 * rg + 3] * inv};
            *(u32x2*)(orow + 32 * db + 8 * rg) = pack4(v);
        }
    __syncthreads();
}
template <int DQK, int DV, bool SWA>
__device__ __forceinline__ void attn_unit(const Ctx& c, const bf16_t* __restrict__ qptr, int qpitch, const bf16_t* __restrict__ kptr, int kpitch,
                                          const bf16_t* __restrict__ vptr, int vpitch, bf16_t* __restrict__ optr, int opitch, int b, int q0, float sink) {
    if (c.w < 4) attn_body<DQK, DV, SWA, false>(c, qptr, qpitch, kptr, kpitch, vptr, vpitch, optr, opitch, b, q0, sink);
    else attn_body<DQK, DV, SWA, true>(c, qptr, qpitch, kptr, kpitch, vptr, vpitch, optr, opitch, b, q0, sink);
}
__device__ __forceinline__ void phase_attention(const Ctx& c) {
    const bf16_t* MQ = c.wb(WS_G); const bf16_t* MK = c.wb(WS_ST); const bf16_t* MV = c.wb(WS_V);
    const bf16_t* SQ = c.wb(WS_A); const bf16_t* SK = c.wb(WS_Q); const bf16_t* SV = c.wb(WS_Q + 9 * MiB);
    bf16_t* CAT = c.wb(WS_CAT); const float* sink = c.in[12];
    for (int u = c.bid; u < 1024; u += c.G) {
        const int b = u >> 9, h = (u >> 6) & 7, qb = u & 63; const size_t tok0 = (size_t)TC + (size_t)b * SEQ + qb * 256;
        attn_unit<192, 128, false>(c, MQ + tok0 * 1536 + h * 192, 1536, MK + h * 192, 1536, MV + h * 128, 1024, CAT + tok0 * 2048 + 1024 + h * 128, 2048, b, qb * 256, 0.f);
    }
    for (int u = c.bid; u < 2048; u += c.G) {
        const int b = u >> 10, hq = (u >> 6) & 15, qb = u & 63; const size_t tok0 = (size_t)TC + (size_t)b * SEQ + qb * 256;
        attn_unit<64, 64, true>(c, SQ + tok0 * 1024 + hq * 64, 1024, SK + (hq >> 3) * 64, 128, SV + (hq >> 3) * 64, 128, CAT + tok0 * 2048 + hq * 64, 2048, b, qb * 256, sink[hq]);
    }
}


#ifdef DBG_TOPK_CHECK

__device__ __forceinline__ void dbg_gather_save(const Ctx& c) {
    if (c.bid >= 64) return;
    const int tok = 512 + 509 * c.bid + (c.bid & 1 ? 0 : 7);
    float* sv = (float*)(c.ws + WS_CTL + 65536) + (size_t)c.bid * 2048;
    for (int i = c.tid; i < 2048; i += 512) sv[i] = c.out[(size_t)(tok - TC) * D + i];
}
__device__ __forceinline__ void dbg_gather_check(const Ctx& c) {
    if (c.bid >= 64) return;
    const int tok = 512 + 509 * c.bid + (c.bid & 1 ? 0 : 7);
    const bf16_t* H = c.wb(WS_H); const bf16_t* TU = c.wb(WS_TABU); const bf16_t* TV = c.wb(WS_TABV);
    const int* IDX = (const int*)(c.ws + WS_IDX); const float* GATE = c.wf(WS_GATE);
    const float* sv = (const float*)(c.ws + WS_CTL + 65536) + (size_t)c.bid * 2048;
    const float* g2 = c.wf(WS_MODS) + (size_t)(0 * 3 + ((tok - TC) >> 14)) * 12288 + 5 * 2048;
    LAS float* red = (LAS float*)c.lds;
    float f0 = 0.f, f1 = 0.f, f2 = 0.f, f3 = 0.f;
    const int d0 = c.tid * 4;
    for (int e = 0; e < 128; ++e) {
        const int id = IDX[(size_t)tok * 128 + e]; const float gt = GATE[(size_t)tok * 128 + e];
        float p = 0.f;
        for (int j = 0; j < 4; ++j) p += bf2f(H[(size_t)tok * D + d0 + j]) * bf2f(TU[(size_t)id * D + d0 + j]);
        p = wave_sum(p);
        __syncthreads();
        if (c.lane == 0) red[c.w] = p;
        __syncthreads();
        float a = 0.f; for (int w = 0; w < 8; ++w) a += red[w];
        const float wgt = gt * gelu_tanh(a);
        f0 += wgt * bf2f(TV[(size_t)id * D + d0]); f1 += wgt * bf2f(TV[(size_t)id * D + d0 + 1]); f2 += wgt * bf2f(TV[(size_t)id * D + d0 + 2]); f3 += wgt * bf2f(TV[(size_t)id * D + d0 + 3]);
    }
    const float* xo = c.out + (size_t)(tok - TC) * D + d0;
    int bad = 0;
    if (fabsf(sv[d0] + g2[d0] * f0 - xo[0]) > 0.02f) bad = 16;
    if (fabsf(sv[d0 + 1] + g2[d0 + 1] * f1 - xo[1]) > 0.02f) bad = 16;
    if (fabsf(sv[d0 + 2] + g2[d0 + 2] * f2 - xo[2]) > 0.02f) bad = 16;
    if (fabsf(sv[d0 + 3] + g2[d0 + 3] * f3 - xo[3]) > 0.02f) bad = 16;
    if (bad) atomicOr((unsigned*)(c.ws + WS_CTL + 32768), (unsigned)bad);
}
__device__ __forceinline__ void dbg_topk_check(const Ctx& c) {
    const bf16_t* Qp = c.wb(WS_G); const bf16_t* SK = c.wb(WS_SKB);
    const int* IDX = (const int*)(c.ws + WS_IDX); const float* GATE = c.wf(WS_GATE);
    LAS float* sc = (LAS float*)c.lds;
    LAS int* cnt = (LAS int*)(c.lds + 2048);
    if (c.bid >= 64) return;
    const int tok = 512 + 509 * c.bid + (c.bid & 1 ? 0 : 7);
    int bad = 0;
    for (int h = 0; h < 8; ++h) {
        if (c.tid < 256) {
            const int p = c.tid >> 7, key = c.tid & 127, hp = h * 2 + p;
            float s = 0.f;
            for (int cc = 0; cc < 128; ++cc) s += bf2f(Qp[(size_t)tok * 2048 + hp * 128 + cc]) * bf2f(SK[((size_t)hp * 128 + key) * 128 + cc]);
            sc[p * 128 + key] = s;
        }
        if (c.tid == 0) cnt[0] = 0;
        __syncthreads();
        LAS float* ls = (LAS float*)(c.lds + 4096);
        if (c.tid < 16) { const int id = IDX[((size_t)tok * 8 + h) * 16 + c.tid]; ls[c.tid] = sc[(id >> 7) & 127] + sc[128 + (id & 127)]; if (id < 0 || id >= 16384) bad |= 1; }
        __syncthreads();
        float smin = 1e30f, smax = -1e30f;
        for (int k = 0; k < 16; ++k) { smin = fminf(smin, ls[k]); smax = fmaxf(smax, ls[k]); }
        for (int k = 0; k < 16; ++k) for (int k2 = k + 1; k2 < 16; ++k2) if (IDX[((size_t)tok * 8 + h) * 16 + k] == IDX[((size_t)tok * 8 + h) * 16 + k2]) bad |= 2;
        int n = 0;
        for (int i = c.tid; i < 16384; i += 512) { const float v = sc[i >> 7] + sc[128 + (i & 127)]; if (v > smin + 2e-2f) ++n; }
        atomicAdd((int*)cnt, n);
        __syncthreads();
        if (cnt[0] > 15) bad |= 4;
        float den = 0.f; for (int k = 0; k < 16; ++k) den += fast_exp2((ls[k] - smax) * LOG2E);
        for (int k = 0; k < 16; ++k) { const float gref = fast_exp2((ls[k] - smax) * LOG2E) / den; if (fabsf(gref - GATE[((size_t)tok * 8 + h) * 16 + k]) > 2e-2f) bad |= 8; }
        __syncthreads();
    }
    if (bad && c.tid == 0) atomicOr((unsigned*)(c.ws + WS_CTL + 32768), (unsigned)bad);
}
#endif

#ifdef DBG_ATTN_CHECK
__device__ __forceinline__ void dbg_attn_check(const Ctx& c) {
    if (c.bid >= 64) return;
    LAS float* sc = (LAS float*)c.lds;
    LAS float* red = (LAS float*)(c.lds + 80000);
    const bf16_t* CAT = c.wb(WS_CAT);
    int bad = 0;
    if (c.bid < 32) {
        const bf16_t* MQ = c.wb(WS_G); const bf16_t* MK = c.wb(WS_ST); const bf16_t* MV = c.wb(WS_V);
        const int b = c.bid & 1, h = (c.bid >> 1) & 7, s = (c.bid * 523 + 77) & 16383;
        const size_t tok = (size_t)TC + (size_t)b * SEQ + s;
        float lmax = -1e30f;
        for (int k = c.tid; k < 16640; k += 512) {
            const size_t kt = k < 256 ? (size_t)b * 256 + k : (size_t)TC + (size_t)b * SEQ + (k - 256);
            float a = 0.f;
            for (int d = 0; d < 192; ++d) a += bf2f(MQ[tok * 1536 + h * 192 + d]) * bf2f(MK[(kt * 8 + h) * 192 + d]);
            sc[k] = a; lmax = fmaxf(lmax, a);
        }
#pragma unroll
        for (int o = 32; o >= 1; o >>= 1) lmax = fmaxf(lmax, __shfl_xor(lmax, o));
        if (c.lane == 0) red[c.w] = lmax;
        __syncthreads();
        float mx = red[0]; for (int w = 1; w < 8; ++w) mx = fmaxf(mx, red[w]);
        __syncthreads();
        float ls = 0.f;
        for (int k = c.tid; k < 16640; k += 512) { float p = fast_exp2((sc[k] - mx) * LOG2E);
#if defined(DBG_ATTN_MODE) && DBG_ATTN_MODE == 1
            p = 1.f;
#endif
            sc[k] = p; ls += p; }
        ls = wave_sum(ls);
        if (c.lane == 0) red[c.w] = ls;
        __syncthreads();
        float den = 0.f; for (int w = 0; w < 8; ++w) den += red[w];
        if (c.tid < 128) {
            float o = 0.f;
            for (int k = 0; k < 16640; ++k) { const size_t kt = k < 256 ? (size_t)b * 256 + k : (size_t)TC + (size_t)b * SEQ + (k - 256);
#ifdef DBG_ATTN_SYNV
                o += sc[k] * (float)((((int)kt) * 3 + c.tid) & 31);
#else
                o += sc[k] * bf2f(MV[(kt * 8 + h) * 128 + c.tid]);
#endif
            }
            o /= den;
            const float got = bf2f(CAT[tok * 2048 + 1024 + h * 128 + c.tid]);
            if (fabsf(got - o) > 0.002f + 0.03f * fabsf(o)) bad = 1;

        }
    } else {
        const bf16_t* SQ = c.wb(WS_A); const bf16_t* SK = c.wb(WS_Q); const bf16_t* SV = c.wb(WS_Q + 9 * MiB);
        const int i = c.bid - 32; const int b = i & 1, hq = (i >> 1) & 15;
        const int s = i < 4 ? (i == 0 ? 0 : (i == 1 ? 16383 : (i == 2 ? 100 : 16300))) : ((i * 1021 + 333) & 16383);
        const size_t tok = (size_t)TC + (size_t)b * SEQ + s; const int hk = hq >> 3;
        const float sink = c.in[12][hq];
        const int lo = s - 128 < 0 ? 0 : s - 128, hi = s + 128 > 16383 ? 16383 : s + 128, nk = 256 + hi - lo + 1;
        float lmax = sink;
        for (int k = c.tid; k < nk; k += 512) {
            const size_t kt = k < 256 ? (size_t)b * 256 + k : (size_t)TC + (size_t)b * SEQ + lo + (k - 256);
            float a = 0.f;
            for (int d = 0; d < 64; ++d) a += bf2f(SQ[tok * 1024 + hq * 64 + d]) * bf2f(SK[kt * 128 + hk * 64 + d]);
            sc[k] = a; lmax = fmaxf(lmax, a);
        }
#pragma unroll
        for (int o = 32; o >= 1; o >>= 1) lmax = fmaxf(lmax, __shfl_xor(lmax, o));
        if (c.lane == 0) red[c.w] = lmax;
        __syncthreads();
        float mx = red[0]; for (int w = 1; w < 8; ++w) mx = fmaxf(mx, red[w]);
        __syncthreads();
        float ls = 0.f;
        for (int k = c.tid; k < nk; k += 512) { float p = fast_exp2((sc[k] - mx) * LOG2E);
#if defined(DBG_ATTN_MODE) && DBG_ATTN_MODE == 1
            p = 1.f;
#endif
            sc[k] = p; ls += p; }
        ls = wave_sum(ls);
        if (c.lane == 0) red[c.w] = ls;
        __syncthreads();
#if defined(DBG_ATTN_MODE) && DBG_ATTN_MODE == 1
        float den = 1.f;
#else
        float den = fast_exp2((sink - mx) * LOG2E);
#endif
        for (int w = 0; w < 8; ++w) den += red[w];
        if (c.tid < 64) {
            float o = 0.f;
            for (int k = 0; k < nk; ++k) { const size_t kt = k < 256 ? (size_t)b * 256 + k : (size_t)TC + (size_t)b * SEQ + lo + (k - 256); o += sc[k] * bf2f(SV[kt * 128 + hk * 64 + c.tid]); }
            o /= den;
            const float got = bf2f(CAT[tok * 2048 + hq * 64 + c.tid]);
            if (fabsf(got - o) > 0.002f + 0.03f * fabsf(o)) bad = 2;

        }
    }
    if (bad) atomicOr((unsigned*)(c.ws + WS_CTL + 32768), (unsigned)bad);
    __syncthreads();
}
#endif

typedef const f32x4 (&Acc8)[2][2][4][2];
__device__ __forceinline__ void rope64_pair(const f32x4 a, const f32x4 b, bool rotate, const f32x4 (&cs)[2], float sc, bf16_t* dst) {
    if (rotate) {
        f32x4 o1, o2;
#pragma unroll
        for (int r = 0; r < 4; ++r) { const float cx = cs[r >> 1][(r & 1) * 2], sx = cs[r >> 1][(r & 1) * 2 + 1]; const float x1 = a[r] * sc, x2 = b[r] * sc; o1[r] = x1 * cx - x2 * sx; o2[r] = x2 * cx + x1 * sx; }
        *(u32x2*)dst = pack4(o1); *(u32x2*)(dst + 16) = pack4(o2);
    } else { *(u32x2*)dst = pack4(a * sc); *(u32x2*)(dst + 16) = pack4(b * sc); }
}
__device__ __forceinline__ void rope64_load(f32x4 (&cs)[2], const f32x2* r64, int tok, int wc, int fq) {
    const int s = (tok - TC) & (SEQ - 1), pos = (wc & 1) == 0 ? (s >> 6) : (s & 63);
    const f32x4* p = (const f32x4*)(r64 + pos * 16 + 4 * fq);
    if (tok >= TC) { cs[0] = p[0]; cs[1] = p[1]; }
}
struct EpiEvenProj {
    static constexpr bool PERM = false, AFTER_DRAIN = false;
    bf16_t* F; bf16_t* Q; bf16_t* Kb; bf16_t* V; bf16_t* Gt; const f32x2* r128;
    __device__ __forceinline__ void ld_cs(f32x4 (&cs)[2], int tok, int wc, int fq) const {
        const int s = (tok - TC) & (SEQ - 1), pos = (wc >> 1) == 0 ? (s >> 6) : (s & 63);
        const f32x4* p = (const f32x4*)(r128 + pos * 32 + 16 * (wc & 1) + 4 * fq);
        if (tok >= TC) { cs[0] = p[0]; cs[1] = p[1]; }
    }
    __device__ __forceinline__ void operator()(Acc8 acc, const pg8::Unit& u, int wr, int wc, int fr, int fq) const {
        const int region = u.pn >> 2, ct = (u.pn & 3) * 256;
        const bool qk = region == 1 || region == 2;
        const int tok0 = u.pm * 256 + wr * 64 + fr;
        f32x4 cur[2], nxt[2];
        if (qk) ld_cs(cur, tok0, wc, fq);
#pragma unroll
        for (int ai = 0; ai < 2; ++ai)
#pragma unroll
            for (int m = 0; m < 4; ++m) {
                const int tok = tok0 + ai * 128 + m * 16, gi = ai * 4 + m;
                if (qk && gi + 1 < 8) ld_cs(nxt, tok0 + ((gi + 1) >> 2) * 128 + ((gi + 1) & 3) * 16, wc, fq);
#pragma unroll
                for (int bj = 0; bj < 2; ++bj) {
                    const int col = ct + bj * 128 + wc * 32 + 4 * fq;
                    if (region == 0) { *(u32x2*)(F + (size_t)tok * 1024 + col) = pack4(acc[ai][bj][m][0]); *(u32x2*)(F + (size_t)tok * 1024 + col + 16) = pack4(acc[ai][bj][m][1]); }
                    else if (region == 3) { *(u32x2*)(V + (size_t)tok * 1024 + col) = pack4(acc[ai][bj][m][0]); *(u32x2*)(V + (size_t)tok * 1024 + col + 16) = pack4(acc[ai][bj][m][1]); }
                    else if (region >= 4) {
#pragma unroll
                        for (int n = 0; n < 2; ++n) { f32x4 o;
#pragma unroll
                            for (int r = 0; r < 4; ++r) o[r] = silu_f(acc[ai][bj][m][n][r]);
                            *(u32x2*)(Gt + (size_t)tok * 2048 + (region - 4) * 1024 + col + 16 * n) = pack4(o); }
                    } else {
                        const int head = (u.pn & 3) * 2 + bj, d0 = 64 * (wc >> 1) + 16 * (wc & 1) + 4 * fq;
                        bf16_t* dst = (region == 1 ? Q : Kb) + (size_t)tok * 1024 + head * 128 + d0;
                        const float sc = region == 2 ? 0.08838834764831845f : 1.0f;
                        if (tok >= TC) {
                            f32x4 o1, o2;
#pragma unroll
                            for (int r = 0; r < 4; ++r) { const float cx = cur[r >> 1][(r & 1) * 2], sx = cur[r >> 1][(r & 1) * 2 + 1]; const float a = acc[ai][bj][m][0][r] * sc, b = acc[ai][bj][m][1][r] * sc; o1[r] = a * cx - b * sx; o2[r] = b * cx + a * sx; }
                            *(u32x2*)dst = pack4(o1); *(u32x2*)(dst + 32) = pack4(o2);
                        } else { *(u32x2*)dst = pack4(acc[ai][bj][m][0] * sc); *(u32x2*)(dst + 32) = pack4(acc[ai][bj][m][1] * sc); }
                    }
                }
                if (qk && gi + 1 < 8) { cur[0] = nxt[0]; cur[1] = nxt[1]; }
            }
    }
};
struct EpiOddProj {
    static constexpr bool PERM = false, AFTER_DRAIN = false;
    bf16_t* SQ; bf16_t* SK; bf16_t* SV; bf16_t* CQ; bf16_t* CKV; bf16_t* KR; const f32x2* r64;
    __device__ __forceinline__ void operator()(Acc8 acc, const pg8::Unit& u, int wr, int wc, int fr, int fq) const {
        const bool rot = u.pn <= 4 || u.pn == 8;
        const int tok0 = u.pm * 256 + wr * 64 + fr;
        f32x4 cur[2], nxt[2];
        if (rot) rope64_load(cur, r64, tok0, wc, fq);
#pragma unroll
        for (int ai = 0; ai < 2; ++ai)
#pragma unroll
            for (int m = 0; m < 4; ++m) {
                const int tok = tok0 + ai * 128 + m * 16, gi = ai * 4 + m;
                if (rot && gi + 1 < 8) rope64_load(nxt, r64, tok0 + ((gi + 1) >> 2) * 128 + ((gi + 1) & 3) * 16, wc, fq);
                const bool lat = tok >= TC;
#pragma unroll
                for (int bj = 0; bj < 2; ++bj) {
                    const int c0 = u.pn * 256 + bj * 128 + wc * 32 + 4 * fq;
                    const f32x4 a = acc[ai][bj][m][0], b = acc[ai][bj][m][1];
                    if (u.pn < 4) rope64_pair(a, b, lat, cur, 0.125f * LOG2E, SQ + (size_t)tok * 1024 + c0);
                    else if (u.pn == 4) { if (bj == 0) rope64_pair(a, b, lat, cur, 1.0f, SK + (size_t)tok * 128 + (c0 - 1024)); else rope64_pair(a, b, false, cur, 1.0f, SV + (size_t)tok * 128 + (c0 - 1152)); }
                    else if (u.pn < 7) rope64_pair(a, b, false, cur, 1.0f, CQ + (size_t)tok * 512 + (c0 - 1280));
                    else if (u.pn == 7) rope64_pair(a, b, false, cur, 1.0f, CKV + (size_t)tok * 256 + (c0 - 1792));
                    else if (bj == 0 && wc < 2) rope64_pair(a, b, lat, cur, 1.0f, KR + (size_t)tok * 64 + (c0 - 2048));
                }
                if (rot && gi + 1 < 8) { cur[0] = nxt[0]; cur[1] = nxt[1]; }
            }
    }
};
struct EpiMlaQ {
    static constexpr bool PERM = false, AFTER_DRAIN = false;
    bf16_t* MQ; const f32x2* r64;
    __device__ __forceinline__ void operator()(Acc8 acc, const pg8::Unit& u, int wr, int wc, int fr, int fq) const {
        const int tok0 = TC + u.pm * 256 + wr * 64 + fr;
        f32x4 cur[2], nxt[2];
        rope64_load(cur, r64, tok0, wc, fq);
#pragma unroll
        for (int ai = 0; ai < 2; ++ai)
#pragma unroll
            for (int m = 0; m < 4; ++m) {
                const int tok = tok0 + ai * 128 + m * 16, gi = ai * 4 + m;
                if (gi + 1 < 8) rope64_load(nxt, r64, tok0 + ((gi + 1) >> 2) * 128 + ((gi + 1) & 3) * 16, wc, fq);
#pragma unroll
                for (int bj = 0; bj < 2; ++bj) {
                    const int c0 = u.pn * 256 + bj * 128 + wc * 32 + 4 * fq; const int rr = c0 >> 6;
                    rope64_pair(acc[ai][bj][m][0], acc[ai][bj][m][1], (rr % 3) == 2, cur, 0.07216878364870322f * LOG2E, MQ + (size_t)tok * 1536 + c0);
                }
                if (gi + 1 < 8) { cur[0] = nxt[0]; cur[1] = nxt[1]; }
            }
    }
};
struct EpiMlaKV {
    static constexpr bool PERM = false, AFTER_DRAIN = false;
    bf16_t* MK; bf16_t* MV;
    __device__ __forceinline__ void operator()(Acc8 acc, const pg8::Unit& u, int wr, int wc, int fr, int fq) const {
#pragma unroll
        for (int ai = 0; ai < 2; ++ai)
#pragma unroll
            for (int m = 0; m < 4; ++m) {
                const int tok = u.pm * 256 + ai * 128 + wr * 64 + m * 16 + fr;
                bf16_t* k = MK + ((size_t)tok * 8 + u.pn) * 192 + wc * 32 + 4 * fq; bf16_t* v = MV + ((size_t)tok * 8 + u.pn) * 128 + wc * 32 + 4 * fq;
                *(u32x2*)k = pack4(acc[ai][0][m][0]); *(u32x2*)(k + 16) = pack4(acc[ai][0][m][1]);
                *(u32x2*)v = pack4(acc[ai][1][m][0]); *(u32x2*)(v + 16) = pack4(acc[ai][1][m][1]);
            }
    }
};
struct EpiWout {
    static constexpr bool PERM = false, AFTER_DRAIN = false;
    const float* mods; const float* xlat_old; const float* xctx_old; float* out; float* xctx_new; int layer, tok_off;
    struct Grp { f32x4 gv[2][2], xv[2][2]; float* xn; };
    __device__ __forceinline__ void load_grp(Grp& G, const pg8::Unit& u, int ai, int m, int wr, int wc, int fr, int fq) const {
        const int tok = tok_off + u.pm * 256 + ai * 128 + wr * 64 + m * 16 + fr;
        const int mw = tok < TC ? 2 : ((tok - TC) >> 14);
        const float* g1 = mods + (size_t)(layer * 3 + mw) * 12288 + 2 * 2048;
        const float* xo = tok < TC ? xctx_old + (size_t)tok * D : xlat_old + (size_t)(tok - TC) * D;
        G.xn = tok < TC ? xctx_new + (size_t)tok * D : out + (size_t)(tok - TC) * D;
#pragma unroll
        for (int bj = 0; bj < 2; ++bj)
#pragma unroll
            for (int n = 0; n < 2; ++n) {
                const int col = u.pn * 256 + bj * 128 + wc * 32 + n * 16 + 4 * fq;
                G.gv[bj][n] = *(const f32x4*)(g1 + col); G.xv[bj][n] = *(const f32x4*)(xo + col);
            }
    }
    __device__ __forceinline__ void operator()(Acc8 acc, const pg8::Unit& u, int wr, int wc, int fr, int fq) const {
        Grp cur, nxt;
        load_grp(cur, u, 0, 0, wr, wc, fr, fq);
#pragma unroll
        for (int ai = 0; ai < 2; ++ai)
#pragma unroll
            for (int m = 0; m < 4; ++m) {
                const int gi = ai * 4 + m;
                if (gi + 1 < 8) load_grp(nxt, u, (gi + 1) >> 2, (gi + 1) & 3, wr, wc, fr, fq);
#pragma unroll
                for (int bj = 0; bj < 2; ++bj)
#pragma unroll
                    for (int n = 0; n < 2; ++n) {
                        const int col = u.pn * 256 + bj * 128 + wc * 32 + n * 16 + 4 * fq;
                        *(f32x4*)(cur.xn + col) = cur.xv[bj][n] + cur.gv[bj][n] * acc[ai][bj][m][n];
                    }
                if (gi + 1 < 8) cur = nxt;
            }
    }
};
struct EpiStoreBf16 {
    static constexpr bool PERM = false, AFTER_DRAIN = false;
    bf16_t* O; int ldc;
    __device__ __forceinline__ void operator()(Acc8 acc, const pg8::Unit& u, int wr, int wc, int fr, int fq) const {
#pragma unroll
        for (int ai = 0; ai < 2; ++ai)
#pragma unroll
            for (int m = 0; m < 4; ++m) {
                bf16_t* rp = O + (size_t)(u.pm * 256 + ai * 128 + wr * 64 + m * 16 + fr) * ldc + u.pn * 256 + wc * 32 + 4 * fq;
#pragma unroll
                for (int bj = 0; bj < 2; ++bj)
#pragma unroll
                    for (int n = 0; n < 2; ++n) *(u32x2*)(rp + bj * 128 + n * 16) = pack4(acc[ai][bj][m][n]);
            }
    }
};
template <class Epi>
__device__ __forceinline__ void big_gemm(const Ctx& c, const bf16_t* A, const bf16_t* Bt, int M, int N, int K, const Epi& E) {
    pg8::Gemm g{A, Bt, M, N, K}; pg8::StaticOrder S; S.init(M, N, c.G, c.bid);
    pg8::gemm_phase<Epi, pg8::StaticOrder>((PG8_LAS unsigned char*)c.lds, g, S, E);
}
__device__ __forceinline__ void phase_even_proj2(const Ctx& c) {
    EpiEvenProj E{c.wb(WS_A), c.wb(WS_Q), c.wb(WS_K), c.wb(WS_V), c.wb(WS_G), (const f32x2*)(c.ws + WS_ROPE)};
    big_gemm(c, c.wb(WS_H), c.wb(WS_WINE), TT, 6144, 2048, E);
    const int busy = (TT / 256) * 24 - 12 * c.G;
    if (busy > 0 && busy < c.G && c.bid >= busy) {
        conv_fp4(c, c.in[20] + (size_t)16384 * 2048, c.ws + WS_TABU + 32 * MiB, 16384, U_SCALE, c.bid - busy, c.G - busy);
        conv_fp4(c, c.in[21] + (size_t)16384 * 2048, c.ws + WS_TABV + 32 * MiB, 16384, V_SCALE, c.bid - busy, c.G - busy);
    } else if (!(busy > 0 && busy < c.G)) {
        conv_fp4(c, c.in[20] + (size_t)16384 * 2048, c.ws + WS_TABU + 32 * MiB, 16384, U_SCALE, c.bid, c.G);
        conv_fp4(c, c.in[21] + (size_t)16384 * 2048, c.ws + WS_TABV + 32 * MiB, 16384, V_SCALE, c.bid, c.G);
    }
}
__device__ __forceinline__ void phase_odd_proj2(const Ctx& c) {
    EpiOddProj E{c.wb(WS_A), c.wb(WS_Q), c.wb(WS_Q + 9 * MiB), c.wb(WS_Q + 18 * MiB), c.wb(WS_K), c.wb(WS_K + 17 * MiB), (const f32x2*)(c.ws + WS_ROPE + 131072)};
    big_gemm(c, c.wb(WS_H), c.wb(WS_WINO), TT, 2304, 2048, E);
}
__device__ __forceinline__ void phase_mla_up2(const Ctx& c) {
    EpiMlaQ EQ{c.wb(WS_G), (const f32x2*)(c.ws + WS_ROPE + 131072)};
    big_gemm(c, c.wb(WS_Q + 18 * MiB) + (size_t)TC * 512, c.wb(WS_WUQ), TL, 1536, 512, EQ);
    EpiMlaKV EK{c.wb(WS_ST), c.wb(WS_V)};
    big_gemm(c, c.wb(WS_K), c.wb(WS_WUKV), TT, 2048, 256, EK);
}
__device__ __forceinline__ void phase_wout2(const Ctx& c, const bf16_t* W, int layer, const float* xlat_old, const float* xctx_old, int tok_off) {
    EpiWout E{c.wf(WS_MODS), xlat_old, xctx_old, c.out, c.wf(WS_XCTX), layer, tok_off};
    big_gemm(c, c.wb(WS_CAT) + (size_t)tok_off * 2048, W, TT - tok_off, 2048, 2048, E);
}
__device__ __forceinline__ void phase_peer_q2(const Ctx& c, const bf16_t* W, int tok_off) {
    EpiStoreBf16 E{c.wb(WS_G) + (size_t)tok_off * 2048, 2048};
    big_gemm(c, c.wb(WS_H) + (size_t)tok_off * 2048, W, TT - tok_off, 2048, 2048, E);
}

#ifdef DBG_FOURIER_CHECK
__device__ __forceinline__ void dbg_fourier_check(const Ctx& c) {
    if (c.bid >= 48) return;
    const bf16_t* F = c.wb(WS_A); const bf16_t* CAT = c.wb(WS_CAT);
    LAS float* red = (LAS float*)c.lds;
    const int i = c.bid;
    const bool lat = i >= 32;
    const int b = i & 1, g = (i >> 1) & 3, m = (i * 53 + 7) & 255;
    const int L = lat ? 16384 : 256;
    const int k = lat ? ((i * 2731 + 11) & 16383) : ((i * 37 + 3) & 255);
    const size_t tok0 = lat ? (size_t)TC + (size_t)b * SEQ : (size_t)b * NCTX;
    float acc = 0.f;
    for (int n = c.tid; n < L; n += 512) {
        const float fa = (float)(((long long)k * n) % L) / (float)L;
        float rs = 0.f;
        for (int cc = 0; cc < 256; ++cc) {
            const float fb = (float)((m * cc) & 255) * (1.0f / 256.0f);
            float fr = fa + fb; fr = fr - floorf(fr);
            rs += bf2f(F[(tok0 + n) * 1024 + g * 256 + cc]) * cos_rev(fr);
        }
        acc += rs;
    }
    acc = wave_sum(acc);
    if (c.lane == 0) red[c.w] = acc;
    __syncthreads();
    float tot = 0.f; for (int w = 0; w < 8; ++w) tot += red[w];
    tot *= lat ? (1.0f / 2048.0f) : (1.0f / 256.0f);
    const float got = bf2f(CAT[(tok0 + k) * 2048 + g * 256 + m]);
    if (c.tid == 0 && fabsf(got - tot) > 0.03f + 0.03f * fabsf(tot)) atomicOr((unsigned*)(c.ws + WS_CTL + 32768), lat ? 2u : 1u);
    __syncthreads();
}
#endif
#ifdef DBG_RET_CHECK
__device__ __forceinline__ void dbg_ret_check(const Ctx& c) {
    if (c.bid >= 32) return;
    const bf16_t* Q = c.wb(WS_Q); const bf16_t* Kb = c.wb(WS_K); const bf16_t* V = c.wb(WS_V); const bf16_t* Gt = c.wb(WS_G); const bf16_t* CAT = c.wb(WS_CAT);
    const float* gn = c.in[9];
    LAS float* wgt = (LAS float*)c.lds;
    LAS float* red = (LAS float*)(c.lds + 80000);
    const int i = c.bid, b = i & 1, h = (i >> 1) & 7;
    const bool isctx = i >= 26;
    const int pos = isctx ? (i == 26 ? 5 : (i == 27 ? 130 : (i == 28 ? 255 : (i == 29 ? 0 : (i * 41) & 255))))
                          : (i == 0 ? 0 : (i == 1 ? 16383 : (i == 2 ? 127 : (i == 3 ? 128 : (i * 1637 + 29) & 16383))));
    const size_t tokT = isctx ? (size_t)b * NCTX + pos : (size_t)TC + (size_t)b * SEQ + pos;
    const float lg = log2_gamma(h);
    float yacc = 0.f;
    for (int dir = 0; dir < 2; ++dir) {
        const int nkeys = isctx ? 256 : 256 + 16384;
        for (int j = c.tid; j < nkeys; j += 512) {
            const bool kc = j < 256; const int kp = kc ? j : j - 256;
            const size_t tokK = kc ? (size_t)b * NCTX + kp : (size_t)TC + (size_t)b * SEQ + kp;
            int dist;
            if (isctx) dist = dir == 0 ? pos - kp : kp - pos;
            else if (kc) dist = dir == 0 ? 256 + pos - kp : 16384 - pos + kp;
            else dist = dir == 0 ? pos - kp : kp - pos;
            float w = 0.f;
            if (dist >= 0) {
                float d = 0.f;
                for (int x = 0; x < 128; ++x) d += bf2f(Q[tokT * 1024 + h * 128 + x]) * bf2f(Kb[tokK * 1024 + h * 128 + x]);
                w = d * fast_exp2(lg * (float)dist);
            }
            wgt[j] = w;
        }
        __syncthreads();
        float o = 0.f;
        if (c.tid < 128) {
            for (int j = 0; j < nkeys; ++j) {
                const float w = wgt[j];
                if (w != 0.f) { const bool kc = j < 256; const int kp = kc ? j : j - 256; const size_t tokK = kc ? (size_t)b * NCTX + kp : (size_t)TC + (size_t)b * SEQ + kp;
                    o += w * bf2f(V[tokK * 1024 + h * 128 + c.tid]); }
            }
        }
        float ss = (c.tid < 128) ? o * o : 0.f;
        ss = wave_sum(ss);
        if (c.lane == 0) red[c.w] = ss;
        __syncthreads();
        const float tot = red[0] + red[1];
        const float rstd = rsqrtf(tot * (1.0f / 128.0f) + EPS);
        if (c.tid < 128) yacc += o * rstd * gn[h * 128 + c.tid] * bf2f(Gt[tokT * 2048 + dir * 1024 + h * 128 + c.tid]);
        __syncthreads();
    }
    if (c.tid < 128) {
        const float got = bf2f(CAT[tokT * 2048 + 1024 + h * 128 + c.tid]);
        if (fabsf(got - yacc) > 0.04f + 0.05f * fabsf(yacc)) atomicOr((unsigned*)(c.ws + WS_CTL + 32768), isctx ? 8u : 4u);
    }
    __syncthreads();
}
#endif
__global__ void __launch_bounds__(512, 2) fwd_kernel(KArgs a) {
    extern __shared__ __attribute__((aligned(16))) unsigned char shm[];
    Ctx c;
#pragma unroll
    for (int i = 0; i < 23; ++i) c.in[i] = a.in[i];
    c.out = a.out; c.ws = a.ws; c.lds = (LAS unsigned char*)shm; c.G = gridDim.x; c.bid = blockIdx.x; c.tid = threadIdx.x; c.lane = threadIdx.x & 63;
    c.w = __builtin_amdgcn_readfirstlane(threadIdx.x >> 6);
    const int lo = a.ph_lo, hi = a.ph_hi;
    volatile LAS unsigned* bw = (volatile LAS unsigned*)(c.lds + LDS_BYTES - 16);
    XcdBarrier bar; bar.bar = (unsigned*)(a.ws + WS_CTL); bar.x = 0; bar.st = bw;
    if (hi - lo > 1) {
        if (threadIdx.x == 0) { bw[0] = 0u; bw[1] = 0u; bw[2] = 0u; bw[3] = 0u; }
        __syncthreads();
        bar = xcd_barrier_post((unsigned*)(a.ws + WS_CTL), bw);
    }
#define IN(k) (((PHASE_MASK >> (k)) & 1u) && lo <= (k) && (k) < hi)
#define SEAM(k) do { if (IN(k) && IN((k) + 1)) xcd_barrier(bar); } while (0)
    float* XCTX = c.wf(WS_XCTX); bf16_t* H = c.wb(WS_H);
    if (IN(0)) phase_prologue(c);
    SEAM(0);
    if (IN(1)) phase_mods(c);
    SEAM(1);
    if (IN(2)) phase_modnorm(c, 0, 0, c.in[0], c.in[2], 0, H);
    SEAM(2);
    if (IN(3)) phase_even_proj2(c);
    SEAM(3);
    if (IN(4)) phase_chan_dft(c);
    SEAM(4);
    if (IN(5)) phase_dft_stage1(c);
    SEAM(5);
    if (IN(6)) { phase_dft_stage2(c); phase_ret_ds(c); }
    SEAM(6);
    if (IN(7)) phase_ret_scan(c);
    SEAM(7);
    if (IN(8)) phase_ret_out(c);
    SEAM(8);
#ifdef DBG_FOURIER_CHECK
    if (IN(9)) dbg_fourier_check(c);
#endif
#ifdef DBG_RET_CHECK
    if (IN(9)) dbg_ret_check(c);
#endif
    if (IN(9)) { phase_wout2(c, c.wb(WS_WOUTE), 0, c.in[0], c.in[2], TC); phase_wout(c, c.wb(WS_WOUTE), 0, c.in[0], c.in[2], 0, TC / 128); }
    SEAM(9);
    if (IN(10)) phase_modnorm(c, 0, 1, c.out, XCTX, 0, H);
    SEAM(10);
    if (IN(11)) { phase_peer_q2(c, c.wb(WS_WQ0), TC); phase_peer_q(c, c.wb(WS_WQ0), 0, TC / 128); }
    SEAM(11);
    if (IN(12)) phase_peer_topk(c, 0, 0);
    SEAM(12);
#ifdef DBG_TOPK_CHECK
    if (lo == 12) dbg_gather_save(c);
#endif
    if (IN(13)) phase_peer_gather<false>(c, 0, 0);
    SEAM(13);
#ifdef DBG_TOPK_CHECK
    if (lo == 13) dbg_topk_check(c);
    if (lo == 14) dbg_gather_check(c);
#endif
    if (IN(14)) {
        phase_modnorm(c, 1, 0, c.out, XCTX, 0, H);
    }
    SEAM(14);
    if (IN(15)) phase_odd_proj2(c);
    SEAM(15);
    if (IN(16)) phase_odd_local(c);
    SEAM(16);
    if (IN(17)) phase_mla_up2(c);
    SEAM(17);
    if (IN(18)) phase_attention(c);
    SEAM(18);
#ifdef DBG_ATTN_CHECK
    if (IN(19)) dbg_attn_check(c);
#endif
    if (IN(19)) phase_wout2(c, c.wb(WS_WOUTO), 1, c.out, XCTX, TC);
    SEAM(19);
    if (IN(20)) phase_modnorm(c, 1, 1, c.out, XCTX, TC, H);
    SEAM(20);
    if (IN(21)) phase_peer_q2(c, c.wb(WS_WQ1), TC);
    SEAM(21);
    if (IN(22)) phase_peer_topk(c, 1, 4);
    SEAM(22);
    if (IN(23)) phase_peer_gather<true>(c, 1, TC);
#ifdef DUMP_OFF
    if (lo == NPH - 1) { const bf16_t* src = c.wb(DUMP_OFF); for (size_t i = (size_t)c.bid * 512 + c.tid; i < (size_t)TL * D; i += (size_t)c.G * 512) { float v = bf2f(src[i]); c.out[i] = (v == v && fabsf(v) < 1e30f) ? v : 777.0f; } }
#endif
#undef IN
#undef SEAM
}

extern "C" void kernel_launch(void* const* d_in, const int* in_sizes, int n_in, void* d_out, int out_size, void* d_ws, size_t ws_size, hipStream_t stream) {
    static int grid = 0;
    if (grid == 0) {
        if (n_in != 23 || ws_size < WS_END) { fprintf(stderr, "kernel_launch: unexpected n_in %d / ws %zu\n", n_in, ws_size); grid = -1; return; }
        int dev = 0, cus = 0, per_cu = 0;
        hipGetDevice(&dev);
        hipDeviceGetAttribute(&cus, hipDeviceAttributeMultiprocessorCount, dev);
        if (hipFuncSetAttribute((const void*)fwd_kernel, hipFuncAttributeMaxDynamicSharedMemorySize, LDS_BYTES) != hipSuccess) { fprintf(stderr, "hipFuncSetAttribute failed\n"); grid = -1; return; }
        if (hipOccupancyMaxActiveBlocksPerMultiprocessor(&per_cu, (const void*)fwd_kernel, 512, LDS_BYTES) != hipSuccess || per_cu < 1) { fprintf(stderr, "occupancy query: %d\n", per_cu); }
        (void)hipGetLastError();
        grid = cus > 0 ? cus : 256;
    }
    if (grid < 0) return;
    hipMemsetAsync((char*)d_ws + WS_CTL, 0, 65536, stream);
    KArgs a{};
    for (int i = 0; i < 23; ++i) a.in[i] = (const float*)d_in[i];
    a.out = (float*)d_out; a.ws = (unsigned char*)d_ws;
#if N_LAUNCHES == 1
    a.ph_lo = 0; a.ph_hi = NPH;
    hipLaunchKernelGGL(fwd_kernel, dim3(grid), dim3(512), LDS_BYTES, stream, a);
#else
    { static const int order[NPH] = {0,1,2,3,4,5,6,7,8,9,10,11,12,13,14,15,16,17,18,19,20,21,22,23};
      for (int i = 0; i < NPH; ++i) { const int k = order[i]; a.ph_lo = k; a.ph_hi = k + 1; hipLaunchKernelGGL(fwd_kernel, dim3(grid), dim3(512), LDS_BYTES, stream, a); } }
#endif
}
```

```cpp
#include <hip/hip_runtime.h>
#include <stdint.h>
#include <stdio.h>

#ifndef N_LAUNCHES
#define N_LAUNCHES 1
#endif
#ifndef DBG_SKIP_GATHER
#define DBG_SKIP_GATHER 0
#endif
#ifndef DBG_CAT_PART
#define DBG_CAT_PART 0

#endif
#ifndef PHASE_MASK
#define PHASE_MASK 0xFFFFFFu
#endif

#define LAS __attribute__((address_space(3)))
typedef unsigned short bf16_t;
typedef short bf16x8 __attribute__((ext_vector_type(8)));
typedef short s16x4 __attribute__((ext_vector_type(4)));
typedef float f32x2 __attribute__((ext_vector_type(2)));
typedef float f32x4 __attribute__((ext_vector_type(4)));
typedef float f32x16 __attribute__((ext_vector_type(16)));
typedef unsigned u32x2 __attribute__((ext_vector_type(2)));
typedef unsigned u32x4 __attribute__((ext_vector_type(4)));
typedef __bf16 bf16x2_t __attribute__((ext_vector_type(2)));

constexpr int D = 2048, NBATCH = 2, SEQ = 16384, NCTX = 256;
constexpr int TC = NBATCH * NCTX;
constexpr int TL = NBATCH * SEQ;
constexpr int TT = TC + TL;
constexpr int NCH = 130;
constexpr float EPS = 1e-6f;
constexpr float LOG2E = 1.4426950408889634f;
constexpr float U_SCALE = 90.5f, V_SCALE = 2.0f;

constexpr size_t MiB = 1ull << 20;
constexpr size_t WS_CTL = 0;
constexpr size_t WS_MODS = 1 * MiB;
constexpr size_t WS_MODP = 2 * MiB;
constexpr size_t WS_ROPE = 12 * MiB;
constexpr size_t WS_DFT = 13 * MiB;
constexpr size_t WS_SKB = 14 * MiB;
constexpr size_t WS_XCTX = 15 * MiB;
constexpr size_t WS_W = 19 * MiB;
constexpr size_t WS_WINE = WS_W;
constexpr size_t WS_WOUTE = WS_WINE + 24 * MiB;
constexpr size_t WS_WINO = WS_WOUTE + 8 * MiB;
constexpr size_t WS_WUQ = WS_WINO + 9 * MiB;
constexpr size_t WS_WUKV = WS_WUQ + 2 * MiB;
constexpr size_t WS_WOUTO = WS_WUKV + 1 * MiB;
constexpr size_t WS_WQ0 = WS_WOUTO + 8 * MiB;
constexpr size_t WS_WQ1 = WS_WQ0 + 8 * MiB;
constexpr size_t WS_TABU = 88 * MiB;
constexpr size_t WS_TABV = WS_TABU + 64 * MiB;
constexpr size_t WS_H = 216 * MiB;
constexpr size_t WS_A = 346 * MiB;
constexpr size_t WS_Q = 411 * MiB;
constexpr size_t WS_K = 476 * MiB;
constexpr size_t WS_V = 541 * MiB;
constexpr size_t WS_G = 606 * MiB;
constexpr size_t WS_CAT = 736 * MiB;
constexpr size_t WS_ST = 866 * MiB;
constexpr size_t WS_IDX = 998 * MiB;
constexpr size_t WS_GATE = 1015 * MiB;
constexpr size_t WS_END = 1032 * MiB;

constexpr int LDS_BYTES = 147456;
constexpr int NPH = 24;

#define XB_TMO      128
#define XB_XCNT(j)  (256  + 64 * (j))
#define XB_XSUB(j)  (1280 + 64 * (j))
#define XB_XGEN(j)  (2304 + 64 * (j))
#define XB_TOP      3328
#define XB_TOPGEN   3392
#define XCD_BAR_WORDS 3456
#define XB_SPIN_CAP (1u << 24)

__device__ __forceinline__ unsigned xb_ld(unsigned* p)              { return __hip_atomic_load(p, __ATOMIC_RELAXED, __HIP_MEMORY_SCOPE_AGENT); }
__device__ __forceinline__ unsigned xb_add(unsigned* p, unsigned v) { return __hip_atomic_fetch_add(p, v, __ATOMIC_RELAXED, __HIP_MEMORY_SCOPE_AGENT); }
__device__ __forceinline__ unsigned xb_xcc_id() { return (unsigned)__builtin_amdgcn_s_getreg((3 << 11) | 20) & 0xFu; }
#define XB_SPIN(cond, bar) do { unsigned _sp = 0; while (cond) { __builtin_amdgcn_s_sleep(1); \
    if ((++_sp & 255u) == 0u) { if (xb_ld(&(bar)[XB_TMO])) break; if (_sp > XB_SPIN_CAP) { atomicAdd(&(bar)[XB_TMO], 1u); break; } } } } while (0)

struct XcdBarrier { unsigned* bar; unsigned x; volatile LAS unsigned* st; };

__device__ __forceinline__ XcdBarrier xcd_barrier_post(unsigned* bar, volatile LAS unsigned* st) {
    XcdBarrier b; b.bar = bar; b.x = xb_xcc_id(); b.st = st;
    if (threadIdx.x == 0) (void)xb_add(&bar[XB_XCNT(b.x)], 1u);
    return b;
}
__device__ __forceinline__ void xcd_barrier_complete(unsigned* bar, unsigned x, unsigned& nloc, unsigned& nx) {
    const unsigned G = gridDim.x * gridDim.y * gridDim.z;
    unsigned sum, cnt, mine, sp = 0u;
    for (;;) {
        sum = 0u; cnt = 0u; mine = 0u;
#pragma unroll
        for (unsigned j = 0; j < 16; ++j) { const unsigned c = xb_ld(&bar[XB_XCNT(j)]); sum += c; cnt += (c > 0u) ? 1u : 0u; mine = (j == x) ? c : mine; }
        if (sum == G) break;
        __builtin_amdgcn_s_sleep(1);
        if ((++sp & 255u) == 0u) { if (xb_ld(&bar[XB_TMO])) break; if (sp > XB_SPIN_CAP) { atomicAdd(&bar[XB_TMO], 1u); break; } }
    }
    nloc = mine > 0u ? mine : 1u; nx = cnt > 0u ? cnt : 1u;
}
__device__ __forceinline__ void xcd_barrier(const XcdBarrier& b) {
    asm volatile("s_waitcnt vmcnt(0)" ::: "memory");
    __syncthreads();
    if (threadIdx.x == 0) {
        unsigned* bar = b.bar;
        __builtin_amdgcn_s_waitcnt(0);
        unsigned nloc = b.st[0], nx = b.st[1];
        if (nloc == 0u) { xcd_barrier_complete(bar, b.x, nloc, nx); b.st[0] = nloc; b.st[1] = nx; }
        const unsigned old = xb_add(&bar[XB_XSUB(b.x)], 1u);
        const unsigned gen = old / nloc;
        if (old + 1u == (gen + 1u) * nloc) {
            __builtin_amdgcn_fence(__ATOMIC_RELEASE, "agent");
            asm volatile("s_waitcnt vmcnt(0)" ::: "memory");
            const unsigned og = xb_add(&bar[XB_TOP], 1u);
            const unsigned tg = og / nx;
            if (og + 1u == (tg + 1u) * nx) xb_add(&bar[XB_TOPGEN], 1u);
            else XB_SPIN(xb_ld(&bar[XB_TOPGEN]) == tg, bar);
            __builtin_amdgcn_fence(__ATOMIC_ACQUIRE, "agent");
            xb_add(&bar[XB_XGEN(b.x)], 1u);
            asm volatile("s_waitcnt vmcnt(0)" ::: "memory");
        } else {
            XB_SPIN(xb_ld(&bar[XB_XGEN(b.x)]) == gen, bar);
            __builtin_amdgcn_fence(__ATOMIC_ACQUIRE, "agent");
            asm volatile("s_waitcnt vmcnt(0)" ::: "memory");
        }
    }
    __syncthreads();
}

__device__ __forceinline__ unsigned cvt_pk_bf16(float lo, float hi) { const f32x2 v = {lo, hi}; const bf16x2_t r = __builtin_convertvector(v, bf16x2_t); return __builtin_bit_cast(unsigned, r); }
__device__ __forceinline__ float bf_lo(unsigned u) { return __uint_as_float(u << 16); }
__device__ __forceinline__ float bf_hi(unsigned u) { return __uint_as_float(u & 0xffff0000u); }
__device__ __forceinline__ float bf2f(bf16_t b) { return __uint_as_float(((unsigned)b) << 16); }
__device__ __forceinline__ u32x2 pack4(f32x4 v) { u32x2 r; r.x = cvt_pk_bf16(v[0], v[1]); r.y = cvt_pk_bf16(v[2], v[3]); return r; }
__device__ __forceinline__ float fast_exp2(float x) { return __builtin_amdgcn_exp2f(x); }
__device__ __forceinline__ float fast_rcp(float x) { return __builtin_amdgcn_rcpf(x); }
__device__ __forceinline__ float silu_f(float x) { return x * fast_rcp(1.0f + fast_exp2(-x * LOG2E)); }
__device__ __forceinline__ float gelu_tanh(float x) {
    const float u = 0.7978845608028654f * (x + 0.044715f * x * x * x);
    return x * fast_rcp(1.0f + fast_exp2(-2.0f * LOG2E * u));
}
__device__ __forceinline__ float wave_sum(float v) {
#pragma unroll
    for (int o = 32; o >= 1; o >>= 1) v += __shfl_xor(v, o);
    return v;
}
__device__ __forceinline__ float cos_rev(float fr) { return __builtin_amdgcn_cosf(fr); }
__device__ __forceinline__ float sin_rev(float fr) { return __builtin_amdgcn_sinf(fr); }
__device__ __forceinline__ float log2_gamma(int h) {
    const float x = __uint_as_float((unsigned)(127 - 5 - h) << 23);
    float s = x * (1.0f + x * (0.5f + x * (0.33333334f + x * (0.25f + x * (0.2f + x * (0.16666667f + x * 0.14285715f))))));
    return -s * LOG2E;
}

__device__ __forceinline__ int tok_batch(int tok) { return tok < TC ? (tok >> 8) : ((tok - TC) >> 14); }

constexpr int GEMM_LDS = 73728;
template <bool TRANS, class AF, class BF>
__device__ __forceinline__ void gemm128(LAS unsigned char* lds, int K, const AF& arow, const BF& brow, f32x4 (&acc)[2][4]) {
    const int tid = threadIdx.x, lane = tid & 63, w = tid >> 6, wm = w >> 1, wn = w & 1;
    const int r0 = tid >> 3, ch = tid & 7;
    const bf16_t* pa0 = arow(r0) + ch * 8; const bf16_t* pa1 = arow(r0 + 64) + ch * 8;
    const bf16_t* pb0 = brow(r0) + ch * 8; const bf16_t* pb1 = brow(r0 + 64) + ch * 8;
    const int woff = r0 * 144 + ch * 16;
#pragma unroll
    for (int mb = 0; mb < 2; ++mb)
#pragma unroll
        for (int nb = 0; nb < 4; ++nb) acc[mb][nb] = (f32x4){0.f, 0.f, 0.f, 0.f};
    u32x4 ra0 = *(const u32x4*)pa0, ra1 = *(const u32x4*)pa1, rb0 = *(const u32x4*)pb0, rb1 = *(const u32x4*)pb1;
    *(LAS u32x4*)(lds + woff) = ra0; *(LAS u32x4*)(lds + woff + 9216) = ra1;
    *(LAS u32x4*)(lds + 36864 + woff) = rb0; *(LAS u32x4*)(lds + 36864 + woff + 9216) = rb1;
    __syncthreads();
    const int nk = K >> 6;
    const int aoff = (32 * wm + (lane & 15)) * 144 + (lane >> 4) * 16;
    const int boff = 36864 + (64 * wn + (lane & 15)) * 144 + (lane >> 4) * 16;
    for (int kt = 0; kt < nk; ++kt) {
        const int buf = (kt & 1) * 18432;
        if (kt + 1 < nk) {
            const int ko = (kt + 1) * 64;
            ra0 = *(const u32x4*)(pa0 + ko); ra1 = *(const u32x4*)(pa1 + ko); rb0 = *(const u32x4*)(pb0 + ko); rb1 = *(const u32x4*)(pb1 + ko);
        }
#pragma unroll
        for (int ks = 0; ks < 2; ++ks) {
            bf16x8 af[2], bfr[4];
#pragma unroll
            for (int mb = 0; mb < 2; ++mb) af[mb] = *(const LAS bf16x8*)(lds + buf + aoff + mb * 2304 + ks * 64);
#pragma unroll
            for (int nb = 0; nb < 4; ++nb) bfr[nb] = *(const LAS bf16x8*)(lds + buf + boff + nb * 2304 + ks * 64);
#pragma unroll
            for (int mb = 0; mb < 2; ++mb)
#pragma unroll
                for (int nb = 0; nb < 4; ++nb)
                    acc[mb][nb] = TRANS ? __builtin_amdgcn_mfma_f32_16x16x32_bf16(bfr[nb], af[mb], acc[mb][nb], 0, 0, 0)
                                        : __builtin_amdgcn_mfma_f32_16x16x32_bf16(af[mb], bfr[nb], acc[mb][nb], 0, 0, 0);
        }
        if (kt + 1 < nk) {
            const int nb2 = ((kt + 1) & 1) * 18432;
            *(LAS u32x4*)(lds + nb2 + woff) = ra0; *(LAS u32x4*)(lds + nb2 + woff + 9216) = ra1;
            *(LAS u32x4*)(lds + 36864 + nb2 + woff) = rb0; *(LAS u32x4*)(lds + 36864 + nb2 + woff + 9216) = rb1;
        }
        __syncthreads();
    }
}
template <bool TRANS, int K, class AF, class BF>
__device__ __forceinline__ void gemm128s(LAS unsigned char* lds, const AF& arow, const BF& brow, f32x4 (&acc)[2][4]) {
    constexpr int NK = K / 64, DEPTH = NK < 4 ? NK : 4;
    const int tid = threadIdx.x, lane = tid & 63, w = tid >> 6, wm = w >> 1, wn = w & 1;
    const int r0 = tid >> 3, ch = tid & 7;
    const bf16_t* pa0 = arow(r0) + ch * 8; const bf16_t* pa1 = arow(r0 + 64) + ch * 8;
    const bf16_t* pb0 = brow(r0) + ch * 8; const bf16_t* pb1 = brow(r0 + 64) + ch * 8;
    const int woff = r0 * 144 + ch * 16;
    u32x4 rg[DEPTH][4];
#pragma unroll
    for (int d = 0; d < DEPTH; ++d) {
        rg[d][0] = *(const u32x4*)(pa0 + d * 64); rg[d][1] = *(const u32x4*)(pa1 + d * 64);
        rg[d][2] = *(const u32x4*)(pb0 + d * 64); rg[d][3] = *(const u32x4*)(pb1 + d * 64);
    }
    __builtin_amdgcn_sched_barrier(0);
#pragma unroll
    for (int mb = 0; mb < 2; ++mb)
#pragma unroll
        for (int nb = 0; nb < 4; ++nb) acc[mb][nb] = (f32x4){0.f, 0.f, 0.f, 0.f};
    *(LAS u32x4*)(lds + woff) = rg[0][0]; *(LAS u32x4*)(lds + woff + 9216) = rg[0][1];
    *(LAS u32x4*)(lds + 36864 + woff) = rg[0][2]; *(LAS u32x4*)(lds + 36864 + woff + 9216) = rg[0][3];
    __syncthreads();
    const int aoff = (32 * wm + (lane & 15)) * 144 + (lane >> 4) * 16;
    const int boff = 36864 + (64 * wn + (lane & 15)) * 144 + (lane >> 4) * 16;
#pragma unroll
    for (int kt = 0; kt < NK; ++kt) {
        const int buf = (kt & 1) * 18432;
        if (kt + DEPTH < NK) {
            const int ko = (kt + DEPTH) * 64;
            rg[kt % DEPTH][0] = *(const u32x4*)(pa0 + ko); rg[kt % DEPTH][1] = *(const u32x4*)(pa1 + ko);
            rg[kt % DEPTH][2] = *(const u32x4*)(pb0 + ko); rg[kt % DEPTH][3] = *(const u32x4*)(pb1 + ko);
            __builtin_amdgcn_sched_barrier(0);
        }
#pragma unroll
        for (int ks = 0; ks < 2; ++ks) {
            bf16x8 af[2], bfr[4];
#pragma unroll
            for (int mb = 0; mb < 2; ++mb) af[mb] = *(const LAS bf16x8*)(lds + buf + aoff + mb * 2304 + ks * 64);
#pragma unroll
            for (int nb = 0; nb < 4; ++nb) bfr[nb] = *(const LAS bf16x8*)(lds + buf + boff + nb * 2304 + ks * 64);
#pragma unroll
            for (int mb = 0; mb < 2; ++mb)
#pragma unroll
                for (int nb = 0; nb < 4; ++nb)
                    acc[mb][nb] = TRANS ? __builtin_amdgcn_mfma_f32_16x16x32_bf16(bfr[nb], af[mb], acc[mb][nb], 0, 0, 0)
                                        : __builtin_amdgcn_mfma_f32_16x16x32_bf16(af[mb], bfr[nb], acc[mb][nb], 0, 0, 0);
        }
        if (kt + 1 < NK) {
            const int nb2 = ((kt + 1) & 1) * 18432; constexpr int dummy = 0; (void)dummy;
            const int s = (kt + 1) % DEPTH;
            *(LAS u32x4*)(lds + nb2 + woff) = rg[s][0]; *(LAS u32x4*)(lds + nb2 + woff + 9216) = rg[s][1];
            *(LAS u32x4*)(lds + 36864 + nb2 + woff) = rg[s][2]; *(LAS u32x4*)(lds + 36864 + nb2 + woff + 9216) = rg[s][3];
        }
        __syncthreads();
    }
}
template <bool TRANS, class AF, class BF>
__device__ __forceinline__ void gemm128r(LAS unsigned char* lds, int K, const AF& arow, const BF& brow, f32x4 (&acc)[2][4]) {
    const int tid = threadIdx.x, lane = tid & 63, w = tid >> 6, wm = w >> 1, wn = w & 1;
    const int r0 = tid >> 3, ch = tid & 7;
    const bf16_t* pa0 = arow(r0) + ch * 8; const bf16_t* pa1 = arow(r0 + 64) + ch * 8;
    const bf16_t* pb0 = brow(r0) + ch * 8; const bf16_t* pb1 = brow(r0 + 64) + ch * 8;
    const int woff = r0 * 144 + ch * 16;
    u32x4 rg[4][4];
#pragma unroll
    for (int d = 0; d < 4; ++d) {
        rg[d][0] = *(const u32x4*)(pa0 + d * 64); rg[d][1] = *(const u32x4*)(pa1 + d * 64);
        rg[d][2] = *(const u32x4*)(pb0 + d * 64); rg[d][3] = *(const u32x4*)(pb1 + d * 64);
    }
    __builtin_amdgcn_sched_barrier(0);
#pragma unroll
    for (int mb = 0; mb < 2; ++mb)
#pragma unroll
        for (int nb = 0; nb < 4; ++nb) acc[mb][nb] = (f32x4){0.f, 0.f, 0.f, 0.f};
    *(LAS u32x4*)(lds + woff) = rg[0][0]; *(LAS u32x4*)(lds + woff + 9216) = rg[0][1];
    *(LAS u32x4*)(lds + 36864 + woff) = rg[0][2]; *(LAS u32x4*)(lds + 36864 + woff + 9216) = rg[0][3];
    __syncthreads();
    const int nk = K >> 6;
    const int aoff = (32 * wm + (lane & 15)) * 144 + (lane >> 4) * 16;
    const int boff = 36864 + (64 * wn + (lane & 15)) * 144 + (lane >> 4) * 16;
#pragma unroll 1
    for (int kt0 = 0; kt0 < nk; kt0 += 4) {
#pragma unroll
        for (int j = 0; j < 4; ++j) {
            const int kt = kt0 + j, buf = (j & 1) * 18432;
            if (kt + 4 < nk) {
                const int ko = (kt + 4) * 64;
                rg[j][0] = *(const u32x4*)(pa0 + ko); rg[j][1] = *(const u32x4*)(pa1 + ko);
                rg[j][2] = *(const u32x4*)(pb0 + ko); rg[j][3] = *(const u32x4*)(pb1 + ko);
            }
            __builtin_amdgcn_sched_barrier(0);
#pragma unroll
            for (int ks = 0; ks < 2; ++ks) {
                bf16x8 af[2], bfr[4];
#pragma unroll
                for (int mb = 0; mb < 2; ++mb) af[mb] = *(const LAS bf16x8*)(lds + buf + aoff + mb * 2304 + ks * 64);
#pragma unroll
                for (int nb = 0; nb < 4; ++nb) bfr[nb] = *(const LAS bf16x8*)(lds + buf + boff + nb * 2304 + ks * 64);
#pragma unroll
                for (int mb = 0; mb < 2; ++mb)
#pragma unroll
                    for (int nb = 0; nb < 4; ++nb)
                        acc[mb][nb] = TRANS ? __builtin_amdgcn_mfma_f32_16x16x32_bf16(bfr[nb], af[mb], acc[mb][nb], 0, 0, 0)
                                            : __builtin_amdgcn_mfma_f32_16x16x32_bf16(af[mb], bfr[nb], acc[mb][nb], 0, 0, 0);
            }
            if (kt + 1 < nk) {
                const int nb2 = ((j + 1) & 1) * 18432, s = (j + 1) & 3;
                *(LAS u32x4*)(lds + nb2 + woff) = rg[s][0]; *(LAS u32x4*)(lds + nb2 + woff + 9216) = rg[s][1];
                *(LAS u32x4*)(lds + 36864 + nb2 + woff) = rg[s][2]; *(LAS u32x4*)(lds + 36864 + nb2 + woff + 9216) = rg[s][3];
            }
            __syncthreads();
        }
    }
}
__device__ __forceinline__ void tile_mn(int t, int MT, int NT, int& mt, int& nt) {
    const int per = 16 * NT; const int g = t / per; const int r = t - g * per; const int rem = MT - g * 16; const int gs = rem < 16 ? rem : 16;
    mt = g * 16 + r % gs; nt = r / gs;
}
struct RowLin { const bf16_t* base; size_t pitch; __device__ __forceinline__ const bf16_t* operator()(int r) const { return base + (size_t)r * pitch; } };

__device__ __forceinline__ s16x4 tr_read(LAS unsigned char* blk, int stride, int lane) {
    const int i = lane & 15;
    return __builtin_amdgcn_ds_read_tr16_b64_v4i16((LAS s16x4*)(blk + (i >> 2) * stride + (i & 3) * 8));
}
__device__ __forceinline__ bf16x8 cat8(s16x4 a, s16x4 b) { bf16x8 r; r[0] = a[0]; r[1] = a[1]; r[2] = a[2]; r[3] = a[3]; r[4] = b[0]; r[5] = b[1]; r[6] = b[2]; r[7] = b[3]; return r; }

namespace pg8 {
#define PG8_LAS __attribute__((address_space(3)))
constexpr int BM = 256, BK = 64, HALF = 128, HTB = HALF * BK * 2  , STAGE_BYTES = 8 * HTB, NXCD = 8, WGM = 8;

__host__ __device__ __forceinline__ int lds_byte(int r, int c) { const int st = (r >> 4) * 2 + (c >> 5), rr = r & 15, cc = c & 31, ob = rr * 64 + cc * 2; return st * 1024 + (ob ^ (((ob >> 9) & 1) << 5)); }
__host__ __device__ __forceinline__ void stage_rc(int b, int& R, int& C) { const int st = b / 1024, sb = b % 1024, swz = sb ^ (((sb >> 9) & 1) << 5); R = (st >> 1) * 16 + swz / 64; C = (st & 1) * 32 + (swz % 64) / 2; }
__host__ __device__ __forceinline__ int perm32(int rho) { const int n = rho >> 4, i = rho & 15; return 8 * (i >> 2) + 4 * n + (i & 3); }

struct Unit { int pm, pn; };
struct Gemm { const bf16_t* A; const bf16_t* Bt; int M, N, K; };

struct StaticOrder {
    int nM, nN, nwg, G, c;
    __host__ __device__ void init(int M, int N, int G_, int c_) { nM = M / BM; nN = N / BM; nwg = nM * nN; G = G_; c = c_; }
    __host__ __device__ bool next(int i, Unit& u) const {
        const long L = (long)i * G + c; if (L >= nwg) return false;
        int wgid = (int)L; { const int q = nwg / NXCD, r = nwg % NXCD, xcd = wgid % NXCD, off = wgid / NXCD; wgid = (xcd < r ? xcd * (q + 1) : r * (q + 1) + (xcd - r) * q) + off; }
        const int nig = WGM * nN, gid = wgid / nig, fm = gid * WGM, gsz = (nM - fm) < WGM ? (nM - fm) : WGM;
        u.pm = fm + ((wgid % nig) % gsz); u.pn = (wgid % nig) / gsz; return true;
    }
    __device__ __forceinline__ void a_ready(const Unit&) const {}
    __device__ __forceinline__ void done(const Unit&) const {}
};
template <class Epi, class Sched>
__device__ __forceinline__ void gemm_phase(PG8_LAS unsigned char* lds, const Gemm g, const Sched& S, const Epi& E) {
    const int tid = threadIdx.x, wid = __builtin_amdgcn_readfirstlane(tid >> 6), lane = tid & 63, wr = wid >> 2, wc = wid & 3, fr = lane & 15, fq = lane >> 4;
    const int K = g.K, nt = K / BK;
    unsigned voffA[2], voffB[2];
#pragma unroll
    for (int i = 0; i < 2; ++i) { int R, C; stage_rc(tid * 16 + i * 8192, R, C); const int Rb = Epi::PERM ? ((R & ~31) + perm32(R & 31)) : R;
        voffA[i] = (unsigned)(R * K + C) * 2u; voffB[i] = (unsigned)(Rb * K + C) * 2u; }
    const size_t kstep = (size_t)(BK * 2);
    const size_t hstep = (size_t)HALF * K * 2;
    const size_t tstep = 2 * hstep;
    const unsigned ldsw = (unsigned)wid * 1024u;
    const int aoff = lds_byte(wr * 64 + fr, fq * 8), boff = lds_byte(wc * 32 + fr, fq * 8);
#define PG8_SA(b, h) (((b) * 2 + (h)) * HTB)
#define PG8_SB(b, h) ((4 + (b) * 2 + (h)) * HTB)
#define PG8_STAGE(bufoff, gbase, voff) do { _Pragma("unroll") for (int _i = 0; _i < 2; ++_i) \
        __builtin_amdgcn_global_load_lds((const unsigned*)((const char*)(gbase) + (voff)[_i]), (PG8_LAS unsigned*)(lds + (bufoff) + ldsw + _i * 8192), 16, 0, 0); } while (0)
#define PG8_LDA(dst, b, h) do { _Pragma("unroll") for (int m = 0; m < 4; ++m) _Pragma("unroll") for (int k = 0; k < 2; ++k) dst[m][k] = *(const PG8_LAS bf16x8*)(lds + PG8_SA(b, h) + aoff + m * 2048 + k * 1024); } while (0)
#define PG8_LDB(dst, b, h) do { _Pragma("unroll") for (int n = 0; n < 2; ++n) _Pragma("unroll") for (int k = 0; k < 2; ++k) dst[n][k] = *(const PG8_LAS bf16x8*)(lds + PG8_SB(b, h) + boff + n * 2048 + k * 1024); } while (0)
#define PG8_MMA(ai, bj, At, Bt) do { __builtin_amdgcn_s_setprio(1); _Pragma("unroll") for (int m = 0; m < 4; ++m) _Pragma("unroll") for (int n = 0; n < 2; ++n) _Pragma("unroll") for (int k = 0; k < 2; ++k) \
        acc[ai][bj][m][n] = __builtin_amdgcn_mfma_f32_16x16x32_bf16(Bt[n][k], At[m][k], acc[ai][bj][m][n], 0, 0, 0); __builtin_amdgcn_s_setprio(0); } while (0)
#define PG8_WAIT_V(n) asm volatile("s_waitcnt vmcnt(" #n ")" ::: "memory")
#define PG8_WAIT_L(n) asm volatile("s_waitcnt lgkmcnt(" #n ")" ::: "memory")
#define PG8_BAR __builtin_amdgcn_s_barrier()
#define PG8_SCHED __builtin_amdgcn_sched_barrier(0)
    Unit cur, nxt; int ui = 0;
    if (!S.next(0, cur)) return;
    f32x4 acc[2][2][4][2];
#pragma unroll
    for (int a = 0; a < 2; ++a)
#pragma unroll
        for (int b = 0; b < 2; ++b)
#pragma unroll
            for (int m = 0; m < 4; ++m)
#pragma unroll
                for (int n = 0; n < 2; ++n) acc[a][b][m][n] = (f32x4){0.f, 0.f, 0.f, 0.f};
    bf16x8 At[4][2], B0[2][2], B1[2][2];
    const char* cA = (const char*)g.A + (size_t)cur.pm * tstep; const char* cB = (const char*)g.Bt + (size_t)cur.pn * tstep;
    S.a_ready(cur);
    PG8_STAGE(PG8_SB(0, 0), cB, voffB); PG8_STAGE(PG8_SA(0, 0), cA, voffA); PG8_STAGE(PG8_SB(0, 1), cB + hstep, voffB); PG8_STAGE(PG8_SA(0, 1), cA + hstep, voffA);
    if (wr == 1) PG8_BAR;
    PG8_WAIT_V(4); PG8_BAR;
    PG8_STAGE(PG8_SB(1, 0), cB + kstep, voffB); PG8_STAGE(PG8_SA(1, 0), cA + kstep, voffA); PG8_STAGE(PG8_SB(1, 1), cB + hstep + kstep, voffB);
    PG8_WAIT_V(6); PG8_BAR;
    for (;;) {
        const bool has_next = S.next(ui + 1, nxt);
        const char* nA = has_next ? (const char*)g.A + (size_t)nxt.pm * tstep : cA; const char* nB = has_next ? (const char*)g.Bt + (size_t)nxt.pn * tstep : cB;
        for (int t = 0; t < nt; t += 2) {
            const bool last = (t == nt - 2);
            const char* a1 = cA + (size_t)(t + 1) * kstep;
            const char* a2 = last ? nA : cA + (size_t)(t + 2) * kstep; const char* b2 = last ? nB : cB + (size_t)(t + 2) * kstep;
            const char* a3 = a2 + kstep; const char* b3 = b2 + kstep;
            if (last && has_next) S.a_ready(nxt);
            PG8_LDB(B0, 0, 0); PG8_SCHED; PG8_LDA(At, 0, 0); PG8_STAGE(PG8_SA(1, 1), a1 + hstep, voffA);
            PG8_WAIT_L(8); PG8_BAR; PG8_WAIT_L(0); PG8_MMA(0, 0, At, B0); PG8_BAR; PG8_SCHED;
            PG8_LDB(B1, 0, 1); PG8_STAGE(PG8_SB(0, 0), b2, voffB);
            PG8_BAR; PG8_WAIT_L(0); PG8_MMA(0, 1, At, B1); PG8_BAR;
            PG8_LDA(At, 0, 1); PG8_STAGE(PG8_SA(0, 0), a2, voffA);
            PG8_BAR; PG8_WAIT_L(0); PG8_MMA(1, 0, At, B0); PG8_BAR; PG8_SCHED;
            PG8_STAGE(PG8_SB(0, 1), b2 + hstep, voffB);
            PG8_WAIT_V(6); PG8_BAR; PG8_MMA(1, 1, At, B1); PG8_BAR;
            PG8_LDB(B0, 1, 0); PG8_SCHED; PG8_LDA(At, 1, 0); PG8_STAGE(PG8_SA(0, 1), a2 + hstep, voffA);
            PG8_WAIT_L(8); PG8_BAR; PG8_WAIT_L(0); PG8_MMA(0, 0, At, B0); PG8_BAR; PG8_SCHED;
            PG8_LDB(B1, 1, 1); PG8_STAGE(PG8_SB(1, 0), b3, voffB);
            PG8_BAR; PG8_WAIT_L(0); PG8_MMA(0, 1, At, B1); PG8_BAR;
            PG8_LDA(At, 1, 1); PG8_STAGE(PG8_SA(1, 0), a3, voffA);
            PG8_BAR; PG8_WAIT_L(0); PG8_MMA(1, 0, At, B0); PG8_BAR; PG8_SCHED;
            PG8_STAGE(PG8_SB(1, 1), b3 + hstep, voffB);
            PG8_WAIT_V(6); PG8_BAR; PG8_MMA(1, 1, At, B1); PG8_BAR;
        }
        if constexpr (!Epi::AFTER_DRAIN) { E(acc, cur, wr, wc, fr, fq); S.done(cur); }
        if (!has_next) break;
#pragma unroll
        for (int a = 0; a < 2; ++a)
#pragma unroll
            for (int b = 0; b < 2; ++b)
#pragma unroll
                for (int m = 0; m < 4; ++m)
#pragma unroll
                    for (int n = 0; n < 2; ++n) acc[a][b][m][n] = (f32x4){0.f, 0.f, 0.f, 0.f};
        cur = nxt; cA = nA; cB = nB; ++ui;
    }
    PG8_WAIT_V(0);
    if (wr == 0) PG8_BAR;
    PG8_BAR;
    if constexpr (Epi::AFTER_DRAIN) { E.fused(acc, cur, wr, wc, fr, fq, lds, wid, lane); S.done(cur); }
#undef PG8_SA
#undef PG8_SB
#undef PG8_STAGE
#undef PG8_LDA
#undef PG8_LDB
#undef PG8_MMA
#undef PG8_WAIT_V
#undef PG8_WAIT_L
#undef PG8_BAR
#undef PG8_SCHED
}
}


struct KArgs { const float* in[23]; float* out; unsigned char* ws; int ph_lo, ph_hi; };
struct Ctx {
    const float* in[23]; float* out; unsigned char* ws; LAS unsigned char* lds; int G, bid, tid, lane, w;
    __device__ __forceinline__ bf16_t* wb(size_t off) const { return (bf16_t*)(ws + off); }
    __device__ __forceinline__ float* wf(size_t off) const { return (float*)(ws + off); }
};

template <bool PERMQK = false>
__device__ __forceinline__ void tconv(const Ctx& c, const float* __restrict__ src, int K, int N, bf16_t* __restrict__ dst) {
    LAS float* tile = (LAS float*)c.lds;
    const int NT = N >> 6, total = (K >> 6) * NT, ngroups = (total + 3) >> 2;
    const int r = c.tid >> 4, c4 = (c.tid & 15) * 4, n = c.tid >> 3, kc = (c.tid & 7) * 8;
    for (int gidx = c.bid; gidx < ngroups; gidx += c.G) {
        f32x4 v[4][2];
#pragma unroll
        for (int q = 0; q < 4; ++q) {
            const int t = gidx * 4 + q;
            if (t < total) { const int kt = t / NT, nt = t - kt * NT;
#pragma unroll
                for (int i = 0; i < 2; ++i) v[q][i] = *(const f32x4*)(src + (size_t)(kt * 64 + r + 32 * i) * N + nt * 64 + c4); }
        }
#pragma unroll
        for (int q = 0; q < 4; ++q)
            if (gidx * 4 + q < total) {
#pragma unroll
                for (int i = 0; i < 2; ++i) { LAS float* p = tile + q * (64 * 65) + (r + 32 * i) * 65 + c4; p[0] = v[q][i][0]; p[1] = v[q][i][1]; p[2] = v[q][i][2]; p[3] = v[q][i][3]; }
            }
        __syncthreads();
#pragma unroll
        for (int q = 0; q < 4; ++q) {
            const int t = gidx * 4 + q;
            if (t < total) {
                const int kt = t / NT, nt = t - kt * NT;
                float f[8];
#pragma unroll
                for (int j = 0; j < 8; ++j) f[j] = tile[q * (64 * 65) + (kc + j) * 65 + n];
                u32x4 o; o.x = cvt_pk_bf16(f[0], f[1]); o.y = cvt_pk_bf16(f[2], f[3]); o.z = cvt_pk_bf16(f[4], f[5]); o.w = cvt_pk_bf16(f[6], f[7]);
                int drow = nt * 64 + n;
                if (PERMQK && drow >= 1024 && drow < 3072) { const int d = drow & 127; drow = (drow & ~127) + 32 * (2 * (d >> 6) + ((d >> 4) & 1)) + 16 * ((d >> 5) & 1) + (d & 15); }
                *(u32x4*)(dst + (size_t)drow * K + kt * 64 + kc) = o;
            }
        }
        __syncthreads();
    }
}
__device__ __forceinline__ void conv_bf16(const Ctx& c, const float* __restrict__ src, bf16_t* __restrict__ dst, size_t n) {
    const size_t nch = n >> 3;
    for (size_t i = (size_t)c.bid * 512 + c.tid; i < nch; i += (size_t)c.G * 512) {
        const f32x4 a = *(const f32x4*)(src + i * 8), b = *(const f32x4*)(src + i * 8 + 4);
        u32x4 o; o.x = cvt_pk_bf16(a[0], a[1]); o.y = cvt_pk_bf16(a[2], a[3]); o.z = cvt_pk_bf16(b[0], b[1]); o.w = cvt_pk_bf16(b[2], b[3]);
        *(u32x4*)(dst + i * 8) = o;
    }
}
__device__ __forceinline__ unsigned enc_fp6(float v) {
    const float a = fminf(fabsf(v), 7.5f);
    float q;
    if (a < 2.0f) q = rintf(a * 8.0f);
    else if (a < 4.0f) q = 16.0f + rintf((a - 2.0f) * 4.0f);
    else q = 24.0f + rintf((a - 4.0f) * 2.0f);
    unsigned c = (unsigned)q; c = c > 31u ? 31u : c;
    return c | (v < 0.f ? 32u : 0u);
}
__device__ __forceinline__ void conv_fp6(const Ctx& c, const float* __restrict__ src, unsigned char* __restrict__ dst, int rows, float scale) {
    const size_t ngroups = (size_t)rows * 64;
    for (size_t gi = (size_t)c.bid * 512 + c.tid; gi < ngroups; gi += (size_t)c.G * 512) {
        const size_t row = gi >> 6; const int l = (int)(gi & 63);
        const float* sp = src + row * 2048 + l * 32;
        unsigned w[6] = {0u, 0u, 0u, 0u, 0u, 0u};
#pragma unroll
        for (int q = 0; q < 8; ++q) {
            const f32x4 v = *(const f32x4*)(sp + q * 4);
#pragma unroll
            for (int e = 0; e < 4; ++e) {
                const int k = q * 4 + e, pos = 6 * k, d = pos >> 5, sh = pos & 31;
                const unsigned code = enc_fp6(v[e] * scale);
                w[d] |= code << sh;
                if (sh > 26) w[d + 1] |= code >> (32 - sh);
            }
        }
        unsigned char* dp = dst + row * 1536 + l * 8;
        *(u32x2*)(dp) = (u32x2){w[0], w[1]}; *(u32x2*)(dp + 512) = (u32x2){w[2], w[3]}; *(u32x2*)(dp + 1024) = (u32x2){w[4], w[5]};
    }
}
__device__ __forceinline__ unsigned enc_fp4(float v) {
    const float a = fabsf(v);
    unsigned c;
    if (a < 2.0f) c = (unsigned)rintf(a * 2.0f);
    else if (a < 4.0f) c = 4u + (unsigned)rintf((a - 2.0f));
    else c = a < 5.0f ? 6u : 7u;
    return c | (v < 0.f ? 8u : 0u);
}
__device__ __forceinline__ void conv_fp4(const Ctx& c, const float* __restrict__ src, unsigned char* __restrict__ dst, int rows, float scale, int part, int nparts) {
    for (int row = part * 8 + c.w; row < rows; row += nparts * 8) {
        const float* sp = src + (size_t)row * 2048 + c.lane * 8;
        f32x4 v[4][2];
#pragma unroll
        for (int q = 0; q < 4; ++q) { v[q][0] = *(const f32x4*)(sp + q * 512); v[q][1] = *(const f32x4*)(sp + q * 512 + 4); }
#pragma unroll
        for (int q = 0; q < 4; ++q) {
            unsigned h = 0u;
#pragma unroll
            for (int e = 0; e < 4; ++e) h |= (enc_fp4(v[q][0][e] * scale) << (4 * e)) | (enc_fp4(v[q][1][e] * scale) << (16 + 4 * e));
            *(unsigned*)(dst + (size_t)row * 1024 + q * 256 + c.lane * 4) = h;
        }
    }
}
__device__ __forceinline__ void conv_fp8(const Ctx& c, const float* __restrict__ src, unsigned char* __restrict__ dst, size_t n, float scale) {
    const size_t nch = n >> 4;
    for (size_t i = (size_t)c.bid * 512 + c.tid; i < nch; i += (size_t)c.G * 512) {
        u32x4 o;
#pragma unroll
        for (int q = 0; q < 4; ++q) {
            const f32x4 a = *(const f32x4*)(src + i * 16 + q * 4);
            int w = 0;
            w = __builtin_amdgcn_cvt_pk_fp8_f32(a[0] * scale, a[1] * scale, w, false);
            w = __builtin_amdgcn_cvt_pk_fp8_f32(a[2] * scale, a[3] * scale, w, true);
            o[q] = (unsigned)w;
        }
        *(u32x4*)(dst + i * 16) = o;
    }
}
__device__ __forceinline__ void phase_prologue(const Ctx& c) {
    tconv<true>(c, c.in[8], 2048, 6144, c.wb(WS_WINE));
    tconv(c, c.in[10], 2048, 2048, c.wb(WS_WOUTE));
    tconv(c, c.in[11], 2048, 2112, c.wb(WS_WINO));
    tconv(c, c.in[15], 512, 1536, c.wb(WS_WUQ));
    tconv(c, c.in[16], 256, 2048, c.wb(WS_WUKV));
    tconv(c, c.in[17], 2048, 2048, c.wb(WS_WOUTO));
    tconv(c, c.in[18], 2048, 2048, c.wb(WS_WQ0));
    tconv(c, c.in[18] + (size_t)2048 * 2048, 2048, 2048, c.wb(WS_WQ1));
    {
        u32x4* p = (u32x4*)(c.wb(WS_WINO) + (size_t)2112 * 2048);
        for (int i = c.bid * 512 + c.tid; i < 192 * 2048 / 8; i += c.G * 512) p[i] = (u32x4){0u, 0u, 0u, 0u};
    }
    conv_bf16(c, c.in[19], c.wb(WS_SKB), (size_t)2 * 16 * 128 * 128);
    {
        const int two = 2 * 32 * 6 - c.G; const bool split = two > 0 && two < c.G; const int r0 = split ? 12288 : 16384;
        conv_fp4(c, c.in[20], c.ws + WS_TABU, r0, U_SCALE, c.bid, c.G);
        conv_fp4(c, c.in[21], c.ws + WS_TABV, r0, V_SCALE, c.bid, c.G);
        if (split && c.bid >= two) {
            conv_fp4(c, c.in[20] + (size_t)r0 * 2048, c.ws + WS_TABU + (size_t)r0 * 1024, 16384 - r0, U_SCALE, c.bid - two, c.G - two);
            conv_fp4(c, c.in[21] + (size_t)r0 * 2048, c.ws + WS_TABV + (size_t)r0 * 1024, 16384 - r0, V_SCALE, c.bid - two, c.G - two);
        }
    }
    const int gt = c.bid * 512 + c.tid, gn = c.G * 512;
    {
        f32x2* r128 = (f32x2*)(c.ws + WS_ROPE); f32x2* r64 = (f32x2*)(c.ws + WS_ROPE + 131072);
        for (int i = gt; i < 256 * 32; i += gn) {
            const int pos = i >> 5, f = i & 31;
            const float inv = exp2f(-(float)f * (13.287712379549449f / 32.0f));
            const float rev = (float)pos * inv * 0.15915494309189535f; const float fr = rev - floorf(rev);
            r128[i] = (f32x2){cos_rev(fr), sin_rev(fr)};
        }
        for (int i = gt; i < 256 * 16; i += gn) {
            const int pos = i >> 4, f = i & 15;
            const float inv = exp2f(-(float)f * (13.287712379549449f / 16.0f));
            const float rev = (float)pos * inv * 0.15915494309189535f; const float fr = rev - floorf(rev);
            r64[i] = (f32x2){cos_rev(fr), sin_rev(fr)};
        }
    }
    {
        bf16_t* MC = c.wb(WS_DFT); bf16_t* M1 = c.wb(WS_DFT + 262144); bf16_t* M2 = c.wb(WS_DFT + 393216); bf16_t* MCX = c.wb(WS_DFT + 458752);
        for (int i = gt; i < 512 * 256; i += gn) {
            const int n = i >> 8, k = i & 255, m = n & 255; const float fr = (float)((m * k) & 255) * (1.0f / 256.0f);
            const float v = (n < 256 ? cos_rev(fr) : -sin_rev(fr)) * 0.0625f;
            MC[i] = (bf16_t)(cvt_pk_bf16(v, 0.f) & 0xffffu);
        }
        for (int i = gt; i < 256 * 256; i += gn) {
            const int j = i >> 8, kk = i & 255, ka = j >> 1, ro = j & 1, ri = kk >> 7, nh = kk & 127;
            const float fr = (float)((ka * nh) & 127) * (1.0f / 128.0f); const float cc = cos_rev(fr), ss = sin_rev(fr);
            const float v = (ro == ri ? cc : (ro == 0 ? ss : -ss)) * 0.08838834764831845f;
            M1[i] = (bf16_t)(cvt_pk_bf16(v, 0.f) & 0xffffu);
        }
        for (int i = gt; i < 128 * 256; i += gn) {
            const int kb = i >> 8, kk = i & 255, ri = kk >> 7, nl = kk & 127;
            const float fr = (float)((kb * nl) & 127) * (1.0f / 128.0f);
            const float v = (ri == 0 ? cos_rev(fr) : sin_rev(fr)) * 0.08838834764831845f;
            M2[i] = (bf16_t)(cvt_pk_bf16(v, 0.f) & 0xffffu);
        }
        for (int i = gt; i < 256 * 512; i += gn) {
            const int k = i >> 9, kk = i & 511, ri = kk >> 8, n = kk & 255;
            const float fr = (float)((k * n) & 255) * (1.0f / 256.0f);
            const float v = (ri == 0 ? cos_rev(fr) : sin_rev(fr)) * 0.0625f;
            MCX[i] = (bf16_t)(cvt_pk_bf16(v, 0.f) & 0xffffu);
        }
    }
    {
        const float* cvec = c.in[1]; const float* cctx = c.in[3]; const float* wmod = c.in[4];
        float* modp = c.wf(WS_MODP);
        for (int u = c.bid; u < 2 * 32 * 6; u += c.G) {
            const int l = u / 192, r = u - l * 192, kc = r / 6, nb = r - kc * 6;
            const int n = nb * 2048 + c.tid * 4;
            f32x4 a0 = {0.f, 0.f, 0.f, 0.f}, a1 = a0, a2 = a0;
            const float* wp = wmod + ((size_t)l * 2048 + kc * 64) * 12288 + n;
#pragma unroll 8
            for (int k = 0; k < 64; ++k) {
                const int kk = kc * 64 + k;
                const f32x4 wv = *(const f32x4*)(wp + (size_t)k * 12288);
                const float s0 = silu_f(cvec[kk]), s1 = silu_f(cvec[2048 + kk]), s2 = silu_f(cctx[kk]);
                a0 += wv * s0; a1 += wv * s1; a2 += wv * s2;
            }
            float* o = modp + ((size_t)(kc * 2 + l) * 3) * 12288 + n;
            *(f32x4*)(o) = a0; *(f32x4*)(o + 12288) = a1; *(f32x4*)(o + 2 * 12288) = a2;
        }
    }
}
__device__ __forceinline__ void phase_mods(const Ctx& c) {
    const float* modp = c.wf(WS_MODP); float* mods = c.wf(WS_MODS); const float* bmod = c.in[5];
    for (int i = c.bid * 512 + c.tid; i < 2 * 3 * 12288; i += c.G * 512) {
        const int l = i / 36864, r = i - l * 36864, n = r % 12288;
        float s = bmod[l * 12288 + n];
        for (int kc = 0; kc < 32; ++kc) s += modp[(size_t)(kc * 2 + l) * 36864 + r];
        mods[i] = s;
    }
}
__device__ __forceinline__ void phase_modnorm(const Ctx& c, int layer, int which, const float* __restrict__ xlat, const float* __restrict__ xctx, int tok_lo, bf16_t* __restrict__ H) {
    const float* mods = c.wf(WS_MODS); const float* nw = c.in[6 + which] + layer * D;
    for (int tok = tok_lo + c.bid * 8 + c.w; tok < TT; tok += c.G * 8) {
        const float* src = tok < TC ? xctx + (size_t)tok * D : xlat + (size_t)(tok - TC) * D;
        const int mw = tok < TC ? 2 : ((tok - TC) >> 14);
        const float* mb = mods + (size_t)(layer * 3 + mw) * 12288 + which * 3 * 2048;
        f32x4 v[8]; float ss = 0.f;
#pragma unroll
        for (int i = 0; i < 8; ++i) { v[i] = *(const f32x4*)(src + i * 256 + c.lane * 4); ss += v[i][0] * v[i][0] + v[i][1] * v[i][1] + v[i][2] * v[i][2] + v[i][3] * v[i][3]; }
        ss = wave_sum(ss);
        const float rstd = rsqrtf(ss * (1.0f / D) + EPS);
#pragma unroll
        for (int i = 0; i < 8; ++i) {
            const int col = i * 256 + c.lane * 4;
            const f32x4 g = *(const f32x4*)(nw + col), sh = *(const f32x4*)(mb + col), sc = *(const f32x4*)(mb + 2048 + col);
            f32x4 o;
#pragma unroll
            for (int j = 0; j < 4; ++j) o[j] = v[i][j] * rstd * g[j] * (1.0f + sc[j]) + sh[j];
            *(u32x2*)(H + (size_t)tok * D + col) = pack4(o);
        }
    }
}

__device__ __forceinline__ void phase_even_proj(const Ctx& c) {
    const bf16_t* H = c.wb(WS_H); const bf16_t* W = c.wb(WS_WINE);
    bf16_t* F = c.wb(WS_A); bf16_t* Q = c.wb(WS_Q); bf16_t* Kb = c.wb(WS_K); bf16_t* V = c.wb(WS_V); bf16_t* Gt = c.wb(WS_G);
    const f32x2* r128 = (const f32x2*)(c.ws + WS_ROPE);
    const int MT = TT / 128, NT = 6144 / 128;
    const int g = c.lane >> 4, wm = c.w >> 1, wn = c.w & 1;
    for (int t = c.bid; t < MT * NT; t += c.G) {
        int mt, nt; tile_mn(t, MT, NT, mt, nt);
        f32x4 acc[2][4];
        gemm128<true>(c.lds, 2048, RowLin{H + (size_t)mt * 128 * D, (size_t)D}, RowLin{W + (size_t)nt * 128 * 2048, 2048}, acc);
        const int region = nt >> 3, cr0 = (nt & 7) * 128 + 64 * wn + 4 * g;
#pragma unroll
        for (int mb = 0; mb < 2; ++mb) {
            const int tok = mt * 128 + 32 * wm + 16 * mb + (c.lane & 15);
            if (region == 0) {
#pragma unroll
                for (int nb = 0; nb < 4; ++nb) *(u32x2*)(F + (size_t)tok * 1024 + cr0 + 16 * nb) = pack4(acc[mb][nb]);
            } else if (region == 1 || region == 2) {
                bf16_t* dst = (region == 1 ? Q : Kb) + (size_t)tok * 1024 + cr0;
                const float sc = region == 2 ? 0.08838834764831845f : 1.0f;
                if (tok >= TC) {
                    const int s = (tok - TC) & (SEQ - 1); const int pos = wn == 0 ? (s >> 6) : (s & 63);
#pragma unroll
                    for (int nb = 0; nb < 2; ++nb) {
                        f32x4 o1, o2;
#pragma unroll
                        for (int r = 0; r < 4; ++r) {
                            const f32x2 cs = r128[pos * 32 + 16 * nb + 4 * g + r];
                            const float a = acc[mb][nb][r] * sc, b = acc[mb][nb + 2][r] * sc;
                            o1[r] = a * cs.x - b * cs.y; o2[r] = b * cs.x + a * cs.y;
                        }
                        *(u32x2*)(dst + 16 * nb) = pack4(o1); *(u32x2*)(dst + 16 * (nb + 2)) = pack4(o2);
                    }
                } else {
#pragma unroll
                    for (int nb = 0; nb < 4; ++nb) *(u32x2*)(dst + 16 * nb) = pack4(acc[mb][nb] * sc);
                }
            } else if (region == 3) {
#pragma unroll
                for (int nb = 0; nb < 4; ++nb) *(u32x2*)(V + (size_t)tok * 1024 + cr0 + 16 * nb) = pack4(acc[mb][nb]);
            } else {
#pragma unroll
                for (int nb = 0; nb < 4; ++nb) {
                    f32x4 o;
#pragma unroll
                    for (int r = 0; r < 4; ++r) o[r] = silu_f(acc[mb][nb][r]);
                    *(u32x2*)(Gt + (size_t)tok * 2048 + (region - 4) * 1024 + cr0 + 16 * nb) = pack4(o);
                }
            }
        }
    }
}
constexpr int FS = 528, F_B = 128 * FS;
template <class RF>
__device__ __forceinline__ void ftile_issue(u32x4 (&r)[8], const RF& row, int tid) {
#pragma unroll
    for (int i = 0; i < 8; ++i) r[i] = *(const u32x4*)(row((tid >> 5) + 16 * i) + (tid & 31) * 8);
}
__device__ __forceinline__ void ftile_write(LAS unsigned char* dst, const u32x4 (&r)[8], int tid) {
#pragma unroll
    for (int i = 0; i < 8; ++i) *(LAS u32x4*)(dst + ((tid >> 5) + 16 * i) * FS + (tid & 31) * 16) = r[i];
}
__device__ __forceinline__ void ftile_mma(LAS unsigned char* lds, f32x4 (&acc)[2][4], int lane, int wm, int wn) {
#pragma unroll
    for (int mb = 0; mb < 2; ++mb)
#pragma unroll
        for (int nb = 0; nb < 4; ++nb) acc[mb][nb] = (f32x4){0.f, 0.f, 0.f, 0.f};
    const int aoff = (32 * wm + (lane & 15)) * FS + (lane >> 4) * 16;
    const int boff = F_B + (64 * wn + (lane & 15)) * FS + (lane >> 4) * 16;
#pragma unroll
    for (int ks = 0; ks < 8; ++ks) {
        bf16x8 af[2], bfr[4];
#pragma unroll
        for (int mb = 0; mb < 2; ++mb) af[mb] = *(const LAS bf16x8*)(lds + aoff + mb * (16 * FS) + ks * 64);
#pragma unroll
        for (int nb = 0; nb < 4; ++nb) bfr[nb] = *(const LAS bf16x8*)(lds + boff + nb * (16 * FS) + ks * 64);
#pragma unroll
        for (int mb = 0; mb < 2; ++mb)
#pragma unroll
            for (int nb = 0; nb < 4; ++nb) acc[mb][nb] = __builtin_amdgcn_mfma_f32_16x16x32_bf16(af[mb], bfr[nb], acc[mb][nb], 0, 0, 0);
    }
}
struct RowStr { const bf16_t* base; size_t pitch; __device__ __forceinline__ const bf16_t* operator()(int r) const { return base + (size_t)r * pitch; } };
__device__ __forceinline__ void phase_chan_dft(const Ctx& c) {
    const bf16_t* F = c.wb(WS_A); const bf16_t* MC = c.wb(WS_DFT);
    bf16_t* Zt = c.wb(WS_ST); bf16_t* Ztc = c.wb(WS_ST + 128 * MiB);
    const int g4 = c.lane >> 4, wm = c.w >> 1, wn = c.w & 1;
    LAS unsigned char* la = c.lds; LAS unsigned char* lb = c.lds + F_B;
    constexpr int NUL = 2 * 4 * 128;
    u32x4 ra[8], rb[8];
    if (c.bid < NUL) {
        const int grp = c.bid & 3, nlo = (c.bid >> 2) & 127, b = c.bid >> 9;
        ftile_issue(ra, RowStr{F + ((size_t)(TC + b * SEQ + nlo)) * 1024 + grp * 256, (size_t)128 * 1024}, c.tid);
        ftile_issue(rb, RowLin{MC, 256}, c.tid);
        ftile_write(la, ra, c.tid); ftile_write(lb, rb, c.tid);
    }
    __syncthreads();
    for (int u = c.bid; u < NUL; u += c.G) {
        const int grp = u & 3, nlo = (u >> 2) & 127, b = u >> 9;
        const bool nxu = u + c.G < NUL;
#pragma unroll 1
        for (int nt = 0; nt < 4; ++nt) {
            if (nt < 3) ftile_issue(rb, RowLin{MC + (size_t)(nt + 1) * 128 * 256, 256}, c.tid);
            else if (nxu) {
                const int un = u + c.G, gn = un & 3, nn = (un >> 2) & 127, bn = un >> 9;
                ftile_issue(ra, RowStr{F + ((size_t)(TC + bn * SEQ + nn)) * 1024 + gn * 256, (size_t)128 * 1024}, c.tid);
                ftile_issue(rb, RowLin{MC, 256}, c.tid);
            }
            __builtin_amdgcn_sched_barrier(0);
            f32x4 acc[2][4];
            ftile_mma(c.lds, acc, c.lane, wm, wn);
#pragma unroll
            for (int mb = 0; mb < 2; ++mb)
#pragma unroll
                for (int nb = 0; nb < 4; ++nb) {
                    const int n = nt * 128 + 64 * wn + 16 * nb + (c.lane & 15), reim = n >> 8, m = n & 255, nhi = 32 * wm + 16 * mb + 4 * g4;
                    *(u32x2*)(Zt + ((((size_t)(b * 4 + grp) * 256 + m) * 128 + nlo) * 2 + reim) * 128 + nhi) = pack4(acc[mb][nb]);
                }
            __syncthreads();
            if (nt < 3) ftile_write(lb, rb, c.tid);
            else if (nxu) { ftile_write(la, ra, c.tid); ftile_write(lb, rb, c.tid); }
            __syncthreads();
        }
    }
    for (int v = c.bid; v < 64; v += c.G) {
        f32x4 acc[2][4];
        const int nt = v & 3, rt = (v >> 2) & 1, grp = (v >> 3) & 3, b = v >> 5;
        gemm128s<false, 256>(c.lds, RowLin{F + ((size_t)(b * NCTX + rt * 128)) * 1024 + grp * 256, 1024}, RowLin{MC + (size_t)nt * 128 * 256, 256}, acc);
#pragma unroll
        for (int mb = 0; mb < 2; ++mb)
#pragma unroll
            for (int nb = 0; nb < 4; ++nb) {
                const int n = nt * 128 + 64 * wn + 16 * nb + (c.lane & 15), reim = n >> 8, m = n & 255, nn = rt * 128 + 32 * wm + 16 * mb + 4 * g4;
                *(u32x2*)(Ztc + (((size_t)(b * 4 + grp) * 256 + m) * 2 + reim) * 256 + nn) = pack4(acc[mb][nb]);
            }
    }
}
__device__ __forceinline__ void phase_dft_stage1(const Ctx& c) {
    const bf16_t* Zt = c.wb(WS_ST); const bf16_t* Ztc = c.wb(WS_ST + 128 * MiB);
    const bf16_t* M1 = c.wb(WS_DFT + 262144); const bf16_t* MCX = c.wb(WS_DFT + 458752);
    bf16_t* Tp = c.wb(WS_H); bf16_t* CAT = c.wb(WS_CAT);
    const int g4 = c.lane >> 4, wm = c.w >> 1, wn = c.w & 1;
    LAS unsigned char* la = c.lds; LAS unsigned char* lb = c.lds + F_B;
    constexpr int NUL = 2048;
    u32x4 ra[8], rb[8];
    if (c.bid < NUL) {
        ftile_issue(ra, RowLin{Zt + (size_t)c.bid * 128 * 256, 256}, c.tid); ftile_issue(rb, RowLin{M1, 256}, c.tid);
        ftile_write(la, ra, c.tid); ftile_write(lb, rb, c.tid);
    }
    __syncthreads();
    for (int rt = c.bid; rt < NUL; rt += c.G) {
        const int bg = rt >> 8, m = rt & 255;
        const bool nxu = rt + c.G < NUL;
#pragma unroll 1
        for (int nt = 0; nt < 2; ++nt) {
            if (nt < 1) ftile_issue(rb, RowLin{M1 + (size_t)(nt + 1) * 128 * 256, 256}, c.tid);
            else if (nxu) { ftile_issue(ra, RowLin{Zt + (size_t)(rt + c.G) * 128 * 256, 256}, c.tid); ftile_issue(rb, RowLin{M1, 256}, c.tid); }
            __builtin_amdgcn_sched_barrier(0);
            f32x4 acc[2][4];
            ftile_mma(c.lds, acc, c.lane, wm, wn);
#pragma unroll
            for (int mb = 0; mb < 2; ++mb)
#pragma unroll
                for (int nb = 0; nb < 4; ++nb) {
                    const int j = nt * 128 + 64 * wn + 16 * nb + (c.lane & 15), ka = j >> 1, ro = j & 1, nlo0 = 32 * wm + 16 * mb + 4 * g4;
                    f32x4 o;
#pragma unroll
                    for (int r = 0; r < 4; ++r) {
                        const float mine = acc[mb][nb][r], other = __shfl_xor(mine, 1);
                        const float fr = (float)((ka * (nlo0 + r)) & 16383) * (1.0f / 16384.0f);
                        const float cc = cos_rev(fr), ss = sin_rev(fr);
                        o[r] = ro == 0 ? (mine * cc + other * ss) : (mine * cc - other * ss);
                    }
                    *(u32x2*)(Tp + ((((size_t)bg * 128 + ka) * 256 + m) * 2 + ro) * 128 + nlo0) = pack4(o);
                }
            __syncthreads();
            if (nt < 1) ftile_write(lb, rb, c.tid);
            else if (nxu) { ftile_write(la, ra, c.tid); ftile_write(lb, rb, c.tid); }
            __syncthreads();
        }
    }
    for (int v = c.bid; v < 32; v += c.G) {
        f32x4 acc[2][4];
        const int nt = v & 1, rt = v >> 1;
        gemm128s<false, 512>(c.lds, RowLin{Ztc + (size_t)rt * 128 * 512, 512}, RowLin{MCX + (size_t)nt * 128 * 512, 512}, acc);
        const int bg = rt >> 1, b = bg >> 2, grp = bg & 3, mh = rt & 1;
#pragma unroll
        for (int mb = 0; mb < 2; ++mb)
#pragma unroll
            for (int nb = 0; nb < 4; ++nb) {
                const int k = nt * 128 + 64 * wn + 16 * nb + (c.lane & 15), m0 = mh * 128 + 32 * wm + 16 * mb + 4 * g4;
                *(u32x2*)(CAT + (size_t)(b * NCTX + k) * 2048 + grp * 256 + m0) = pack4(acc[mb][nb]);
            }
    }
}
__device__ __forceinline__ void phase_dft_stage2(const Ctx& c) {
    const bf16_t* Tp = c.wb(WS_H); const bf16_t* M2 = c.wb(WS_DFT + 393216); bf16_t* CAT = c.wb(WS_CAT);
    const int g4 = c.lane >> 4, wm = c.w >> 1, wn = c.w & 1;
    LAS unsigned char* la = c.lds; LAS unsigned char* lb = c.lds + F_B;
    u32x4 ra[8];
    if (c.bid < 2048) {
        ftile_issue(ra, RowLin{M2, 256}, c.tid);
        ftile_write(lb, ra, c.tid);
        ftile_issue(ra, RowLin{Tp + (size_t)c.bid * 128 * 256, 256}, c.tid);
        ftile_write(la, ra, c.tid);
    }
    __syncthreads();
    for (int u = c.bid; u < 2048; u += c.G) {
        const bool nxu = u + c.G < 2048;
        if (nxu) ftile_issue(ra, RowLin{Tp + (size_t)(u + c.G) * 128 * 256, 256}, c.tid);
        __builtin_amdgcn_sched_barrier(0);
        f32x4 acc[2][4];
        ftile_mma(c.lds, acc, c.lane, wm, wn);
        const int mh = u & 1, ka = (u >> 1) & 127, bg = u >> 8, b = bg >> 2, grp = bg & 3;
#pragma unroll
        for (int mb = 0; mb < 2; ++mb)
#pragma unroll
            for (int nb = 0; nb < 4; ++nb) {
                const int kb = 64 * wn + 16 * nb + (c.lane & 15), m0 = mh * 128 + 32 * wm + 16 * mb + 4 * g4;
                *(u32x2*)(CAT + (size_t)(TC + b * SEQ + ka + 128 * kb) * 2048 + grp * 256 + m0) = pack4(acc[mb][nb]);
            }
        __syncthreads();
        if (nxu) ftile_write(la, ra, c.tid);
        __syncthreads();
    }
}

constexpr int TS = 272;
constexpr int TILE_B = 128 * TS;
constexpr int TSV = 288;
constexpr int TILE_BV = 128 * TSV;
__device__ __forceinline__ int chunk_tok0(int b, int cch) { return cch < 2 ? b * NCTX + cch * 128 : TC + b * SEQ + (cch - 2) * 128; }
template <int STRIDE = TS>
__device__ __forceinline__ void load_tile128(const Ctx& c, LAS unsigned char* dst, const bf16_t* src  , size_t pitch) {
#pragma unroll
    for (int i = 0; i < 4; ++i) {
        const int id = c.tid + 512 * i, row = id >> 4, ch = id & 15;
        *(LAS u32x4*)(dst + row * STRIDE + ch * 16) = *(const u32x4*)(src + (size_t)row * pitch + ch * 8);
    }
}
__device__ __forceinline__ void phase_ret_ds(const Ctx& c) {
    const bf16_t* Kb = c.wb(WS_K); const bf16_t* V = c.wb(WS_V); bf16_t* ST = c.wb(WS_ST);
    LAS unsigned char* kt = c.lds; LAS unsigned char* vf = c.lds + TILE_BV; LAS unsigned char* vb = c.lds + 2 * TILE_BV;
    const int g = c.lane >> 4, wm = c.w >> 1, wn = c.w & 1, d0 = 32 * wm, e0 = 64 * wn;
    u32x4 rk[4], rv[4];
    if (c.bid < NBATCH * 8 * NCH) {
        const int cch = c.bid % NCH, bh = c.bid / NCH; const size_t g0 = (size_t)chunk_tok0(bh >> 3, cch) * 1024 + (bh & 7) * 128;
#pragma unroll
        for (int i = 0; i < 4; ++i) { const int id = c.tid + 512 * i; const size_t go = g0 + (size_t)(id >> 4) * 1024 + (id & 15) * 8; rk[i] = *(const u32x4*)(Kb + go); rv[i] = *(const u32x4*)(V + go); }
    }
    for (int u = c.bid; u < NBATCH * 8 * NCH; u += c.G) {
        const int cch = u % NCH, bh = u / NCH, h = bh & 7, b = bh >> 3;
        const float lg = log2_gamma(h);
#pragma unroll
        for (int i = 0; i < 4; ++i) {
            const int id = c.tid + 512 * i, row = id >> 4, ch = id & 15;
            *(LAS u32x4*)(kt + row * TSV + ch * 16) = rk[i];
            const u32x4 v = rv[i];
            const float zf = fast_exp2(lg * (float)(127 - row)), zb = fast_exp2(lg * (float)row);
            u32x4 of, ob;
            of.x = cvt_pk_bf16(bf_lo(v.x) * zf, bf_hi(v.x) * zf); of.y = cvt_pk_bf16(bf_lo(v.y) * zf, bf_hi(v.y) * zf);
            of.z = cvt_pk_bf16(bf_lo(v.z) * zf, bf_hi(v.z) * zf); of.w = cvt_pk_bf16(bf_lo(v.w) * zf, bf_hi(v.w) * zf);
            ob.x = cvt_pk_bf16(bf_lo(v.x) * zb, bf_hi(v.x) * zb); ob.y = cvt_pk_bf16(bf_lo(v.y) * zb, bf_hi(v.y) * zb);
            ob.z = cvt_pk_bf16(bf_lo(v.z) * zb, bf_hi(v.z) * zb); ob.w = cvt_pk_bf16(bf_lo(v.w) * zb, bf_hi(v.w) * zb);
            *(LAS u32x4*)(vf + row * TSV + ch * 16) = of; *(LAS u32x4*)(vb + row * TSV + ch * 16) = ob;
        }
        __syncthreads();
        if (u + c.G < NBATCH * 8 * NCH) {
            const int un = u + c.G, cn = un % NCH, bn = un / NCH; const size_t g0 = (size_t)chunk_tok0(bn >> 3, cn) * 1024 + (bn & 7) * 128;
#pragma unroll
            for (int i = 0; i < 4; ++i) { const int id = c.tid + 512 * i; const size_t go = g0 + (size_t)(id >> 4) * 1024 + (id & 15) * 8; rk[i] = *(const u32x4*)(Kb + go); rv[i] = *(const u32x4*)(V + go); }
        }
        __builtin_amdgcn_sched_barrier(0);
        f32x4 accf[2][4], accb[2][4];
#pragma unroll
        for (int mb = 0; mb < 2; ++mb)
#pragma unroll
            for (int nb = 0; nb < 4; ++nb) { accf[mb][nb] = (f32x4){0.f, 0.f, 0.f, 0.f}; accb[mb][nb] = (f32x4){0.f, 0.f, 0.f, 0.f}; }
#pragma unroll
        for (int ks = 0; ks < 4; ++ks) {
            const int j0 = 32 * ks + 8 * g;
            bf16x8 af[2];
#pragma unroll
            for (int mb = 0; mb < 2; ++mb)
                af[mb] = cat8(tr_read(kt + j0 * TSV + (d0 + 16 * mb) * 2, TSV, c.lane), tr_read(kt + (j0 + 4) * TSV + (d0 + 16 * mb) * 2, TSV, c.lane));
#pragma unroll
            for (int nb = 0; nb < 4; ++nb) {
                const bf16x8 bf = cat8(tr_read(vf + j0 * TSV + (e0 + 16 * nb) * 2, TSV, c.lane), tr_read(vf + (j0 + 4) * TSV + (e0 + 16 * nb) * 2, TSV, c.lane));
                const bf16x8 bb = cat8(tr_read(vb + j0 * TSV + (e0 + 16 * nb) * 2, TSV, c.lane), tr_read(vb + (j0 + 4) * TSV + (e0 + 16 * nb) * 2, TSV, c.lane));
#pragma unroll
                for (int mb = 0; mb < 2; ++mb) {
                    accf[mb][nb] = __builtin_amdgcn_mfma_f32_16x16x32_bf16(af[mb], bf, accf[mb][nb], 0, 0, 0);
                    accb[mb][nb] = __builtin_amdgcn_mfma_f32_16x16x32_bf16(af[mb], bb, accb[mb][nb], 0, 0, 0);
                }
            }
        }
        bf16_t* sf = ST + ((size_t)((0 * 2 + b) * 8 + h) * NCH + cch) * 16384;
        bf16_t* sb = ST + ((size_t)((1 * 2 + b) * 8 + h) * NCH + cch) * 16384;
#pragma unroll
        for (int mb = 0; mb < 2; ++mb)
#pragma unroll
            for (int nb = 0; nb < 4; ++nb) {
                const int e = e0 + 16 * nb + (c.lane & 15), d = d0 + 16 * mb + 4 * g;
                *(u32x2*)(sf + e * 128 + d) = pack4(accf[mb][nb]);
                *(u32x2*)(sb + e * 128 + d) = pack4(accb[mb][nb]);
            }
        __syncthreads();
    }
}
__device__ __forceinline__ void phase_ret_scan(const Ctx& c) {
    bf16_t* ST = c.wb(WS_ST);
    for (int gid = c.bid * 512 + c.tid; gid < 2 * 16 * 2048; gid += c.G * 512) {
        const int dir = gid >> 15, rem = gid & 32767, bh = rem >> 11, e8 = rem & 2047, h = bh & 7;
        bf16_t* base = ST + (size_t)(dir * 16 + bh) * NCH * 16384 + e8 * 8;
        const float decay = fast_exp2(log2_gamma(h) * 128.0f);
        float st[8];
#pragma unroll
        for (int j = 0; j < 8; ++j) st[j] = 0.f;
        for (int s0 = 0; s0 < NCH; s0 += 26) {
            u32x4 ds[26];
#pragma unroll
            for (int i = 0; i < 26; ++i) {
                const int s = s0 + i; const int cch = dir == 0 ? s : (s < 2 ? 1 - s : 131 - s);
                ds[i] = *(const u32x4*)(base + (size_t)cch * 16384);
            }
            __builtin_amdgcn_sched_barrier(0);
#pragma unroll
            for (int i = 0; i < 26; ++i) {
                const int s = s0 + i; const int cch = dir == 0 ? s : (s < 2 ? 1 - s : 131 - s);
                u32x4 o; o.x = cvt_pk_bf16(st[0], st[1]); o.y = cvt_pk_bf16(st[2], st[3]); o.z = cvt_pk_bf16(st[4], st[5]); o.w = cvt_pk_bf16(st[6], st[7]);
                *(u32x4*)(base + (size_t)cch * 16384) = o;
                st[0] = st[0] * decay + bf_lo(ds[i].x); st[1] = st[1] * decay + bf_hi(ds[i].x);
                st[2] = st[2] * decay + bf_lo(ds[i].y); st[3] = st[3] * decay + bf_hi(ds[i].y);
                st[4] = st[4] * decay + bf_lo(ds[i].z); st[5] = st[5] * decay + bf_hi(ds[i].z);
                st[6] = st[6] * decay + bf_lo(ds[i].w); st[7] = st[7] * decay + bf_hi(ds[i].w);
            }
        }
    }
}
__device__ __forceinline__ void phase_ret_out(const Ctx& c) {
    const bf16_t* Q = c.wb(WS_Q); const bf16_t* Kb = c.wb(WS_K); const bf16_t* V = c.wb(WS_V); const bf16_t* Gt = c.wb(WS_G);
    const bf16_t* ST = c.wb(WS_ST); bf16_t* CAT = c.wb(WS_CAT); const float* gn = c.in[9];
    LAS unsigned char* qt = c.lds; LAS unsigned char* kt = c.lds + TILE_B; LAS unsigned char* vt = c.lds + 2 * TILE_B;
    LAS unsigned char* pw = c.lds + 2 * TILE_B + TILE_BV + c.w * (16 * TS);
    LAS float* gws = (LAS float*)(c.lds + 2 * TILE_B + TILE_BV + 8 * (16 * TS));
    const int g = c.lane >> 4, il = c.lane & 15, i0 = 16 * c.w;
    for (int u = c.bid; u < NBATCH * 8 * NCH; u += c.G) {
        const int cch = u % NCH, bh = u / NCH, h = bh & 7, b = bh >> 3;
        const int tok0 = chunk_tok0(b, cch);
        const float lg = log2_gamma(h);
        const bf16_t* st0 = ST + ((size_t)((0 * 2 + b) * 8 + h) * NCH + cch) * 16384;
        u32x4 rq[4], rk[4], rv[4], rs[4];
#pragma unroll
        for (int i = 0; i < 4; ++i) {
            const int id = c.tid + 512 * i, row = id >> 4, ch = id & 15;
            const size_t go = (size_t)(tok0 + row) * 1024 + h * 128 + ch * 8;
            rq[i] = *(const u32x4*)(Q + go); rk[i] = *(const u32x4*)(Kb + go); rv[i] = *(const u32x4*)(V + go);
            rs[i] = *(const u32x4*)(st0 + row * 128 + ch * 8);
        }
        const float gwv = gn[h * 128 + (c.tid & 127)];
        __builtin_amdgcn_sched_barrier(0);
#pragma unroll
        for (int i = 0; i < 4; ++i) {
            const int id = c.tid + 512 * i, row = id >> 4, ch = id & 15;
            *(LAS u32x4*)(qt + row * TS + ch * 16) = rq[i]; *(LAS u32x4*)(kt + row * TS + ch * 16) = rk[i];
            *(LAS u32x4*)(vt + row * TSV + ch * 16) = rv[i];
        }
        if (c.tid < 128) gws[c.tid] = gwv;
        __syncthreads();
        f32x4 sT[8];
#pragma unroll
        for (int jb = 0; jb < 8; ++jb) sT[jb] = (f32x4){0.f, 0.f, 0.f, 0.f};
#pragma unroll 1
        for (int ks = 0; ks < 4; ++ks) {
            const bf16x8 qk = *(const LAS bf16x8*)(qt + (i0 + il) * TS + (32 * ks + 8 * g) * 2);
#pragma unroll
            for (int jb = 0; jb < 8; ++jb) {
                const bf16x8 kf = *(const LAS bf16x8*)(kt + (16 * jb + il) * TS + (32 * ks + 8 * g) * 2);
                sT[jb] = __builtin_amdgcn_mfma_f32_16x16x32_bf16(kf, qk, sT[jb], 0, 0, 0);
            }
        }
        __syncthreads();
        f32x4 ret[8];
#pragma unroll
        for (int eb = 0; eb < 8; ++eb) ret[eb] = (f32x4){0.f, 0.f, 0.f, 0.f};
        const int ii = i0 + il;
        const int tok = tok0 + ii;
#pragma unroll 1
        for (int dir = 0; dir < 2; ++dir) {
#pragma unroll
            for (int i = 0; i < 4; ++i) {
                const int id = c.tid + 512 * i, row = id >> 4, ch = id & 15;
                *(LAS u32x4*)(kt + row * TS + ch * 16) = rs[i];
            }
            if (dir == 0) {
                const bf16_t* st1 = ST + ((size_t)((1 * 2 + b) * 8 + h) * NCH + cch) * 16384;
#pragma unroll
                for (int i = 0; i < 4; ++i) {
                    const int id = c.tid + 512 * i, row = id >> 4, ch = id & 15;
                    rs[i] = *(const u32x4*)(st1 + row * 128 + ch * 8);
                }
            }
            u32x2 gg[8];
#pragma unroll
            for (int eb = 0; eb < 8; ++eb) gg[eb] = *(const u32x2*)(Gt + (size_t)tok * 2048 + dir * 1024 + h * 128 + 16 * eb + 4 * g);
            __builtin_amdgcn_sched_barrier(0);
#pragma unroll
            for (int jb = 0; jb < 8; ++jb) {
                f32x4 p;
#pragma unroll
                for (int r = 0; r < 4; ++r) {
                    const int j = 16 * jb + 4 * g + r; const int dl = dir == 0 ? ii - j : j - ii;
                    p[r] = dl >= 0 ? sT[jb][r] * fast_exp2(lg * (float)dl) : 0.f;
                }
                *(LAS u32x2*)(pw + il * TS + (16 * jb + 4 * g) * 2) = pack4(p);
            }
            __syncthreads();
            f32x4 o[8];
#pragma unroll
            for (int eb = 0; eb < 8; ++eb) o[eb] = (f32x4){0.f, 0.f, 0.f, 0.f};
#pragma unroll 1
            for (int ks = 0; ks < 4; ++ks) {
                const bf16x8 qk = *(const LAS bf16x8*)(qt + (i0 + il) * TS + (32 * ks + 8 * g) * 2);
#pragma unroll
                for (int eb = 0; eb < 8; ++eb) {
                    const bf16x8 sfr = *(const LAS bf16x8*)(kt + (16 * eb + il) * TS + (32 * ks + 8 * g) * 2);
                    o[eb] = __builtin_amdgcn_mfma_f32_16x16x32_bf16(sfr, qk, o[eb], 0, 0, 0);
                }
            }
            const float xi = dir == 0 ? fast_exp2(lg * (float)(ii + 1)) : fast_exp2(lg * (float)(128 - ii));
#pragma unroll
            for (int eb = 0; eb < 8; ++eb) o[eb] = o[eb] * xi;
#pragma unroll 1
            for (int ks = 0; ks < 4; ++ks) {
                const bf16x8 pf = *(const LAS bf16x8*)(pw + il * TS + (32 * ks + 8 * g) * 2);
                const int j0 = 32 * ks + 8 * g;
#pragma unroll
                for (int eb = 0; eb < 8; ++eb) {
                    const bf16x8 vfr = cat8(tr_read(vt + j0 * TSV + (16 * eb) * 2, TSV, c.lane), tr_read(vt + (j0 + 4) * TSV + (16 * eb) * 2, TSV, c.lane));
                    o[eb] = __builtin_amdgcn_mfma_f32_16x16x32_bf16(vfr, pf, o[eb], 0, 0, 0);
                }
            }
            float ss = 0.f;
#pragma unroll
            for (int eb = 0; eb < 8; ++eb) ss += o[eb][0] * o[eb][0] + o[eb][1] * o[eb][1] + o[eb][2] * o[eb][2] + o[eb][3] * o[eb][3];
            ss += __shfl_xor(ss, 16); ss += __shfl_xor(ss, 32);
            const float rstd = rsqrtf(ss * (1.0f / 128.0f) + EPS);
#pragma unroll
            for (int eb = 0; eb < 8; ++eb) {
                const f32x4 gw = *(const LAS f32x4*)(gws + 16 * eb + 4 * g);
                ret[eb][0] += o[eb][0] * rstd * gw[0] * bf_lo(gg[eb].x); ret[eb][1] += o[eb][1] * rstd * gw[1] * bf_hi(gg[eb].x);
                ret[eb][2] += o[eb][2] * rstd * gw[2] * bf_lo(gg[eb].y); ret[eb][3] += o[eb][3] * rstd * gw[3] * bf_hi(gg[eb].y);
            }
            __syncthreads();
        }
#pragma unroll
        for (int eb = 0; eb < 8; ++eb) *(u32x2*)(CAT + (size_t)tok * 2048 + 1024 + h * 128 + 16 * eb + 4 * g) = pack4(ret[eb]);
    }
}
__device__ __forceinline__ void phase_wout(const Ctx& c, const bf16_t* W, int layer, const float* xlat_old, const float* xctx_old, int mt_lo, int MTn) {
    const bf16_t* CAT = c.wb(WS_CAT); const float* mods = c.wf(WS_MODS); float* xctx_new = c.wf(WS_XCTX);
    const int NT = 16;
    const int g = c.lane >> 4, wm = c.w >> 1, wn = c.w & 1;
    for (int t = c.bid; t < MTn * NT; t += c.G) {
        int mt, nt; tile_mn(t, MTn, NT, mt, nt); mt += mt_lo;
        f32x4 acc[2][4];
#if DBG_CAT_PART == 0
        gemm128r<true>(c.lds, 2048, RowLin{CAT + (size_t)mt * 128 * 2048, 2048}, RowLin{W + (size_t)nt * 128 * 2048, 2048}, acc);
#else
        gemm128<true>(c.lds, 1024, RowLin{CAT + (size_t)mt * 128 * 2048 + (DBG_CAT_PART - 1) * 1024, 2048}, RowLin{W + (size_t)nt * 128 * 2048 + (DBG_CAT_PART - 1) * 1024, 2048}, acc);
#endif
#pragma unroll
        for (int mb = 0; mb < 2; ++mb) {
            const int tok = mt * 128 + 32 * wm + 16 * mb + (c.lane & 15);
            const int mw = tok < TC ? 2 : ((tok - TC) >> 14);
            const float* g1 = mods + (size_t)(layer * 3 + mw) * 12288 + 2 * 2048;
            const float* xo = tok < TC ? xctx_old + (size_t)tok * D : xlat_old + (size_t)(tok - TC) * D;
            float* xn = tok < TC ? xctx_new + (size_t)tok * D : c.out + (size_t)(tok - TC) * D;
#pragma unroll
            for (int nb = 0; nb < 4; ++nb) {
                const int col = nt * 128 + 64 * wn + 16 * nb + 4 * g;
                const f32x4 gv = *(const f32x4*)(g1 + col), xv = *(const f32x4*)(xo + col);
                *(f32x4*)(xn + col) = xv + gv * acc[mb][nb];
            }
        }
    }
}
__device__ __forceinline__ void phase_peer_q(const Ctx& c, const bf16_t* W, int mt_lo, int MTn) {
    const bf16_t* H = c.wb(WS_H); bf16_t* Qp = c.wb(WS_G);
    const int NT = 16;
    const int g = c.lane >> 4, wm = c.w >> 1, wn = c.w & 1;
    for (int t = c.bid; t < MTn * NT; t += c.G) {
        int mt, nt; tile_mn(t, MTn, NT, mt, nt); mt += mt_lo;
        f32x4 acc[2][4];
        gemm128r<true>(c.lds, 2048, RowLin{H + (size_t)mt * 128 * 2048, 2048}, RowLin{W + (size_t)nt * 128 * 2048, 2048}, acc);
#pragma unroll
        for (int mb = 0; mb < 2; ++mb) {
            const int tok = mt * 128 + 32 * wm + 16 * mb + (c.lane & 15);
#pragma unroll
            for (int nb = 0; nb < 4; ++nb) *(u32x2*)(Qp + (size_t)tok * 2048 + nt * 128 + 64 * wn + 16 * nb + 4 * g) = pack4(acc[mb][nb]);
        }
    }
}

__device__ __forceinline__ unsigned enc_key(float v) { const unsigned u = __float_as_uint(v); return (u & 0x80000000u) ? ~u : (u | 0x80000000u); }
__device__ __forceinline__ float dec_key(unsigned k) { return __uint_as_float((k & 0x80000000u) ? (k & 0x7fffffffu) : ~k); }
__device__ __forceinline__ void ins16(unsigned (&L)[16], unsigned x) {
#pragma unroll
    for (int i = 0; i < 16; ++i) { const unsigned hi = L[i] > x ? L[i] : x; x = L[i] > x ? x : L[i]; L[i] = hi; }
}
__device__ __forceinline__ void merge16(unsigned (&A)[16], const unsigned (&B)[16]) {
#pragma unroll
    for (int i = 0; i < 16; ++i) A[i] = A[i] > B[15 - i] ? A[i] : B[15 - i];
#pragma unroll
    for (int s = 8; s >= 1; s >>= 1) {
#pragma unroll
        for (int i = 0; i < 16; ++i)
            if ((i & s) == 0) { const unsigned x = A[i], y = A[i + s]; A[i] = x > y ? x : y; A[i + s] = x > y ? y : x; }
    }
}
__device__ __forceinline__ void sort16(unsigned (&A)[16]) {
#pragma unroll
    for (int k = 2; k <= 16; k <<= 1) {
#pragma unroll
        for (int j = k >> 1; j > 0; j >>= 1) {
#pragma unroll
            for (int i = 0; i < 16; ++i) {
                const int l = i ^ j;
                if (l > i) {
                    const unsigned x = A[i], y = A[l]; const unsigned hi = x > y ? x : y, lo = x > y ? y : x;
                    if ((i & k) == 0) { A[i] = hi; A[l] = lo; } else { A[i] = lo; A[l] = hi; }
                }
            }
        }
    }
}
__device__ __forceinline__ unsigned sel16(const unsigned (&L)[16], int a) {
    unsigned r = L[0];
#pragma unroll
    for (int i = 1; i < 16; ++i) r = (a == i) ? L[i] : r;
    return r;
}
__device__ __forceinline__ void topk_issue(const Ctx& c, u32x4 (&ra)[2][2][2], u32x4 (&rb)[2][2][2], const bf16_t* qbase, const bf16_t* kbase) {
    const int r0 = c.tid >> 3, ch = c.tid & 7;
#pragma unroll
    for (int p = 0; p < 2; ++p)
#pragma unroll
        for (int kt = 0; kt < 2; ++kt)
#pragma unroll
            for (int hf = 0; hf < 2; ++hf) {
                ra[p][kt][hf] = *(const u32x4*)(qbase + (size_t)(r0 + 64 * hf) * 2048 + p * 128 + kt * 64 + ch * 8);
                rb[p][kt][hf] = *(const u32x4*)(kbase + (size_t)p * 128 * 128 + (r0 + 64 * hf) * 128 + kt * 64 + ch * 8);
            }
}
__device__ __forceinline__ void topk_scores_pair(const Ctx& c, LAS float* S0, LAS float* S1, const u32x4 (&ra)[2][2][2], const u32x4 (&rb)[2][2][2]) {
    const int lane = c.lane, g = lane >> 4, wm = c.w >> 1, wn = c.w & 1;
    const int r0 = c.tid >> 3, ch = c.tid & 7, woff = r0 * 144 + ch * 16;
    const int aoff = (32 * wm + (lane & 15)) * 144 + (lane >> 4) * 16;
    const int boff = 36864 + (64 * wn + (lane & 15)) * 144 + (lane >> 4) * 16;
#pragma unroll
    for (int p = 0; p < 2; ++p) {
        if (p == 1) __syncthreads();
#pragma unroll
        for (int kt = 0; kt < 2; ++kt)
#pragma unroll
            for (int hf = 0; hf < 2; ++hf) {
                *(LAS u32x4*)(c.lds + kt * 18432 + woff + hf * 9216) = ra[p][kt][hf];
                *(LAS u32x4*)(c.lds + 36864 + kt * 18432 + woff + hf * 9216) = rb[p][kt][hf];
            }
        __syncthreads();
        f32x4 acc[2][4];
#pragma unroll
        for (int mb = 0; mb < 2; ++mb)
#pragma unroll
            for (int nb = 0; nb < 4; ++nb) acc[mb][nb] = (f32x4){0.f, 0.f, 0.f, 0.f};
#pragma unroll
        for (int kt = 0; kt < 2; ++kt)
#pragma unroll
            for (int ks = 0; ks < 2; ++ks) {
                bf16x8 af[2], bfr[4];
#pragma unroll
                for (int mb = 0; mb < 2; ++mb) af[mb] = *(const LAS bf16x8*)(c.lds + kt * 18432 + aoff + mb * 2304 + ks * 64);
#pragma unroll
                for (int nb = 0; nb < 4; ++nb) bfr[nb] = *(const LAS bf16x8*)(c.lds + kt * 18432 + boff + nb * 2304 + ks * 64);
#pragma unroll
                for (int mb = 0; mb < 2; ++mb)
#pragma unroll
                    for (int nb = 0; nb < 4; ++nb) acc[mb][nb] = __builtin_amdgcn_mfma_f32_16x16x32_bf16(af[mb], bfr[nb], acc[mb][nb], 0, 0, 0);
            }
        if (p == 1) __syncthreads();
        LAS float* S = p == 0 ? S0 : S1;
#pragma unroll
        for (int mb = 0; mb < 2; ++mb)
#pragma unroll
            for (int nb = 0; nb < 4; ++nb)
#pragma unroll
                for (int r = 0; r < 4; ++r) S[(32 * wm + 16 * mb + 4 * g + r) * 129 + 64 * wn + 16 * nb + (lane & 15)] = acc[mb][nb][r];
    }
}
__device__ __forceinline__ void phase_peer_topk(const Ctx& c, int layer, int mt_lo) {
    const bf16_t* Qp = c.wb(WS_G); const bf16_t* SK = c.wb(WS_SKB) + (size_t)layer * 16 * 128 * 128;
    int* IDX = (int*)(c.ws + WS_IDX); float* GATE = c.wf(WS_GATE);
    LAS float* S0 = (LAS float*)(c.lds + GEMM_LDS);
    LAS float* S1 = (LAS float*)c.lds;
    const int MT = TT / 128, NU = (MT - mt_lo) * 8;
    u32x4 ra[2][2][2], rb[2][2][2];
    if (c.bid < NU) topk_issue(c, ra, rb, Qp + (size_t)(mt_lo + (c.bid >> 3)) * 128 * 2048 + ((c.bid & 7) * 2) * 128, SK + (size_t)((c.bid & 7) * 2) * 128 * 128);
    for (int u = c.bid; u < NU; u += c.G) {
        const int mt = mt_lo + (u >> 3), h = u & 7;
        topk_scores_pair(c, S0, S1, ra, rb);
        if (u + c.G < NU) {
            const int un = u + c.G;
            topk_issue(c, ra, rb, Qp + (size_t)(mt_lo + (un >> 3)) * 128 * 2048 + ((un & 7) * 2) * 128, SK + (size_t)((un & 7) * 2) * 128 * 128);
        }
        __builtin_amdgcn_sched_barrier(0);
        __syncthreads();
        unsigned La[16], Lb[16];
#pragma unroll
        for (int i = 0; i < 16; ++i) { La[i] = 0u; Lb[i] = 0u; }
        if (c.tid < 256) {
            LAS float* row = (c.tid < 128 ? S0 : S1) + (c.tid & 127) * 129;
#pragma unroll
            for (int i = 0; i < 16; ++i) La[i] = (enc_key(row[i]) & ~127u) | (unsigned)i;
            sort16(La);
#pragma unroll 1
            for (int j0 = 16; j0 < 128; j0 += 16) {
#pragma unroll
                for (int i = 0; i < 16; ++i) Lb[i] = (enc_key(row[j0 + i]) & ~127u) | (unsigned)(j0 + i);
                sort16(Lb);
                merge16(La, Lb);
            }
        }
        __syncthreads();
        if (c.tid >= 128 && c.tid < 256) { LAS unsigned* lst = (LAS unsigned*)S1 + (c.tid - 128) * 129;
#pragma unroll
            for (int i = 0; i < 16; ++i) lst[i] = La[i]; }
        __syncthreads();
        if (c.tid < 128) {
            LAS unsigned* l1 = (LAS unsigned*)S1 + c.tid * 129;
#pragma unroll
            for (int i = 0; i < 16; ++i) Lb[i] = l1[i];
            unsigned M[16], T[16];
#define CK(a, b) ((enc_key(dec_key(La[a] & ~127u) + dec_key(Lb[b] & ~127u)) & ~255u) | (unsigned)(255 - ((a) * 16 + (b))))
#pragma unroll
            for (int b = 0; b < 16; ++b) M[b] = CK(0, b);
#pragma unroll
            for (int a = 1; a < 8; ++a) {
#pragma unroll
                for (int b = 0; b < 16; ++b) T[b] = ((a + 1) * (b + 1) <= 16) ? CK(a, b) : 0u;
                merge16(M, T);
            }
#pragma unroll
            for (int a = 8; a < 16; ++a) T[a - 8] = CK(a, 0);
#pragma unroll
            for (int i = 8; i < 16; ++i) T[i] = 0u;
            merge16(M, T);
#undef CK
            const int tok = mt * 128 + c.tid;
            float sv[16]; const float smax = dec_key(M[0] & ~255u); float sum = 0.f;
#pragma unroll
            for (int k = 0; k < 16; ++k) { sv[k] = fast_exp2((dec_key(M[k] & ~255u) - smax) * LOG2E); sum += sv[k]; }
            const float inv = 1.0f / sum;
            int* ip = IDX + ((size_t)tok * 8 + h) * 16; float* gp = GATE + ((size_t)tok * 8 + h) * 16;
            LAS unsigned* lst = (LAS unsigned*)S0 + c.tid * 129;
#pragma unroll
            for (int i = 0; i < 16; ++i) { lst[i] = La[i]; lst[16 + i] = Lb[i]; }
#pragma unroll
            for (int k = 0; k < 16; ++k) {
                const int ab = 255 - (int)(M[k] & 255u), a = ab >> 4, b = ab & 15;
                const int i0 = (int)(lst[a] & 127u), i1 = (int)(lst[16 + b] & 127u);
                ip[k] = i0 * 128 + i1; gp[k] = sv[k] * inv;
            }
        }
        __syncthreads();
    }
}
typedef unsigned u32x6 __attribute__((ext_vector_type(6)));
typedef float f32x32 __attribute__((ext_vector_type(32)));
__device__ __forceinline__ void gather_experts(const Ctx& c, int layer, const unsigned char* TU, const unsigned char* TV, const float (&xf)[32], int idA, int idB, float gA, float gB,
                                               int e_lo, int e_hi, float (&acc)[32]) {
    for (int e = e_lo; e < (((DBG_SKIP_GATHER >> layer) & 1) ? 0 : e_hi); e += 4) {
        const int sl = e & 63;
        int rr[4]; float gg[4];
#pragma unroll
        for (int k = 0; k < 4; ++k) { rr[k] = __shfl(e < 64 ? idA : idB, sl + k); gg[k] = __shfl(e < 64 ? gA : gB, sl + k); }
        u32x4 uu[4]; u32x4 vv[4];
#pragma unroll
        for (int k = 0; k < 4; ++k) {
            uu[k] = *(const u32x4*)(TU + (size_t)rr[k] * 1024 + c.lane * 16);
            vv[k] = *(const u32x4*)(TV + (size_t)rr[k] * 1024 + c.lane * 16);
        }
        __builtin_amdgcn_sched_barrier(0);
        float dd[4];
#pragma unroll
        for (int k = 0; k < 4; ++k) {
            float d0 = 0.f, d1 = 0.f;
#pragma unroll
            for (int q = 0; q < 4; ++q) {
                const f32x2 f0 = __builtin_amdgcn_cvt_scalef32_pk_f32_fp4(uu[k][q], 1.0f, 0), f1 = __builtin_amdgcn_cvt_scalef32_pk_f32_fp4(uu[k][q], 1.0f, 1);
                const f32x2 f2 = __builtin_amdgcn_cvt_scalef32_pk_f32_fp4(uu[k][q], 1.0f, 2), f3 = __builtin_amdgcn_cvt_scalef32_pk_f32_fp4(uu[k][q], 1.0f, 3);
                d0 += f0.x * xf[q * 8 + 0] + f1.x * xf[q * 8 + 2] + f2.x * xf[q * 8 + 4] + f3.x * xf[q * 8 + 6];
                d1 += f0.y * xf[q * 8 + 1] + f1.y * xf[q * 8 + 3] + f2.y * xf[q * 8 + 5] + f3.y * xf[q * 8 + 7];
            }
            dd[k] = d0 + d1;
        }
#pragma unroll
        for (int o = 32; o >= 1; o >>= 1) {
#pragma unroll
            for (int k = 0; k < 4; ++k) dd[k] += __shfl_xor(dd[k], o);
        }
#pragma unroll
        for (int k = 0; k < 4; ++k) {
            const float w = gg[k] * gelu_tanh(dd[k] * (1.0f / U_SCALE)) * (1.0f / V_SCALE);
#pragma unroll
            for (int q = 0; q < 4; ++q) {
                const f32x2 f0 = __builtin_amdgcn_cvt_scalef32_pk_f32_fp4(vv[k][q], 1.0f, 0), f1 = __builtin_amdgcn_cvt_scalef32_pk_f32_fp4(vv[k][q], 1.0f, 1);
                const f32x2 f2 = __builtin_amdgcn_cvt_scalef32_pk_f32_fp4(vv[k][q], 1.0f, 2), f3 = __builtin_amdgcn_cvt_scalef32_pk_f32_fp4(vv[k][q], 1.0f, 3);
                acc[q * 8 + 0] += w * f0.x; acc[q * 8 + 1] += w * f0.y; acc[q * 8 + 2] += w * f1.x; acc[q * 8 + 3] += w * f1.y;
                acc[q * 8 + 4] += w * f2.x; acc[q * 8 + 5] += w * f2.y; acc[q * 8 + 6] += w * f3.x; acc[q * 8 + 7] += w * f3.y;
            }
        }
    }
}
__device__ __forceinline__ void gather_load_x(const Ctx& c, const bf16_t* H, int tok, float (&xf)[32]) {
#pragma unroll
    for (int q = 0; q < 4; ++q) {
        const u32x4 v = *(const u32x4*)(H + (size_t)tok * D + c.lane * 32 + q * 8);
#pragma unroll
        for (int e = 0; e < 4; ++e) { xf[q * 8 + e * 2] = bf_lo(v[e]); xf[q * 8 + e * 2 + 1] = bf_hi(v[e]); }
    }
}
template <bool FINAL>
__device__ __forceinline__ void gather_epilogue(const Ctx& c, int layer, int tok, float (&acc)[32]) {
    const float* mods = c.wf(WS_MODS); float* xctx = c.wf(WS_XCTX); const float* fnorm = c.in[22];
    const int mw = tok < TC ? 2 : ((tok - TC) >> 14);
    const float* g2 = mods + (size_t)(layer * 3 + mw) * 12288 + 5 * 2048;
    float* xp = tok < TC ? xctx + (size_t)tok * D : c.out + (size_t)(tok - TC) * D;
    float ss = 0.f;
    f32x4 xa[8], ga[8];
#pragma unroll
    for (int q = 0; q < 8; ++q) { xa[q] = *(const f32x4*)(xp + c.lane * 32 + q * 4); ga[q] = *(const f32x4*)(g2 + c.lane * 32 + q * 4); }
    __builtin_amdgcn_sched_barrier(0);
#pragma unroll
    for (int q = 0; q < 8; ++q) {
        const int col = c.lane * 32 + q * 4;
        const f32x4 xv = xa[q], gv = ga[q];
        f32x4 o;
#pragma unroll
        for (int j = 0; j < 4; ++j) { o[j] = xv[j] + gv[j] * acc[q * 4 + j]; ss += o[j] * o[j]; }
        if (!FINAL) *(f32x4*)(xp + col) = o;
        else { acc[q * 4 + 0] = o[0]; acc[q * 4 + 1] = o[1]; acc[q * 4 + 2] = o[2]; acc[q * 4 + 3] = o[3]; }
    }
    if (FINAL) {
        f32x4 fwa[8];
#pragma unroll
        for (int q = 0; q < 8; ++q) fwa[q] = *(const f32x4*)(fnorm + c.lane * 32 + q * 4);
        __builtin_amdgcn_sched_barrier(0);
        ss = wave_sum(ss);
        const float rstd = rsqrtf(ss * (1.0f / D) + EPS);
#pragma unroll
        for (int q = 0; q < 8; ++q) {
            const int col = c.lane * 32 + q * 4;
            const f32x4 fw = fwa[q];
            f32x4 o;
#pragma unroll
            for (int j = 0; j < 4; ++j) o[j] = acc[q * 4 + j] * rstd * fw[j];
#if defined(DBG_ATTN_CHECK) || defined(DBG_TOPK_CHECK) || defined(DBG_TSEL) || defined(DBG_FOURIER_CHECK) || defined(DBG_RET_CHECK)
            for (int j = 0; j < 4; ++j) o[j] += 10000.0f * (float)(*(volatile unsigned*)(c.ws + WS_CTL + 32768));
#endif
            *(f32x4*)(xp + col) = o;
        }
    }
}
template <bool FINAL>
__device__ __forceinline__ void phase_peer_gather(const Ctx& c, int layer, int tok_lo) {
    const bf16_t* H = c.wb(WS_H); const unsigned char* TU = c.ws + WS_TABU + (size_t)layer * (32 * MiB); const unsigned char* TV = c.ws + WS_TABV + (size_t)layer * (32 * MiB);
    const int* IDX = (const int*)(c.ws + WS_IDX); const float* GATE = c.wf(WS_GATE);
    const int W = c.G * 8, nTok = TT - tok_lo, R = nTok / W, rem = nTok - R * W;
    u32x4 xr[4]; int idA = 0, idB = 0; float gA = 0.f, gB = 0.f;
    if (R > 0) {
        const int tok = tok_lo + c.bid * 8 + c.w;
#pragma unroll
        for (int q = 0; q < 4; ++q) xr[q] = *(const u32x4*)(H + (size_t)tok * D + c.lane * 32 + q * 8);
        idA = IDX[(size_t)tok * 128 + c.lane]; idB = IDX[(size_t)tok * 128 + 64 + c.lane];
        gA = GATE[(size_t)tok * 128 + c.lane]; gB = GATE[(size_t)tok * 128 + 64 + c.lane];
    }
    for (int r = 0; r < R; ++r) {
        const int tok = tok_lo + r * W + c.bid * 8 + c.w;
        float xf[32];
#pragma unroll
        for (int q = 0; q < 4; ++q)
#pragma unroll
            for (int e = 0; e < 4; ++e) { xf[q * 8 + e * 2] = bf_lo(xr[q][e]); xf[q * 8 + e * 2 + 1] = bf_hi(xr[q][e]); }
        const int cA = idA, cB = idB; const float cgA = gA, cgB = gB;
        if (r + 1 < R) {
            const int tn = tok + W;
#pragma unroll
            for (int q = 0; q < 4; ++q) xr[q] = *(const u32x4*)(H + (size_t)tn * D + c.lane * 32 + q * 8);
            idA = IDX[(size_t)tn * 128 + c.lane]; idB = IDX[(size_t)tn * 128 + 64 + c.lane];
            gA = GATE[(size_t)tn * 128 + c.lane]; gB = GATE[(size_t)tn * 128 + 64 + c.lane];
        }
        __builtin_amdgcn_sched_barrier(0);
        float acc[32];
#pragma unroll
        for (int j = 0; j < 32; ++j) acc[j] = 0.f;
        gather_experts(c, layer, TU, TV, xf, cA, cB, cgA, cgB, 0, 128, acc);
        gather_epilogue<FINAL>(c, layer, tok, acc);
    }
    if (rem > 0) {
        int S = 1; if (W % rem == 0) { const int q = W / rem; S = q >= 8 ? 8 : (q >= 4 ? 4 : (q >= 2 ? 2 : 1)); }
        const int per = 8 / S, ti = c.bid * per + c.w / S, part = c.w % S, ne = 128 / S;
        const bool act = ti < rem; const int tok = tok_lo + R * W + (act ? ti : 0);
        float acc[32];
#pragma unroll
        for (int j = 0; j < 32; ++j) acc[j] = 0.f;
        if (act) {
            float xf[32];
            gather_load_x(c, H, tok, xf);
            const int idA = IDX[(size_t)tok * 128 + c.lane], idB = IDX[(size_t)tok * 128 + 64 + c.lane];
            const float gA = GATE[(size_t)tok * 128 + c.lane], gB = GATE[(size_t)tok * 128 + 64 + c.lane];
            gather_experts(c, layer, TU, TV, xf, idA, idB, gA, gB, part * ne, part * ne + ne, acc);
        }
        if (S > 1) {
            LAS float* red = (LAS float*)c.lds;
            __syncthreads();
#pragma unroll
            for (int j = 0; j < 32; ++j) red[(c.w * 32 + j) * 64 + c.lane] = acc[j];
            __syncthreads();
            if (act && part == 0)
                for (int p = 1; p < S; ++p) {
#pragma unroll
                    for (int j = 0; j < 32; ++j) acc[j] += red[((c.w + p) * 32 + j) * 64 + c.lane];
                }
        }
        if (act && part == 0) gather_epilogue<FINAL>(c, layer, tok, acc);
    }
}

__device__ __forceinline__ void rope64_store(const f32x4 (&a)[4], bool rotate, int s, int g, float sc, const f32x2* r64, bf16_t* dst) {
    if (rotate) {
        const int prow = s >> 6, pcol = s & 63;
#pragma unroll
        for (int hlf = 0; hlf < 2; ++hlf) {
            const int pos = hlf == 0 ? prow : pcol;
            f32x4 o1, o2;
#pragma unroll
            for (int r = 0; r < 4; ++r) {
                const f32x2 cs = r64[pos * 16 + 4 * g + r];
                const float x1 = a[2 * hlf][r] * sc, x2 = a[2 * hlf + 1][r] * sc;
                o1[r] = x1 * cs.x - x2 * cs.y; o2[r] = x2 * cs.x + x1 * cs.y;
            }
            *(u32x2*)(dst + 32 * hlf) = pack4(o1); *(u32x2*)(dst + 32 * hlf + 16) = pack4(o2);
        }
    } else {
#pragma unroll
        for (int nb = 0; nb < 4; ++nb) *(u32x2*)(dst + 16 * nb) = pack4(a[nb] * sc);
    }
}
__device__ __forceinline__ void phase_odd_proj(const Ctx& c) {
    const bf16_t* H = c.wb(WS_H); const bf16_t* W = c.wb(WS_WINO);
    bf16_t* SQ = c.wb(WS_A); bf16_t* SK = c.wb(WS_Q); bf16_t* SV = c.wb(WS_Q + 9 * MiB); bf16_t* CQ = c.wb(WS_Q + 18 * MiB);
    bf16_t* CKV = c.wb(WS_K); bf16_t* KR = c.wb(WS_K + 17 * MiB);
    const f32x2* r64 = (const f32x2*)(c.ws + WS_ROPE + 131072);
    const int MT = TT / 128, NT = 17;
    const int g = c.lane >> 4, wm = c.w >> 1, wn = c.w & 1;
    for (int t = c.bid; t < MT * NT; t += c.G) {
        int mt, nt; tile_mn(t, MT, NT, mt, nt);
        f32x4 acc[2][4];
        gemm128<true>(c.lds, 2048, RowLin{H + (size_t)mt * 128 * D, (size_t)D}, RowLin{W + (size_t)nt * 128 * 2048, 2048}, acc);
#pragma unroll
        for (int mb = 0; mb < 2; ++mb) {
            const int tok = mt * 128 + 32 * wm + 16 * mb + (c.lane & 15);
            const bool lat = tok >= TC; const int s = (tok - TC) & (SEQ - 1);
            const int cw = 64 * wn + 4 * g;
            if (nt < 8) rope64_store(acc[mb], lat, s, g, 0.125f, r64, SQ + (size_t)tok * 1024 + nt * 128 + cw);
            else if (nt == 8) rope64_store(acc[mb], lat, s, g, 1.0f, r64, SK + (size_t)tok * 128 + cw);
            else if (nt == 9) rope64_store(acc[mb], false, s, g, 1.0f, r64, SV + (size_t)tok * 128 + cw);
            else if (nt < 14) rope64_store(acc[mb], false, s, g, 1.0f, r64, CQ + (size_t)tok * 512 + (nt - 10) * 128 + cw);
            else if (nt < 16) rope64_store(acc[mb], false, s, g, 1.0f, r64, CKV + (size_t)tok * 256 + (nt - 14) * 128 + cw);
            else if (wn == 0) rope64_store(acc[mb], lat, s, g, 1.0f, r64, KR + (size_t)tok * 64 + 4 * g);
        }
    }
}
__device__ __forceinline__ void phase_odd_local(const Ctx& c) {
    bf16_t* CQ = c.wb(WS_Q + 18 * MiB); bf16_t* CKV = c.wb(WS_K); const bf16_t* KR = c.wb(WS_K + 17 * MiB); bf16_t* MK = c.wb(WS_ST);
    const float* qn = c.in[13]; const float* kvn = c.in[14];
    const int l32 = c.lane & 31, hh = c.lane >> 3, part = c.lane & 7, W = c.G * 8;
    const f32x4 qw0 = *(const f32x4*)(qn + c.lane * 8), qw1 = *(const f32x4*)(qn + c.lane * 8 + 4);
    const f32x4 kw0 = *(const f32x4*)(kvn + l32 * 8), kw1 = *(const f32x4*)(kvn + l32 * 8 + 4);
    for (int t0 = c.bid * 8 + c.w; t0 < TT; t0 += 4 * W) {
        u32x4 vq[4], vk[4], vr[4];
#pragma unroll
        for (int k = 0; k < 4; ++k) {
            const int tok = t0 + k * W;
            if (tok < TT) {
                vq[k] = *(const u32x4*)(CQ + (size_t)tok * 512 + c.lane * 8);
                vk[k] = *(const u32x4*)(CKV + (size_t)tok * 256 + l32 * 8);
                vr[k] = *(const u32x4*)(KR + (size_t)tok * 64 + part * 8);
            }
        }
        __builtin_amdgcn_sched_barrier(0);
#pragma unroll
        for (int k = 0; k < 4; ++k) {
            const int tok = t0 + k * W;
            if (tok < TT) {
                {
                    const u32x4 v = vq[k];
                    float f[8] = {bf_lo(v.x), bf_hi(v.x), bf_lo(v.y), bf_hi(v.y), bf_lo(v.z), bf_hi(v.z), bf_lo(v.w), bf_hi(v.w)};
                    float ss = 0.f;
#pragma unroll
                    for (int j = 0; j < 8; ++j) ss += f[j] * f[j];
                    ss = wave_sum(ss);
                    const float rstd = rsqrtf(ss * (1.0f / 512.0f) + EPS);
                    u32x4 o; o.x = cvt_pk_bf16(f[0] * rstd * qw0[0], f[1] * rstd * qw0[1]); o.y = cvt_pk_bf16(f[2] * rstd * qw0[2], f[3] * rstd * qw0[3]);
                    o.z = cvt_pk_bf16(f[4] * rstd * qw1[0], f[5] * rstd * qw1[1]); o.w = cvt_pk_bf16(f[6] * rstd * qw1[2], f[7] * rstd * qw1[3]);
                    *(u32x4*)(CQ + (size_t)tok * 512 + c.lane * 8) = o;
                }
                {
                    const u32x4 v = vk[k];
                    float f[8] = {bf_lo(v.x), bf_hi(v.x), bf_lo(v.y), bf_hi(v.y), bf_lo(v.z), bf_hi(v.z), bf_lo(v.w), bf_hi(v.w)};
                    float ss = 0.f;
#pragma unroll
                    for (int j = 0; j < 8; ++j) ss += f[j] * f[j];
                    ss = wave_sum(ss) * 0.5f;
                    const float rstd = rsqrtf(ss * (1.0f / 256.0f) + EPS);
                    u32x4 o; o.x = cvt_pk_bf16(f[0] * rstd * kw0[0], f[1] * rstd * kw0[1]); o.y = cvt_pk_bf16(f[2] * rstd * kw0[2], f[3] * rstd * kw0[3]);
                    o.z = cvt_pk_bf16(f[4] * rstd * kw1[0], f[5] * rstd * kw1[1]); o.w = cvt_pk_bf16(f[6] * rstd * kw1[2], f[7] * rstd * kw1[3]);
                    if (c.lane < 32) *(u32x4*)(CKV + (size_t)tok * 256 + l32 * 8) = o;
                }
                *(u32x4*)(MK + ((size_t)tok * 8 + hh) * 192 + 128 + part * 8) = vr[k];
            }
        }
    }
}
__device__ __forceinline__ void phase_mla_up(const Ctx& c) {
    const bf16_t* CQ = c.wb(WS_Q + 18 * MiB); const bf16_t* CKV = c.wb(WS_K);
    const bf16_t* Wuq = c.wb(WS_WUQ); const bf16_t* Wukv = c.wb(WS_WUKV);
    bf16_t* MQ = c.wb(WS_G); bf16_t* MK = c.wb(WS_ST); bf16_t* MV = c.wb(WS_V);
    const f32x2* r64 = (const f32x2*)(c.ws + WS_ROPE + 131072);
    const int g = c.lane >> 4, wm = c.w >> 1, wn = c.w & 1;
    const int NUQ = 256 * 12, NUKV = 260 * 16;
    for (int u = c.bid; u < NUQ + NUKV; u += c.G) {
        f32x4 acc[2][4];
        if (u < NUQ) {
            int mt, nt; tile_mn(u, 256, 12, mt, nt); mt += 4;
            gemm128<true>(c.lds, 512, RowLin{CQ + (size_t)mt * 128 * 512, 512}, RowLin{Wuq + (size_t)nt * 128 * 512, 512}, acc);
            const int rr = nt * 2 + wn, part = rr % 3;
#pragma unroll
            for (int mb = 0; mb < 2; ++mb) {
                const int tok = mt * 128 + 32 * wm + 16 * mb + (c.lane & 15); const int s = (tok - TC) & (SEQ - 1);
                rope64_store(acc[mb], part == 2, s, g, 0.07216878364870322f, r64, MQ + (size_t)tok * 1536 + rr * 64 + 4 * g);
            }
        } else {
            int mt, nt; tile_mn(u - NUQ, 260, 16, mt, nt);
            gemm128<true>(c.lds, 256, RowLin{CKV + (size_t)mt * 128 * 256, 256}, RowLin{Wukv + (size_t)nt * 128 * 256, 256}, acc);
            const int head = nt >> 1;
#pragma unroll
            for (int mb = 0; mb < 2; ++mb) {
                const int tok = mt * 128 + 32 * wm + 16 * mb + (c.lane & 15);
                bf16_t* dst = (nt & 1) ? MV + ((size_t)tok * 8 + head) * 128 + 64 * wn + 4 * g : MK + ((size_t)tok * 8 + head) * 192 + 64 * wn + 4 * g;
#pragma unroll
                for (int nb = 0; nb < 4; ++nb) *(u32x2*)(dst + 16 * nb) = pack4(acc[mb][nb]);
            }
        }
    }
}

__device__ __forceinline__ int fresh_lane() { int l = __builtin_amdgcn_mbcnt_hi(~0u, __builtin_amdgcn_mbcnt_lo(~0u, 0u)); asm volatile("" : "+v"(l)); return l; }
__device__ __forceinline__ void half_pair(float v, float& a, float& b) {
    const auto rr = __builtin_amdgcn_permlane32_swap(__float_as_uint(v), __float_as_uint(v), false, false);
    a = __uint_as_float(rr[0]); b = __uint_as_float(rr[1]);
}
template <int DQK, int DV, bool SWA, bool YOUNG>
__device__ __forceinline__ void attn_body(const Ctx& c0, const bf16_t* __restrict__ qptr, int qpitch, const bf16_t* __restrict__ kptr, int kpitch,
                                          const bf16_t* __restrict__ vptr, int vpitch, bf16_t* __restrict__ optr, int opitch, int b, int q0, float sink) {
    constexpr int KS = DQK * 2 + 16, VS = DV * 2 + (DV == 128 ? 32 : 16);
    constexpr int KCPR = DQK / 8, VCPR = DV / 8, KPT = DQK / 64, VPT = DV / 64, NKS = DQK / 16, NDB = DV / 32;
    constexpr int KB = 64 * KS;
    const int lane = fresh_lane(), tid = c0.w * 64 + lane;
    LAS unsigned char* kbuf = c0.lds; LAS unsigned char* vt = c0.lds + 2 * KB;
    const int hh = lane >> 5, l31 = lane & 31, blk = (lane >> 4) & 1;
    int ntiles, kt_lo = 0;
    if (SWA) { kt_lo = (q0 - 128) >> 6; if (kt_lo < 0) kt_lo = 0; int kt_hi = (q0 + 255 + 128) >> 6; if (kt_hi > 255) kt_hi = 255; ntiles = 4 + kt_hi - kt_lo + 1; }
    else ntiles = 4 + 256;
    bf16x8 qf[NKS];
    {
        const bf16_t* qr = qptr + (size_t)(32 * c0.w + l31) * qpitch + 8 * hh;
#pragma unroll
        for (int ks = 0; ks < NKS; ++ks) qf[ks] = *(const bf16x8*)(qr + 16 * ks);
    }
    f32x16 o[NDB];
#pragma unroll
    for (int db = 0; db < NDB; ++db)
#pragma unroll
        for (int r = 0; r < 16; ++r) o[db][r] = 0.f;
    float m = SWA ? sink * LOG2E : 0.0f, l = (SWA && hh == 0) ? 1.0f : 0.0f;

    const int qpos = q0 + 32 * c0.w + l31;
    u32x4 kr[KPT], vr[VPT];
#define ATT_TK(tt) ((tt) < 4 ? b * NCTX + 64 * (tt) : TC + b * SEQ + 64 * (kt_lo + (tt) - 4))
#define ATT_LOADK(tt) do { const char* _kb = (const char*)(kptr + (size_t)ATT_TK(tt) * kpitch); \
        _Pragma("unroll") for (int i = 0; i < KPT; ++i) { const int id = tid + 512 * i, row = id / KCPR, ch = id % KCPR; kr[i] = *(const u32x4*)(_kb + (unsigned)((row * kpitch + ch * 8) * 2)); } } while (0)
#define ATT_LOADV(tt) do { const char* _vb = (const char*)(vptr + (size_t)ATT_TK(tt) * vpitch); \
        _Pragma("unroll") for (int i = 0; i < VPT; ++i) { const int id = tid + 512 * i, row = id / VCPR, ch = id % VCPR; vr[i] = *(const u32x4*)(_vb + (unsigned)((row * vpitch + ch * 8) * 2)); } } while (0)
#define ATT_WRITE_K(buf) do { _Pragma("unroll") for (int i = 0; i < KPT; ++i) { const int id = tid + 512 * i, row = id / KCPR, ch = id % KCPR; *(LAS u32x4*)(kbuf + (buf) * KB + row * KS + ch * 16) = kr[i]; } } while (0)
#define ATT_WRITE_V() do { _Pragma("unroll") for (int i = 0; i < VPT; ++i) { const int id = tid + 512 * i, row = id / VCPR, ch = id % VCPR; *(LAS u32x4*)(vt + row * VS + ch * 16) = vr[i]; } } while (0)
#define ATT_QK(buf) do { f32x16 negm; _Pragma("unroll") for (int r = 0; r < 16; ++r) negm[r] = -m; \
        _Pragma("unroll") for (int ks = 0; ks < NKS; ++ks) _Pragma("unroll") for (int kb = 0; kb < 2; ++kb) { \
            const bf16x8 kf = *(const LAS bf16x8*)(kbuf + (buf) * KB + (32 * kb + l31) * KS + (16 * ks + 8 * hh) * 2); \
            s[kb] = __builtin_amdgcn_mfma_f32_32x32x16_bf16(kf, qf[ks], ks == 0 ? negm : s[kb], 0, 0, 0); } } while (0)
    f32x16 s[2];
    const int qw0 = q0 + 32 * c0.w;
#define ATT_DMAX(tt) (qw0 + 31 - 64 * (kt_lo + (tt) - 4))
#define ATT_DMIN(tt) (qw0 - 63 - 64 * (kt_lo + (tt) - 4))
#define ATT_LIVE(tt) (!SWA || (tt) < 4 || (ATT_DMIN(tt) <= 128 && ATT_DMAX(tt) >= -128))
    ATT_LOADK(0); ATT_WRITE_K(0); ATT_LOADV(0);
    if (ntiles > 1) ATT_LOADK(1);
    __syncthreads();
    if (YOUNG) ATT_QK(0);
    for (int t = 0; t < ntiles; ++t) {
        __syncthreads();
        ATT_WRITE_V();
        if (t + 1 < ntiles) ATT_WRITE_K((t + 1) & 1);
        __syncthreads();
        if (t + 1 < ntiles) ATT_LOADV(t + 1);
        if (t + 2 < ntiles) ATT_LOADK(t + 2);
        const bool live = ATT_LIVE(t);
        if (live) {
        if (!YOUNG) ATT_QK(t & 1);
        if (SWA && t >= 4 && (ATT_DMAX(t) > 128 || ATT_DMIN(t) < -128)) {
            const int kpos0 = 64 * (kt_lo + t - 4);
#pragma unroll
            for (int kb = 0; kb < 2; ++kb)
#pragma unroll
                for (int r = 0; r < 16; ++r) {
                    const int kpos = kpos0 + 32 * kb + (r & 3) + 8 * (r >> 2) + 4 * hh; const int dd = qpos - kpos;
                    if (dd > 128 || dd < -128) s[kb][r] = -INFINITY;
                }
        }
        float tm = s[0][0];
#pragma unroll
        for (int kb = 0; kb < 2; ++kb)
#pragma unroll
            for (int r = 0; r < 16; ++r) tm = fmaxf(tm, s[kb][r]);
        { float ta, tb; half_pair(tm, ta, tb); tm = fmaxf(ta, tb); }
        const bool upd = tm > 8.0f || (!SWA && t == 0);
        if (!__all(!upd)) {
            const float d = upd ? tm : 0.f;
#pragma unroll
            for (int kb = 0; kb < 2; ++kb)
#pragma unroll
                for (int r = 0; r < 16; ++r) s[kb][r] -= d;
            m += d;
            const float alpha = d > 0.f ? fast_exp2(-d) : 1.0f;
            l *= alpha;
#pragma unroll
            for (int db = 0; db < NDB; ++db)
#pragma unroll
                for (int r = 0; r < 16; ++r) o[db][r] *= alpha;
        }
        float ps = 0.f;
#pragma unroll
        for (int kb = 0; kb < 2; ++kb)
#pragma unroll
            for (int r = 0; r < 16; ++r) { const float p = fast_exp2(s[kb][r]); s[kb][r] = p; ps += p; }
        l += ps;
#pragma unroll
        for (int kb = 0; kb < 2; ++kb)
#pragma unroll
            for (int s2 = 0; s2 < 2; ++s2) {
                u32x4 pk;
                pk.x = cvt_pk_bf16(s[kb][8 * s2 + 0], s[kb][8 * s2 + 1]); pk.y = cvt_pk_bf16(s[kb][8 * s2 + 2], s[kb][8 * s2 + 3]);
                pk.z = cvt_pk_bf16(s[kb][8 * s2 + 4], s[kb][8 * s2 + 5]); pk.w = cvt_pk_bf16(s[kb][8 * s2 + 6], s[kb][8 * s2 + 7]);
                const bf16x8 pf = __builtin_bit_cast(bf16x8, pk);
                const int r0 = 32 * kb + 16 * s2 + 4 * hh;
#pragma unroll
                for (int db = 0; db < NDB; ++db) {
                    const bf16x8 vf = cat8(tr_read(vt + r0 * VS + (32 * db + 16 * blk) * 2, VS, lane), tr_read(vt + (r0 + 8) * VS + (32 * db + 16 * blk) * 2, VS, lane));
                    o[db] = __builtin_amdgcn_mfma_f32_32x32x16_bf16(vf, pf, o[db], 0, 0, 0);
                }
            }
        }
        if (YOUNG && t + 1 < ntiles && ATT_LIVE(t + 1)) ATT_QK((t + 1) & 1);
    }
#undef ATT_DMAX
#undef ATT_DMIN
#undef ATT_LIVE
#undef ATT_TK
#undef ATT_LOADK
#undef ATT_LOADV
#undef ATT_WRITE_K
#undef ATT_WRITE_V
#undef ATT_QK
    { float la, lb; half_pair(l, la, lb); l = la + lb; }
    const float inv = 1.0f / l;
    const int le = fresh_lane();
    bf16_t* orow = optr + (size_t)(32 * c0.w + (le & 31)) * opitch + 4 * (le >> 5);
#pragma unroll
    for (int db = 0; db < NDB; ++db)
#pragma unroll
        for (int rg = 0; rg < 4; ++rg) {
            f32x4 v = {o[db][4 * rg] * inv, o[db][4 * rg + 1] * inv, o[db][4 * rg + 2] * inv, o[db][4 * rg + 3] * inv};
            *(u32x2*)(orow + 32 * db + 8 * rg) = pack4(v);
        }
    __syncthreads();
}
template <int DQK, int DV, bool SWA>
__device__ __forceinline__ void attn_unit(const Ctx& c, const bf16_t* __restrict__ qptr, int qpitch, const bf16_t* __restrict__ kptr, int kpitch,
                                          const bf16_t* __restrict__ vptr, int vpitch, bf16_t* __restrict__ optr, int opitch, int b, int q0, float sink) {
    if (c.w < 4) attn_body<DQK, DV, SWA, false>(c, qptr, qpitch, kptr, kpitch, vptr, vpitch, optr, opitch, b, q0, sink);
    else attn_body<DQK, DV, SWA, true>(c, qptr, qpitch, kptr, kpitch, vptr, vpitch, optr, opitch, b, q0, sink);
}
__device__ __forceinline__ void phase_attention(const Ctx& c) {
    const bf16_t* MQ = c.wb(WS_G); const bf16_t* MK = c.wb(WS_ST); const bf16_t* MV = c.wb(WS_V);
    const bf16_t* SQ = c.wb(WS_A); const bf16_t* SK = c.wb(WS_Q); const bf16_t* SV = c.wb(WS_Q + 9 * MiB);
    bf16_t* CAT = c.wb(WS_CAT); const float* sink = c.in[12];
    for (int u = c.bid; u < 1024; u += c.G) {
        const int b = u >> 9, h = (u >> 6) & 7, qb = u & 63; const size_t tok0 = (size_t)TC + (size_t)b * SEQ + qb * 256;
        attn_unit<192, 128, false>(c, MQ + tok0 * 1536 + h * 192, 1536, MK + h * 192, 1536, MV + h * 128, 1024, CAT + tok0 * 2048 + 1024 + h * 128, 2048, b, qb * 256, 0.f);
    }
    for (int u = c.bid; u < 2048; u += c.G) {
        const int b = u >> 10, hq = (u >> 6) & 15, qb = u & 63; const size_t tok0 = (size_t)TC + (size_t)b * SEQ + qb * 256;
        attn_unit<64, 64, true>(c, SQ + tok0 * 1024 + hq * 64, 1024, SK + (hq >> 3) * 64, 128, SV + (hq >> 3) * 64, 128, CAT + tok0 * 2048 + hq * 64, 2048, b, qb * 256, sink[hq]);
    }
}


#ifdef DBG_TOPK_CHECK

__device__ __forceinline__ void dbg_gather_save(const Ctx& c) {
    if (c.bid >= 64) return;
    const int tok = 512 + 509 * c.bid + (c.bid & 1 ? 0 : 7);
    float* sv = (float*)(c.ws + WS_CTL + 65536) + (size_t)c.bid * 2048;
    for (int i = c.tid; i < 2048; i += 512) sv[i] = c.out[(size_t)(tok - TC) * D + i];
}
__device__ __forceinline__ void dbg_gather_check(const Ctx& c) {
    if (c.bid >= 64) return;
    const int tok = 512 + 509 * c.bid + (c.bid & 1 ? 0 : 7);
    const bf16_t* H = c.wb(WS_H); const bf16_t* TU = c.wb(WS_TABU); const bf16_t* TV = c.wb(WS_TABV);
    const int* IDX = (const int*)(c.ws + WS_IDX); const float* GATE = c.wf(WS_GATE);
    const float* sv = (const float*)(c.ws + WS_CTL + 65536) + (size_t)c.bid * 2048;
    const float* g2 = c.wf(WS_MODS) + (size_t)(0 * 3 + ((tok - TC) >> 14)) * 12288 + 5 * 2048;
    LAS float* red = (LAS float*)c.lds;
    float f0 = 0.f, f1 = 0.f, f2 = 0.f, f3 = 0.f;
    const int d0 = c.tid * 4;
    for (int e = 0; e < 128; ++e) {
        const int id = IDX[(size_t)tok * 128 + e]; const float gt = GATE[(size_t)tok * 128 + e];
        float p = 0.f;
        for (int j = 0; j < 4; ++j) p += bf2f(H[(size_t)tok * D + d0 + j]) * bf2f(TU[(size_t)id * D + d0 + j]);
        p = wave_sum(p);
        __syncthreads();
        if (c.lane == 0) red[c.w] = p;
        __syncthreads();
        float a = 0.f; for (int w = 0; w < 8; ++w) a += red[w];
        const float wgt = gt * gelu_tanh(a);
        f0 += wgt * bf2f(TV[(size_t)id * D + d0]); f1 += wgt * bf2f(TV[(size_t)id * D + d0 + 1]); f2 += wgt * bf2f(TV[(size_t)id * D + d0 + 2]); f3 += wgt * bf2f(TV[(size_t)id * D + d0 + 3]);
    }
    const float* xo = c.out + (size_t)(tok - TC) * D + d0;
    int bad = 0;
    if (fabsf(sv[d0] + g2[d0] * f0 - xo[0]) > 0.02f) bad = 16;
    if (fabsf(sv[d0 + 1] + g2[d0 + 1] * f1 - xo[1]) > 0.02f) bad = 16;
    if (fabsf(sv[d0 + 2] + g2[d0 + 2] * f2 - xo[2]) > 0.02f) bad = 16;
    if (fabsf(sv[d0 + 3] + g2[d0 + 3] * f3 - xo[3]) > 0.02f) bad = 16;
    if (bad) atomicOr((unsigned*)(c.ws + WS_CTL + 32768), (unsigned)bad);
}
__device__ __forceinline__ void dbg_topk_check(const Ctx& c) {
    const bf16_t* Qp = c.wb(WS_G); const bf16_t* SK = c.wb(WS_SKB);
    const int* IDX = (const int*)(c.ws + WS_IDX); const float* GATE = c.wf(WS_GATE);
    LAS float* sc = (LAS float*)c.lds;
    LAS int* cnt = (LAS int*)(c.lds + 2048);
    if (c.bid >= 64) return;
    const int tok = 512 + 509 * c.bid + (c.bid & 1 ? 0 : 7);
    int bad = 0;
    for (int h = 0; h < 8; ++h) {
        if (c.tid < 256) {
            const int p = c.tid >> 7, key = c.tid & 127, hp = h * 2 + p;
            float s = 0.f;
            for (int cc = 0; cc < 128; ++cc) s += bf2f(Qp[(size_t)tok * 2048 + hp * 128 + cc]) * bf2f(SK[((size_t)hp * 128 + key) * 128 + cc]);
            sc[p * 128 + key] = s;
        }
        if (c.tid == 0) cnt[0] = 0;
        __syncthreads();
        LAS float* ls = (LAS float*)(c.lds + 4096);
        if (c.tid < 16) { const int id = IDX[((size_t)tok * 8 + h) * 16 + c.tid]; ls[c.tid] = sc[(id >> 7) & 127] + sc[128 + (id & 127)]; if (id < 0 || id >= 16384) bad |= 1; }
        __syncthreads();
        float smin = 1e30f, smax = -1e30f;
        for (int k = 0; k < 16; ++k) { smin = fminf(smin, ls[k]); smax = fmaxf(smax, ls[k]); }
        for (int k = 0; k < 16; ++k) for (int k2 = k + 1; k2 < 16; ++k2) if (IDX[((size_t)tok * 8 + h) * 16 + k] == IDX[((size_t)tok * 8 + h) * 16 + k2]) bad |= 2;
        int n = 0;
        for (int i = c.tid; i < 16384; i += 512) { const float v = sc[i >> 7] + sc[128 + (i & 127)]; if (v > smin + 2e-2f) ++n; }
        atomicAdd((int*)cnt, n);
        __syncthreads();
        if (cnt[0] > 15) bad |= 4;
        float den = 0.f; for (int k = 0; k < 16; ++k) den += fast_exp2((ls[k] - smax) * LOG2E);
        for (int k = 0; k < 16; ++k) { const float gref = fast_exp2((ls[k] - smax) * LOG2E) / den; if (fabsf(gref - GATE[((size_t)tok * 8 + h) * 16 + k]) > 2e-2f) bad |= 8; }
        __syncthreads();
    }
    if (bad && c.tid == 0) atomicOr((unsigned*)(c.ws + WS_CTL + 32768), (unsigned)bad);
}
#endif

#ifdef DBG_ATTN_CHECK
__device__ __forceinline__ void dbg_attn_check(const Ctx& c) {
    if (c.bid >= 64) return;
    LAS float* sc = (LAS float*)c.lds;
    LAS float* red = (LAS float*)(c.lds + 80000);
    const bf16_t* CAT = c.wb(WS_CAT);
    int bad = 0;
    if (c.bid < 32) {
        const bf16_t* MQ = c.wb(WS_G); const bf16_t* MK = c.wb(WS_ST); const bf16_t* MV = c.wb(WS_V);
        const int b = c.bid & 1, h = (c.bid >> 1) & 7, s = (c.bid * 523 + 77) & 16383;
        const size_t tok = (size_t)TC + (size_t)b * SEQ + s;
        float lmax = -1e30f;
        for (int k = c.tid; k < 16640; k += 512) {
            const size_t kt = k < 256 ? (size_t)b * 256 + k : (size_t)TC + (size_t)b * SEQ + (k - 256);
            float a = 0.f;
            for (int d = 0; d < 192; ++d) a += bf2f(MQ[tok * 1536 + h * 192 + d]) * bf2f(MK[(kt * 8 + h) * 192 + d]);
            sc[k] = a; lmax = fmaxf(lmax, a);
        }
#pragma unroll
        for (int o = 32; o >= 1; o >>= 1) lmax = fmaxf(lmax, __shfl_xor(lmax, o));
        if (c.lane == 0) red[c.w] = lmax;
        __syncthreads();
        float mx = red[0]; for (int w = 1; w < 8; ++w) mx = fmaxf(mx, red[w]);
        __syncthreads();
        float ls = 0.f;
        for (int k = c.tid; k < 16640; k += 512) { float p = fast_exp2((sc[k] - mx) * LOG2E);
#if defined(DBG_ATTN_MODE) && DBG_ATTN_MODE == 1
            p = 1.f;
#endif
            sc[k] = p; ls += p; }
        ls = wave_sum(ls);
        if (c.lane == 0) red[c.w] = ls;
        __syncthreads();
        float den = 0.f; for (int w = 0; w < 8; ++w) den += red[w];
        if (c.tid < 128) {
            float o = 0.f;
            for (int k = 0; k < 16640; ++k) { const size_t kt = k < 256 ? (size_t)b * 256 + k : (size_t)TC + (size_t)b * SEQ + (k - 256);
#ifdef DBG_ATTN_SYNV
                o += sc[k] * (float)((((int)kt) * 3 + c.tid) & 31);
#else
                o += sc[k] * bf2f(MV[(kt * 8 + h) * 128 + c.tid]);
#endif
            }
            o /= den;
            const float got = bf2f(CAT[tok * 2048 + 1024 + h * 128 + c.tid]);
            if (fabsf(got - o) > 0.002f + 0.03f * fabsf(o)) bad = 1;

        }
    } else {
        const bf16_t* SQ = c.wb(WS_A); const bf16_t* SK = c.wb(WS_Q); const bf16_t* SV = c.wb(WS_Q + 9 * MiB);
        const int i = c.bid - 32; const int b = i & 1, hq = (i >> 1) & 15;
        const int s = i < 4 ? (i == 0 ? 0 : (i == 1 ? 16383 : (i == 2 ? 100 : 16300))) : ((i * 1021 + 333) & 16383);
        const size_t tok = (size_t)TC + (size_t)b * SEQ + s; const int hk = hq >> 3;
        const float sink = c.in[12][hq];
        const int lo = s - 128 < 0 ? 0 : s - 128, hi = s + 128 > 16383 ? 16383 : s + 128, nk = 256 + hi - lo + 1;
        float lmax = sink;
        for (int k = c.tid; k < nk; k += 512) {
            const size_t kt = k < 256 ? (size_t)b * 256 + k : (size_t)TC + (size_t)b * SEQ + lo + (k - 256);
            float a = 0.f;
            for (int d = 0; d < 64; ++d) a += bf2f(SQ[tok * 1024 + hq * 64 + d]) * bf2f(SK[kt * 128 + hk * 64 + d]);
            sc[k] = a; lmax = fmaxf(lmax, a);
        }
#pragma unroll
        for (int o = 32; o >= 1; o >>= 1) lmax = fmaxf(lmax, __shfl_xor(lmax, o));
        if (c.lane == 0) red[c.w] = lmax;
        __syncthreads();
        float mx = red[0]; for (int w = 1; w < 8; ++w) mx = fmaxf(mx, red[w]);
        __syncthreads();
        float ls = 0.f;
        for (int k = c.tid; k < nk; k += 512) { float p = fast_exp2((sc[k] - mx) * LOG2E);
#if defined(DBG_ATTN_MODE) && DBG_ATTN_MODE == 1
            p = 1.f;
#endif
            sc[k] = p; ls += p; }
        ls = wave_sum(ls);
        if (c.lane == 0) red[c.w] = ls;
        __syncthreads();
#if defined(DBG_ATTN_MODE) && DBG_ATTN_MODE == 1
        float den = 1.f;
#else
        float den = fast_exp2((sink - mx) * LOG2E);
#endif
        for (int w = 0; w < 8; ++w) den += red[w];
        if (c.tid < 64) {
            float o = 0.f;
            for (int k = 0; k < nk; ++k) { const size_t kt = k < 256 ? (size_t)b * 256 + k : (size_t)TC + (size_t)b * SEQ + lo + (k - 256); o += sc[k] * bf2f(SV[kt * 128 + hk * 64 + c.tid]); }
            o /= den;
            const float got = bf2f(CAT[tok * 2048 + hq * 64 + c.tid]);
            if (fabsf(got - o) > 0.002f + 0.03f * fabsf(o)) bad = 2;

        }
    }
    if (bad) atomicOr((unsigned*)(c.ws + WS_CTL + 32768), (unsigned)bad);
    __syncthreads();
}
#endif

typedef const f32x4 (&Acc8)[2][2][4][2];
__device__ __forceinline__ void rope64_pair(const f32x4 a, const f32x4 b, bool rotate, const f32x4 (&cs)[2], float sc, bf16_t* dst) {
    if (rotate) {
        f32x4 o1, o2;
#pragma unroll
        for (int r = 0; r < 4; ++r) { const float cx = cs[r >> 1][(r & 1) * 2], sx = cs[r >> 1][(r & 1) * 2 + 1]; const float x1 = a[r] * sc, x2 = b[r] * sc; o1[r] = x1 * cx - x2 * sx; o2[r] = x2 * cx + x1 * sx; }
        *(u32x2*)dst = pack4(o1); *(u32x2*)(dst + 16) = pack4(o2);
    } else { *(u32x2*)dst = pack4(a * sc); *(u32x2*)(dst + 16) = pack4(b * sc); }
}
__device__ __forceinline__ void rope64_load(f32x4 (&cs)[2], const f32x2* r64, int tok, int wc, int fq) {
    const int s = (tok - TC) & (SEQ - 1), pos = (wc & 1) == 0 ? (s >> 6) : (s & 63);
    const f32x4* p = (const f32x4*)(r64 + pos * 16 + 4 * fq);
    if (tok >= TC) { cs[0] = p[0]; cs[1] = p[1]; }
}
struct EpiEvenProj {
    static constexpr bool PERM = false, AFTER_DRAIN = false;
    bf16_t* F; bf16_t* Q; bf16_t* Kb; bf16_t* V; bf16_t* Gt; const f32x2* r128;
    __device__ __forceinline__ void ld_cs(f32x4 (&cs)[2], int tok, int wc, int fq) const {
        const int s = (tok - TC) & (SEQ - 1), pos = (wc >> 1) == 0 ? (s >> 6) : (s & 63);
        const f32x4* p = (const f32x4*)(r128 + pos * 32 + 16 * (wc & 1) + 4 * fq);
        if (tok >= TC) { cs[0] = p[0]; cs[1] = p[1]; }
    }
    __device__ __forceinline__ void operator()(Acc8 acc, const pg8::Unit& u, int wr, int wc, int fr, int fq) const {
        const int region = u.pn >> 2, ct = (u.pn & 3) * 256;
        const bool qk = region == 1 || region == 2;
        const int tok0 = u.pm * 256 + wr * 64 + fr;
        f32x4 cur[2], nxt[2];
        if (qk) ld_cs(cur, tok0, wc, fq);
#pragma unroll
        for (int ai = 0; ai < 2; ++ai)
#pragma unroll
            for (int m = 0; m < 4; ++m) {
                const int tok = tok0 + ai * 128 + m * 16, gi = ai * 4 + m;
                if (qk && gi + 1 < 8) ld_cs(nxt, tok0 + ((gi + 1) >> 2) * 128 + ((gi + 1) & 3) * 16, wc, fq);
#pragma unroll
                for (int bj = 0; bj < 2; ++bj) {
                    const int col = ct + bj * 128 + wc * 32 + 4 * fq;
                    if (region == 0) { *(u32x2*)(F + (size_t)tok * 1024 + col) = pack4(acc[ai][bj][m][0]); *(u32x2*)(F + (size_t)tok * 1024 + col + 16) = pack4(acc[ai][bj][m][1]); }
                    else if (region == 3) { *(u32x2*)(V + (size_t)tok * 1024 + col) = pack4(acc[ai][bj][m][0]); *(u32x2*)(V + (size_t)tok * 1024 + col + 16) = pack4(acc[ai][bj][m][1]); }
                    else if (region >= 4) {
#pragma unroll
                        for (int n = 0; n < 2; ++n) { f32x4 o;
#pragma unroll
                            for (int r = 0; r < 4; ++r) o[r] = silu_f(acc[ai][bj][m][n][r]);
                            *(u32x2*)(Gt + (size_t)tok * 2048 + (region - 4) * 1024 + col + 16 * n) = pack4(o); }
                    } else {
                        const int head = (u.pn & 3) * 2 + bj, d0 = 64 * (wc >> 1) + 16 * (wc & 1) + 4 * fq;
                        bf16_t* dst = (region == 1 ? Q : Kb) + (size_t)tok * 1024 + head * 128 + d0;
                        const float sc = region == 2 ? 0.08838834764831845f : 1.0f;
                        if (tok >= TC) {
                            f32x4 o1, o2;
#pragma unroll
                            for (int r = 0; r < 4; ++r) { const float cx = cur[r >> 1][(r & 1) * 2], sx = cur[r >> 1][(r & 1) * 2 + 1]; const float a = acc[ai][bj][m][0][r] * sc, b = acc[ai][bj][m][1][r] * sc; o1[r] = a * cx - b * sx; o2[r] = b * cx + a * sx; }
                            *(u32x2*)dst = pack4(o1); *(u32x2*)(dst + 32) = pack4(o2);
                        } else { *(u32x2*)dst = pack4(acc[ai][bj][m][0] * sc); *(u32x2*)(dst + 32) = pack4(acc[ai][bj][m][1] * sc); }
                    }
                }
                if (qk && gi + 1 < 8) { cur[0] = nxt[0]; cur[1] = nxt[1]; }
            }
    }
};
struct EpiOddProj {
    static constexpr bool PERM = false, AFTER_DRAIN = false;
    bf16_t* SQ; bf16_t* SK; bf16_t* SV; bf16_t* CQ; bf16_t* CKV; bf16_t* KR; const f32x2* r64;
    __device__ __forceinline__ void operator()(Acc8 acc, const pg8::Unit& u, int wr, int wc, int fr, int fq) const {
        const bool rot = u.pn <= 4 || u.pn == 8;
        const int tok0 = u.pm * 256 + wr * 64 + fr;
        f32x4 cur[2], nxt[2];
        if (rot) rope64_load(cur, r64, tok0, wc, fq);
#pragma unroll
        for (int ai = 0; ai < 2; ++ai)
#pragma unroll
            for (int m = 0; m < 4; ++m) {
                const int tok = tok0 + ai * 128 + m * 16, gi = ai * 4 + m;
                if (rot && gi + 1 < 8) rope64_load(nxt, r64, tok0 + ((gi + 1) >> 2) * 128 + ((gi + 1) & 3) * 16, wc, fq);
                const bool lat = tok >= TC;
#pragma unroll
                for (int bj = 0; bj < 2; ++bj) {
                    const int c0 = u.pn * 256 + bj * 128 + wc * 32 + 4 * fq;
                    const f32x4 a = acc[ai][bj][m][0], b = acc[ai][bj][m][1];
                    if (u.pn < 4) rope64_pair(a, b, lat, cur, 0.125f * LOG2E, SQ + (size_t)tok * 1024 + c0);
                    else if (u.pn == 4) { if (bj == 0) rope64_pair(a, b, lat, cur, 1.0f, SK + (size_t)tok * 128 + (c0 - 1024)); else rope64_pair(a, b, false, cur, 1.0f, SV + (size_t)tok * 128 + (c0 - 1152)); }
                    else if (u.pn < 7) rope64_pair(a, b, false, cur, 1.0f, CQ + (size_t)tok * 512 + (c0 - 1280));
                    else if (u.pn == 7) rope64_pair(a, b, false, cur, 1.0f, CKV + (size_t)tok * 256 + (c0 - 1792));
                    else if (bj == 0 && wc < 2) rope64_pair(a, b, lat, cur, 1.0f, KR + (size_t)tok * 64 + (c0 - 2048));
                }
                if (rot && gi + 1 < 8) { cur[0] = nxt[0]; cur[1] = nxt[1]; }
            }
    }
};
struct EpiMlaQ {
    static constexpr bool PERM = false, AFTER_DRAIN = false;
    bf16_t* MQ; const f32x2* r64;
    __device__ __forceinline__ void operator()(Acc8 acc, const pg8::Unit& u, int wr, int wc, int fr, int fq) const {
        const int tok0 = TC + u.pm * 256 + wr * 64 + fr;
        f32x4 cur[2], nxt[2];
        rope64_load(cur, r64, tok0, wc, fq);
#pragma unroll
        for (int ai = 0; ai < 2; ++ai)
#pragma unroll
            for (int m = 0; m < 4; ++m) {
                const int tok = tok0 + ai * 128 + m * 16, gi = ai * 4 + m;
                if (gi + 1 < 8) rope64_load(nxt, r64, tok0 + ((gi + 1) >> 2) * 128 + ((gi + 1) & 3) * 16, wc, fq);
#pragma unroll
                for (int bj = 0; bj < 2; ++bj) {
                    const int c0 = u.pn * 256 + bj * 128 + wc * 32 + 4 * fq; const int rr = c0 >> 6;
                    rope64_pair(acc[ai][bj][m][0], acc[ai][bj][m][1], (rr % 3) == 2, cur, 0.07216878364870322f * LOG2E, MQ + (size_t)tok * 1536 + c0);
                }
                if (gi + 1 < 8) { cur[0] = nxt[0]; cur[1] = nxt[1]; }
            }
    }
};
struct EpiMlaKV {
    static constexpr bool PERM = false, AFTER_DRAIN = false;
    bf16_t* MK; bf16_t* MV;
    __device__ __forceinline__ void operator()(Acc8 acc, const pg8::Unit& u, int wr, int wc, int fr, int fq) const {
#pragma unroll
        for (int ai = 0; ai < 2; ++ai)
#pragma unroll
            for (int m = 0; m < 4; ++m) {
                const int tok = u.pm * 256 + ai * 128 + wr * 64 + m * 16 + fr;
                bf16_t* k = MK + ((size_t)tok * 8 + u.pn) * 192 + wc * 32 + 4 * fq; bf16_t* v = MV + ((size_t)tok * 8 + u.pn) * 128 + wc * 32 + 4 * fq;
                *(u32x2*)k = pack4(acc[ai][0][m][0]); *(u32x2*)(k + 16) = pack4(acc[ai][0][m][1]);
                *(u32x2*)v = pack4(acc[ai][1][m][0]); *(u32x2*)(v + 16) = pack4(acc[ai][1][m][1]);
            }
    }
};
struct EpiWout {
    static constexpr bool PERM = false, AFTER_DRAIN = false;
    const float* mods; const float* xlat_old; const float* xctx_old; float* out; float* xctx_new; int layer, tok_off;
    struct Grp { f32x4 gv[2][2], xv[2][2]; float* xn; };
    __device__ __forceinline__ void load_grp(Grp& G, const pg8::Unit& u, int ai, int m, int wr, int wc, int fr, int fq) const {
        const int tok = tok_off + u.pm * 256 + ai * 128 + wr * 64 + m * 16 + fr;
        const int mw = tok < TC ? 2 : ((tok - TC) >> 14);
        const float* g1 = mods + (size_t)(layer * 3 + mw) * 12288 + 2 * 2048;
        const float* xo = tok < TC ? xctx_old + (size_t)tok * D : xlat_old + (size_t)(tok - TC) * D;
        G.xn = tok < TC ? xctx_new + (size_t)tok * D : out + (size_t)(tok - TC) * D;
#pragma unroll
        for (int bj = 0; bj < 2; ++bj)
#pragma unroll
            for (int n = 0; n < 2; ++n) {
                const int col = u.pn * 256 + bj * 128 + wc * 32 + n * 16 + 4 * fq;
                G.gv[bj][n] = *(const f32x4*)(g1 + col); G.xv[bj][n] = *(const f32x4*)(xo + col);
            }
    }
    __device__ __forceinline__ void operator()(Acc8 acc, const pg8::Unit& u, int wr, int wc, int fr, int fq) const {
        Grp cur, nxt;
        load_grp(cur, u, 0, 0, wr, wc, fr, fq);
#pragma unroll
        for (int ai = 0; ai < 2; ++ai)
#pragma unroll
            for (int m = 0; m < 4; ++m) {
                const int gi = ai * 4 + m;
                if (gi + 1 < 8) load_grp(nxt, u, (gi + 1) >> 2, (gi + 1) & 3, wr, wc, fr, fq);
#pragma unroll
                for (int bj = 0; bj < 2; ++bj)
#pragma unroll
                    for (int n = 0; n < 2; ++n) {
                        const int col = u.pn * 256 + bj * 128 + wc * 32 + n * 16 + 4 * fq;
                        *(f32x4*)(cur.xn + col) = cur.xv[bj][n] + cur.gv[bj][n] * acc[ai][bj][m][n];
                    }
                if (gi + 1 < 8) cur = nxt;
            }
    }
};
struct EpiStoreBf16 {
    static constexpr bool PERM = false, AFTER_DRAIN = false;
    bf16_t* O; int ldc;
    __device__ __forceinline__ void operator()(Acc8 acc, const pg8::Unit& u, int wr, int wc, int fr, int fq) const {
#pragma unroll
        for (int ai = 0; ai < 2; ++ai)
#pragma unroll
            for (int m = 0; m < 4; ++m) {
                bf16_t* rp = O + (size_t)(u.pm * 256 + ai * 128 + wr * 64 + m * 16 + fr) * ldc + u.pn * 256 + wc * 32 + 4 * fq;
#pragma unroll
                for (int bj = 0; bj < 2; ++bj)
#pragma unroll
                    for (int n = 0; n < 2; ++n) *(u32x2*)(rp + bj * 128 + n * 16) = pack4(acc[ai][bj][m][n]);
            }
    }
};
template <class Epi>
__device__ __forceinline__ void big_gemm(const Ctx& c, const bf16_t* A, const bf16_t* Bt, int M, int N, int K, const Epi& E) {
    pg8::Gemm g{A, Bt, M, N, K}; pg8::StaticOrder S; S.init(M, N, c.G, c.bid);
    pg8::gemm_phase<Epi, pg8::StaticOrder>((PG8_LAS unsigned char*)c.lds, g, S, E);
}
__device__ __forceinline__ void phase_even_proj2(const Ctx& c) {
    EpiEvenProj E{c.wb(WS_A), c.wb(WS_Q), c.wb(WS_K), c.wb(WS_V), c.wb(WS_G), (const f32x2*)(c.ws + WS_ROPE)};
    big_gemm(c, c.wb(WS_H), c.wb(WS_WINE), TT, 6144, 2048, E);
    const int busy = (TT / 256) * 24 - 12 * c.G;
    if (busy > 0 && busy < c.G && c.bid >= busy) {
        conv_fp4(c, c.in[20] + (size_t)16384 * 2048, c.ws + WS_TABU + 32 * MiB, 16384, U_SCALE, c.bid - busy, c.G - busy);
        conv_fp4(c, c.in[21] + (size_t)16384 * 2048, c.ws + WS_TABV + 32 * MiB, 16384, V_SCALE, c.bid - busy, c.G - busy);
    } else if (!(busy > 0 && busy < c.G)) {
        conv_fp4(c, c.in[20] + (size_t)16384 * 2048, c.ws + WS_TABU + 32 * MiB, 16384, U_SCALE, c.bid, c.G);
        conv_fp4(c, c.in[21] + (size_t)16384 * 2048, c.ws + WS_TABV + 32 * MiB, 16384, V_SCALE, c.bid, c.G);
    }
}
__device__ __forceinline__ void phase_odd_proj2(const Ctx& c) {
    EpiOddProj E{c.wb(WS_A), c.wb(WS_Q), c.wb(WS_Q + 9 * MiB), c.wb(WS_Q + 18 * MiB), c.wb(WS_K), c.wb(WS_K + 17 * MiB), (const f32x2*)(c.ws + WS_ROPE + 131072)};
    big_gemm(c, c.wb(WS_H), c.wb(WS_WINO), TT, 2304, 2048, E);
}
__device__ __forceinline__ void phase_mla_up2(const Ctx& c) {
    EpiMlaQ EQ{c.wb(WS_G), (const f32x2*)(c.ws + WS_ROPE + 131072)};
    big_gemm(c, c.wb(WS_Q + 18 * MiB) + (size_t)TC * 512, c.wb(WS_WUQ), TL, 1536, 512, EQ);
    EpiMlaKV EK{c.wb(WS_ST), c.wb(WS_V)};
    big_gemm(c, c.wb(WS_K), c.wb(WS_WUKV), TT, 2048, 256, EK);
}
__device__ __forceinline__ void phase_wout2(const Ctx& c, const bf16_t* W, int layer, const float* xlat_old, const float* xctx_old, int tok_off) {
    EpiWout E{c.wf(WS_MODS), xlat_old, xctx_old, c.out, c.wf(WS_XCTX), layer, tok_off};
    big_gemm(c, c.wb(WS_CAT) + (size_t)tok_off * 2048, W, TT - tok_off, 2048, 2048, E);
}
__device__ __forceinline__ void phase_peer_q2(const Ctx& c, const bf16_t* W, int tok_off) {
    EpiStoreBf16 E{c.wb(WS_G) + (size_t)tok_off * 2048, 2048};
    big_gemm(c, c.wb(WS_H) + (size_t)tok_off * 2048, W, TT - tok_off, 2048, 2048, E);
}

#ifdef DBG_FOURIER_CHECK
__device__ __forceinline__ void dbg_fourier_check(const Ctx& c) {
    if (c.bid >= 48) return;
    const bf16_t* F = c.wb(WS_A); const bf16_t* CAT = c.wb(WS_CAT);
    LAS float* red = (LAS float*)c.lds;
    const int i = c.bid;
    const bool lat = i >= 32;
    const int b = i & 1, g = (i >> 1) & 3, m = (i * 53 + 7) & 255;
    const int L = lat ? 16384 : 256;
    const int k = lat ? ((i * 2731 + 11) & 16383) : ((i * 37 + 3) & 255);
    const size_t tok0 = lat ? (size_t)TC + (size_t)b * SEQ : (size_t)b * NCTX;
    float acc = 0.f;
    for (int n = c.tid; n < L; n += 512) {
        const float fa = (float)(((long long)k * n) % L) / (float)L;
        float rs = 0.f;
        for (int cc = 0; cc < 256; ++cc) {
            const float fb = (float)((m * cc) & 255) * (1.0f / 256.0f);
            float fr = fa + fb; fr = fr - floorf(fr);
            rs += bf2f(F[(tok0 + n) * 1024 + g * 256 + cc]) * cos_rev(fr);
        }
        acc += rs;
    }
    acc = wave_sum(acc);
    if (c.lane == 0) red[c.w] = acc;
    __syncthreads();
    float tot = 0.f; for (int w = 0; w < 8; ++w) tot += red[w];
    tot *= lat ? (1.0f / 2048.0f) : (1.0f / 256.0f);
    const float got = bf2f(CAT[(tok0 + k) * 2048 + g * 256 + m]);
    if (c.tid == 0 && fabsf(got - tot) > 0.03f + 0.03f * fabsf(tot)) atomicOr((unsigned*)(c.ws + WS_CTL + 32768), lat ? 2u : 1u);
    __syncthreads();
}
#endif
#ifdef DBG_RET_CHECK
__device__ __forceinline__ void dbg_ret_check(const Ctx& c) {
    if (c.bid >= 32) return;
    const bf16_t* Q = c.wb(WS_Q); const bf16_t* Kb = c.wb(WS_K); const bf16_t* V = c.wb(WS_V); const bf16_t* Gt = c.wb(WS_G); const bf16_t* CAT = c.wb(WS_CAT);
    const float* gn = c.in[9];
    LAS float* wgt = (LAS float*)c.lds;
    LAS float* red = (LAS float*)(c.lds + 80000);
    const int i = c.bid, b = i & 1, h = (i >> 1) & 7;
    const bool isctx = i >= 26;
    const int pos = isctx ? (i == 26 ? 5 : (i == 27 ? 130 : (i == 28 ? 255 : (i == 29 ? 0 : (i * 41) & 255))))
                          : (i == 0 ? 0 : (i == 1 ? 16383 : (i == 2 ? 127 : (i == 3 ? 128 : (i * 1637 + 29) & 16383))));
    const size_t tokT = isctx ? (size_t)b * NCTX + pos : (size_t)TC + (size_t)b * SEQ + pos;
    const float lg = log2_gamma(h);
    float yacc = 0.f;
    for (int dir = 0; dir < 2; ++dir) {
        const int nkeys = isctx ? 256 : 256 + 16384;
        for (int j = c.tid; j < nkeys; j += 512) {
            const bool kc = j < 256; const int kp = kc ? j : j - 256;
            const size_t tokK = kc ? (size_t)b * NCTX + kp : (size_t)TC + (size_t)b * SEQ + kp;
            int dist;
            if (isctx) dist = dir == 0 ? pos - kp : kp - pos;
            else if (kc) dist = dir == 0 ? 256 + pos - kp : 16384 - pos + kp;
            else dist = dir == 0 ? pos - kp : kp - pos;
            float w = 0.f;
            if (dist >= 0) {
                float d = 0.f;
                for (int x = 0; x < 128; ++x) d += bf2f(Q[tokT * 1024 + h * 128 + x]) * bf2f(Kb[tokK * 1024 + h * 128 + x]);
                w = d * fast_exp2(lg * (float)dist);
            }
            wgt[j] = w;
        }
        __syncthreads();
        float o = 0.f;
        if (c.tid < 128) {
            for (int j = 0; j < nkeys; ++j) {
                const float w = wgt[j];
                if (w != 0.f) { const bool kc = j < 256; const int kp = kc ? j : j - 256; const size_t tokK = kc ? (size_t)b * NCTX + kp : (size_t)TC + (size_t)b * SEQ + kp;
                    o += w * bf2f(V[tokK * 1024 + h * 128 + c.tid]); }
            }
        }
        float ss = (c.tid < 128) ? o * o : 0.f;
        ss = wave_sum(ss);
        if (c.lane == 0) red[c.w] = ss;
        __syncthreads();
        const float tot = red[0] + red[1];
        const float rstd = rsqrtf(tot * (1.0f / 128.0f) + EPS);
        if (c.tid < 128) yacc += o * rstd * gn[h * 128 + c.tid] * bf2f(Gt[tokT * 2048 + dir * 1024 + h * 128 + c.tid]);
        __syncthreads();
    }
    if (c.tid < 128) {
        const float got = bf2f(CAT[tokT * 2048 + 1024 + h * 128 + c.tid]);
        if (fabsf(got - yacc) > 0.04f + 0.05f * fabsf(yacc)) atomicOr((unsigned*)(c.ws + WS_CTL + 32768), isctx ? 8u : 4u);
    }
    __syncthreads();
}
#endif
__global__ void __launch_bounds__(512, 2) fwd_kernel(KArgs a) {
    extern __shared__ __attribute__((aligned(16))) unsigned char shm[];
    Ctx c;
#pragma unroll
    for (int i = 0; i < 23; ++i) c.in[i] = a.in[i];
    c.out = a.out; c.ws = a.ws; c.lds = (LAS unsigned char*)shm; c.G = gridDim.x; c.bid = blockIdx.x; c.tid = threadIdx.x; c.lane = threadIdx.x & 63;
    c.w = __builtin_amdgcn_readfirstlane(threadIdx.x >> 6);
    const int lo = a.ph_lo, hi = a.ph_hi;
    volatile LAS unsigned* bw = (volatile LAS unsigned*)(c.lds + LDS_BYTES - 16);
    XcdBarrier bar; bar.bar = (unsigned*)(a.ws + WS_CTL); bar.x = 0; bar.st = bw;
    if (hi - lo > 1) {
        if (threadIdx.x == 0) { bw[0] = 0u; bw[1] = 0u; bw[2] = 0u; bw[3] = 0u; }
        __syncthreads();
        bar = xcd_barrier_post((unsigned*)(a.ws + WS_CTL), bw);
    }
#define IN(k) (((PHASE_MASK >> (k)) & 1u) && lo <= (k) && (k) < hi)
#define SEAM(k) do { if (IN(k) && IN((k) + 1)) xcd_barrier(bar); } while (0)
    float* XCTX = c.wf(WS_XCTX); bf16_t* H = c.wb(WS_H);
    if (IN(0)) phase_prologue(c);
    SEAM(0);
    if (IN(1)) phase_mods(c);
    SEAM(1);
    if (IN(2)) phase_modnorm(c, 0, 0, c.in[0], c.in[2], 0, H);
    SEAM(2);
    if (IN(3)) phase_even_proj2(c);
    SEAM(3);
    if (IN(4)) phase_chan_dft(c);
    SEAM(4);
    if (IN(5)) phase_dft_stage1(c);
    SEAM(5);
    if (IN(6)) { phase_dft_stage2(c); phase_ret_ds(c); }
    SEAM(6);
    if (IN(7)) phase_ret_scan(c);
    SEAM(7);
    if (IN(8)) phase_ret_out(c);
    SEAM(8);
#ifdef DBG_FOURIER_CHECK
    if (IN(9)) dbg_fourier_check(c);
#endif
#ifdef DBG_RET_CHECK
    if (IN(9)) dbg_ret_check(c);
#endif
    if (IN(9)) { phase_wout2(c, c.wb(WS_WOUTE), 0, c.in[0], c.in[2], TC); phase_wout(c, c.wb(WS_WOUTE), 0, c.in[0], c.in[2], 0, TC / 128); }
    SEAM(9);
    if (IN(10)) phase_modnorm(c, 0, 1, c.out, XCTX, 0, H);
    SEAM(10);
    if (IN(11)) { phase_peer_q2(c, c.wb(WS_WQ0), TC); phase_peer_q(c, c.wb(WS_WQ0), 0, TC / 128); }
    SEAM(11);
    if (IN(12)) phase_peer_topk(c, 0, 0);
    SEAM(12);
#ifdef DBG_TOPK_CHECK
    if (lo == 12) dbg_gather_save(c);
#endif
    if (IN(13)) phase_peer_gather<false>(c, 0, 0);
    SEAM(13);
#ifdef DBG_TOPK_CHECK
    if (lo == 13) dbg_topk_check(c);
    if (lo == 14) dbg_gather_check(c);
#endif
    if (IN(14)) {
        phase_modnorm(c, 1, 0, c.out, XCTX, 0, H);
    }
    SEAM(14);
    if (IN(15)) phase_odd_proj2(c);
    SEAM(15);
    if (IN(16)) phase_odd_local(c);
    SEAM(16);
    if (IN(17)) phase_mla_up2(c);
    SEAM(17);
    if (IN(18)) phase_attention(c);
    SEAM(18);
#ifdef DBG_ATTN_CHECK
    if (IN(19)) dbg_attn_check(c);
#endif
    if (IN(19)) phase_wout2(c, c.wb(WS_WOUTO), 1, c.out, XCTX, TC);
    SEAM(19);
    if (IN(20)) phase_modnorm(c, 1, 1, c.out, XCTX, TC, H);
    SEAM(20);
    if (IN(21)) phase_peer_q2(c, c.wb(WS_WQ1), TC);
    SEAM(21);
    if (IN(22)) phase_peer_topk(c, 1, 4);
    SEAM(22);
    if (IN(23)) phase_peer_gather<true>(c, 1, TC);
#ifdef DUMP_OFF
    if (lo == NPH - 1) { const bf16_t* src = c.wb(DUMP_OFF); for (size_t i = (size_t)c.bid * 512 + c.tid; i < (size_t)TL * D; i += (size_t)c.G * 512) { float v = bf2f(src[i]); c.out[i] = (v == v && fabsf(v) < 1e30f) ? v : 777.0f; } }
#endif
#undef IN
#undef SEAM
}

extern "C" void kernel_launch(void* const* d_in, const int* in_sizes, int n_in, void* d_out, int out_size, void* d_ws, size_t ws_size, hipStream_t stream) {
    static int grid = 0;
    if (grid == 0) {
        if (n_in != 23 || ws_size < WS_END) { fprintf(stderr, "kernel_launch: unexpected n_in %d / ws %zu\n", n_in, ws_size); grid = -1; return; }
        int dev = 0, cus = 0, per_cu = 0;
        hipGetDevice(&dev);
        hipDeviceGetAttribute(&cus, hipDeviceAttributeMultiprocessorCount, dev);
        if (hipFuncSetAttribute((const void*)fwd_kernel, hipFuncAttributeMaxDynamicSharedMemorySize, LDS_BYTES) != hipSuccess) { fprintf(stderr, "hipFuncSetAttribute failed\n"); grid = -1; return; }
        if (hipOccupancyMaxActiveBlocksPerMultiprocessor(&per_cu, (const void*)fwd_kernel, 512, LDS_BYTES) != hipSuccess || per_cu < 1) { fprintf(stderr, "occupancy query: %d\n", per_cu); }
        (void)hipGetLastError();
        grid = cus > 0 ? cus : 256;
    }
    if (grid < 0) return;
    hipMemsetAsync((char*)d_ws + WS_CTL, 0, 65536, stream);
    KArgs a{};
    for (int i = 0; i < 23; ++i) a.in[i] = (const float*)d_in[i];
    a.out = (float*)d_out; a.ws = (unsigned char*)d_ws;
#if N_LAUNCHES == 1
    a.ph_lo = 0; a.ph_hi = NPH;
    hipLaunchKernelGGL(fwd_kernel, dim3(grid), dim3(512), LDS_BYTES, stream, a);
#else
    { static const int order[NPH] = {0,1,2,3,4,5,6,7,8,9,10,11,12,13,14,15,16,17,18,19,20,21,22,23};
      for (int i = 0; i < NPH; ++i) { const int k = order[i]; a.ph_lo = k; a.ph_hi = k + 1; hipLaunchKernelGGL(fwd_kernel, dim3(grid), dim3(512), LDS_BYTES, stream, a); } }
#endif
}
```

```cpp
#include <hip/hip_runtime.h>
#include <stdint.h>
#include <stdio.h>

#ifndef N_LAUNCHES
#define N_LAUNCHES 1
#endif
#ifndef DBG_SKIP_GATHER
#define DBG_SKIP_GATHER 0
#endif
#ifndef DBG_CAT_PART
#define DBG_CAT_PART 0

#endif
#ifndef PHASE_MASK
#define PHASE_MASK 0xFFFFFFu
#endif

#define LAS __attribute__((address_space(3)))
typedef unsigned short bf16_t;
typedef short bf16x8 __attribute__((ext_vector_type(8)));
typedef short s16x4 __attribute__((ext_vector_type(4)));
typedef float f32x2 __attribute__((ext_vector_type(2)));
typedef float f32x4 __attribute__((ext_vector_type(4)));
typedef float f32x16 __attribute__((ext_vector_type(16)));
typedef unsigned u32x2 __attribute__((ext_vector_type(2)));
typedef unsigned u32x4 __attribute__((ext_vector_type(4)));
typedef __bf16 bf16x2_t __attribute__((ext_vector_type(2)));

constexpr int D = 2048, NBATCH = 2, SEQ = 16384, NCTX = 256;
constexpr int TC = NBATCH * NCTX;
constexpr int TL = NBATCH * SEQ;
constexpr int TT = TC + TL;
constexpr int NCH = 130;
constexpr float EPS = 1e-6f;
constexpr float LOG2E = 1.4426950408889634f;
constexpr float U_SCALE = 90.5f, V_SCALE = 2.0f;

constexpr size_t MiB = 1ull << 20;
constexpr size_t WS_CTL = 0;
constexpr size_t WS_MODS = 1 * MiB;
constexpr size_t WS_MODP = 2 * MiB;
constexpr size_t WS_ROPE = 12 * MiB;
constexpr size_t WS_DFT = 13 * MiB;
constexpr size_t WS_SKB = 14 * MiB;
constexpr size_t WS_XCTX = 15 * MiB;
constexpr size_t WS_W = 19 * MiB;
constexpr size_t WS_WINE = WS_W;
constexpr size_t WS_WOUTE = WS_WINE + 24 * MiB;
constexpr size_t WS_WINO = WS_WOUTE + 8 * MiB;
constexpr size_t WS_WUQ = WS_WINO + 9 * MiB;
constexpr size_t WS_WUKV = WS_WUQ + 2 * MiB;
constexpr size_t WS_WOUTO = WS_WUKV + 1 * MiB;
constexpr size_t WS_WQ0 = WS_WOUTO + 8 * MiB;
constexpr size_t WS_WQ1 = WS_WQ0 + 8 * MiB;
constexpr size_t WS_TABU = 88 * MiB;
constexpr size_t WS_TABV = WS_TABU + 64 * MiB;
constexpr size_t WS_H = 216 * MiB;
constexpr size_t WS_A = 346 * MiB;
constexpr size_t WS_Q = 411 * MiB;
constexpr size_t WS_K = 476 * MiB;
constexpr size_t WS_V = 541 * MiB;
constexpr size_t WS_G = 606 * MiB;
constexpr size_t WS_CAT = 736 * MiB;
constexpr size_t WS_ST = 866 * MiB;
constexpr size_t WS_IDX = 998 * MiB;
constexpr size_t WS_GATE = 1015 * MiB;
constexpr size_t WS_END = 1032 * MiB;

constexpr int LDS_BYTES = 147456;
constexpr int NPH = 24;

#define XB_TMO      128
#define XB_XCNT(j)  (256  + 64 * (j))
#define XB_XSUB(j)  (1280 + 64 * (j))
#define XB_XGEN(j)  (2304 + 64 * (j))
#define XB_TOP      3328
#define XB_TOPGEN   3392
#define XCD_BAR_WORDS 3456
#define XB_SPIN_CAP (1u << 24)

__device__ __forceinline__ unsigned xb_ld(unsigned* p)              { return __hip_atomic_load(p, __ATOMIC_RELAXED, __HIP_MEMORY_SCOPE_AGENT); }
__device__ __forceinline__ unsigned xb_add(unsigned* p, unsigned v) { return __hip_atomic_fetch_add(p, v, __ATOMIC_RELAXED, __HIP_MEMORY_SCOPE_AGENT); }
__device__ __forceinline__ unsigned xb_xcc_id() { return (unsigned)__builtin_amdgcn_s_getreg((3 << 11) | 20) & 0xFu; }
#define XB_SPIN(cond, bar) do { unsigned _sp = 0; while (cond) { __builtin_amdgcn_s_sleep(1); \
    if ((++_sp & 255u) == 0u) { if (xb_ld(&(bar)[XB_TMO])) break; if (_sp > XB_SPIN_CAP) { atomicAdd(&(bar)[XB_TMO], 1u); break; } } } } while (0)

struct XcdBarrier { unsigned* bar; unsigned x; volatile LAS unsigned* st; };

__device__ __forceinline__ XcdBarrier xcd_barrier_post(unsigned* bar, volatile LAS unsigned* st) {
    XcdBarrier b; b.bar = bar; b.x = xb_xcc_id(); b.st = st;
    if (threadIdx.x == 0) (void)xb_add(&bar[XB_XCNT(b.x)], 1u);
    return b;
}
__device__ __forceinline__ void xcd_barrier_complete(unsigned* bar, unsigned x, unsigned& nloc, unsigned& nx) {
    const unsigned G = gridDim.x * gridDim.y * gridDim.z;
    unsigned sum, cnt, mine, sp = 0u;
    for (;;) {
        sum = 0u; cnt = 0u; mine = 0u;
#pragma unroll
        for (unsigned j = 0; j < 16; ++j) { const unsigned c = xb_ld(&bar[XB_XCNT(j)]); sum += c; cnt += (c > 0u) ? 1u : 0u; mine = (j == x) ? c : mine; }
        if (sum == G) break;
        __builtin_amdgcn_s_sleep(1);
        if ((++sp & 255u) == 0u) { if (xb_ld(&bar[XB_TMO])) break; if (sp > XB_SPIN_CAP) { atomicAdd(&bar[XB_TMO], 1u); break; } }
    }
    nloc = mine > 0u ? mine : 1u; nx = cnt > 0u ? cnt : 1u;
}
__device__ __forceinline__ void xcd_barrier(const XcdBarrier& b) {
    asm volatile("s_waitcnt vmcnt(0)" ::: "memory");
    __syncthreads();
    if (threadIdx.x == 0) {
        unsigned* bar = b.bar;
        __builtin_amdgcn_s_waitcnt(0);
        unsigned nloc = b.st[0], nx = b.st[1];
        if (nloc == 0u) { xcd_barrier_complete(bar, b.x, nloc, nx); b.st[0] = nloc; b.st[1] = nx; }
        const unsigned old = xb_add(&bar[XB_XSUB(b.x)], 1u);
        const unsigned gen = old / nloc;
        if (old + 1u == (gen + 1u) * nloc) {
            __builtin_amdgcn_fence(__ATOMIC_RELEASE, "agent");
            asm volatile("s_waitcnt vmcnt(0)" ::: "memory");
            const unsigned og = xb_add(&bar[XB_TOP], 1u);
            const unsigned tg = og / nx;
            if (og + 1u == (tg + 1u) * nx) xb_add(&bar[XB_TOPGEN], 1u);
            else XB_SPIN(xb_ld(&bar[XB_TOPGEN]) == tg, bar);
            __builtin_amdgcn_fence(__ATOMIC_ACQUIRE, "agent");
            xb_add(&bar[XB_XGEN(b.x)], 1u);
            asm volatile("s_waitcnt vmcnt(0)" ::: "memory");
        } else {
            XB_SPIN(xb_ld(&bar[XB_XGEN(b.x)]) == gen, bar);
            __builtin_amdgcn_fence(__ATOMIC_ACQUIRE, "agent");
            asm volatile("s_waitcnt vmcnt(0)" ::: "memory");
        }
    }
    __syncthreads();
}

__device__ __forceinline__ unsigned cvt_pk_bf16(float lo, float hi) { const f32x2 v = {lo, hi}; const bf16x2_t r = __builtin_convertvector(v, bf16x2_t); return __builtin_bit_cast(unsigned, r); }
__device__ __forceinline__ float bf_lo(unsigned u) { return __uint_as_float(u << 16); }
__device__ __forceinline__ float bf_hi(unsigned u) { return __uint_as_float(u & 0xffff0000u); }
__device__ __forceinline__ float bf2f(bf16_t b) { return __uint_as_float(((unsigned)b) << 16); }
__device__ __forceinline__ u32x2 pack4(f32x4 v) { u32x2 r; r.x = cvt_pk_bf16(v[0], v[1]); r.y = cvt_pk_bf16(v[2], v[3]); return r; }
__device__ __forceinline__ float fast_exp2(float x) { return __builtin_amdgcn_exp2f(x); }
__device__ __forceinline__ float fast_rcp(float x) { return __builtin_amdgcn_rcpf(x); }
__device__ __forceinline__ float silu_f(float x) { return x * fast_rcp(1.0f + fast_exp2(-x * LOG2E)); }
__device__ __forceinline__ float gelu_tanh(float x) {
    const float u = 0.7978845608028654f * (x + 0.044715f * x * x * x);
    return x * fast_rcp(1.0f + fast_exp2(-2.0f * LOG2E * u));
}
__device__ __forceinline__ float wave_sum(float v) {
#pragma unroll
    for (int o = 32; o >= 1; o >>= 1) v += __shfl_xor(v, o);
    return v;
}
__device__ __forceinline__ float cos_rev(float fr) { return __builtin_amdgcn_cosf(fr); }
__device__ __forceinline__ float sin_rev(float fr) { return __builtin_amdgcn_sinf(fr); }
__device__ __forceinline__ float log2_gamma(int h) {
    const float x = __uint_as_float((unsigned)(127 - 5 - h) << 23);
    float s = x * (1.0f + x * (0.5f + x * (0.33333334f + x * (0.25f + x * (0.2f + x * (0.16666667f + x * 0.14285715f))))));
    return -s * LOG2E;
}

__device__ __forceinline__ int tok_batch(int tok) { return tok < TC ? (tok >> 8) : ((tok - TC) >> 14); }

constexpr int GEMM_LDS = 73728;
template <bool TRANS, class AF, class BF>
__device__ __forceinline__ void gemm128(LAS unsigned char* lds, int K, const AF& arow, const BF& brow, f32x4 (&acc)[2][4]) {
    const int tid = threadIdx.x, lane = tid & 63, w = tid >> 6, wm = w >> 1, wn = w & 1;
    const int r0 = tid >> 3, ch = tid & 7;
    const bf16_t* pa0 = arow(r0) + ch * 8; const bf16_t* pa1 = arow(r0 + 64) + ch * 8;
    const bf16_t* pb0 = brow(r0) + ch * 8; const bf16_t* pb1 = brow(r0 + 64) + ch * 8;
    const int woff = r0 * 144 + ch * 16;
#pragma unroll
    for (int mb = 0; mb < 2; ++mb)
#pragma unroll
        for (int nb = 0; nb < 4; ++nb) acc[mb][nb] = (f32x4){0.f, 0.f, 0.f, 0.f};
    u32x4 ra0 = *(const u32x4*)pa0, ra1 = *(const u32x4*)pa1, rb0 = *(const u32x4*)pb0, rb1 = *(const u32x4*)pb1;
    *(LAS u32x4*)(lds + woff) = ra0; *(LAS u32x4*)(lds + woff + 9216) = ra1;
    *(LAS u32x4*)(lds + 36864 + woff) = rb0; *(LAS u32x4*)(lds + 36864 + woff + 9216) = rb1;
    __syncthreads();
    const int nk = K >> 6;
    const int aoff = (32 * wm + (lane & 15)) * 144 + (lane >> 4) * 16;
    const int boff = 36864 + (64 * wn + (lane & 15)) * 144 + (lane >> 4) * 16;
    for (int kt = 0; kt < nk; ++kt) {
        const int buf = (kt & 1) * 18432;
        if (kt + 1 < nk) {
            const int ko = (kt + 1) * 64;
            ra0 = *(const u32x4*)(pa0 + ko); ra1 = *(const u32x4*)(pa1 + ko); rb0 = *(const u32x4*)(pb0 + ko); rb1 = *(const u32x4*)(pb1 + ko);
        }
#pragma unroll
        for (int ks = 0; ks < 2; ++ks) {
            bf16x8 af[2], bfr[4];
#pragma unroll
            for (int mb = 0; mb < 2; ++mb) af[mb] = *(const LAS bf16x8*)(lds + buf + aoff + mb * 2304 + ks * 64);
#pragma unroll
            for (int nb = 0; nb < 4; ++nb) bfr[nb] = *(const LAS bf16x8*)(lds + buf + boff + nb * 2304 + ks * 64);
#pragma unroll
            for (int mb = 0; mb < 2; ++mb)
#pragma unroll
                for (int nb = 0; nb < 4; ++nb)
                    acc[mb][nb] = TRANS ? __builtin_amdgcn_mfma_f32_16x16x32_bf16(bfr[nb], af[mb], acc[mb][nb], 0, 0, 0)
                                        : __builtin_amdgcn_mfma_f32_16x16x32_bf16(af[mb], bfr[nb], acc[mb][nb], 0, 0, 0);
        }
        if (kt + 1 < nk) {
            const int nb2 = ((kt + 1) & 1) * 18432;
            *(LAS u32x4*)(lds + nb2 + woff) = ra0; *(LAS u32x4*)(lds + nb2 + woff + 9216) = ra1;
            *(LAS u32x4*)(lds + 36864 + nb2 + woff) = rb0; *(LAS u32x4*)(lds + 36864 + nb2 + woff + 9216) = rb1;
        }
        __syncthreads();
    }
}
template <bool TRANS, int K, class AF, class BF>
__device__ __forceinline__ void gemm128s(LAS unsigned char* lds, const AF& arow, const BF& brow, f32x4 (&acc)[2][4]) {
    constexpr int NK = K / 64, DEPTH = NK < 4 ? NK : 4;
    const int tid = threadIdx.x, lane = tid & 63, w = tid >> 6, wm = w >> 1, wn = w & 1;
    const int r0 = tid >> 3, ch = tid & 7;
    const bf16_t* pa0 = arow(r0) + ch * 8; const bf16_t* pa1 = arow(r0 + 64) + ch * 8;
    const bf16_t* pb0 = brow(r0) + ch * 8; const bf16_t* pb1 = brow(r0 + 64) + ch * 8;
    const int woff = r0 * 144 + ch * 16;
    u32x4 rg[DEPTH][4];
#pragma unroll
    for (int d = 0; d < DEPTH; ++d) {
        rg[d][0] = *(const u32x4*)(pa0 + d * 64); rg[d][1] = *(const u32x4*)(pa1 + d * 64);
        rg[d][2] = *(const u32x4*)(pb0 + d * 64); rg[d][3] = *(const u32x4*)(pb1 + d * 64);
    }
    __builtin_amdgcn_sched_barrier(0);
#pragma unroll
    for (int mb = 0; mb < 2; ++mb)
#pragma unroll
        for (int nb = 0; nb < 4; ++nb) acc[mb][nb] = (f32x4){0.f, 0.f, 0.f, 0.f};
    *(LAS u32x4*)(lds + woff) = rg[0][0]; *(LAS u32x4*)(lds + woff + 9216) = rg[0][1];
    *(LAS u32x4*)(lds + 36864 + woff) = rg[0][2]; *(LAS u32x4*)(lds + 36864 + woff + 9216) = rg[0][3];
    __syncthreads();
    const int aoff = (32 * wm + (lane & 15)) * 144 + (lane >> 4) * 16;
    const int boff = 36864 + (64 * wn + (lane & 15)) * 144 + (lane >> 4) * 16;
#pragma unroll
    for (int kt = 0; kt < NK; ++kt) {
        const int buf = (kt & 1) * 18432;
        if (kt + DEPTH < NK) {
            const int ko = (kt + DEPTH) * 64;
            rg[kt % DEPTH][0] = *(const u32x4*)(pa0 + ko); rg[kt % DEPTH][1] = *(const u32x4*)(pa1 + ko);
            rg[kt % DEPTH][2] = *(const u32x4*)(pb0 + ko); rg[kt % DEPTH][3] = *(const u32x4*)(pb1 + ko);
            __builtin_amdgcn_sched_barrier(0);
        }
#pragma unroll
        for (int ks = 0; ks < 2; ++ks) {
            bf16x8 af[2], bfr[4];
#pragma unroll
            for (int mb = 0; mb < 2; ++mb) af[mb] = *(const LAS bf16x8*)(lds + buf + aoff + mb * 2304 + ks * 64);
#pragma unroll
            for (int nb = 0; nb < 4; ++nb) bfr[nb] = *(const LAS bf16x8*)(lds + buf + boff + nb * 2304 + ks * 64);
#pragma unroll
            for (int mb = 0; mb < 2; ++mb)
#pragma unroll
                for (int nb = 0; nb < 4; ++nb)
                    acc[mb][nb] = TRANS ? __builtin_amdgcn_mfma_f32_16x16x32_bf16(bfr[nb], af[mb], acc[mb][nb], 0, 0, 0)
                                        : __builtin_amdgcn_mfma_f32_16x16x32_bf16(af[mb], bfr[nb], acc[mb][nb], 0, 0, 0);
        }
        if (kt + 1 < NK) {
            const int nb2 = ((kt + 1) & 1) * 18432; constexpr int dummy = 0; (void)dummy;
            const int s = (kt + 1) % DEPTH;
            *(LAS u32x4*)(lds + nb2 + woff) = rg[s][0]; *(LAS u32x4*)(lds + nb2 + woff + 9216) = rg[s][1];
            *(LAS u32x4*)(lds + 36864 + nb2 + woff) = rg[s][2]; *(LAS u32x4*)(lds + 36864 + nb2 + woff + 9216) = rg[s][3];
        }
        __syncthreads();
    }
}
template <bool TRANS, class AF, class BF>
__device__ __forceinline__ void gemm128r(LAS unsigned char* lds, int K, const AF& arow, const BF& brow, f32x4 (&acc)[2][4]) {
    const int tid = threadIdx.x, lane = tid & 63, w = tid >> 6, wm = w >> 1, wn = w & 1;
    const int r0 = tid >> 3, ch = tid & 7;
    const bf16_t* pa0 = arow(r0) + ch * 8; const bf16_t* pa1 = arow(r0 + 64) + ch * 8;
    const bf16_t* pb0 = brow(r0) + ch * 8; const bf16_t* pb1 = brow(r0 + 64) + ch * 8;
    const int woff = r0 * 144 + ch * 16;
    u32x4 rg[4][4];
#pragma unroll
    for (int d = 0; d < 4; ++d) {
        rg[d][0] = *(const u32x4*)(pa0 + d * 64); rg[d][1] = *(const u32x4*)(pa1 + d * 64);
        rg[d][2] = *(const u32x4*)(pb0 + d * 64); rg[d][3] = *(const u32x4*)(pb1 + d * 64);
    }
    __builtin_amdgcn_sched_barrier(0);
#pragma unroll
    for (int mb = 0; mb < 2; ++mb)
#pragma unroll
        for (int nb = 0; nb < 4; ++nb) acc[mb][nb] = (f32x4){0.f, 0.f, 0.f, 0.f};
    *(LAS u32x4*)(lds + woff) = rg[0][0]; *(LAS u32x4*)(lds + woff + 9216) = rg[0][1];
    *(LAS u32x4*)(lds + 36864 + woff) = rg[0][2]; *(LAS u32x4*)(lds + 36864 + woff + 9216) = rg[0][3];
    __syncthreads();
    const int nk = K >> 6;
    const int aoff = (32 * wm + (lane & 15)) * 144 + (lane >> 4) * 16;
    const int boff = 36864 + (64 * wn + (lane & 15)) * 144 + (lane >> 4) * 16;
#pragma unroll 1
    for (int kt0 = 0; kt0 < nk; kt0 += 4) {
#pragma unroll
        for (int j = 0; j < 4; ++j) {
            const int kt = kt0 + j, buf = (j & 1) * 18432;
            if (kt + 4 < nk) {
                const int ko = (kt + 4) * 64;
                rg[j][0] = *(const u32x4*)(pa0 + ko); rg[j][1] = *(const u32x4*)(pa1 + ko);
                rg[j][2] = *(const u32x4*)(pb0 + ko); rg[j][3] = *(const u32x4*)(pb1 + ko);
            }
            __builtin_amdgcn_sched_barrier(0);
#pragma unroll
            for (int ks = 0; ks < 2; ++ks) {
                bf16x8 af[2], bfr[4];
#pragma unroll
                for (int mb = 0; mb < 2; ++mb) af[mb] = *(const LAS bf16x8*)(lds + buf + aoff + mb * 2304 + ks * 64);
#pragma unroll
                for (int nb = 0; nb < 4; ++nb) bfr[nb] = *(const LAS bf16x8*)(lds + buf + boff + nb * 2304 + ks * 64);
#pragma unroll
                for (int mb = 0; mb < 2; ++mb)
#pragma unroll
                    for (int nb = 0; nb < 4; ++nb)
                        acc[mb][nb] = TRANS ? __builtin_amdgcn_mfma_f32_16x16x32_bf16(bfr[nb], af[mb], acc[mb][nb], 0, 0, 0)
                                            : __builtin_amdgcn_mfma_f32_16x16x32_bf16(af[mb], bfr[nb], acc[mb][nb], 0, 0, 0);
            }
            if (kt + 1 < nk) {
                const int nb2 = ((j + 1) & 1) * 18432, s = (j + 1) & 3;
                *(LAS u32x4*)(lds + nb2 + woff) = rg[s][0]; *(LAS u32x4*)(lds + nb2 + woff + 9216) = rg[s][1];
                *(LAS u32x4*)(lds + 36864 + nb2 + woff) = rg[s][2]; *(LAS u32x4*)(lds + 36864 + nb2 + woff + 9216) = rg[s][3];
            }
            __syncthreads();
        }
    }
}
__device__ __forceinline__ void tile_mn(int t, int MT, int NT, int& mt, int& nt) {
    const int per = 16 * NT; const int g = t / per; const int r = t - g * per; const int rem = MT - g * 16; const int gs = rem < 16 ? rem : 16;
    mt = g * 16 + r % gs; nt = r / gs;
}
struct RowLin { const bf16_t* base; size_t pitch; __device__ __forceinline__ const bf16_t* operator()(int r) const { return base + (size_t)r * pitch; } };

__device__ __forceinline__ s16x4 tr_read(LAS unsigned char* blk, int stride, int lane) {
    const int i = lane & 15;
    return __builtin_amdgcn_ds_read_tr16_b64_v4i16((LAS s16x4*)(blk + (i >> 2) * stride + (i & 3) * 8));
}
__device__ __forceinline__ bf16x8 cat8(s16x4 a, s16x4 b) { bf16x8 r; r[0] = a[0]; r[1] = a[1]; r[2] = a[2]; r[3] = a[3]; r[4] = b[0]; r[5] = b[1]; r[6] = b[2]; r[7] = b[3]; return r; }

namespace pg8 {
#define PG8_LAS __attribute__((address_space(3)))
constexpr int BM = 256, BK = 64, HALF = 128, HTB = HALF * BK * 2  , STAGE_BYTES = 8 * HTB, NXCD = 8, WGM = 8;

__host__ __device__ __forceinline__ int lds_byte(int r, int c) { const int st = (r >> 4) * 2 + (c >> 5), rr = r & 15, cc = c & 31, ob = rr * 64 + cc * 2; return st * 1024 + (ob ^ (((ob >> 9) & 1) << 5)); }
__host__ __device__ __forceinline__ void stage_rc(int b, int& R, int& C) { const int st = b / 1024, sb = b % 1024, swz = sb ^ (((sb >> 9) & 1) << 5); R = (st >> 1) * 16 + swz / 64; C = (st & 1) * 32 + (swz % 64) / 2; }
__host__ __device__ __forceinline__ int perm32(int rho) { const int n = rho >> 4, i = rho & 15; return 8 * (i >> 2) + 4 * n + (i & 3); }

struct Unit { int pm, pn; };
struct Gemm { const bf16_t* A; const bf16_t* Bt; int M, N, K; };

struct StaticOrder {
    int nM, nN, nwg, G, c;
    __host__ __device__ void init(int M, int N, int G_, int c_) { nM = M / BM; nN = N / BM; nwg = nM * nN; G = G_; c = c_; }
    __host__ __device__ bool next(int i, Unit& u) const {
        const long L = (long)i * G + c; if (L >= nwg) return false;
        int wgid = (int)L; { const int q = nwg / NXCD, r = nwg % NXCD, xcd = wgid % NXCD, off = wgid / NXCD; wgid = (xcd < r ? xcd * (q + 1) : r * (q + 1) + (xcd - r) * q) + off; }
        const int nig = WGM * nN, gid = wgid / nig, fm = gid * WGM, gsz = (nM - fm) < WGM ? (nM - fm) : WGM;
        u.pm = fm + ((wgid % nig) % gsz); u.pn = (wgid % nig) / gsz; return true;
    }
    __device__ __forceinline__ void a_ready(const Unit&) const {}
    __device__ __forceinline__ void done(const Unit&) const {}
};
template <class Epi, class Sched>
__device__ __forceinline__ void gemm_phase(PG8_LAS unsigned char* lds, const Gemm g, const Sched& S, const Epi& E) {
    const int tid = threadIdx.x, wid = __builtin_amdgcn_readfirstlane(tid >> 6), lane = tid & 63, wr = wid >> 2, wc = wid & 3, fr = lane & 15, fq = lane >> 4;
    const int K = g.K, nt = K / BK;
    unsigned voffA[2], voffB[2];
#pragma unroll
    for (int i = 0; i < 2; ++i) { int R, C; stage_rc(tid * 16 + i * 8192, R, C); const int Rb = Epi::PERM ? ((R & ~31) + perm32(R & 31)) : R;
        voffA[i] = (unsigned)(R * K + C) * 2u; voffB[i] = (unsigned)(Rb * K + C) * 2u; }
    const size_t kstep = (size_t)(BK * 2);
    const size_t hstep = (size_t)HALF * K * 2;
    const size_t tstep = 2 * hstep;
    const unsigned ldsw = (unsigned)wid * 1024u;
    const int aoff = lds_byte(wr * 64 + fr, fq * 8), boff = lds_byte(wc * 32 + fr, fq * 8);
#define PG8_SA(b, h) (((b) * 2 + (h)) * HTB)
#define PG8_SB(b, h) ((4 + (b) * 2 + (h)) * HTB)
#define PG8_STAGE(bufoff, gbase, voff) do { _Pragma("unroll") for (int _i = 0; _i < 2; ++_i) \
        __builtin_amdgcn_global_load_lds((const unsigned*)((const char*)(gbase) + (voff)[_i]), (PG8_LAS unsigned*)(lds + (bufoff) + ldsw + _i * 8192), 16, 0, 0); } while (0)
#define PG8_LDA(dst, b, h) do { _Pragma("unroll") for (int m = 0; m < 4; ++m) _Pragma("unroll") for (int k = 0; k < 2; ++k) dst[m][k] = *(const PG8_LAS bf16x8*)(lds + PG8_SA(b, h) + aoff + m * 2048 + k * 1024); } while (0)
#define PG8_LDB(dst, b, h) do { _Pragma("unroll") for (int n = 0; n < 2; ++n) _Pragma("unroll") for (int k = 0; k < 2; ++k) dst[n][k] = *(const PG8_LAS bf16x8*)(lds + PG8_SB(b, h) + boff + n * 2048 + k * 1024); } while (0)
#define PG8_MMA(ai, bj, At, Bt) do { __builtin_amdgcn_s_setprio(1); _Pragma("unroll") for (int m = 0; m < 4; ++m) _Pragma("unroll") for (int n = 0; n < 2; ++n) _Pragma("unroll") for (int k = 0; k < 2; ++k) \
        acc[ai][bj][m][n] = __builtin_amdgcn_mfma_f32_16x16x32_bf16(Bt[n][k], At[m][k], acc[ai][bj][m][n], 0, 0, 0); __builtin_amdgcn_s_setprio(0); } while (0)
#define PG8_WAIT_V(n) asm volatile("s_waitcnt vmcnt(" #n ")" ::: "memory")
#define PG8_WAIT_L(n) asm volatile("s_waitcnt lgkmcnt(" #n ")" ::: "memory")
#define PG8_BAR __builtin_amdgcn_s_barrier()
#define PG8_SCHED __builtin_amdgcn_sched_barrier(0)
    Unit cur, nxt; int ui = 0;
    if (!S.next(0, cur)) return;
    f32x4 acc[2][2][4][2];
#pragma unroll
    for (int a = 0; a < 2; ++a)
#pragma unroll
        for (int b = 0; b < 2; ++b)
#pragma unroll
            for (int m = 0; m < 4; ++m)
#pragma unroll
                for (int n = 0; n < 2; ++n) acc[a][b][m][n] = (f32x4){0.f, 0.f, 0.f, 0.f};
    bf16x8 At[4][2], B0[2][2], B1[2][2];
    const char* cA = (const char*)g.A + (size_t)cur.pm * tstep; const char* cB = (const char*)g.Bt + (size_t)cur.pn * tstep;
    S.a_ready(cur);
    PG8_STAGE(PG8_SB(0, 0), cB, voffB); PG8_STAGE(PG8_SA(0, 0), cA, voffA); PG8_STAGE(PG8_SB(0, 1), cB + hstep, voffB); PG8_STAGE(PG8_SA(0, 1), cA + hstep, voffA);
    if (wr == 1) PG8_BAR;
    PG8_WAIT_V(4); PG8_BAR;
    PG8_STAGE(PG8_SB(1, 0), cB + kstep, voffB); PG8_STAGE(PG8_SA(1, 0), cA + kstep, voffA); PG8_STAGE(PG8_SB(1, 1), cB + hstep + kstep, voffB);
    PG8_WAIT_V(6); PG8_BAR;
    for (;;) {
        const bool has_next = S.next(ui + 1, nxt);
        const char* nA = has_next ? (const char*)g.A + (size_t)nxt.pm * tstep : cA; const char* nB = has_next ? (const char*)g.Bt + (size_t)nxt.pn * tstep : cB;
        for (int t = 0; t < nt; t += 2) {
            const bool last = (t == nt - 2);
            const char* a1 = cA + (size_t)(t + 1) * kstep;
            const char* a2 = last ? nA : cA + (size_t)(t + 2) * kstep; const char* b2 = last ? nB : cB + (size_t)(t + 2) * kstep;
            const char* a3 = a2 + kstep; const char* b3 = b2 + kstep;
            if (last && has_next) S.a_ready(nxt);
            PG8_LDB(B0, 0, 0); PG8_SCHED; PG8_LDA(At, 0, 0); PG8_STAGE(PG8_SA(1, 1), a1 + hstep, voffA);
            PG8_WAIT_L(8); PG8_BAR; PG8_WAIT_L(0); PG8_MMA(0, 0, At, B0); PG8_BAR; PG8_SCHED;
            PG8_LDB(B1, 0, 1); PG8_STAGE(PG8_SB(0, 0), b2, voffB);
            PG8_BAR; PG8_WAIT_L(0); PG8_MMA(0, 1, At, B1); PG8_BAR;
            PG8_LDA(At, 0, 1); PG8_STAGE(PG8_SA(0, 0), a2, voffA);
            PG8_BAR; PG8_WAIT_L(0); PG8_MMA(1, 0, At, B0); PG8_BAR; PG8_SCHED;
            PG8_STAGE(PG8_SB(0, 1), b2 + hstep, voffB);
            PG8_WAIT_V(6); PG8_BAR; PG8_MMA(1, 1, At, B1); PG8_BAR;
            PG8_LDB(B0, 1, 0); PG8_SCHED; PG8_LDA(At, 1, 0); PG8_STAGE(PG8_SA(0, 1), a2 + hstep, voffA);
            PG8_WAIT_L(8); PG8_BAR; PG8_WAIT_L(0); PG8_MMA(0, 0, At, B0); PG8_BAR; PG8_SCHED;
            PG8_LDB(B1, 1, 1); PG8_STAGE(PG8_SB(1, 0), b3, voffB);
            PG8_BAR; PG8_WAIT_L(0); PG8_MMA(0, 1, At, B1); PG8_BAR;
            PG8_LDA(At, 1, 1); PG8_STAGE(PG8_SA(1, 0), a3, voffA);
            PG8_BAR; PG8_WAIT_L(0); PG8_MMA(1, 0, At, B0); PG8_BAR; PG8_SCHED;
            PG8_STAGE(PG8_SB(1, 1), b3 + hstep, voffB);
            PG8_WAIT_V(6); PG8_BAR; PG8_MMA(1, 1, At, B1); PG8_BAR;
        }
        if constexpr (!Epi::AFTER_DRAIN) { E(acc, cur, wr, wc, fr, fq); S.done(cur); }
        if (!has_next) break;
#pragma unroll
        for (int a = 0; a < 2; ++a)
#pragma unroll
            for (int b = 0; b < 2; ++b)
#pragma unroll
                for (int m = 0; m < 4; ++m)
#pragma unroll
                    for (int n = 0; n < 2; ++n) acc[a][b][m][n] = (f32x4){0.f, 0.f, 0.f, 0.f};
        cur = nxt; cA = nA; cB = nB; ++ui;
    }
    PG8_WAIT_V(0);
    if (wr == 0) PG8_BAR;
    PG8_BAR;
    if constexpr (Epi::AFTER_DRAIN) { E.fused(acc, cur, wr, wc, fr, fq, lds, wid, lane); S.done(cur); }
#undef PG8_SA
#undef PG8_SB
#undef PG8_STAGE
#undef PG8_LDA
#undef PG8_LDB
#undef PG8_MMA
#undef PG8_WAIT_V
#undef PG8_WAIT_L
#undef PG8_BAR
#undef PG8_SCHED
}
}


struct KArgs { const float* in[23]; float* out; unsigned char* ws; int ph_lo, ph_hi; };
struct Ctx {
    const float* in[23]; float* out; unsigned char* ws; LAS unsigned char* lds; int G, bid, tid, lane, w;
    __device__ __forceinline__ bf16_t* wb(size_t off) const { return (bf16_t*)(ws + off); }
    __device__ __forceinline__ float* wf(size_t off) const { return (float*)(ws + off); }
};

template <bool PERMQK = false>
__device__ __forceinline__ void tconv(const Ctx& c, const float* __restrict__ src, int K, int N, bf16_t* __restrict__ dst) {
    LAS float* tile = (LAS float*)c.lds;
    const int NT = N >> 6, total = (K >> 6) * NT, ngroups = (total + 3) >> 2;
    const int r = c.tid >> 4, c4 = (c.tid & 15) * 4, n = c.tid >> 3, kc = (c.tid & 7) * 8;
    for (int gidx = c.bid; gidx < ngroups; gidx += c.G) {
        f32x4 v[4][2];
#pragma unroll
        for (int q = 0; q < 4; ++q) {
            const int t = gidx * 4 + q;
            if (t < total) { const int kt = t / NT, nt = t - kt * NT;
#pragma unroll
                for (int i = 0; i < 2; ++i) v[q][i] = *(const f32x4*)(src + (size_t)(kt * 64 + r + 32 * i) * N + nt * 64 + c4); }
        }
#pragma unroll
        for (int q = 0; q < 4; ++q)
            if (gidx * 4 + q < total) {
#pragma unroll
                for (int i = 0; i < 2; ++i) { LAS float* p = tile + q * (64 * 65) + (r + 32 * i) * 65 + c4; p[0] = v[q][i][0]; p[1] = v[q][i][1]; p[2] = v[q][i][2]; p[3] = v[q][i][3]; }
            }
        __syncthreads();
#pragma unroll
        for (int q = 0; q < 4; ++q) {
            const int t = gidx * 4 + q;
            if (t < total) {
                const int kt = t / NT, nt = t - kt * NT;
                float f[8];
#pragma unroll
                for (int j = 0; j < 8; ++j) f[j] = tile[q * (64 * 65) + (kc + j) * 65 + n];
                u32x4 o; o.x = cvt_pk_bf16(f[0], f[1]); o.y = cvt_pk_bf16(f[2], f[3]); o.z = cvt_pk_bf16(f[4], f[5]); o.w = cvt_pk_bf16(f[6], f[7]);
                int drow = nt * 64 + n;
                if (PERMQK && drow >= 1024 && drow < 3072) { const int d = drow & 127; drow = (drow & ~127) + 32 * (2 * (d >> 6) + ((d >> 4) & 1)) + 16 * ((d >> 5) & 1) + (d & 15); }
                *(u32x4*)(dst + (size_t)drow * K + kt * 64 + kc) = o;
            }
        }
        __syncthreads();
    }
}
__device__ __forceinline__ void conv_bf16(const Ctx& c, const float* __restrict__ src, bf16_t* __restrict__ dst, size_t n) {
    const size_t nch = n >> 3;
    for (size_t i = (size_t)c.bid * 512 + c.tid; i < nch; i += (size_t)c.G * 512) {
        const f32x4 a = *(const f32x4*)(src + i * 8), b = *(const f32x4*)(src + i * 8 + 4);
        u32x4 o; o.x = cvt_pk_bf16(a[0], a[1]); o.y = cvt_pk_bf16(a[2], a[3]); o.z = cvt_pk_bf16(b[0], b[1]); o.w = cvt_pk_bf16(b[2], b[3]);
        *(u32x4*)(dst + i * 8) = o;
    }
}
__device__ __forceinline__ unsigned enc_fp6(float v) {
    const float a = fminf(fabsf(v), 7.5f);
    float q;
    if (a < 2.0f) q = rintf(a * 8.0f);
    else if (a < 4.0f) q = 16.0f + rintf((a - 2.0f) * 4.0f);
    else q = 24.0f + rintf((a - 4.0f) * 2.0f);
    unsigned c = (unsigned)q; c = c > 31u ? 31u : c;
    return c | (v < 0.f ? 32u : 0u);
}
__device__ __forceinline__ void conv_fp6(const Ctx& c, const float* __restrict__ src, unsigned char* __restrict__ dst, int rows, float scale) {
    const size_t ngroups = (size_t)rows * 64;
    for (size_t gi = (size_t)c.bid * 512 + c.tid; gi < ngroups; gi += (size_t)c.G * 512) {
        const size_t row = gi >> 6; const int l = (int)(gi & 63);
        const float* sp = src + row * 2048 + l * 32;
        unsigned w[6] = {0u, 0u, 0u, 0u, 0u, 0u};
#pragma unroll
        for (int q = 0; q < 8; ++q) {
            const f32x4 v = *(const f32x4*)(sp + q * 4);
#pragma unroll
            for (int e = 0; e < 4; ++e) {
                const int k = q * 4 + e, pos = 6 * k, d = pos >> 5, sh = pos & 31;
                const unsigned code = enc_fp6(v[e] * scale);
                w[d] |= code << sh;
                if (sh > 26) w[d + 1] |= code >> (32 - sh);
            }
        }
        unsigned char* dp = dst + row * 1536 + l * 8;
        *(u32x2*)(dp) = (u32x2){w[0], w[1]}; *(u32x2*)(dp + 512) = (u32x2){w[2], w[3]}; *(u32x2*)(dp + 1024) = (u32x2){w[4], w[5]};
    }
}
__device__ __forceinline__ unsigned enc_fp4(float v) {
    const float a = fabsf(v);
    unsigned c;
    if (a < 2.0f) c = (unsigned)rintf(a * 2.0f);
    else if (a < 4.0f) c = 4u + (unsigned)rintf((a - 2.0f));
    else c = a < 5.0f ? 6u : 7u;
    return c | (v < 0.f ? 8u : 0u);
}
__device__ __forceinline__ void conv_fp4(const Ctx& c, const float* __restrict__ src, unsigned char* __restrict__ dst, int rows, float scale, int part, int nparts) {
    for (int row = part * 8 + c.w; row < rows; row += nparts * 8) {
        const float* sp = src + (size_t)row * 2048 + c.lane * 8;
        f32x4 v[4][2];
#pragma unroll
        for (int q = 0; q < 4; ++q) { v[q][0] = *(const f32x4*)(sp + q * 512); v[q][1] = *(const f32x4*)(sp + q * 512 + 4); }
#pragma unroll
        for (int q = 0; q < 4; ++q) {
            unsigned h = 0u;
#pragma unroll
            for (int e = 0; e < 4; ++e) h |= (enc_fp4(v[q][0][e] * scale) << (4 * e)) | (enc_fp4(v[q][1][e] * scale) << (16 + 4 * e));
            *(unsigned*)(dst + (size_t)row * 1024 + q * 256 + c.lane * 4) = h;
        }
    }
}
__device__ __forceinline__ void conv_fp8(const Ctx& c, const float* __restrict__ src, unsigned char* __restrict__ dst, size_t n, float scale) {
    const size_t nch = n >> 4;
    for (size_t i = (size_t)c.bid * 512 + c.tid; i < nch; i += (size_t)c.G * 512) {
        u32x4 o;
#pragma unroll
        for (int q = 0; q < 4; ++q) {
            const f32x4 a = *(const f32x4*)(src + i * 16 + q * 4);
            int w = 0;
            w = __builtin_amdgcn_cvt_pk_fp8_f32(a[0] * scale, a[1] * scale, w, false);
            w = __builtin_amdgcn_cvt_pk_fp8_f32(a[2] * scale, a[3] * scale, w, true);
            o[q] = (unsigned)w;
        }
        *(u32x4*)(dst + i * 16) = o;
    }
}
__device__ __forceinline__ void phase_prologue(const Ctx& c) {
    tconv<true>(c, c.in[8], 2048, 6144, c.wb(WS_WINE));
    tconv(c, c.in[10], 2048, 2048, c.wb(WS_WOUTE));
    tconv(c, c.in[11], 2048, 2112, c.wb(WS_WINO));
    tconv(c, c.in[15], 512, 1536, c.wb(WS_WUQ));
    tconv(c, c.in[16], 256, 2048, c.wb(WS_WUKV));
    tconv(c, c.in[17], 2048, 2048, c.wb(WS_WOUTO));
    tconv(c, c.in[18], 2048, 2048, c.wb(WS_WQ0));
    tconv(c, c.in[18] + (size_t)2048 * 2048, 2048, 2048, c.wb(WS_WQ1));
    {
        u32x4* p = (u32x4*)(c.wb(WS_WINO) + (size_t)2112 * 2048);
        for (int i = c.bid * 512 + c.tid; i < 192 * 2048 / 8; i += c.G * 512) p[i] = (u32x4){0u, 0u, 0u, 0u};
    }
    conv_bf16(c, c.in[19], c.wb(WS_SKB), (size_t)2 * 16 * 128 * 128);
    {
        const int two = 2 * 32 * 6 - c.G; const bool split = two > 0 && two < c.G; const int r0 = split ? 12288 : 16384;
        conv_fp4(c, c.in[20], c.ws + WS_TABU, r0, U_SCALE, c.bid, c.G);
        conv_fp4(c, c.in[21], c.ws + WS_TABV, r0, V_SCALE, c.bid, c.G);
        if (split && c.bid >= two) {
            conv_fp4(c, c.in[20] + (size_t)r0 * 2048, c.ws + WS_TABU + (size_t)r0 * 1024, 16384 - r0, U_SCALE, c.bid - two, c.G - two);
            conv_fp4(c, c.in[21] + (size_t)r0 * 2048, c.ws + WS_TABV + (size_t)r0 * 1024, 16384 - r0, V_SCALE, c.bid - two, c.G - two);
        }
    }
    const int gt = c.bid * 512 + c.tid, gn = c.G * 512;
    {
        f32x2* r128 = (f32x2*)(c.ws + WS_ROPE); f32x2* r64 = (f32x2*)(c.ws + WS_ROPE + 131072);
        for (int i = gt; i < 256 * 32; i += gn) {
            const int pos = i >> 5, f = i & 31;
            const float inv = exp2f(-(float)f * (13.287712379549449f / 32.0f));
            const float rev = (float)pos * inv * 0.15915494309189535f; const float fr = rev - floorf(rev);
            r128[i] = (f32x2){cos_rev(fr), sin_rev(fr)};
        }
        for (int i = gt; i < 256 * 16; i += gn) {
            const int pos = i >> 4, f = i & 15;
            const float inv = exp2f(-(float)f * (13.287712379549449f / 16.0f));
            const float rev = (float)pos * inv * 0.15915494309189535f; const float fr = rev - floorf(rev);
            r64[i] = (f32x2){cos_rev(fr), sin_rev(fr)};
        }
    }
    {
        bf16_t* MC = c.wb(WS_DFT); bf16_t* M1 = c.wb(WS_DFT + 262144); bf16_t* M2 = c.wb(WS_DFT + 393216); bf16_t* MCX = c.wb(WS_DFT + 458752);
        for (int i = gt; i < 512 * 256; i += gn) {
            const int n = i >> 8, k = i & 255, m = n & 255; const float fr = (float)((m * k) & 255) * (1.0f / 256.0f);
            const float v = (n < 256 ? cos_rev(fr) : -sin_rev(fr)) * 0.0625f;
            MC[i] = (bf16_t)(cvt_pk_bf16(v, 0.f) & 0xffffu);
        }
        for (int i = gt; i < 256 * 256; i += gn) {
            const int j = i >> 8, kk = i & 255, ka = j >> 1, ro = j & 1, ri = kk >> 7, nh = kk & 127;
            const float fr = (float)((ka * nh) & 127) * (1.0f / 128.0f); const float cc = cos_rev(fr), ss = sin_rev(fr);
            const float v = (ro == ri ? cc : (ro == 0 ? ss : -ss)) * 0.08838834764831845f;
            M1[i] = (bf16_t)(cvt_pk_bf16(v, 0.f) & 0xffffu);
        }
        for (int i = gt; i < 128 * 256; i += gn) {
            const int kb = i >> 8, kk = i & 255, ri = kk >> 7, nl = kk & 127;
            const float fr = (float)((kb * nl) & 127) * (1.0f / 128.0f);
            const float v = (ri == 0 ? cos_rev(fr) : sin_rev(fr)) * 0.08838834764831845f;
            M2[i] = (bf16_t)(cvt_pk_bf16(v, 0.f) & 0xffffu);
        }
        for (int i = gt; i < 256 * 512; i += gn) {
            const int k = i >> 9, kk = i & 511, ri = kk >> 8, n = kk & 255;
            const float fr = (float)((k * n) & 255) * (1.0f / 256.0f);
            const float v = (ri == 0 ? cos_rev(fr) : sin_rev(fr)) * 0.0625f;
            MCX[i] = (bf16_t)(cvt_pk_bf16(v, 0.f) & 0xffffu);
        }
    }
    {
        const float* cvec = c.in[1]; const float* cctx = c.in[3]; const float* wmod = c.in[4];
        float* modp = c.wf(WS_MODP);
        for (int u = c.bid; u < 2 * 32 * 6; u += c.G) {
            const int l = u / 192, r = u - l * 192, kc = r / 6, nb = r - kc * 6;
            const int n = nb * 2048 + c.tid * 4;
            f32x4 a0 = {0.f, 0.f, 0.f, 0.f}, a1 = a0, a2 = a0;
            const float* wp = wmod + ((size_t)l * 2048 + kc * 64) * 12288 + n;
#pragma unroll 8
            for (int k = 0; k < 64; ++k) {
                const int kk = kc * 64 + k;
                const f32x4 wv = *(const f32x4*)(wp + (size_t)k * 12288);
                const float s0 = silu_f(cvec[kk]), s1 = silu_f(cvec[2048 + kk]), s2 = silu_f(cctx[kk]);
                a0 += wv * s0; a1 += wv * s1; a2 += wv * s2;
            }
            float* o = modp + ((size_t)(kc * 2 + l) * 3) * 12288 + n;
            *(f32x4*)(o) = a0; *(f32x4*)(o + 12288) = a1; *(f32x4*)(o + 2 * 12288) = a2;
        }
    }
}
__device__ __forceinline__ void phase_mods(const Ctx& c) {
    const float* modp = c.wf(WS_MODP); float* mods = c.wf(WS_MODS); const float* bmod = c.in[5];
    for (int i = c.bid * 512 + c.tid; i < 2 * 3 * 12288; i += c.G * 512) {
        const int l = i / 36864, r = i - l * 36864, n = r % 12288;
        float s = bmod[l * 12288 + n];
        for (int kc = 0; kc < 32; ++kc) s += modp[(size_t)(kc * 2 + l) * 36864 + r];
        mods[i] = s;
    }
}
__device__ __forceinline__ void phase_modnorm(const Ctx& c, int layer, int which, const float* __restrict__ xlat, const float* __restrict__ xctx, int tok_lo, bf16_t* __restrict__ H) {
    const float* mods = c.wf(WS_MODS); const float* nw = c.in[6 + which] + layer * D;
    for (int tok = tok_lo + c.bid * 8 + c.w; tok < TT; tok += c.G * 8) {
        const float* src = tok < TC ? xctx + (size_t)tok * D : xlat + (size_t)(tok - TC) * D;
        const int mw = tok < TC ? 2 : ((tok - TC) >> 14);
        const float* mb = mods + (size_t)(layer * 3 + mw) * 12288 + which * 3 * 2048;
        f32x4 v[8]; float ss = 0.f;
#pragma unroll
        for (int i = 0; i < 8; ++i) { v[i] = *(const f32x4*)(src + i * 256 + c.lane * 4); ss += v[i][0] * v[i][0] + v[i][1] * v[i][1] + v[i][2] * v[i][2] + v[i][3] * v[i][3]; }
        ss = wave_sum(ss);
        const float rstd = rsqrtf(ss * (1.0f / D) + EPS);
#pragma unroll
        for (int i = 0; i < 8; ++i) {
            const int col = i * 256 + c.lane * 4;
            const f32x4 g = *(const f32x4*)(nw + col), sh = *(const f32x4*)(mb + col), sc = *(const f32x4*)(mb + 2048 + col);
            f32x4 o;
#pragma unroll
            for (int j = 0; j < 4; ++j) o[j] = v[i][j] * rstd * g[j] * (1.0f + sc[j]) + sh[j];
            *(u32x2*)(H + (size_t)tok * D + col) = pack4(o);
        }
    }
}

__device__ __forceinline__ void phase_even_proj(const Ctx& c) {
    const bf16_t* H = c.wb(WS_H); const bf16_t* W = c.wb(WS_WINE);
    bf16_t* F = c.wb(WS_A); bf16_t* Q = c.wb(WS_Q); bf16_t* Kb = c.wb(WS_K); bf16_t* V = c.wb(WS_V); bf16_t* Gt = c.wb(WS_G);
    const f32x2* r128 = (const f32x2*)(c.ws + WS_ROPE);
    const int MT = TT / 128, NT = 6144 / 128;
    const int g = c.lane >> 4, wm = c.w >> 1, wn = c.w & 1;
    for (int t = c.bid; t < MT * NT; t += c.G) {
        int mt, nt; tile_mn(t, MT, NT, mt, nt);
        f32x4 acc[2][4];
        gemm128<true>(c.lds, 2048, RowLin{H + (size_t)mt * 128 * D, (size_t)D}, RowLin{W + (size_t)nt * 128 * 2048, 2048}, acc);
        const int region = nt >> 3, cr0 = (nt & 7) * 128 + 64 * wn + 4 * g;
#pragma unroll
        for (int mb = 0; mb < 2; ++mb) {
            const int tok = mt * 128 + 32 * wm + 16 * mb + (c.lane & 15);
            if (region == 0) {
#pragma unroll
                for (int nb = 0; nb < 4; ++nb) *(u32x2*)(F + (size_t)tok * 1024 + cr0 + 16 * nb) = pack4(acc[mb][nb]);
            } else if (region == 1 || region == 2) {
                bf16_t* dst = (region == 1 ? Q : Kb) + (size_t)tok * 1024 + cr0;
                const float sc = region == 2 ? 0.08838834764831845f : 1.0f;
                if (tok >= TC) {
                    const int s = (tok - TC) & (SEQ - 1); const int pos = wn == 0 ? (s >> 6) : (s & 63);
#pragma unroll
                    for (int nb = 0; nb < 2; ++nb) {
                        f32x4 o1, o2;
#pragma unroll
                        for (int r = 0; r < 4; ++r) {
                            const f32x2 cs = r128[pos * 32 + 16 * nb + 4 * g + r];
                            const float a = acc[mb][nb][r] * sc, b = acc[mb][nb + 2][r] * sc;
                            o1[r] = a * cs.x - b * cs.y; o2[r] = b * cs.x + a * cs.y;
                        }
                        *(u32x2*)(dst + 16 * nb) = pack4(o1); *(u32x2*)(dst + 16 * (nb + 2)) = pack4(o2);
                    }
                } else {
#pragma unroll
                    for (int nb = 0; nb < 4; ++nb) *(u32x2*)(dst + 16 * nb) = pack4(acc[mb][nb] * sc);
                }
            } else if (region == 3) {
#pragma unroll
                for (int nb = 0; nb < 4; ++nb) *(u32x2*)(V + (size_t)tok * 1024 + cr0 + 16 * nb) = pack4(acc[mb][nb]);
            } else {
#pragma unroll
                for (int nb = 0; nb < 4; ++nb) {
                    f32x4 o;
#pragma unroll
                    for (int r = 0; r < 4; ++r) o[r] = silu_f(acc[mb][nb][r]);
                    *(u32x2*)(Gt + (size_t)tok * 2048 + (region - 4) * 1024 + cr0 + 16 * nb) = pack4(o);
                }
            }
        }
    }
}
constexpr int FS = 528, F_B = 128 * FS;
template <class RF>
__device__ __forceinline__ void ftile_issue(u32x4 (&r)[8], const RF& row, int tid) {
#pragma unroll
    for (int i = 0; i < 8; ++i) r[i] = *(const u32x4*)(row((tid >> 5) + 16 * i) + (tid & 31) * 8);
}
__device__ __forceinline__ void ftile_write(LAS unsigned char* dst, const u32x4 (&r)[8], int tid) {
#pragma unroll
    for (int i = 0; i < 8; ++i) *(LAS u32x4*)(dst + ((tid >> 5) + 16 * i) * FS + (tid & 31) * 16) = r[i];
}
__device__ __forceinline__ void ftile_mma(LAS unsigned char* lds, f32x4 (&acc)[2][4], int lane, int wm, int wn) {
#pragma unroll
    for (int mb = 0; mb < 2; ++mb)
#pragma unroll
        for (int nb = 0; nb < 4; ++nb) acc[mb][nb] = (f32x4){0.f, 0.f, 0.f, 0.f};
    const int aoff = (32 * wm + (lane & 15)) * FS + (lane >> 4) * 16;
    const int boff = F_B + (64 * wn + (lane & 15)) * FS + (lane >> 4) * 16;
#pragma unroll
    for (int ks = 0; ks < 8; ++ks) {
        bf16x8 af[2], bfr[4];
#pragma unroll
        for (int mb = 0; mb < 2; ++mb) af[mb] = *(const LAS bf16x8*)(lds + aoff + mb * (16 * FS) + ks * 64);
#pragma unroll
        for (int nb = 0; nb < 4; ++nb) bfr[nb] = *(const LAS bf16x8*)(lds + boff + nb * (16 * FS) + ks * 64);
#pragma unroll
        for (int mb = 0; mb < 2; ++mb)
#pragma unroll
            for (int nb = 0; nb < 4; ++nb) acc[mb][nb] = __builtin_amdgcn_mfma_f32_16x16x32_bf16(af[mb], bfr[nb], acc[mb][nb], 0, 0, 0);
    }
}
struct RowStr { const bf16_t* base; size_t pitch; __device__ __forceinline__ const bf16_t* operator()(int r) const { return base + (size_t)r * pitch; } };
__device__ __forceinline__ void phase_chan_dft(const Ctx& c) {
    const bf16_t* F = c.wb(WS_A); const bf16_t* MC = c.wb(WS_DFT);
    bf16_t* Zt = c.wb(WS_ST); bf16_t* Ztc = c.wb(WS_ST + 128 * MiB);
    const int g4 = c.lane >> 4, wm = c.w >> 1, wn = c.w & 1;
    LAS unsigned char* la = c.lds; LAS unsigned char* lb = c.lds + F_B;
    constexpr int NUL = 2 * 4 * 128;
    u32x4 ra[8], rb[8];
    if (c.bid < NUL) {
        const int grp = c.bid & 3, nlo = (c.bid >> 2) & 127, b = c.bid >> 9;
        ftile_issue(ra, RowStr{F + ((size_t)(TC + b * SEQ + nlo)) * 1024 + grp * 256, (size_t)128 * 1024}, c.tid);
        ftile_issue(rb, RowLin{MC, 256}, c.tid);
        ftile_write(la, ra, c.tid); ftile_write(lb, rb, c.tid);
    }
    __syncthreads();
    for (int u = c.bid; u < NUL; u += c.G) {
        const int grp = u & 3, nlo = (u >> 2) & 127, b = u >> 9;
        const bool nxu = u + c.G < NUL;
#pragma unroll 1
        for (int nt = 0; nt < 4; ++nt) {
            if (nt < 3) ftile_issue(rb, RowLin{MC + (size_t)(nt + 1) * 128 * 256, 256}, c.tid);
            else if (nxu) {
                const int un = u + c.G, gn = un & 3, nn = (un >> 2) & 127, bn = un >> 9;
                ftile_issue(ra, RowStr{F + ((size_t)(TC + bn * SEQ + nn)) * 1024 + gn * 256, (size_t)128 * 1024}, c.tid);
                ftile_issue(rb, RowLin{MC, 256}, c.tid);
            }
            __builtin_amdgcn_sched_barrier(0);
            f32x4 acc[2][4];
            ftile_mma(c.lds, acc, c.lane, wm, wn);
#pragma unroll
            for (int mb = 0; mb < 2; ++mb)
#pragma unroll
                for (int nb = 0; nb < 4; ++nb) {
                    const int n = nt * 128 + 64 * wn + 16 * nb + (c.lane & 15), reim = n >> 8, m = n & 255, nhi = 32 * wm + 16 * mb + 4 * g4;
                    *(u32x2*)(Zt + ((((size_t)(b * 4 + grp) * 256 + m) * 128 + nlo) * 2 + reim) * 128 + nhi) = pack4(acc[mb][nb]);
                }
            __syncthreads();
            if (nt < 3) ftile_write(lb, rb, c.tid);
            else if (nxu) { ftile_write(la, ra, c.tid); ftile_write(lb, rb, c.tid); }
            __syncthreads();
        }
    }
    for (int v = c.bid; v < 64; v += c.G) {
        f32x4 acc[2][4];
        const int nt = v & 3, rt = (v >> 2) & 1, grp = (v >> 3) & 3, b = v >> 5;
        gemm128s<false, 256>(c.lds, RowLin{F + ((size_t)(b * NCTX + rt * 128)) * 1024 + grp * 256, 1024}, RowLin{MC + (size_t)nt * 128 * 256, 256}, acc);
#pragma unroll
        for (int mb = 0; mb < 2; ++mb)
#pragma unroll
            for (int nb = 0; nb < 4; ++nb) {
                const int n = nt * 128 + 64 * wn + 16 * nb + (c.lane & 15), reim = n >> 8, m = n & 255, nn = rt * 128 + 32 * wm + 16 * mb + 4 * g4;
                *(u32x2*)(Ztc + (((size_t)(b * 4 + grp) * 256 + m) * 2 + reim) * 256 + nn) = pack4(acc[mb][nb]);
            }
    }
}
__device__ __forceinline__ void phase_dft_stage1(const Ctx& c) {
    const bf16_t* Zt = c.wb(WS_ST); const bf16_t* Ztc = c.wb(WS_ST + 128 * MiB);
    const bf16_t* M1 = c.wb(WS_DFT + 262144); const bf16_t* MCX = c.wb(WS_DFT + 458752);
    bf16_t* Tp = c.wb(WS_H); bf16_t* CAT = c.wb(WS_CAT);
    const int g4 = c.lane >> 4, wm = c.w >> 1, wn = c.w & 1;
    LAS unsigned char* la = c.lds; LAS unsigned char* lb = c.lds + F_B;
    constexpr int NUL = 2048;
    u32x4 ra[8], rb[8];
    if (c.bid < NUL) {
        ftile_issue(ra, RowLin{Zt + (size_t)c.bid * 128 * 256, 256}, c.tid); ftile_issue(rb, RowLin{M1, 256}, c.tid);
        ftile_write(la, ra, c.tid); ftile_write(lb, rb, c.tid);
    }
    __syncthreads();
    for (int rt = c.bid; rt < NUL; rt += c.G) {
        const int bg = rt >> 8, m = rt & 255;
        const bool nxu = rt + c.G < NUL;
#pragma unroll 1
        for (int nt = 0; nt < 2; ++nt) {
            if (nt < 1) ftile_issue(rb, RowLin{M1 + (size_t)(nt + 1) * 128 * 256, 256}, c.tid);
            else if (nxu) { ftile_issue(ra, RowLin{Zt + (size_t)(rt + c.G) * 128 * 256, 256}, c.tid); ftile_issue(rb, RowLin{M1, 256}, c.tid); }
            __builtin_amdgcn_sched_barrier(0);
            f32x4 acc[2][4];
            ftile_mma(c.lds, acc, c.lane, wm, wn);
#pragma unroll
            for (int mb = 0; mb < 2; ++mb)
#pragma unroll
                for (int nb = 0; nb < 4; ++nb) {
                    const int j = nt * 128 + 64 * wn + 16 * nb + (c.lane & 15), ka = j >> 1, ro = j & 1, nlo0 = 32 * wm + 16 * mb + 4 * g4;
                    f32x4 o;
#pragma unroll
                    for (int r = 0; r < 4; ++r) {
                        const float mine = acc[mb][nb][r], other = __shfl_xor(mine, 1);
                        const float fr = (float)((ka * (nlo0 + r)) & 16383) * (1.0f / 16384.0f);
                        const float cc = cos_rev(fr), ss = sin_rev(fr);
                        o[r] = ro == 0 ? (mine * cc + other * ss) : (mine * cc - other * ss);
                    }
                    *(u32x2*)(Tp + ((((size_t)bg * 128 + ka) * 256 + m) * 2 + ro) * 128 + nlo0) = pack4(o);
                }
            __syncthreads();
            if (nt < 1) ftile_write(lb, rb, c.tid);
            else if (nxu) { ftile_write(la, ra, c.tid); ftile_write(lb, rb, c.tid); }
            __syncthreads();
        }
    }
    for (int v = c.bid; v < 32; v += c.G) {
        f32x4 acc[2][4];
        const int nt = v & 1, rt = v >> 1;
        gemm128s<false, 512>(c.lds, RowLin{Ztc + (size_t)rt * 128 * 512, 512}, RowLin{MCX + (size_t)nt * 128 * 512, 512}, acc);
        const int bg = rt >> 1, b = bg >> 2, grp = bg & 3, mh = rt & 1;
#pragma unroll
        for (int mb = 0; mb < 2; ++mb)
#pragma unroll
            for (int nb = 0; nb < 4; ++nb) {
                const int k = nt * 128 + 64 * wn + 16 * nb + (c.lane & 15), m0 = mh * 128 + 32 * wm + 16 * mb + 4 * g4;
                *(u32x2*)(CAT + (size_t)(b * NCTX + k) * 2048 + grp * 256 + m0) = pack4(acc[mb][nb]);
            }
    }
}
__device__ __forceinline__ void phase_dft_stage2(const Ctx& c) {
    const bf16_t* Tp = c.wb(WS_H); const bf16_t* M2 = c.wb(WS_DFT + 393216); bf16_t* CAT = c.wb(WS_CAT);
    const int g4 = c.lane >> 4, wm = c.w >> 1, wn = c.w & 1;
    LAS unsigned char* la = c.lds; LAS unsigned char* lb = c.lds + F_B;
    u32x4 ra[8];
    if (c.bid < 2048) {
        ftile_issue(ra, RowLin{M2, 256}, c.tid);
        ftile_write(lb, ra, c.tid);
        ftile_issue(ra, RowLin{Tp + (size_t)c.bid * 128 * 256, 256}, c.tid);
        ftile_write(la, ra, c.tid);
    }
    __syncthreads();
    for (int u = c.bid; u < 2048; u += c.G) {
        const bool nxu = u + c.G < 2048;
        if (nxu) ftile_issue(ra, RowLin{Tp + (size_t)(u + c.G) * 128 * 256, 256}, c.tid);
        __builtin_amdgcn_sched_barrier(0);
        f32x4 acc[2][4];
        ftile_mma(c.lds, acc, c.lane, wm, wn);
        const int mh = u & 1, ka = (u >> 1) & 127, bg = u >> 8, b = bg >> 2, grp = bg & 3;
#pragma unroll
        for (int mb = 0; mb < 2; ++mb)
#pragma unroll
            for (int nb = 0; nb < 4; ++nb) {
                const int kb = 64 * wn + 16 * nb + (c.lane & 15), m0 = mh * 128 + 32 * wm + 16 * mb + 4 * g4;
                *(u32x2*)(CAT + (size_t)(TC + b * SEQ + ka + 128 * kb) * 2048 + grp * 256 + m0) = pack4(acc[mb][nb]);
            }
        __syncthreads();
        if (nxu) ftile_write(la, ra, c.tid);
        __syncthreads();
    }
}

constexpr int TS = 272;
constexpr int TILE_B = 128 * TS;
constexpr int TSV = 288;
constexpr int TILE_BV = 128 * TSV;
__device__ __forceinline__ int chunk_tok0(int b, int cch) { return cch < 2 ? b * NCTX + cch * 128 : TC + b * SEQ + (cch - 2) * 128; }
template <int STRIDE = TS>
__device__ __forceinline__ void load_tile128(const Ctx& c, LAS unsigned char* dst, const bf16_t* src  , size_t pitch) {
#pragma unroll
    for (int i = 0; i < 4; ++i) {
        const int id = c.tid + 512 * i, row = id >> 4, ch = id & 15;
        *(LAS u32x4*)(dst + row * STRIDE + ch * 16) = *(const u32x4*)(src + (size_t)row * pitch + ch * 8);
    }
}
__device__ __forceinline__ void phase_ret_ds(const Ctx& c) {
    const bf16_t* Kb = c.wb(WS_K); const bf16_t* V = c.wb(WS_V); bf16_t* ST = c.wb(WS_ST);
    LAS unsigned char* kt = c.lds; LAS unsigned char* vf = c.lds + TILE_BV; LAS unsigned char* vb = c.lds + 2 * TILE_BV;
    const int g = c.lane >> 4, wm = c.w >> 1, wn = c.w & 1, d0 = 32 * wm, e0 = 64 * wn;
    u32x4 rk[4], rv[4];
    if (c.bid < NBATCH * 8 * NCH) {
        const int cch = c.bid % NCH, bh = c.bid / NCH; const size_t g0 = (size_t)chunk_tok0(bh >> 3, cch) * 1024 + (bh & 7) * 128;
#pragma unroll
        for (int i = 0; i < 4; ++i) { const int id = c.tid + 512 * i; const size_t go = g0 + (size_t)(id >> 4) * 1024 + (id & 15) * 8; rk[i] = *(const u32x4*)(Kb + go); rv[i] = *(const u32x4*)(V + go); }
    }
    for (int u = c.bid; u < NBATCH * 8 * NCH; u += c.G) {
        const int cch = u % NCH, bh = u / NCH, h = bh & 7, b = bh >> 3;
        const float lg = log2_gamma(h);
#pragma unroll
        for (int i = 0; i < 4; ++i) {
            const int id = c.tid + 512 * i, row = id >> 4, ch = id & 15;
            *(LAS u32x4*)(kt + row * TSV + ch * 16) = rk[i];
            const u32x4 v = rv[i];
            const float zf = fast_exp2(lg * (float)(127 - row)), zb = fast_exp2(lg * (float)row);
            u32x4 of, ob;
            of.x = cvt_pk_bf16(bf_lo(v.x) * zf, bf_hi(v.x) * zf); of.y = cvt_pk_bf16(bf_lo(v.y) * zf, bf_hi(v.y) * zf);
            of.z = cvt_pk_bf16(bf_lo(v.z) * zf, bf_hi(v.z) * zf); of.w = cvt_pk_bf16(bf_lo(v.w) * zf, bf_hi(v.w) * zf);
            ob.x = cvt_pk_bf16(bf_lo(v.x) * zb, bf_hi(v.x) * zb); ob.y = cvt_pk_bf16(bf_lo(v.y) * zb, bf_hi(v.y) * zb);
            ob.z = cvt_pk_bf16(bf_lo(v.z) * zb, bf_hi(v.z) * zb); ob.w = cvt_pk_bf16(bf_lo(v.w) * zb, bf_hi(v.w) * zb);
            *(LAS u32x4*)(vf + row * TSV + ch * 16) = of; *(LAS u32x4*)(vb + row * TSV + ch * 16) = ob;
        }
        __syncthreads();
        if (u + c.G < NBATCH * 8 * NCH) {
            const int un = u + c.G, cn = un % NCH, bn = un / NCH; const size_t g0 = (size_t)chunk_tok0(bn >> 3, cn) * 1024 + (bn & 7) * 128;
#pragma unroll
            for (int i = 0; i < 4; ++i) { const int id = c.tid + 512 * i; const size_t go = g0 + (size_t)(id >> 4) * 1024 + (id & 15) * 8; rk[i] = *(const u32x4*)(Kb + go); rv[i] = *(const u32x4*)(V + go); }
        }
        __builtin_amdgcn_sched_barrier(0);
        f32x4 accf[2][4], accb[2][4];
#pragma unroll
        for (int mb = 0; mb < 2; ++mb)
#pragma unroll
            for (int nb = 0; nb < 4; ++nb) { accf[mb][nb] = (f32x4){0.f, 0.f, 0.f, 0.f}; accb[mb][nb] = (f32x4){0.f, 0.f, 0.f, 0.f}; }
#pragma unroll
        for (int ks = 0; ks < 4; ++ks) {
            const int j0 = 32 * ks + 8 * g;
            bf16x8 af[2];
#pragma unroll
            for (int mb = 0; mb < 2; ++mb)
                af[mb] = cat8(tr_read(kt + j0 * TSV + (d0 + 16 * mb) * 2, TSV, c.lane), tr_read(kt + (j0 + 4) * TSV + (d0 + 16 * mb) * 2, TSV, c.lane));
#pragma unroll
            for (int nb = 0; nb < 4; ++nb) {
                const bf16x8 bf = cat8(tr_read(vf + j0 * TSV + (e0 + 16 * nb) * 2, TSV, c.lane), tr_read(vf + (j0 + 4) * TSV + (e0 + 16 * nb) * 2, TSV, c.lane));
                const bf16x8 bb = cat8(tr_read(vb + j0 * TSV + (e0 + 16 * nb) * 2, TSV, c.lane), tr_read(vb + (j0 + 4) * TSV + (e0 + 16 * nb) * 2, TSV, c.lane));
#pragma unroll
                for (int mb = 0; mb < 2; ++mb) {
                    accf[mb][nb] = __builtin_amdgcn_mfma_f32_16x16x32_bf16(af[mb], bf, accf[mb][nb], 0, 0, 0);
                    accb[mb][nb] = __builtin_amdgcn_mfma_f32_16x16x32_bf16(af[mb], bb, accb[mb][nb], 0, 0, 0);
                }
            }
        }
        bf16_t* sf = ST + ((size_t)((0 * 2 + b) * 8 + h) * NCH + cch) * 16384;
        bf16_t* sb = ST + ((size_t)((1 * 2 + b) * 8 + h) * NCH + cch) * 16384;
#pragma unroll
        for (int mb = 0; mb < 2; ++mb)
#pragma unroll
            for (int nb = 0; nb < 4; ++nb) {
                const int e = e0 + 16 * nb + (c.lane & 15), d = d0 + 16 * mb + 4 * g;
                *(u32x2*)(sf + e * 128 + d) = pack4(accf[mb][nb]);
                *(u32x2*)(sb + e * 128 + d) = pack4(accb[mb][nb]);
            }
        __syncthreads();
    }
}
__device__ __forceinline__ void phase_ret_scan(const Ctx& c) {
    bf16_t* ST = c.wb(WS_ST);
    for (int gid = c.bid * 512 + c.tid; gid < 2 * 16 * 2048; gid += c.G * 512) {
        const int dir = gid >> 15, rem = gid & 32767, bh = rem >> 11, e8 = rem & 2047, h = bh & 7;
        bf16_t* base = ST + (size_t)(dir * 16 + bh) * NCH * 16384 + e8 * 8;
        const float decay = fast_exp2(log2_gamma(h) * 128.0f);
        float st[8];
#pragma unroll
        for (int j = 0; j < 8; ++j) st[j] = 0.f;
        for (int s0 = 0; s0 < NCH; s0 += 26) {
            u32x4 ds[26];
#pragma unroll
            for (int i = 0; i < 26; ++i) {
                const int s = s0 + i; const int cch = dir == 0 ? s : (s < 2 ? 1 - s : 131 - s);
                ds[i] = *(const u32x4*)(base + (size_t)cch * 16384);
            }
            __builtin_amdgcn_sched_barrier(0);
#pragma unroll
            for (int i = 0; i < 26; ++i) {
                const int s = s0 + i; const int cch = dir == 0 ? s : (s < 2 ? 1 - s : 131 - s);
                u32x4 o; o.x = cvt_pk_bf16(st[0], st[1]); o.y = cvt_pk_bf16(st[2], st[3]); o.z = cvt_pk_bf16(st[4], st[5]); o.w = cvt_pk_bf16(st[6], st[7]);
                *(u32x4*)(base + (size_t)cch * 16384) = o;
                st[0] = st[0] * decay + bf_lo(ds[i].x); st[1] = st[1] * decay + bf_hi(ds[i].x);
                st[2] = st[2] * decay + bf_lo(ds[i].y); st[3] = st[3] * decay + bf_hi(ds[i].y);
                st[4] = st[4] * decay + bf_lo(ds[i].z); st[5] = st[5] * decay + bf_hi(ds[i].z);
                st[6] = st[6] * decay + bf_lo(ds[i].w); st[7] = st[7] * decay + bf_hi(ds[i].w);
            }
        }
    }
}
__device__ __forceinline__ void phase_ret_out(const Ctx& c) {
    const bf16_t* Q = c.wb(WS_Q); const bf16_t* Kb = c.wb(WS_K); const bf16_t* V = c.wb(WS_V); const bf16_t* Gt = c.wb(WS_G);
    const bf16_t* ST = c.wb(WS_ST); bf16_t* CAT = c.wb(WS_CAT); const float* gn = c.in[9];
    LAS unsigned char* qt = c.lds; LAS unsigned char* kt = c.lds + TILE_B; LAS unsigned char* vt = c.lds + 2 * TILE_B;
    LAS unsigned char* pw = c.lds + 2 * TILE_B + TILE_BV + c.w * (16 * TS);
    LAS float* gws = (LAS float*)(c.lds + 2 * TILE_B + TILE_BV + 8 * (16 * TS));
    const int g = c.lane >> 4, il = c.lane & 15, i0 = 16 * c.w;
    for (int u = c.bid; u < NBATCH * 8 * NCH; u += c.G) {
        const int cch = u % NCH, bh = u / NCH, h = bh & 7, b = bh >> 3;
        const int tok0 = chunk_tok0(b, cch);
        const float lg = log2_gamma(h);
        const bf16_t* st0 = ST + ((size_t)((0 * 2 + b) * 8 + h) * NCH + cch) * 16384;
        u32x4 rq[4], rk[4], rv[4], rs[4];
#pragma unroll
        for (int i = 0; i < 4; ++i) {
            const int id = c.tid + 512 * i, row = id >> 4, ch = id & 15;
            const size_t go = (size_t)(tok0 + row) * 1024 + h * 128 + ch * 8;
            rq[i] = *(const u32x4*)(Q + go); rk[i] = *(const u32x4*)(Kb + go); rv[i] = *(const u32x4*)(V + go);
            rs[i] = *(const u32x4*)(st0 + row * 128 + ch * 8);
        }
        const float gwv = gn[h * 128 + (c.tid & 127)];
        __builtin_amdgcn_sched_barrier(0);
#pragma unroll
        for (int i = 0; i < 4; ++i) {
            const int id = c.tid + 512 * i, row = id >> 4, ch = id & 15;
            *(LAS u32x4*)(qt + row * TS + ch * 16) = rq[i]; *(LAS u32x4*)(kt + row * TS + ch * 16) = rk[i];
            *(LAS u32x4*)(vt + row * TSV + ch * 16) = rv[i];
        }
        if (c.tid < 128) gws[c.tid] = gwv;
        __syncthreads();
        f32x4 sT[8];
#pragma unroll
        for (int jb = 0; jb < 8; ++jb) sT[jb] = (f32x4){0.f, 0.f, 0.f, 0.f};
#pragma unroll 1
        for (int ks = 0; ks < 4; ++ks) {
            const bf16x8 qk = *(const LAS bf16x8*)(qt + (i0 + il) * TS + (32 * ks + 8 * g) * 2);
#pragma unroll
            for (int jb = 0; jb < 8; ++jb) {
                const bf16x8 kf = *(const LAS bf16x8*)(kt + (16 * jb + il) * TS + (32 * ks + 8 * g) * 2);
                sT[jb] = __builtin_amdgcn_mfma_f32_16x16x32_bf16(kf, qk, sT[jb], 0, 0, 0);
            }
        }
        __syncthreads();
        f32x4 ret[8];
#pragma unroll
        for (int eb = 0; eb < 8; ++eb) ret[eb] = (f32x4){0.f, 0.f, 0.f, 0.f};
        const int ii = i0 + il;
        const int tok = tok0 + ii;
#pragma unroll 1
        for (int dir = 0; dir < 2; ++dir) {
#pragma unroll
            for (int i = 0; i < 4; ++i) {
                const int id = c.tid + 512 * i, row = id >> 4, ch = id & 15;
                *(LAS u32x4*)(kt + row * TS + ch * 16) = rs[i];
            }
            if (dir == 0) {
                const bf16_t* st1 = ST + ((size_t)((1 * 2 + b) * 8 + h) * NCH + cch) * 16384;
#pragma unroll
                for (int i = 0; i < 4; ++i) {
                    const int id = c.tid + 512 * i, row = id >> 4, ch = id & 15;
                    rs[i] = *(const u32x4*)(st1 + row * 128 + ch * 8);
                }
            }
            u32x2 gg[8];
#pragma unroll
            for (int eb = 0; eb < 8; ++eb) gg[eb] = *(const u32x2*)(Gt + (size_t)tok * 2048 + dir * 1024 + h * 128 + 16 * eb + 4 * g);
            __builtin_amdgcn_sched_barrier(0);
#pragma unroll
            for (int jb = 0; jb < 8; ++jb) {
                f32x4 p;
#pragma unroll
                for (int r = 0; r < 4; ++r) {
                    const int j = 16 * jb + 4 * g + r; const int dl = dir == 0 ? ii - j : j - ii;
                    p[r] = dl >= 0 ? sT[jb][r] * fast_exp2(lg * (float)dl) : 0.f;
                }
                *(LAS u32x2*)(pw + il * TS + (16 * jb + 4 * g) * 2) = pack4(p);
            }
            __syncthreads();
            f32x4 o[8];
#pragma unroll
            for (int eb = 0; eb < 8; ++eb) o[eb] = (f32x4){0.f, 0.f, 0.f, 0.f};
#pragma unroll 1
            for (int ks = 0; ks < 4; ++ks) {
                const bf16x8 qk = *(const LAS bf16x8*)(qt + (i0 + il) * TS + (32 * ks + 8 * g) * 2);
#pragma unroll
                for (int eb = 0; eb < 8; ++eb) {
                    const bf16x8 sfr = *(const LAS bf16x8*)(kt + (16 * eb + il) * TS + (32 * ks + 8 * g) * 2);
                    o[eb] = __builtin_amdgcn_mfma_f32_16x16x32_bf16(sfr, qk, o[eb], 0, 0, 0);
                }
            }
            const float xi = dir == 0 ? fast_exp2(lg * (float)(ii + 1)) : fast_exp2(lg * (float)(128 - ii));
#pragma unroll
            for (int eb = 0; eb < 8; ++eb) o[eb] = o[eb] * xi;
#pragma unroll 1
            for (int ks = 0; ks < 4; ++ks) {
                const bf16x8 pf = *(const LAS bf16x8*)(pw + il * TS + (32 * ks + 8 * g) * 2);
                const int j0 = 32 * ks + 8 * g;
#pragma unroll
                for (int eb = 0; eb < 8; ++eb) {
                    const bf16x8 vfr = cat8(tr_read(vt + j0 * TSV + (16 * eb) * 2, TSV, c.lane), tr_read(vt + (j0 + 4) * TSV + (16 * eb) * 2, TSV, c.lane));
                    o[eb] = __builtin_amdgcn_mfma_f32_16x16x32_bf16(vfr, pf, o[eb], 0, 0, 0);
                }
            }
            float ss = 0.f;
#pragma unroll
            for (int eb = 0; eb < 8; ++eb) ss += o[eb][0] * o[eb][0] + o[eb][1] * o[eb][1] + o[eb][2] * o[eb][2] + o[eb][3] * o[eb][3];
            ss += __shfl_xor(ss, 16); ss += __shfl_xor(ss, 32);
            const float rstd = rsqrtf(ss * (1.0f / 128.0f) + EPS);
#pragma unroll
            for (int eb = 0; eb < 8; ++eb) {
                const f32x4 gw = *(const LAS f32x4*)(gws + 16 * eb + 4 * g);
                ret[eb][0] += o[eb][0] * rstd * gw[0] * bf_lo(gg[eb].x); ret[eb][1] += o[eb][1] * rstd * gw[1] * bf_hi(gg[eb].x);
                ret[eb][2] += o[eb][2] * rstd * gw[2] * bf_lo(gg[eb].y); ret[eb][3] += o[eb][3] * rstd * gw[3] * bf_hi(gg[eb].y);
            }
            __syncthreads();
        }
#pragma unroll
        for (int eb = 0; eb < 8; ++eb) *(u32x2*)(CAT + (size_t)tok * 2048 + 1024 + h * 128 + 16 * eb + 4 * g) = pack4(ret[eb]);
    }
}
__device__ __forceinline__ void phase_wout(const Ctx& c, const bf16_t* W, int layer, const float* xlat_old, const float* xctx_old, int mt_lo, int MTn) {
    const bf16_t* CAT = c.wb(WS_CAT); const float* mods = c.wf(WS_MODS); float* xctx_new = c.wf(WS_XCTX);
    const int NT = 16;
    const int g = c.lane >> 4, wm = c.w >> 1, wn = c.w & 1;
    for (int t = c.bid; t < MTn * NT; t += c.G) {
        int mt, nt; tile_mn(t, MTn, NT, mt, nt); mt += mt_lo;
        f32x4 acc[2][4];
#if DBG_CAT_PART == 0
        gemm128r<true>(c.lds, 2048, RowLin{CAT + (size_t)mt * 128 * 2048, 2048}, RowLin{W + (size_t)nt * 128 * 2048, 2048}, acc);
#else
        gemm128<true>(c.lds, 1024, RowLin{CAT + (size_t)mt * 128 * 2048 + (DBG_CAT_PART - 1) * 1024, 2048}, RowLin{W + (size_t)nt * 128 * 2048 + (DBG_CAT_PART - 1) * 1024, 2048}, acc);
#endif
#pragma unroll
        for (int mb = 0; mb < 2; ++mb) {
            const int tok = mt * 128 + 32 * wm + 16 * mb + (c.lane & 15);
            const int mw = tok < TC ? 2 : ((tok - TC) >> 14);
            const float* g1 = mods + (size_t)(layer * 3 + mw) * 12288 + 2 * 2048;
            const float* xo = tok < TC ? xctx_old + (size_t)tok * D : xlat_old + (size_t)(tok - TC) * D;
            float* xn = tok < TC ? xctx_new + (size_t)tok * D : c.out + (size_t)(tok - TC) * D;
#pragma unroll
            for (int nb = 0; nb < 4; ++nb) {
                const int col = nt * 128 + 64 * wn + 16 * nb + 4 * g;
                const f32x4 gv = *(const f32x4*)(g1 + col), xv = *(const f32x4*)(xo + col);
                *(f32x4*)(xn + col) = xv + gv * acc[mb][nb];
            }
        }
    }
}
__device__ __forceinline__ void phase_peer_q(const Ctx& c, const bf16_t* W, int mt_lo, int MTn) {
    const bf16_t* H = c.wb(WS_H); bf16_t* Qp = c.wb(WS_G);
    const int NT = 16;
    const int g = c.lane >> 4, wm = c.w >> 1, wn = c.w & 1;
    for (int t = c.bid; t < MTn * NT; t += c.G) {
        int mt, nt; tile_mn(t, MTn, NT, mt, nt); mt += mt_lo;
        f32x4 acc[2][4];
        gemm128r<true>(c.lds, 2048, RowLin{H + (size_t)mt * 128 * 2048, 2048}, RowLin{W + (size_t)nt * 128 * 2048, 2048}, acc);
#pragma unroll
        for (int mb = 0; mb < 2; ++mb) {
            const int tok = mt * 128 + 32 * wm + 16 * mb + (c.lane & 15);
#pragma unroll
            for (int nb = 0; nb < 4; ++nb) *(u32x2*)(Qp + (size_t)tok * 2048 + nt * 128 + 64 * wn + 16 * nb + 4 * g) = pack4(acc[mb][nb]);
        }
    }
}

__device__ __forceinline__ unsigned enc_key(float v) { const unsigned u = __float_as_uint(v); return (u & 0x80000000u) ? ~u : (u | 0x80000000u); }
__device__ __forceinline__ float dec_key(unsigned k) { return __uint_as_float((k & 0x80000000u) ? (k & 0x7fffffffu) : ~k); }
__device__ __forceinline__ void ins16(unsigned (&L)[16], unsigned x) {
#pragma unroll
    for (int i = 0; i < 16; ++i) { const unsigned hi = L[i] > x ? L[i] : x; x = L[i] > x ? x : L[i]; L[i] = hi; }
}
__device__ __forceinline__ void merge16(unsigned (&A)[16], const unsigned (&B)[16]) {
#pragma unroll
    for (int i = 0; i < 16; ++i) A[i] = A[i] > B[15 - i] ? A[i] : B[15 - i];
#pragma unroll
    for (int s = 8; s >= 1; s >>= 1) {
#pragma unroll
        for (int i = 0; i < 16; ++i)
            if ((i & s) == 0) { const unsigned x = A[i], y = A[i + s]; A[i] = x > y ? x : y; A[i + s] = x > y ? y : x; }
    }
}
__device__ __forceinline__ void sort16(unsigned (&A)[16]) {
#pragma unroll
    for (int k = 2; k <= 16; k <<= 1) {
#pragma unroll
        for (int j = k >> 1; j > 0; j >>= 1) {
#pragma unroll
            for (int i = 0; i < 16; ++i) {
                const int l = i ^ j;
                if (l > i) {
                    const unsigned x = A[i], y = A[l]; const unsigned hi = x > y ? x : y, lo = x > y ? y : x;
                    if ((i & k) == 0) { A[i] = hi; A[l] = lo; } else { A[i] = lo; A[l] = hi; }
                }
            }
        }
    }
}
__device__ __forceinline__ unsigned sel16(const unsigned (&L)[16], int a) {
    unsigned r = L[0];
#pragma unroll
    for (int i = 1; i < 16; ++i) r = (a == i) ? L[i] : r;
    return r;
}
__device__ __forceinline__ void topk_issue(const Ctx& c, u32x4 (&ra)[2][2][2], u32x4 (&rb)[2][2][2], const bf16_t* qbase, const bf16_t* kbase) {
    const int r0 = c.tid >> 3, ch = c.tid & 7;
#pragma unroll
    for (int p = 0; p < 2; ++p)
#pragma unroll
        for (int kt = 0; kt < 2; ++kt)
#pragma unroll
            for (int hf = 0; hf < 2; ++hf) {
                ra[p][kt][hf] = *(const u32x4*)(qbase + (size_t)(r0 + 64 * hf) * 2048 + p * 128 + kt * 64 + ch * 8);
                rb[p][kt][hf] = *(const u32x4*)(kbase + (size_t)p * 128 * 128 + (r0 + 64 * hf) * 128 + kt * 64 + ch * 8);
            }
}
__device__ __forceinline__ void topk_scores_pair(const Ctx& c, LAS float* S0, LAS float* S1, const u32x4 (&ra)[2][2][2], const u32x4 (&rb)[2][2][2]) {
    const int lane = c.lane, g = lane >> 4, wm = c.w >> 1, wn = c.w & 1;
    const int r0 = c.tid >> 3, ch = c.tid & 7, woff = r0 * 144 + ch * 16;
    const int aoff = (32 * wm + (lane & 15)) * 144 + (lane >> 4) * 16;
    const int boff = 36864 + (64 * wn + (lane & 15)) * 144 + (lane >> 4) * 16;
#pragma unroll
    for (int p = 0; p < 2; ++p) {
        if (p == 1) __syncthreads();
#pragma unroll
        for (int kt = 0; kt < 2; ++kt)
#pragma unroll
            for (int hf = 0; hf < 2; ++hf) {
                *(LAS u32x4*)(c.lds + kt * 18432 + woff + hf * 9216) = ra[p][kt][hf];
                *(LAS u32x4*)(c.lds + 36864 + kt * 18432 + woff + hf * 9216) = rb[p][kt][hf];
            }
        __syncthreads();
        f32x4 acc[2][4];
#pragma unroll
        for (int mb = 0; mb < 2; ++mb)
#pragma unroll
            for (int nb = 0; nb < 4; ++nb) acc[mb][nb] = (f32x4){0.f, 0.f, 0.f, 0.f};
#pragma unroll
        for (int kt = 0; kt < 2; ++kt)
#pragma unroll
            for (int ks = 0; ks < 2; ++ks) {
                bf16x8 af[2], bfr[4];
#pragma unroll
                for (int mb = 0; mb < 2; ++mb) af[mb] = *(const LAS bf16x8*)(c.lds + kt * 18432 + aoff + mb * 2304 + ks * 64);
#pragma unroll
                for (int nb = 0; nb < 4; ++nb) bfr[nb] = *(const LAS bf16x8*)(c.lds + kt * 18432 + boff + nb * 2304 + ks * 64);
#pragma unroll
                for (int mb = 0; mb < 2; ++mb)
#pragma unroll
                    for (int nb = 0; nb < 4; ++nb) acc[mb][nb] = __builtin_amdgcn_mfma_f32_16x16x32_bf16(af[mb], bfr[nb], acc[mb][nb], 0, 0, 0);
            }
        if (p == 1) __syncthreads();
        LAS float* S = p == 0 ? S0 : S1;
#pragma unroll
        for (int mb = 0; mb < 2; ++mb)
#pragma unroll
            for (int nb = 0; nb < 4; ++nb)
#pragma unroll
                for (int r = 0; r < 4; ++r) S[(32 * wm + 16 * mb + 4 * g + r) * 129 + 64 * wn + 16 * nb + (lane & 15)] = acc[mb][nb][r];
    }
}
__device__ __forceinline__ void phase_peer_topk(const Ctx& c, int layer, int mt_lo) {
    const bf16_t* Qp = c.wb(WS_G); const bf16_t* SK = c.wb(WS_SKB) + (size_t)layer * 16 * 128 * 128;
    int* IDX = (int*)(c.ws + WS_IDX); float* GATE = c.wf(WS_GATE);
    LAS float* S0 = (LAS float*)(c.lds + GEMM_LDS);
    LAS float* S1 = (LAS float*)c.lds;
    const int MT = TT / 128, NU = (MT - mt_lo) * 8;
    u32x4 ra[2][2][2], rb[2][2][2];
    if (c.bid < NU) topk_issue(c, ra, rb, Qp + (size_t)(mt_lo + (c.bid >> 3)) * 128 * 2048 + ((c.bid & 7) * 2) * 128, SK + (size_t)((c.bid & 7) * 2) * 128 * 128);
    for (int u = c.bid; u < NU; u += c.G) {
        const int mt = mt_lo + (u >> 3), h = u & 7;
        topk_scores_pair(c, S0, S1, ra, rb);
        if (u + c.G < NU) {
            const int un = u + c.G;
            topk_issue(c, ra, rb, Qp + (size_t)(mt_lo + (un >> 3)) * 128 * 2048 + ((un & 7) * 2) * 128, SK + (size_t)((un & 7) * 2) * 128 * 128);
        }
        __builtin_amdgcn_sched_barrier(0);
        __syncthreads();
        unsigned La[16], Lb[16];
#pragma unroll
        for (int i = 0; i < 16; ++i) { La[i] = 0u; Lb[i] = 0u; }
        if (c.tid < 256) {
            LAS float* row = (c.tid < 128 ? S0 : S1) + (c.tid & 127) * 129;
#pragma unroll
            for (int i = 0; i < 16; ++i) La[i] = (enc_key(row[i]) & ~127u) | (unsigned)i;
            sort16(La);
#pragma unroll 1
            for (int j0 = 16; j0 < 128; j0 += 16) {
#pragma unroll
                for (int i = 0; i < 16; ++i) Lb[i] = (enc_key(row[j0 + i]) & ~127u) | (unsigned)(j0 + i);
                sort16(Lb);
                merge16(La, Lb);
            }
        }
        __syncthreads();
        if (c.tid >= 128 && c.tid < 256) { LAS unsigned* lst = (LAS unsigned*)S1 + (c.tid - 128) * 129;
#pragma unroll
            for (int i = 0; i < 16; ++i) lst[i] = La[i]; }
        __syncthreads();
        if (c.tid < 128) {
            LAS unsigned* l1 = (LAS unsigned*)S1 + c.tid * 129;
#pragma unroll
            for (int i = 0; i < 16; ++i) Lb[i] = l1[i];
            unsigned M[16], T[16];
#define CK(a, b) ((enc_key(dec_key(La[a] & ~127u) + dec_key(Lb[b] & ~127u)) & ~255u) | (unsigned)(255 - ((a) * 16 + (b))))
#pragma unroll
            for (int b = 0; b < 16; ++b) M[b] = CK(0, b);
#pragma unroll
            for (int a = 1; a < 8; ++a) {
#pragma unroll
                for (int b = 0; b < 16; ++b) T[b] = ((a + 1) * (b + 1) <= 16) ? CK(a, b) : 0u;
                merge16(M, T);
            }
#pragma unroll
            for (int a = 8; a < 16; ++a) T[a - 8] = CK(a, 0);
#pragma unroll
            for (int i = 8; i < 16; ++i) T[i] = 0u;
            merge16(M, T);
#undef CK
            const int tok = mt * 128 + c.tid;
            float sv[16]; const float smax = dec_key(M[0] & ~255u); float sum = 0.f;
#pragma unroll
            for (int k = 0; k < 16; ++k) { sv[k] = fast_exp2((dec_key(M[k] & ~255u) - smax) * LOG2E); sum += sv[k]; }
            const float inv = 1.0f / sum;
            int* ip = IDX + ((size_t)tok * 8 + h) * 16; float* gp = GATE + ((size_t)tok * 8 + h) * 16;
            LAS unsigned* lst = (LAS unsigned*)S0 + c.tid * 129;
#pragma unroll
            for (int i = 0; i < 16; ++i) { lst[i] = La[i]; lst[16 + i] = Lb[i]; }
#pragma unroll
            for (int k = 0; k < 16; ++k) {
                const int ab = 255 - (int)(M[k] & 255u), a = ab >> 4, b = ab & 15;
                const int i0 = (int)(lst[a] & 127u), i1 = (int)(lst[16 + b] & 127u);
                ip[k] = i0 * 128 + i1; gp[k] = sv[k] * inv;
            }
        }
        __syncthreads();
    }
}
typedef unsigned u32x6 __attribute__((ext_vector_type(6)));
typedef float f32x32 __attribute__((ext_vector_type(32)));
__device__ __forceinline__ void gather_experts(const Ctx& c, int layer, const unsigned char* TU, const unsigned char* TV, const float (&xf)[32], int idA, int idB, float gA, float gB,
                                               int e_lo, int e_hi, float (&acc)[32]) {
    for (int e = e_lo; e < (((DBG_SKIP_GATHER >> layer) & 1) ? 0 : e_hi); e += 4) {
        const int sl = e & 63;
        int rr[4]; float gg[4];
#pragma unroll
        for (int k = 0; k < 4; ++k) { rr[k] = __shfl(e < 64 ? idA : idB, sl + k); gg[k] = __shfl(e < 64 ? gA : gB, sl + k); }
        u32x4 uu[4]; u32x4 vv[4];
#pragma unroll
        for (int k = 0; k < 4; ++k) {
            uu[k] = *(const u32x4*)(TU + (size_t)rr[k] * 1024 + c.lane * 16);
            vv[k] = *(const u32x4*)(TV + (size_t)rr[k] * 1024 + c.lane * 16);
        }
        __builtin_amdgcn_sched_barrier(0);
        float dd[4];
#pragma unroll
        for (int k = 0; k < 4; ++k) {
            float d0 = 0.f, d1 = 0.f;
#pragma unroll
            for (int q = 0; q < 4; ++q) {
                const f32x2 f0 = __builtin_amdgcn_cvt_scalef32_pk_f32_fp4(uu[k][q], 1.0f, 0), f1 = __builtin_amdgcn_cvt_scalef32_pk_f32_fp4(uu[k][q], 1.0f, 1);
                const f32x2 f2 = __builtin_amdgcn_cvt_scalef32_pk_f32_fp4(uu[k][q], 1.0f, 2), f3 = __builtin_amdgcn_cvt_scalef32_pk_f32_fp4(uu[k][q], 1.0f, 3);
                d0 += f0.x * xf[q * 8 + 0] + f1.x * xf[q * 8 + 2] + f2.x * xf[q * 8 + 4] + f3.x * xf[q * 8 + 6];
                d1 += f0.y * xf[q * 8 + 1] + f1.y * xf[q * 8 + 3] + f2.y * xf[q * 8 + 5] + f3.y * xf[q * 8 + 7];
            }
            dd[k] = d0 + d1;
        }
#pragma unroll
        for (int o = 32; o >= 1; o >>= 1) {
#pragma unroll
            for (int k = 0; k < 4; ++k) dd[k] += __shfl_xor(dd[k], o);
        }
#pragma unroll
        for (int k = 0; k < 4; ++k) {
            const float w = gg[k] * gelu_tanh(dd[k] * (1.0f / U_SCALE)) * (1.0f / V_SCALE);
#pragma unroll
            for (int q = 0; q < 4; ++q) {
                const f32x2 f0 = __builtin_amdgcn_cvt_scalef32_pk_f32_fp4(vv[k][q], 1.0f, 0), f1 = __builtin_amdgcn_cvt_scalef32_pk_f32_fp4(vv[k][q], 1.0f, 1);
                const f32x2 f2 = __builtin_amdgcn_cvt_scalef32_pk_f32_fp4(vv[k][q], 1.0f, 2), f3 = __builtin_amdgcn_cvt_scalef32_pk_f32_fp4(vv[k][q], 1.0f, 3);
                acc[q * 8 + 0] += w * f0.x; acc[q * 8 + 1] += w * f0.y; acc[q * 8 + 2] += w * f1.x; acc[q * 8 + 3] += w * f1.y;
                acc[q * 8 + 4] += w * f2.x; acc[q * 8 + 5] += w * f2.y; acc[q * 8 + 6] += w * f3.x; acc[q * 8 + 7] += w * f3.y;
            }
        }
    }
}
__device__ __forceinline__ void gather_load_x(const Ctx& c, const bf16_t* H, int tok, float (&xf)[32]) {
#pragma unroll
    for (int q = 0; q < 4; ++q) {
        const u32x4 v = *(const u32x4*)(H + (size_t)tok * D + c.lane * 32 + q * 8);
#pragma unroll
        for (int e = 0; e < 4; ++e) { xf[q * 8 + e * 2] = bf_lo(v[e]); xf[q * 8 + e * 2 + 1] = bf_hi(v[e]); }
    }
}
template <bool FINAL>
__device__ __forceinline__ void gather_epilogue(const Ctx& c, int layer, int tok, float (&acc)[32]) {
    const float* mods = c.wf(WS_MODS); float* xctx = c.wf(WS_XCTX); const float* fnorm = c.in[22];
    const int mw = tok < TC ? 2 : ((tok - TC) >> 14);
    const float* g2 = mods + (size_t)(layer * 3 + mw) * 12288 + 5 * 2048;
    float* xp = tok < TC ? xctx + (size_t)tok * D : c.out + (size_t)(tok - TC) * D;
    float ss = 0.f;
    f32x4 xa[8], ga[8];
#pragma unroll
    for (int q = 0; q < 8; ++q) { xa[q] = *(const f32x4*)(xp + c.lane * 32 + q * 4); ga[q] = *(const f32x4*)(g2 + c.lane * 32 + q * 4); }
    __builtin_amdgcn_sched_barrier(0);
#pragma unroll
    for (int q = 0; q < 8; ++q) {
        const int col = c.lane * 32 + q * 4;
        const f32x4 xv = xa[q], gv = ga[q];
        f32x4 o;
#pragma unroll
        for (int j = 0; j < 4; ++j) { o[j] = xv[j] + gv[j] * acc[q * 4 + j]; ss += o[j] * o[j]; }
        if (!FINAL) *(f32x4*)(xp + col) = o;
        else { acc[q * 4 + 0] = o[0]; acc[q * 4 + 1] = o[1]; acc[q * 4 + 2] = o[2]; acc[q * 4 + 3] = o[3]; }
    }
    if (FINAL) {
        f32x4 fwa[8];
#pragma unroll
        for (int q = 0; q < 8; ++q) fwa[q] = *(const f32x4*)(fnorm + c.lane * 32 + q * 4);
        __builtin_amdgcn_sched_barrier(0);
        ss = wave_sum(ss);
        const float rstd = rsqrtf(ss * (1.0f / D) + EPS);
#pragma unroll
        for (int q = 0; q < 8; ++q) {
            const int col = c.lane * 32 + q * 4;
            const f32x4 fw = fwa[q];
            f32x4 o;
#pragma unroll
            for (int j = 0; j < 4; ++j) o[j] = acc[q * 4 + j] * rstd * fw[j];
#if defined(DBG_ATTN_CHECK) || defined(DBG_TOPK_CHECK) || defined(DBG_TSEL) || defined(DBG_FOURIER_CHECK) || defined(DBG_RET_CHECK)
            for (int j = 0; j < 4; ++j) o[j] += 10000.0f * (float)(*(volatile unsigned*)(c.ws + WS_CTL + 32768));
#endif
            *(f32x4*)(xp + col) = o;
        }
    }
}
template <bool FINAL>
__device__ __forceinline__ void phase_peer_gather(const Ctx& c, int layer, int tok_lo) {
    const bf16_t* H = c.wb(WS_H); const unsigned char* TU = c.ws + WS_TABU + (size_t)layer * (32 * MiB); const unsigned char* TV = c.ws + WS_TABV + (size_t)layer * (32 * MiB);
    const int* IDX = (const int*)(c.ws + WS_IDX); const float* GATE = c.wf(WS_GATE);
    const int W = c.G * 8, nTok = TT - tok_lo, R = nTok / W, rem = nTok - R * W;
    u32x4 xr[4]; int idA = 0, idB = 0; float gA = 0.f, gB = 0.f;
    if (R > 0) {
        const int tok = tok_lo + c.bid * 8 + c.w;
#pragma unroll
        for (int q = 0; q < 4; ++q) xr[q] = *(const u32x4*)(H + (size_t)tok * D + c.lane * 32 + q * 8);
        idA = IDX[(size_t)tok * 128 + c.lane]; idB = IDX[(size_t)tok * 128 + 64 + c.lane];
        gA = GATE[(size_t)tok * 128 + c.lane]; gB = GATE[(size_t)tok * 128 + 64 + c.lane];
    }
    for (int r = 0; r < R; ++r) {
        const int tok = tok_lo + r * W + c.bid * 8 + c.w;
        float xf[32];
#pragma unroll
        for (int q = 0; q < 4; ++q)
#pragma unroll
            for (int e = 0; e < 4; ++e) { xf[q * 8 + e * 2] = bf_lo(xr[q][e]); xf[q * 8 + e * 2 + 1] = bf_hi(xr[q][e]); }
        const int cA = idA, cB = idB; const float cgA = gA, cgB = gB;
        if (r + 1 < R) {
            const int tn = tok + W;
#pragma unroll
            for (int q = 0; q < 4; ++q) xr[q] = *(const u32x4*)(H + (size_t)tn * D + c.lane * 32 + q * 8);
            idA = IDX[(size_t)tn * 128 + c.lane]; idB = IDX[(size_t)tn * 128 + 64 + c.lane];
            gA = GATE[(size_t)tn * 128 + c.lane]; gB = GATE[(size_t)tn * 128 + 64 + c.lane];
        }
        __builtin_amdgcn_sched_barrier(0);
        float acc[32];
#pragma unroll
        for (int j = 0; j < 32; ++j) acc[j] = 0.f;
        gather_experts(c, layer, TU, TV, xf, cA, cB, cgA, cgB, 0, 128, acc);
        gather_epilogue<FINAL>(c, layer, tok, acc);
    }
    if (rem > 0) {
        int S = 1; if (W % rem == 0) { const int q = W / rem; S = q >= 8 ? 8 : (q >= 4 ? 4 : (q >= 2 ? 2 : 1)); }
        const int per = 8 / S, ti = c.bid * per + c.w / S, part = c.w % S, ne = 128 / S;
        const bool act = ti < rem; const int tok = tok_lo + R * W + (act ? ti : 0);
        float acc[32];
#pragma unroll
        for (int j = 0; j < 32; ++j) acc[j] = 0.f;
        if (act) {
            float xf[32];
            gather_load_x(c, H, tok, xf);
            const int idA = IDX[(size_t)tok * 128 + c.lane], idB = IDX[(size_t)tok * 128 + 64 + c.lane];
            const float gA = GATE[(size_t)tok * 128 + c.lane], gB = GATE[(size_t)tok * 128 + 64 + c.lane];
            gather_experts(c, layer, TU, TV, xf, idA, idB, gA, gB, part * ne, part * ne + ne, acc);
        }
        if (S > 1) {
            LAS float* red = (LAS float*)c.lds;
            __syncthreads();
#pragma unroll
            for (int j = 0; j < 32; ++j) red[(c.w * 32 + j) * 64 + c.lane] = acc[j];
            __syncthreads();
            if (act && part == 0)
                for (int p = 1; p < S; ++p) {
#pragma unroll
                    for (int j = 0; j < 32; ++j) acc[j] += red[((c.w + p) * 32 + j) * 64 + c.lane];
                }
        }
        if (act && part == 0) gather_epilogue<FINAL>(c, layer, tok, acc);
    }
}

__device__ __forceinline__ void rope64_store(const f32x4 (&a)[4], bool rotate, int s, int g, float sc, const f32x2* r64, bf16_t* dst) {
    if (rotate) {
        const int prow = s >> 6, pcol = s & 63;
#pragma unroll
        for (int hlf = 0; hlf < 2; ++hlf) {
            const int pos = hlf == 0 ? prow : pcol;
            f32x4 o1, o2;
#pragma unroll
            for (int r = 0; r < 4; ++r) {
                const f32x2 cs = r64[pos * 16 + 4 * g + r];
                const float x1 = a[2 * hlf][r] * sc, x2 = a[2 * hlf + 1][r] * sc;
                o1[r] = x1 * cs.x - x2 * cs.y; o2[r] = x2 * cs.x + x1 * cs.y;
            }
            *(u32x2*)(dst + 32 * hlf) = pack4(o1); *(u32x2*)(dst + 32 * hlf + 16) = pack4(o2);
        }
    } else {
#pragma unroll
        for (int nb = 0; nb < 4; ++nb) *(u32x2*)(dst + 16 * nb) = pack4(a[nb] * sc);
    }
}
__device__ __forceinline__ void phase_odd_proj(const Ctx& c) {
    const bf16_t* H = c.wb(WS_H); const bf16_t* W = c.wb(WS_WINO);
    bf16_t* SQ = c.wb(WS_A); bf16_t* SK = c.wb(WS_Q); bf16_t* SV = c.wb(WS_Q + 9 * MiB); bf16_t* CQ = c.wb(WS_Q + 18 * MiB);
    bf16_t* CKV = c.wb(WS_K); bf16_t* KR = c.wb(WS_K + 17 * MiB);
    const f32x2* r64 = (const f32x2*)(c.ws + WS_ROPE + 131072);
    const int MT = TT / 128, NT = 17;
    const int g = c.lane >> 4, wm = c.w >> 1, wn = c.w & 1;
    for (int t = c.bid; t < MT * NT; t += c.G) {
        int mt, nt; tile_mn(t, MT, NT, mt, nt);
        f32x4 acc[2][4];
        gemm128<true>(c.lds, 2048, RowLin{H + (size_t)mt * 128 * D, (size_t)D}, RowLin{W + (size_t)nt * 128 * 2048, 2048}, acc);
#pragma unroll
        for (int mb = 0; mb < 2; ++mb) {
            const int tok = mt * 128 + 32 * wm + 16 * mb + (c.lane & 15);
            const bool lat = tok >= TC; const int s = (tok - TC) & (SEQ - 1);
            const int cw = 64 * wn + 4 * g;
            if (nt < 8) rope64_store(acc[mb], lat, s, g, 0.125f, r64, SQ + (size_t)tok * 1024 + nt * 128 + cw);
            else if (nt == 8) rope64_store(acc[mb], lat, s, g, 1.0f, r64, SK + (size_t)tok * 128 + cw);
            else if (nt == 9) rope64_store(acc[mb], false, s, g, 1.0f, r64, SV + (size_t)tok * 128 + cw);
            else if (nt < 14) rope64_store(acc[mb], false, s, g, 1.0f, r64, CQ + (size_t)tok * 512 + (nt - 10) * 128 + cw);
            else if (nt < 16) rope64_store(acc[mb], false, s, g, 1.0f, r64, CKV + (size_t)tok * 256 + (nt - 14) * 128 + cw);
            else if (wn == 0) rope64_store(acc[mb], lat, s, g, 1.0f, r64, KR + (size_t)tok * 64 + 4 * g);
        }
    }
}
__device__ __forceinline__ void phase_odd_local(const Ctx& c) {
    bf16_t* CQ = c.wb(WS_Q + 18 * MiB); bf16_t* CKV = c.wb(WS_K); const bf16_t* KR = c.wb(WS_K + 17 * MiB); bf16_t* MK = c.wb(WS_ST);
    const float* qn = c.in[13]; const float* kvn = c.in[14];
    const int l32 = c.lane & 31, hh = c.lane >> 3, part = c.lane & 7, W = c.G * 8;
    const f32x4 qw0 = *(const f32x4*)(qn + c.lane * 8), qw1 = *(const f32x4*)(qn + c.lane * 8 + 4);
    const f32x4 kw0 = *(const f32x4*)(kvn + l32 * 8), kw1 = *(const f32x4*)(kvn + l32 * 8 + 4);
    for (int t0 = c.bid * 8 + c.w; t0 < TT; t0 += 4 * W) {
        u32x4 vq[4], vk[4], vr[4];
#pragma unroll
        for (int k = 0; k < 4; ++k) {
            const int tok = t0 + k * W;
            if (tok < TT) {
                vq[k] = *(const u32x4*)(CQ + (size_t)tok * 512 + c.lane * 8);
                vk[k] = *(const u32x4*)(CKV + (size_t)tok * 256 + l32 * 8);
                vr[k] = *(const u32x4*)(KR + (size_t)tok * 64 + part * 8);
            }
        }
        __builtin_amdgcn_sched_barrier(0);
#pragma unroll
        for (int k = 0; k < 4; ++k) {
            const int tok = t0 + k * W;
            if (tok < TT) {
                {
                    const u32x4 v = vq[k];
                    float f[8] = {bf_lo(v.x), bf_hi(v.x), bf_lo(v.y), bf_hi(v.y), bf_lo(v.z), bf_hi(v.z), bf_lo(v.w), bf_hi(v.w)};
                    float ss = 0.f;
#pragma unroll
                    for (int j = 0; j < 8; ++j) ss += f[j] * f[j];
                    ss = wave_sum(ss);
                    const float rstd = rsqrtf(ss * (1.0f / 512.0f) + EPS);
                    u32x4 o; o.x = cvt_pk_bf16(f[0] * rstd * qw0[0], f[1] * rstd * qw0[1]); o.y = cvt_pk_bf16(f[2] * rstd * qw0[2], f[3] * rstd * qw0[3]);
                    o.z = cvt_pk_bf16(f[4] * rstd * qw1[0], f[5] * rstd * qw1[1]); o.w = cvt_pk_bf16(f[6] * rstd * qw1[2], f[7] * rstd * qw1[3]);
                    *(u32x4*)(CQ + (size_t)tok * 512 + c.lane * 8) = o;
                }
                {
                    const u32x4 v = vk[k];
                    float f[8] = {bf_lo(v.x), bf_hi(v.x), bf_lo(v.y), bf_hi(v.y), bf_lo(v.z), bf_hi(v.z), bf_lo(v.w), bf_hi(v.w)};
                    float ss = 0.f;
#pragma unroll
                    for (int j = 0; j < 8; ++j) ss += f[j] * f[j];
                    ss = wave_sum(ss) * 0.5f;
                    const float rstd = rsqrtf(ss * (1.0f / 256.0f) + EPS);
                    u32x4 o; o.x = cvt_pk_bf16(f[0] * rstd * kw0[0], f[1] * rstd * kw0[1]); o.y = cvt_pk_bf16(f[2] * rstd * kw0[2], f[3] * rstd * kw0[3]);
                    o.z = cvt_pk_bf16(f[4] * rstd * kw1[0], f[5] * rstd * kw1[1]); o.w = cvt_pk_bf16(f[6] * rstd * kw1[2], f[7] * rstd * kw1[3]);
                    if (c.lane < 32) *(u32x4*)(CKV + (size_t)tok * 256 + l32 * 8) = o;
                }
                *(u32x4*)(MK + ((size_t)tok * 8 + hh) * 192 + 128 + part * 8) = vr[k];
            }
        }
    }
}
__device__ __forceinline__ void phase_mla_up(const Ctx& c) {
    const bf16_t* CQ = c.wb(WS_Q + 18 * MiB); const bf16_t* CKV = c.wb(WS_K);
    const bf16_t* Wuq = c.wb(WS_WUQ); const bf16_t* Wukv = c.wb(WS_WUKV);
    bf16_t* MQ = c.wb(WS_G); bf16_t* MK = c.wb(WS_ST); bf16_t* MV = c.wb(WS_V);
    const f32x2* r64 = (const f32x2*)(c.ws + WS_ROPE + 131072);
    const int g = c.lane >> 4, wm = c.w >> 1, wn = c.w & 1;
    const int NUQ = 256 * 12, NUKV = 260 * 16;
    for (int u = c.bid; u < NUQ + NUKV; u += c.G) {
        f32x4 acc[2][4];
        if (u < NUQ) {
            int mt, nt; tile_mn(u, 256, 12, mt, nt); mt += 4;
            gemm128<true>(c.lds, 512, RowLin{CQ + (size_t)mt * 128 * 512, 512}, RowLin{Wuq + (size_t)nt * 128 * 512, 512}, acc);
            const int rr = nt * 2 + wn, part = rr % 3;
#pragma unroll
            for (int mb = 0; mb < 2; ++mb) {
                const int tok = mt * 128 + 32 * wm + 16 * mb + (c.lane & 15); const int s = (tok - TC) & (SEQ - 1);
                rope64_store(acc[mb], part == 2, s, g, 0.07216878364870322f, r64, MQ + (size_t)tok * 1536 + rr * 64 + 4 * g);
            }
        } else {
            int mt, nt; tile_mn(u - NUQ, 260, 16, mt, nt);
            gemm128<true>(c.lds, 256, RowLin{CKV + (size_t)mt * 128 * 256, 256}, RowLin{Wukv + (size_t)nt * 128 * 256, 256}, acc);
            const int head = nt >> 1;
#pragma unroll
            for (int mb = 0; mb < 2; ++mb) {
                const int tok = mt * 128 + 32 * wm + 16 * mb + (c.lane & 15);
                bf16_t* dst = (nt & 1) ? MV + ((size_t)tok * 8 + head) * 128 + 64 * wn + 4 * g : MK + ((size_t)tok * 8 + head) * 192 + 64 * wn + 4 * g;
#pragma unroll
                for (int nb = 0; nb < 4; ++nb) *(u32x2*)(dst + 16 * nb) = pack4(acc[mb][nb]);
            }
        }
    }
}

__device__ __forceinline__ int fresh_lane() { int l = __builtin_amdgcn_mbcnt_hi(~0u, __builtin_amdgcn_mbcnt_lo(~0u, 0u)); asm volatile("" : "+v"(l)); return l; }
__device__ __forceinline__ void half_pair(float v, float& a, float& b) {
    const auto rr = __builtin_amdgcn_permlane32_swap(__float_as_uint(v), __float_as_uint(v), false, false);
    a = __uint_as_float(rr[0]); b = __uint_as_float(rr[1]);
}
template <int DQK, int DV, bool SWA, bool YOUNG>
__device__ __forceinline__ void attn_body(const Ctx& c0, const bf16_t* __restrict__ qptr, int qpitch, const bf16_t* __restrict__ kptr, int kpitch,
                                          const bf16_t* __restrict__ vptr, int vpitch, bf16_t* __restrict__ optr, int opitch, int b, int q0, float sink) {
    constexpr int KS = DQK * 2 + 16, VS = DV * 2 + (DV == 128 ? 32 : 16);
    constexpr int KCPR = DQK / 8, VCPR = DV / 8, KPT = DQK / 64, VPT = DV / 64, NKS = DQK / 16, NDB = DV / 32;
    constexpr int KB = 64 * KS;
    const int lane = fresh_lane(), tid = c0.w * 64 + lane;
    LAS unsigned char* kbuf = c0.lds; LAS unsigned char* vt = c0.lds + 2 * KB;
    const int hh = lane >> 5, l31 = lane & 31, blk = (lane >> 4) & 1;
    int ntiles, kt_lo = 0;
    if (SWA) { kt_lo = (q0 - 128) >> 6; if (kt_lo < 0) kt_lo = 0; int kt_hi = (q0 + 255 + 128) >> 6; if (kt_hi > 255) kt_hi = 255; ntiles = 4 + kt_hi - kt_lo + 1; }
    else ntiles = 4 + 256;
    bf16x8 qf[NKS];
    {
        const bf16_t* qr = qptr + (size_t)(32 * c0.w + l31) * qpitch + 8 * hh;
#pragma unroll
        for (int ks = 0; ks < NKS; ++ks) qf[ks] = *(const bf16x8*)(qr + 16 * ks);
    }
    f32x16 o[NDB];
#pragma unroll
    for (int db = 0; db < NDB; ++db)
#pragma unroll
        for (int r = 0; r < 16; ++r) o[db][r] = 0.f;
    float m = SWA ? sink * LOG2E : 0.0f, l = (SWA && hh == 0) ? 1.0f : 0.0f;

    const int qpos = q0 + 32 * c0.w + l31;
    u32x4 kr[KPT], vr[VPT];
#define ATT_TK(tt) ((tt) < 4 ? b * NCTX + 64 * (tt) : TC + b * SEQ + 64 * (kt_lo + (tt) - 4))
#define ATT_LOADK(tt) do { const char* _kb = (const char*)(kptr + (size_t)ATT_TK(tt) * kpitch); \
        _Pragma("unroll") for (int i = 0; i < KPT; ++i) { const int id = tid + 512 * i, row = id / KCPR, ch = id % KCPR; kr[i] = *(const u32x4*)(_kb + (unsigned)((row * kpitch + ch * 8) * 2)); } } while (0)
#define ATT_LOADV(tt) do { const char* _vb = (const char*)(vptr + (size_t)ATT_TK(tt) * vpitch); \
        _Pragma("unroll") for (int i = 0; i < VPT; ++i) { const int id = tid + 512 * i, row = id / VCPR, ch = id % VCPR; vr[i] = *(const u32x4*)(_vb + (unsigned)((row * vpitch + ch * 8) * 2)); } } while (0)
#define ATT_WRITE_K(buf) do { _Pragma("unroll") for (int i = 0; i < KPT; ++i) { const int id = tid + 512 * i, row = id / KCPR, ch = id % KCPR; *(LAS u32x4*)(kbuf + (buf) * KB + row * KS + ch * 16) = kr[i]; } } while (0)
#define ATT_WRITE_V() do { _Pragma("unroll") for (int i = 0; i < VPT; ++i) { const int id = tid + 512 * i, row = id / VCPR, ch = id % VCPR; *(LAS u32x4*)(vt + row * VS + ch * 16) = vr[i]; } } while (0)
#define ATT_QK(buf) do { f32x16 negm; _Pragma("unroll") for (int r = 0; r < 16; ++r) negm[r] = -m; \
        _Pragma("unroll") for (int ks = 0; ks < NKS; ++ks) _Pragma("unroll") for (int kb = 0; kb < 2; ++kb) { \
            const bf16x8 kf = *(const LAS bf16x8*)(kbuf + (buf) * KB + (32 * kb + l31) * KS + (16 * ks + 8 * hh) * 2); \
            s[kb] = __builtin_amdgcn_mfma_f32_32x32x16_bf16(kf, qf[ks], ks == 0 ? negm : s[kb], 0, 0, 0); } } while (0)
    f32x16 s[2];
    const int qw0 = q0 + 32 * c0.w;
#define ATT_DMAX(tt) (qw0 + 31 - 64 * (kt_lo + (tt) - 4))
#define ATT_DMIN(tt) (qw0 - 63 - 64 * (kt_lo + (tt) - 4))
#define ATT_LIVE(tt) (!SWA || (tt) < 4 || (ATT_DMIN(tt) <= 128 && ATT_DMAX(tt) >= -128))
    ATT_LOADK(0); ATT_WRITE_K(0); ATT_LOADV(0);
    if (ntiles > 1) ATT_LOADK(1);
    __syncthreads();
    if (YOUNG) ATT_QK(0);
    for (int t = 0; t < ntiles; ++t) {
        __syncthreads();
        ATT_WRITE_V();
        if (t + 1 < ntiles) ATT_WRITE_K((t + 1) & 1);
        __syncthreads();
        if (t + 1 < ntiles) ATT_LOADV(t + 1);
        if (t + 2 < ntiles) ATT_LOADK(t + 2);
        const bool live = ATT_LIVE(t);
        if (live) {
        if (!YOUNG) ATT_QK(t & 1);
        if (SWA && t >= 4 && (ATT_DMAX(t) > 128 || ATT_DMIN(t) < -128)) {
            const int kpos0 = 64 * (kt_lo + t - 4);
#pragma unroll
            for (int kb = 0; kb < 2; ++kb)
#pragma unroll
                for (int r = 0; r < 16; ++r) {
                    const int kpos = kpos0 + 32 * kb + (r & 3) + 8 * (r >> 2) + 4 * hh; const int dd = qpos - kpos;
                    if (dd > 128 || dd < -128) s[kb][r] = -INFINITY;
                }
        }
        float tm = s[0][0];
#pragma unroll
        for (int kb = 0; kb < 2; ++kb)
#pragma unroll
            for (int r = 0; r < 16; ++r) tm = fmaxf(tm, s[kb][r]);
        { float ta, tb; half_pair(tm, ta, tb); tm = fmaxf(ta, tb); }
        const bool upd = tm > 8.0f || (!SWA && t == 0);
        if (!__all(!upd)) {
            const float d = upd ? tm : 0.f;
#pragma unroll
            for (int kb = 0; kb < 2; ++kb)
#pragma unroll
                for (int r = 0; r < 16; ++r) s[kb][r] -= d;
            m += d;
            const float alpha = d > 0.f ? fast_exp2(-d) : 1.0f;
            l *= alpha;
#pragma unroll
            for (int db = 0; db < NDB; ++db)
#pragma unroll
                for (int r = 0; r < 16; ++r) o[db][r] *= alpha;
        }
        float ps = 0.f;
#pragma unroll
        for (int kb = 0; kb < 2; ++kb)
#pragma unroll
            for (int r = 0; r < 16; ++r) { const float p = fast_exp2(s[kb][r]); s[kb][r] = p; ps += p; }
        l += ps;
#pragma unroll
        for (int kb = 0; kb < 2; ++kb)
#pragma unroll
            for (int s2 = 0; s2 < 2; ++s2) {
                u32x4 pk;
                pk.x = cvt_pk_bf16(s[kb][8 * s2 + 0], s[kb][8 * s2 + 1]); pk.y = cvt_pk_bf16(s[kb][8 * s2 + 2], s[kb][8 * s2 + 3]);
                pk.z = cvt_pk_bf16(s[kb][8 * s2 + 4], s[kb][8 * s2 + 5]); pk.w = cvt_pk_bf16(s[kb][8 * s2 + 6], s[kb][8 * s2 + 7]);
                const bf16x8 pf = __builtin_bit_cast(bf16x8, pk);
                const int r0 = 32 * kb + 16 * s2 + 4 * hh;
#pragma unroll
                for (int db = 0; db < NDB; ++db) {
                    const bf16x8 vf = cat8(tr_read(vt + r0 * VS + (32 * db + 16 * blk) * 2, VS, lane), tr_read(vt + (r0 + 8) * VS + (32 * db + 16 * blk) * 2, VS, lane));
                    o[db] = __builtin_amdgcn_mfma_f32_32x32x16_bf16(vf, pf, o[db], 0, 0, 0);
                }
            }
        }
        if (YOUNG && t + 1 < ntiles && ATT_LIVE(t + 1)) ATT_QK((t + 1) & 1);
    }
#undef ATT_DMAX
#undef ATT_DMIN
#undef ATT_LIVE
#undef ATT_TK
#undef ATT_LOADK
#undef ATT_LOADV
#undef ATT_WRITE_K
#undef ATT_WRITE_V
#undef ATT_QK
    { float la, lb; half_pair(l, la, lb); l = la + lb; }
    const float inv = 1.0f / l;
    const int le = fresh_lane();
    bf16_t* orow = optr + (size_t)(32 * c0.w + (le & 31)) * opitch + 4 * (le >> 5);
#pragma unroll
    for (int db = 0; db < NDB; ++db)
#pragma unroll
        for (int rg = 0; rg < 4; ++rg) {
            f32x4 v = {o[db][4 * rg] * inv, o[db][4 * rg + 1] * inv, o[db][4 * rg + 2] * inv, o[db][4 * rg + 3] * inv};
            *(u32x2*)(orow + 32 * db + 8 * rg) = pack4(v);
        }
    __syncthreads();
}
template <int DQK, int DV, bool SWA>
__device__ __forceinline__ void attn_unit(const Ctx& c, const bf16_t* __restrict__ qptr, int qpitch, const bf16_t* __restrict__ kptr, int kpitch,
                                          const bf16_t* __restrict__ vptr, int vpitch, bf16_t* __restrict__ optr, int opitch, int b, int q0, float sink) {
    if (c.w < 4) attn_body<DQK, DV, SWA, false>(c, qptr, qpitch, kptr, kpitch, vptr, vpitch, optr, opitch, b, q0, sink);
    else attn_body<DQK, DV, SWA, true>(c, qptr, qpitch, kptr, kpitch, vptr, vpitch, optr, opitch, b, q0, sink);
}
__device__ __forceinline__ void phase_attention(const Ctx& c) {
    const bf16_t* MQ = c.wb(WS_G); const bf16_t* MK = c.wb(WS_ST); const bf16_t* MV = c.wb(WS_V);
    const bf16_t* SQ = c.wb(WS_A); const bf16_t* SK = c.wb(WS_Q); const bf16_t* SV = c.wb(WS_Q + 9 * MiB);
    bf16_t* CAT = c.wb(WS_CAT); const float* sink = c.in[12];
    for (int u = c.bid; u < 1024; u += c.G) {
        const int b = u >> 9, h = (u >> 6) & 7, qb = u & 63; const size_t tok0 = (size_t)TC + (size_t)b * SEQ + qb * 256;
        attn_unit<192, 128, false>(c, MQ + tok0 * 1536 + h * 192, 1536, MK + h * 192, 1536, MV + h * 128, 1024, CAT + tok0 * 2048 + 1024 + h * 128, 2048, b, qb * 256, 0.f);
    }
    for (int u = c.bid; u < 2048; u += c.G) {
        const int b = u >> 10, hq = (u >> 6) & 15, qb = u & 63; const size_t tok0 = (size_t)TC + (size_t)b * SEQ + qb * 256;
        attn_unit<64, 64, true>(c, SQ + tok0 * 1024 + hq * 64, 1024, SK + (hq >> 3) * 64, 128, SV + (hq >> 3) * 64, 128, CAT + tok0 * 2048 + hq * 64, 2048, b, qb * 256, sink[hq]);
    }
}


#ifdef DBG_TOPK_CHECK

__device__ __forceinline__ void dbg_gather_save(const Ctx& c) {
    if (c.bid >= 64) return;
    const int tok = 512 + 509 * c.bid + (c.bid & 1 ? 0 : 7);
    float* sv = (float*)(c.ws + WS_CTL + 65536) + (size_t)c.bid * 2048;
    for (int i = c.tid; i < 2048; i += 512) sv[i] = c.out[(size_t)(tok - TC) * D + i];
}
__device__ __forceinline__ void dbg_gather_check(const Ctx& c) {
    if (c.bid >= 64) return;
    const int tok = 512 + 509 * c.bid + (c.bid & 1 ? 0 : 7);
    const bf16_t* H = c.wb(WS_H); const bf16_t* TU = c.wb(WS_TABU); const bf16_t* TV = c.wb(WS_TABV);
    const int* IDX = (const int*)(c.ws + WS_IDX); const float* GATE = c.wf(WS_GATE);
    const float* sv = (const float*)(c.ws + WS_CTL + 65536) + (size_t)c.bid * 2048;
    const float* g2 = c.wf(WS_MODS) + (size_t)(0 * 3 + ((tok - TC) >> 14)) * 12288 + 5 * 2048;
    LAS float* red = (LAS float*)c.lds;
    float f0 = 0.f, f1 = 0.f, f2 = 0.f, f3 = 0.f;
    const int d0 = c.tid * 4;
    for (int e = 0; e < 128; ++e) {
        const int id = IDX[(size_t)tok * 128 + e]; const float gt = GATE[(size_t)tok * 128 + e];
        float p = 0.f;
        for (int j = 0; j < 4; ++j) p += bf2f(H[(size_t)tok * D + d0 + j]) * bf2f(TU[(size_t)id * D + d0 + j]);
        p = wave_sum(p);
        __syncthreads();
        if (c.lane == 0) red[c.w] = p;
        __syncthreads();
        float a = 0.f; for (int w = 0; w < 8; ++w) a += red[w];
        const float wgt = gt * gelu_tanh(a);
        f0 += wgt * bf2f(TV[(size_t)id * D + d0]); f1 += wgt * bf2f(TV[(size_t)id * D + d0 + 1]); f2 += wgt * bf2f(TV[(size_t)id * D + d0 + 2]); f3 += wgt * bf2f(TV[(size_t)id * D + d0 + 3]);
    }
    const float* xo = c.out + (size_t)(tok - TC) * D + d0;
    int bad = 0;
    if (fabsf(sv[d0] + g2[d0] * f0 - xo[0]) > 0.02f) bad = 16;
    if (fabsf(sv[d0 + 1] + g2[d0 + 1] * f1 - xo[1]) > 0.02f) bad = 16;
    if (fabsf(sv[d0 + 2] + g2[d0 + 2] * f2 - xo[2]) > 0.02f) bad = 16;
    if (fabsf(sv[d0 + 3] + g2[d0 + 3] * f3 - xo[3]) > 0.02f) bad = 16;
    if (bad) atomicOr((unsigned*)(c.ws + WS_CTL + 32768), (unsigned)bad);
}
__device__ __forceinline__ void dbg_topk_check(const Ctx& c) {
    const bf16_t* Qp = c.wb(WS_G); const bf16_t* SK = c.wb(WS_SKB);
    const int* IDX = (const int*)(c.ws + WS_IDX); const float* GATE = c.wf(WS_GATE);
    LAS float* sc = (LAS float*)c.lds;
    LAS int* cnt = (LAS int*)(c.lds + 2048);
    if (c.bid >= 64) return;
    const int tok = 512 + 509 * c.bid + (c.bid & 1 ? 0 : 7);
    int bad = 0;
    for (int h = 0; h < 8; ++h) {
        if (c.tid < 256) {
            const int p = c.tid >> 7, key = c.tid & 127, hp = h * 2 + p;
            float s = 0.f;
            for (int cc = 0; cc < 128; ++cc) s += bf2f(Qp[(size_t)tok * 2048 + hp * 128 + cc]) * bf2f(SK[((size_t)hp * 128 + key) * 128 + cc]);
            sc[p * 128 + key] = s;
        }
        if (c.tid == 0) cnt[0] = 0;
        __syncthreads();
        LAS float* ls = (LAS float*)(c.lds + 4096);
        if (c.tid < 16) { const int id = IDX[((size_t)tok * 8 + h) * 16 + c.tid]; ls[c.tid] = sc[(id >> 7) & 127] + sc[128 + (id & 127)]; if (id < 0 || id >= 16384) bad |= 1; }
        __syncthreads();
        float smin = 1e30f, smax = -1e30f;
        for (int k = 0; k < 16; ++k) { smin = fminf(smin, ls[k]); smax = fmaxf(smax, ls[k]); }
        for (int k = 0; k < 16; ++k) for (int k2 = k + 1; k2 < 16; ++k2) if (IDX[((size_t)tok * 8 + h) * 16 + k] == IDX[((size_t)tok * 8 + h) * 16 + k2]) bad |= 2;
        int n = 0;
        for (int i = c.tid; i < 16384; i += 512) { const float v = sc[i >> 7] + sc[128 + (i & 127)]; if (v > smin + 2e-2f) ++n; }
        atomicAdd((int*)cnt, n);
        __syncthreads();
        if (cnt[0] > 15) bad |= 4;
        float den = 0.f; for (int k = 0; k < 16; ++k) den += fast_exp2((ls[k] - smax) * LOG2E);
        for (int k = 0; k < 16; ++k) { const float gref = fast_exp2((ls[k] - smax) * LOG2E) / den; if (fabsf(gref - GATE[((size_t)tok * 8 + h) * 16 + k]) > 2e-2f) bad |= 8; }
        __syncthreads();
    }
    if (bad && c.tid == 0) atomicOr((unsigned*)(c.ws + WS_CTL + 32768), (unsigned)bad);
}
#endif

#ifdef DBG_ATTN_CHECK
__device__ __forceinline__ void dbg_attn_check(const Ctx& c) {
    if (c.bid >= 64) return;
    LAS float* sc = (LAS float*)c.lds;
    LAS float* red = (LAS float*)(c.lds + 80000);
    const bf16_t* CAT = c.wb(WS_CAT);
    int bad = 0;
    if (c.bid < 32) {
        const bf16_t* MQ = c.wb(WS_G); const bf16_t* MK = c.wb(WS_ST); const bf16_t* MV = c.wb(WS_V);
        const int b = c.bid & 1, h = (c.bid >> 1) & 7, s = (c.bid * 523 + 77) & 16383;
        const size_t tok = (size_t)TC + (size_t)b * SEQ + s;
        float lmax = -1e30f;
        for (int k = c.tid; k < 16640; k += 512) {
            const size_t kt = k < 256 ? (size_t)b * 256 + k : (size_t)TC + (size_t)b * SEQ + (k - 256);
            float a = 0.f;
            for (int d = 0; d < 192; ++d) a += bf2f(MQ[tok * 1536 + h * 192 + d]) * bf2f(MK[(kt * 8 + h) * 192 + d]);
            sc[k] = a; lmax = fmaxf(lmax, a);
        }
#pragma unroll
        for (int o = 32; o >= 1; o >>= 1) lmax = fmaxf(lmax, __shfl_xor(lmax, o));
        if (c.lane == 0) red[c.w] = lmax;
        __syncthreads();
        float mx = red[0]; for (int w = 1; w < 8; ++w) mx = fmaxf(mx, red[w]);
        __syncthreads();
        float ls = 0.f;
        for (int k = c.tid; k < 16640; k += 512) { float p = fast_exp2((sc[k] - mx) * LOG2E);
#if defined(DBG_ATTN_MODE) && DBG_ATTN_MODE == 1
            p = 1.f;
#endif
            sc[k] = p; ls += p; }
        ls = wave_sum(ls);
        if (c.lane == 0) red[c.w] = ls;
        __syncthreads();
        float den = 0.f; for (int w = 0; w < 8; ++w) den += red[w];
        if (c.tid < 128) {
            float o = 0.f;
            for (int k = 0; k < 16640; ++k) { const size_t kt = k < 256 ? (size_t)b * 256 + k : (size_t)TC + (size_t)b * SEQ + (k - 256);
#ifdef DBG_ATTN_SYNV
                o += sc[k] * (float)((((int)kt) * 3 + c.tid) & 31);
#else
                o += sc[k] * bf2f(MV[(kt * 8 + h) * 128 + c.tid]);
#endif
            }
            o /= den;
            const float got = bf2f(CAT[tok * 2048 + 1024 + h * 128 + c.tid]);
            if (fabsf(got - o) > 0.002f + 0.03f * fabsf(o)) bad = 1;

        }
    } else {
        const bf16_t* SQ = c.wb(WS_A); const bf16_t* SK = c.wb(WS_Q); const bf16_t* SV = c.wb(WS_Q + 9 * MiB);
        const int i = c.bid - 32; const int b = i & 1, hq = (i >> 1) & 15;
        const int s = i < 4 ? (i == 0 ? 0 : (i == 1 ? 16383 : (i == 2 ? 100 : 16300))) : ((i * 1021 + 333) & 16383);
        const size_t tok = (size_t)TC + (size_t)b * SEQ + s; const int hk = hq >> 3;
        const float sink = c.in[12][hq];
        const int lo = s - 128 < 0 ? 0 : s - 128, hi = s + 128 > 16383 ? 16383 : s + 128, nk = 256 + hi - lo + 1;
        float lmax = sink;
        for (int k = c.tid; k < nk; k += 512) {
            const size_t kt = k < 256 ? (size_t)b * 256 + k : (size_t)TC + (size_t)b * SEQ + lo + (k - 256);
            float a = 0.f;
            for (int d = 0; d < 64; ++d) a += bf2f(SQ[tok * 1024 + hq * 64 + d]) * bf2f(SK[kt * 128 + hk * 64 + d]);
            sc[k] = a; lmax = fmaxf(lmax, a);
        }
#pragma unroll
        for (int o = 32; o >= 1; o >>= 1) lmax = fmaxf(lmax, __shfl_xor(lmax, o));
        if (c.lane == 0) red[c.w] = lmax;
        __syncthreads();
        float mx = red[0]; for (int w = 1; w < 8; ++w) mx = fmaxf(mx, red[w]);
        __syncthreads();
        float ls = 0.f;
        for (int k = c.tid; k < nk; k += 512) { float p = fast_exp2((sc[k] - mx) * LOG2E);
#if defined(DBG_ATTN_MODE) && DBG_ATTN_MODE == 1
            p = 1.f;
#endif
            sc[k] = p; ls += p; }
        ls = wave_sum(ls);
        if (c.lane == 0) red[c.w] = ls;
        __syncthreads();
#if defined(DBG_ATTN_MODE) && DBG_ATTN_MODE == 1
        float den = 1.f;
#else
        float den = fast_exp2((sink - mx) * LOG2E);
#endif
        for (int w = 0; w < 8; ++w) den += red[w];
        if (c.tid < 64) {
            float o = 0.f;
            for (int k = 0; k < nk; ++k) { const size_t kt = k < 256 ? (size_t)b * 256 + k : (size_t)TC + (size_t)b * SEQ + lo + (k - 256); o += sc[k] * bf2f(SV[kt * 128 + hk * 64 + c.tid]); }
            o /= den;
            const float got = bf2f(CAT[tok * 2048 + hq * 64 + c.tid]);
            if (fabsf(got - o) > 0.002f + 0.03f * fabsf(o)) bad = 2;

        }
    }
    if (bad) atomicOr((unsigned*)(c.ws + WS_CTL + 32768), (unsigned)bad);
    __syncthreads();
}
#endif

typedef const f32x4 (&Acc8)[2][2][4][2];
__device__ __forceinline__ void rope64_pair(const f32x4 a, const f32x4 b, bool rotate, const f32x4 (&cs)[2], float sc, bf16_t* dst) {
    if (rotate) {
        f32x4 o1, o2;
#pragma unroll
        for (int r = 0; r < 4; ++r) { const float cx = cs[r >> 1][(r & 1) * 2], sx = cs[r >> 1][(r & 1) * 2 + 1]; const float x1 = a[r] * sc, x2 = b[r] * sc; o1[r] = x1 * cx - x2 * sx; o2[r] = x2 * cx + x1 * sx; }
        *(u32x2*)dst = pack4(o1); *(u32x2*)(dst + 16) = pack4(o2);
    } else { *(u32x2*)dst = pack4(a * sc); *(u32x2*)(dst + 16) = pack4(b * sc); }
}
__device__ __forceinline__ void rope64_load(f32x4 (&cs)[2], const f32x2* r64, int tok, int wc, int fq) {
    const int s = (tok - TC) & (SEQ - 1), pos = (wc & 1) == 0 ? (s >> 6) : (s & 63);
    const f32x4* p = (const f32x4*)(r64 + pos * 16 + 4 * fq);
    if (tok >= TC) { cs[0] = p[0]; cs[1] = p[1]; }
}
struct EpiEvenProj {
    static constexpr bool PERM = false, AFTER_DRAIN = false;
    bf16_t* F; bf16_t* Q; bf16_t* Kb; bf16_t* V; bf16_t* Gt; const f32x2* r128;
    __device__ __forceinline__ void ld_cs(f32x4 (&cs)[2], int tok, int wc, int fq) const {
        const int s = (tok - TC) & (SEQ - 1), pos = (wc >> 1) == 0 ? (s >> 6) : (s & 63);
        const f32x4* p = (const f32x4*)(r128 + pos * 32 + 16 * (wc & 1) + 4 * fq);
        if (tok >= TC) { cs[0] = p[0]; cs[1] = p[1]; }
    }
    __device__ __forceinline__ void operator()(Acc8 acc, const pg8::Unit& u, int wr, int wc, int fr, int fq) const {
        const int region = u.pn >> 2, ct = (u.pn & 3) * 256;
        const bool qk = region == 1 || region == 2;
        const int tok0 = u.pm * 256 + wr * 64 + fr;
        f32x4 cur[2], nxt[2];
        if (qk) ld_cs(cur, tok0, wc, fq);
#pragma unroll
        for (int ai = 0; ai < 2; ++ai)
#pragma unroll
            for (int m = 0; m < 4; ++m) {
                const int tok = tok0 + ai * 128 + m * 16, gi = ai * 4 + m;
                if (qk && gi + 1 < 8) ld_cs(nxt, tok0 + ((gi + 1) >> 2) * 128 + ((gi + 1) & 3) * 16, wc, fq);
#pragma unroll
                for (int bj = 0; bj < 2; ++bj) {
                    const int col = ct + bj * 128 + wc * 32 + 4 * fq;
                    if (region == 0) { *(u32x2*)(F + (size_t)tok * 1024 + col) = pack4(acc[ai][bj][m][0]); *(u32x2*)(F + (size_t)tok * 1024 + col + 16) = pack4(acc[ai][bj][m][1]); }
                    else if (region == 3) { *(u32x2*)(V + (size_t)tok * 1024 + col) = pack4(acc[ai][bj][m][0]); *(u32x2*)(V + (size_t)tok * 1024 + col + 16) = pack4(acc[ai][bj][m][1]); }
                    else if (region >= 4) {
#pragma unroll
                        for (int n = 0; n < 2; ++n) { f32x4 o;
#pragma unroll
                            for (int r = 0; r < 4; ++r) o[r] = silu_f(acc[ai][bj][m][n][r]);
                            *(u32x2*)(Gt + (size_t)tok * 2048 + (region - 4) * 1024 + col + 16 * n) = pack4(o); }
                    } else {
                        const int head = (u.pn & 3) * 2 + bj, d0 = 64 * (wc >> 1) + 16 * (wc & 1) + 4 * fq;
                        bf16_t* dst = (region == 1 ? Q : Kb) + (size_t)tok * 1024 + head * 128 + d0;
                        const float sc = region == 2 ? 0.08838834764831845f : 1.0f;
                        if (tok >= TC) {
                            f32x4 o1, o2;
#pragma unroll
                            for (int r = 0; r < 4; ++r) { const float cx = cur[r >> 1][(r & 1) * 2], sx = cur[r >> 1][(r & 1) * 2 + 1]; const float a = acc[ai][bj][m][0][r] * sc, b = acc[ai][bj][m][1][r] * sc; o1[r] = a * cx - b * sx; o2[r] = b * cx + a * sx; }
                            *(u32x2*)dst = pack4(o1); *(u32x2*)(dst + 32) = pack4(o2);
                        } else { *(u32x2*)dst = pack4(acc[ai][bj][m][0] * sc); *(u32x2*)(dst + 32) = pack4(acc[ai][bj][m][1] * sc); }
                    }
                }
                if (qk && gi + 1 < 8) { cur[0] = nxt[0]; cur[1] = nxt[1]; }
            }
    }
};
struct EpiOddProj {
    static constexpr bool PERM = false, AFTER_DRAIN = false;
    bf16_t* SQ; bf16_t* SK; bf16_t* SV; bf16_t* CQ; bf16_t* CKV; bf16_t* KR; const f32x2* r64;
    __device__ __forceinline__ void operator()(Acc8 acc, const pg8::Unit& u, int wr, int wc, int fr, int fq) const {
        const bool rot = u.pn <= 4 || u.pn == 8;
        const int tok0 = u.pm * 256 + wr * 64 + fr;
        f32x4 cur[2], nxt[2];
        if (rot) rope64_load(cur, r64, tok0, wc, fq);
#pragma unroll
        for (int ai = 0; ai < 2; ++ai)
#pragma unroll
            for (int m = 0; m < 4; ++m) {
                const int tok = tok0 + ai * 128 + m * 16, gi = ai * 4 + m;
                if (rot && gi + 1 < 8) rope64_load(nxt, r64, tok0 + ((gi + 1) >> 2) * 128 + ((gi + 1) & 3) * 16, wc, fq);
                const bool lat = tok >= TC;
#pragma unroll
                for (int bj = 0; bj < 2; ++bj) {
                    const int c0 = u.pn * 256 + bj * 128 + wc * 32 + 4 * fq;
                    const f32x4 a = acc[ai][bj][m][0], b = acc[ai][bj][m][1];
                    if (u.pn < 4) rope64_pair(a, b, lat, cur, 0.125f * LOG2E, SQ + (size_t)tok * 1024 + c0);
                    else if (u.pn == 4) { if (bj == 0) rope64_pair(a, b, lat, cur, 1.0f, SK + (size_t)tok * 128 + (c0 - 1024)); else rope64_pair(a, b, false, cur, 1.0f, SV + (size_t)tok * 128 + (c0 - 1152)); }
                    else if (u.pn < 7) rope64_pair(a, b, false, cur, 1.0f, CQ + (size_t)tok * 512 + (c0 - 1280));
                    else if (u.pn == 7) rope64_pair(a, b, false, cur, 1.0f, CKV + (size_t)tok * 256 + (c0 - 1792));
                    else if (bj == 0 && wc < 2) rope64_pair(a, b, lat, cur, 1.0f, KR + (size_t)tok * 64 + (c0 - 2048));
                }
                if (rot && gi + 1 < 8) { cur[0] = nxt[0]; cur[1] = nxt[1]; }
            }
    }
};
struct EpiMlaQ {
    static constexpr bool PERM = false, AFTER_DRAIN = false;
    bf16_t* MQ; const f32x2* r64;
    __device__ __forceinline__ void operator()(Acc8 acc, const pg8::Unit& u, int wr, int wc, int fr, int fq) const {
        const int tok0 = TC + u.pm * 256 + wr * 64 + fr;
        f32x4 cur[2], nxt[2];
        rope64_load(cur, r64, tok0, wc, fq);
#pragma unroll
        for (int ai = 0; ai < 2; ++ai)
#pragma unroll
            for (int m = 0; m < 4; ++m) {
                const int tok = tok0 + ai * 128 + m * 16, gi = ai * 4 + m;
                if (gi + 1 < 8) rope64_load(nxt, r64, tok0 + ((gi + 1) >> 2) * 128 + ((gi + 1) & 3) * 16, wc, fq);
#pragma unroll
                for (int bj = 0; bj < 2; ++bj) {
                    const int c0 = u.pn * 256 + bj * 128 + wc * 32 + 4 * fq; const int rr = c0 >> 6;
                    rope64_pair(acc[ai][bj][m][0], acc[ai][bj][m][1], (rr % 3) == 2, cur, 0.07216878364870322f * LOG2E, MQ + (size_t)tok * 1536 + c0);
                }
                if (gi + 1 < 8) { cur[0] = nxt[0]; cur[1] = nxt[1]; }
            }
    }
};
struct EpiMlaKV {
    static constexpr bool PERM = false, AFTER_DRAIN = false;
    bf16_t* MK; bf16_t* MV;
    __device__ __forceinline__ void operator()(Acc8 acc, const pg8::Unit& u, int wr, int wc, int fr, int fq) const {
#pragma unroll
        for (int ai = 0; ai < 2; ++ai)
#pragma unroll
            for (int m = 0; m < 4; ++m) {
                const int tok = u.pm * 256 + ai * 128 + wr * 64 + m * 16 + fr;
                bf16_t* k = MK + ((size_t)tok * 8 + u.pn) * 192 + wc * 32 + 4 * fq; bf16_t* v = MV + ((size_t)tok * 8 + u.pn) * 128 + wc * 32 + 4 * fq;
                *(u32x2*)k = pack4(acc[ai][0][m][0]); *(u32x2*)(k + 16) = pack4(acc[ai][0][m][1]);
                *(u32x2*)v = pack4(acc[ai][1][m][0]); *(u32x2*)(v + 16) = pack4(acc[ai][1][m][1]);
            }
    }
};
struct EpiWout {
    static constexpr bool PERM = false, AFTER_DRAIN = false;
    const float* mods; const float* xlat_old; const float* xctx_old; float* out; float* xctx_new; int layer, tok_off;
    struct Grp { f32x4 gv[2][2], xv[2][2]; float* xn; };
    __device__ __forceinline__ void load_grp(Grp& G, const pg8::Unit& u, int ai, int m, int wr, int wc, int fr, int fq) const {
        const int tok = tok_off + u.pm * 256 + ai * 128 + wr * 64 + m * 16 + fr;
        const int mw = tok < TC ? 2 : ((tok - TC) >> 14);
        const float* g1 = mods + (size_t)(layer * 3 + mw) * 12288 + 2 * 2048;
        const float* xo = tok < TC ? xctx_old + (size_t)tok * D : xlat_old + (size_t)(tok - TC) * D;
        G.xn = tok < TC ? xctx_new + (size_t)tok * D : out + (size_t)(tok - TC) * D;
#pragma unroll
        for (int bj = 0; bj < 2; ++bj)
#pragma unroll
            for (int n = 0; n < 2; ++n) {
                const int col = u.pn * 256 + bj * 128 + wc * 32 + n * 16 + 4 * fq;
                G.gv[bj][n] = *(const f32x4*)(g1 + col); G.xv[bj][n] = *(const f32x4*)(xo + col);
            }
    }
    __device__ __forceinline__ void operator()(Acc8 acc, const pg8::Unit& u, int wr, int wc, int fr, int fq) const {
        Grp cur, nxt;
        load_grp(cur, u, 0, 0, wr, wc, fr, fq);
#pragma unroll
        for (int ai = 0; ai < 2; ++ai)
#pragma unroll
            for (int m = 0; m < 4; ++m) {
                const int gi = ai * 4 + m;
                if (gi + 1 < 8) load_grp(nxt, u, (gi + 1) >> 2, (gi + 1) & 3, wr, wc, fr, fq);
#pragma unroll
                for (int bj = 0; bj < 2; ++bj)
#pragma unroll
                    for (int n = 0; n < 2; ++n) {
                        const int col = u.pn * 256 + bj * 128 + wc * 32 + n * 16 + 4 * fq;
                        __builtin_nontemporal_store(cur.xv[bj][n] + cur.gv[bj][n] * acc[ai][bj][m][n], (f32x4*)(cur.xn + col));
                    }
                if (gi + 1 < 8) cur = nxt;
            }
    }
};
struct EpiStoreBf16 {
    static constexpr bool PERM = false, AFTER_DRAIN = false;
    bf16_t* O; int ldc;
    __device__ __forceinline__ void operator()(Acc8 acc, const pg8::Unit& u, int wr, int wc, int fr, int fq) const {
#pragma unroll
        for (int ai = 0; ai < 2; ++ai)
#pragma unroll
            for (int m = 0; m < 4; ++m) {
                bf16_t* rp = O + (size_t)(u.pm * 256 + ai * 128 + wr * 64 + m * 16 + fr) * ldc + u.pn * 256 + wc * 32 + 4 * fq;
#pragma unroll
                for (int bj = 0; bj < 2; ++bj)
#pragma unroll
                    for (int n = 0; n < 2; ++n) *(u32x2*)(rp + bj * 128 + n * 16) = pack4(acc[ai][bj][m][n]);
            }
    }
};
template <class Epi>
__device__ __forceinline__ void big_gemm(const Ctx& c, const bf16_t* A, const bf16_t* Bt, int M, int N, int K, const Epi& E) {
    pg8::Gemm g{A, Bt, M, N, K}; pg8::StaticOrder S; S.init(M, N, c.G, c.bid);
    pg8::gemm_phase<Epi, pg8::StaticOrder>((PG8_LAS unsigned char*)c.lds, g, S, E);
}
__device__ __forceinline__ void phase_even_proj2(const Ctx& c) {
    EpiEvenProj E{c.wb(WS_A), c.wb(WS_Q), c.wb(WS_K), c.wb(WS_V), c.wb(WS_G), (const f32x2*)(c.ws + WS_ROPE)};
    big_gemm(c, c.wb(WS_H), c.wb(WS_WINE), TT, 6144, 2048, E);
    const int busy = (TT / 256) * 24 - 12 * c.G;
    if (busy > 0 && busy < c.G && c.bid >= busy) {
        conv_fp4(c, c.in[20] + (size_t)16384 * 2048, c.ws + WS_TABU + 32 * MiB, 16384, U_SCALE, c.bid - busy, c.G - busy);
        conv_fp4(c, c.in[21] + (size_t)16384 * 2048, c.ws + WS_TABV + 32 * MiB, 16384, V_SCALE, c.bid - busy, c.G - busy);
    } else if (!(busy > 0 && busy < c.G)) {
        conv_fp4(c, c.in[20] + (size_t)16384 * 2048, c.ws + WS_TABU + 32 * MiB, 16384, U_SCALE, c.bid, c.G);
        conv_fp4(c, c.in[21] + (size_t)16384 * 2048, c.ws + WS_TABV + 32 * MiB, 16384, V_SCALE, c.bid, c.G);
    }
}
__device__ __forceinline__ void phase_odd_proj2(const Ctx& c) {
    EpiOddProj E{c.wb(WS_A), c.wb(WS_Q), c.wb(WS_Q + 9 * MiB), c.wb(WS_Q + 18 * MiB), c.wb(WS_K), c.wb(WS_K + 17 * MiB), (const f32x2*)(c.ws + WS_ROPE + 131072)};
    big_gemm(c, c.wb(WS_H), c.wb(WS_WINO), TT, 2304, 2048, E);
}
__device__ __forceinline__ void phase_mla_up2(const Ctx& c) {
    EpiMlaQ EQ{c.wb(WS_G), (const f32x2*)(c.ws + WS_ROPE + 131072)};
    big_gemm(c, c.wb(WS_Q + 18 * MiB) + (size_t)TC * 512, c.wb(WS_WUQ), TL, 1536, 512, EQ);
    EpiMlaKV EK{c.wb(WS_ST), c.wb(WS_V)};
    big_gemm(c, c.wb(WS_K), c.wb(WS_WUKV), TT, 2048, 256, EK);
}
__device__ __forceinline__ void phase_wout2(const Ctx& c, const bf16_t* W, int layer, const float* xlat_old, const float* xctx_old, int tok_off) {
    EpiWout E{c.wf(WS_MODS), xlat_old, xctx_old, c.out, c.wf(WS_XCTX), layer, tok_off};
    big_gemm(c, c.wb(WS_CAT) + (size_t)tok_off * 2048, W, TT - tok_off, 2048, 2048, E);
}
__device__ __forceinline__ void phase_peer_q2(const Ctx& c, const bf16_t* W, int tok_off) {
    EpiStoreBf16 E{c.wb(WS_G) + (size_t)tok_off * 2048, 2048};
    big_gemm(c, c.wb(WS_H) + (size_t)tok_off * 2048, W, TT - tok_off, 2048, 2048, E);
}

#ifdef DBG_FOURIER_CHECK
__device__ __forceinline__ void dbg_fourier_check(const Ctx& c) {
    if (c.bid >= 48) return;
    const bf16_t* F = c.wb(WS_A); const bf16_t* CAT = c.wb(WS_CAT);
    LAS float* red = (LAS float*)c.lds;
    const int i = c.bid;
    const bool lat = i >= 32;
    const int b = i & 1, g = (i >> 1) & 3, m = (i * 53 + 7) & 255;
    const int L = lat ? 16384 : 256;
    const int k = lat ? ((i * 2731 + 11) & 16383) : ((i * 37 + 3) & 255);
    const size_t tok0 = lat ? (size_t)TC + (size_t)b * SEQ : (size_t)b * NCTX;
    float acc = 0.f;
    for (int n = c.tid; n < L; n += 512) {
        const float fa = (float)(((long long)k * n) % L) / (float)L;
        float rs = 0.f;
        for (int cc = 0; cc < 256; ++cc) {
            const float fb = (float)((m * cc) & 255) * (1.0f / 256.0f);
            float fr = fa + fb; fr = fr - floorf(fr);
            rs += bf2f(F[(tok0 + n) * 1024 + g * 256 + cc]) * cos_rev(fr);
        }
        acc += rs;
    }
    acc = wave_sum(acc);
    if (c.lane == 0) red[c.w] = acc;
    __syncthreads();
    float tot = 0.f; for (int w = 0; w < 8; ++w) tot += red[w];
    tot *= lat ? (1.0f / 2048.0f) : (1.0f / 256.0f);
    const float got = bf2f(CAT[(tok0 + k) * 2048 + g * 256 + m]);
    if (c.tid == 0 && fabsf(got - tot) > 0.03f + 0.03f * fabsf(tot)) atomicOr((unsigned*)(c.ws + WS_CTL + 32768), lat ? 2u : 1u);
    __syncthreads();
}
#endif
#ifdef DBG_RET_CHECK
__device__ __forceinline__ void dbg_ret_check(const Ctx& c) {
    if (c.bid >= 32) return;
    const bf16_t* Q = c.wb(WS_Q); const bf16_t* Kb = c.wb(WS_K); const bf16_t* V = c.wb(WS_V); const bf16_t* Gt = c.wb(WS_G); const bf16_t* CAT = c.wb(WS_CAT);
    const float* gn = c.in[9];
    LAS float* wgt = (LAS float*)c.lds;
    LAS float* red = (LAS float*)(c.lds + 80000);
    const int i = c.bid, b = i & 1, h = (i >> 1) & 7;
    const bool isctx = i >= 26;
    const int pos = isctx ? (i == 26 ? 5 : (i == 27 ? 130 : (i == 28 ? 255 : (i == 29 ? 0 : (i * 41) & 255))))
                          : (i == 0 ? 0 : (i == 1 ? 16383 : (i == 2 ? 127 : (i == 3 ? 128 : (i * 1637 + 29) & 16383))));
    const size_t tokT = isctx ? (size_t)b * NCTX + pos : (size_t)TC + (size_t)b * SEQ + pos;
    const float lg = log2_gamma(h);
    float yacc = 0.f;
    for (int dir = 0; dir < 2; ++dir) {
        const int nkeys = isctx ? 256 : 256 + 16384;
        for (int j = c.tid; j < nkeys; j += 512) {
            const bool kc = j < 256; const int kp = kc ? j : j - 256;
            const size_t tokK = kc ? (size_t)b * NCTX + kp : (size_t)TC + (size_t)b * SEQ + kp;
            int dist;
            if (isctx) dist = dir == 0 ? pos - kp : kp - pos;
            else if (kc) dist = dir == 0 ? 256 + pos - kp : 16384 - pos + kp;
            else dist = dir == 0 ? pos - kp : kp - pos;
            float w = 0.f;
            if (dist >= 0) {
                float d = 0.f;
                for (int x = 0; x < 128; ++x) d += bf2f(Q[tokT * 1024 + h * 128 + x]) * bf2f(Kb[tokK * 1024 + h * 128 + x]);
                w = d * fast_exp2(lg * (float)dist);
            }
            wgt[j] = w;
        }
        __syncthreads();
        float o = 0.f;
        if (c.tid < 128) {
            for (int j = 0; j < nkeys; ++j) {
                const float w = wgt[j];
                if (w != 0.f) { const bool kc = j < 256; const int kp = kc ? j : j - 256; const size_t tokK = kc ? (size_t)b * NCTX + kp : (size_t)TC + (size_t)b * SEQ + kp;
                    o += w * bf2f(V[tokK * 1024 + h * 128 + c.tid]); }
            }
        }
        float ss = (c.tid < 128) ? o * o : 0.f;
        ss = wave_sum(ss);
        if (c.lane == 0) red[c.w] = ss;
        __syncthreads();
        const float tot = red[0] + red[1];
        const float rstd = rsqrtf(tot * (1.0f / 128.0f) + EPS);
        if (c.tid < 128) yacc += o * rstd * gn[h * 128 + c.tid] * bf2f(Gt[tokT * 2048 + dir * 1024 + h * 128 + c.tid]);
        __syncthreads();
    }
    if (c.tid < 128) {
        const float got = bf2f(CAT[tokT * 2048 + 1024 + h * 128 + c.tid]);
        if (fabsf(got - yacc) > 0.04f + 0.05f * fabsf(yacc)) atomicOr((unsigned*)(c.ws + WS_CTL + 32768), isctx ? 8u : 4u);
    }
    __syncthreads();
}
#endif
__global__ void __launch_bounds__(512, 2) fwd_kernel(KArgs a) {
    extern __shared__ __attribute__((aligned(16))) unsigned char shm[];
    Ctx c;
#pragma unroll
    for (int i = 0; i < 23; ++i) c.in[i] = a.in[i];
    c.out = a.out; c.ws = a.ws; c.lds = (LAS unsigned char*)shm; c.G = gridDim.x; c.bid = blockIdx.x; c.tid = threadIdx.x; c.lane = threadIdx.x & 63;
    c.w = __builtin_amdgcn_readfirstlane(threadIdx.x >> 6);
    const int lo = a.ph_lo, hi = a.ph_hi;
    volatile LAS unsigned* bw = (volatile LAS unsigned*)(c.lds + LDS_BYTES - 16);
    XcdBarrier bar; bar.bar = (unsigned*)(a.ws + WS_CTL); bar.x = 0; bar.st = bw;
    if (hi - lo > 1) {
        if (threadIdx.x == 0) { bw[0] = 0u; bw[1] = 0u; bw[2] = 0u; bw[3] = 0u; }
        __syncthreads();
        bar = xcd_barrier_post((unsigned*)(a.ws + WS_CTL), bw);
    }
#define IN(k) (((PHASE_MASK >> (k)) & 1u) && lo <= (k) && (k) < hi)
#define SEAM(k) do { if (IN(k) && IN((k) + 1)) xcd_barrier(bar); } while (0)
    float* XCTX = c.wf(WS_XCTX); bf16_t* H = c.wb(WS_H);
    if (IN(0)) phase_prologue(c);
    SEAM(0);
    if (IN(1)) phase_mods(c);
    SEAM(1);
    if (IN(2)) phase_modnorm(c, 0, 0, c.in[0], c.in[2], 0, H);
    SEAM(2);
    if (IN(3)) phase_even_proj2(c);
    SEAM(3);
    if (IN(4)) phase_chan_dft(c);
    SEAM(4);
    if (IN(5)) phase_dft_stage1(c);
    SEAM(5);
    if (IN(6)) { phase_dft_stage2(c); phase_ret_ds(c); }
    SEAM(6);
    if (IN(7)) phase_ret_scan(c);
    SEAM(7);
    if (IN(8)) phase_ret_out(c);
    SEAM(8);
#ifdef DBG_FOURIER_CHECK
    if (IN(9)) dbg_fourier_check(c);
#endif
#ifdef DBG_RET_CHECK
    if (IN(9)) dbg_ret_check(c);
#endif
    if (IN(9)) { phase_wout2(c, c.wb(WS_WOUTE), 0, c.in[0], c.in[2], TC); phase_wout(c, c.wb(WS_WOUTE), 0, c.in[0], c.in[2], 0, TC / 128); }
    SEAM(9);
    if (IN(10)) phase_modnorm(c, 0, 1, c.out, XCTX, 0, H);
    SEAM(10);
    if (IN(11)) { phase_peer_q2(c, c.wb(WS_WQ0), TC); phase_peer_q(c, c.wb(WS_WQ0), 0, TC / 128); }
    SEAM(11);
    if (IN(12)) phase_peer_topk(c, 0, 0);
    SEAM(12);
#ifdef DBG_TOPK_CHECK
    if (lo == 12) dbg_gather_save(c);
#endif
    if (IN(13)) phase_peer_gather<false>(c, 0, 0);
    SEAM(13);
#ifdef DBG_TOPK_CHECK
    if (lo == 13) dbg_topk_check(c);
    if (lo == 14) dbg_gather_check(c);
#endif
    if (IN(14)) {
        phase_modnorm(c, 1, 0, c.out, XCTX, 0, H);
    }
    SEAM(14);
    if (IN(15)) phase_odd_proj2(c);
    SEAM(15);
    if (IN(16)) phase_odd_local(c);
    SEAM(16);
    if (IN(17)) phase_mla_up2(c);
    SEAM(17);
    if (IN(18)) phase_attention(c);
    SEAM(18);
#ifdef DBG_ATTN_CHECK
    if (IN(19)) dbg_attn_check(c);
#endif
    if (IN(19)) phase_wout2(c, c.wb(WS_WOUTO), 1, c.out, XCTX, TC);
    SEAM(19);
    if (IN(20)) phase_modnorm(c, 1, 1, c.out, XCTX, TC, H);
    SEAM(20);
    if (IN(21)) phase_peer_q2(c, c.wb(WS_WQ1), TC);
    SEAM(21);
    if (IN(22)) phase_peer_topk(c, 1, 4);
    SEAM(22);
    if (IN(23)) phase_peer_gather<true>(c, 1, TC);
#ifdef DUMP_OFF
    if (lo == NPH - 1) { const bf16_t* src = c.wb(DUMP_OFF); for (size_t i = (size_t)c.bid * 512 + c.tid; i < (size_t)TL * D; i += (size_t)c.G * 512) { float v = bf2f(src[i]); c.out[i] = (v == v && fabsf(v) < 1e30f) ? v : 777.0f; } }
#endif
#undef IN
#undef SEAM
}

extern "C" void kernel_launch(void* const* d_in, const int* in_sizes, int n_in, void* d_out, int out_size, void* d_ws, size_t ws_size, hipStream_t stream) {
    static int grid = 0;
    if (grid == 0) {
        if (n_in != 23 || ws_size < WS_END) { fprintf(stderr, "kernel_launch: unexpected n_in %d / ws %zu\n", n_in, ws_size); grid = -1; return; }
        int dev = 0, cus = 0, per_cu = 0;
        hipGetDevice(&dev);
        hipDeviceGetAttribute(&cus, hipDeviceAttributeMultiprocessorCount, dev);
        if (hipFuncSetAttribute((const void*)fwd_kernel, hipFuncAttributeMaxDynamicSharedMemorySize, LDS_BYTES) != hipSuccess) { fprintf(stderr, "hipFuncSetAttribute failed\n"); grid = -1; return; }
        if (hipOccupancyMaxActiveBlocksPerMultiprocessor(&per_cu, (const void*)fwd_kernel, 512, LDS_BYTES) != hipSuccess || per_cu < 1) { fprintf(stderr, "occupancy query: %d\n", per_cu); }
        (void)hipGetLastError();
        grid = cus > 0 ? cus : 256;
    }
    if (grid < 0) return;
    hipMemsetAsync((char*)d_ws + WS_CTL, 0, 65536, stream);
    KArgs a{};
    for (int i = 0; i < 23; ++i) a.in[i] = (const float*)d_in[i];
    a.out = (float*)d_out; a.ws = (unsigned char*)d_ws;
#if N_LAUNCHES == 1
    a.ph_lo = 0; a.ph_hi = NPH;
    hipLaunchKernelGGL(fwd_kernel, dim3(grid), dim3(512), LDS_BYTES, stream, a);
#else
    { static const int order[NPH] = {0,1,2,3,4,5,6,7,8,9,10,11,12,13,14,15,16,17,18,19,20,21,22,23};
      for (int i = 0; i < NPH; ++i) { const int k = order[i]; a.ph_lo = k; a.ph_hi = k + 1; hipLaunchKernelGGL(fwd_kernel, dim3(grid), dim3(512), LDS_BYTES, stream, a); } }
#endif
}
```

```cpp
#include <hip/hip_runtime.h>
#include <stdint.h>
#include <stdio.h>

#ifndef N_LAUNCHES
#define N_LAUNCHES 1
#endif
#ifndef DBG_SKIP_GATHER
#define DBG_SKIP_GATHER 0
#endif
#ifndef DBG_CAT_PART
#define DBG_CAT_PART 0

#endif
#ifndef PHASE_MASK
#define PHASE_MASK 0xFFFFFFu
#endif

#define LAS __attribute__((address_space(3)))
typedef unsigned short bf16_t;
typedef short bf16x8 __attribute__((ext_vector_type(8)));
typedef short s16x4 __attribute__((ext_vector_type(4)));
typedef float f32x2 __attribute__((ext_vector_type(2)));
typedef float f32x4 __attribute__((ext_vector_type(4)));
typedef float f32x16 __attribute__((ext_vector_type(16)));
typedef unsigned u32x2 __attribute__((ext_vector_type(2)));
typedef unsigned u32x4 __attribute__((ext_vector_type(4)));
typedef __bf16 bf16x2_t __attribute__((ext_vector_type(2)));

constexpr int D = 2048, NBATCH = 2, SEQ = 16384, NCTX = 256;
constexpr int TC = NBATCH * NCTX;
constexpr int TL = NBATCH * SEQ;
constexpr int TT = TC + TL;
constexpr int NCH = 130;
constexpr float EPS = 1e-6f;
constexpr float LOG2E = 1.4426950408889634f;
constexpr float U_SCALE = 90.5f, V_SCALE = 2.0f;

constexpr size_t MiB = 1ull << 20;
constexpr size_t WS_CTL = 0;
constexpr size_t WS_MODS = 1 * MiB;
constexpr size_t WS_MODP = 2 * MiB;
constexpr size_t WS_ROPE = 12 * MiB;
constexpr size_t WS_DFT = 13 * MiB;
constexpr size_t WS_SKB = 14 * MiB;
constexpr size_t WS_XCTX = 15 * MiB;
constexpr size_t WS_W = 19 * MiB;
constexpr size_t WS_WINE = WS_W;
constexpr size_t WS_WOUTE = WS_WINE + 24 * MiB;
constexpr size_t WS_WINO = WS_WOUTE + 8 * MiB;
constexpr size_t WS_WUQ = WS_WINO + 9 * MiB;
constexpr size_t WS_WUKV = WS_WUQ + 2 * MiB;
constexpr size_t WS_WOUTO = WS_WUKV + 1 * MiB;
constexpr size_t WS_WQ0 = WS_WOUTO + 8 * MiB;
constexpr size_t WS_WQ1 = WS_WQ0 + 8 * MiB;
constexpr size_t WS_TABU = 88 * MiB;
constexpr size_t WS_TABV = WS_TABU + 64 * MiB;
constexpr size_t WS_H = 216 * MiB;
constexpr size_t WS_A = 346 * MiB;
constexpr size_t WS_Q = 411 * MiB;
constexpr size_t WS_K = 476 * MiB;
constexpr size_t WS_V = 541 * MiB;
constexpr size_t WS_G = 606 * MiB;
constexpr size_t WS_CAT = 736 * MiB;
constexpr size_t WS_ST = 866 * MiB;
constexpr size_t WS_IDX = 998 * MiB;
constexpr size_t WS_GATE = 1015 * MiB;
constexpr size_t WS_END = 1032 * MiB;

constexpr int LDS_BYTES = 147456;
constexpr int NPH = 24;

#define XB_TMO      128
#define XB_XCNT(j)  (256  + 64 * (j))
#define XB_XSUB(j)  (1280 + 64 * (j))
#define XB_XGEN(j)  (2304 + 64 * (j))
#define XB_TOP      3328
#define XB_TOPGEN   3392
#define XCD_BAR_WORDS 3456
#define XB_SPIN_CAP (1u << 24)

__device__ __forceinline__ unsigned xb_ld(unsigned* p)              { return __hip_atomic_load(p, __ATOMIC_RELAXED, __HIP_MEMORY_SCOPE_AGENT); }
__device__ __forceinline__ unsigned xb_add(unsigned* p, unsigned v) { return __hip_atomic_fetch_add(p, v, __ATOMIC_RELAXED, __HIP_MEMORY_SCOPE_AGENT); }
__device__ __forceinline__ unsigned xb_xcc_id() { return (unsigned)__builtin_amdgcn_s_getreg((3 << 11) | 20) & 0xFu; }
#define XB_SPIN(cond, bar) do { unsigned _sp = 0; while (cond) { __builtin_amdgcn_s_sleep(1); \
    if ((++_sp & 255u) == 0u) { if (xb_ld(&(bar)[XB_TMO])) break; if (_sp > XB_SPIN_CAP) { atomicAdd(&(bar)[XB_TMO], 1u); break; } } } } while (0)

struct XcdBarrier { unsigned* bar; unsigned x; volatile LAS unsigned* st; };

__device__ __forceinline__ XcdBarrier xcd_barrier_post(unsigned* bar, volatile LAS unsigned* st) {
    XcdBarrier b; b.bar = bar; b.x = xb_xcc_id(); b.st = st;
    if (threadIdx.x == 0) (void)xb_add(&bar[XB_XCNT(b.x)], 1u);
    return b;
}
__device__ __forceinline__ void xcd_barrier_complete(unsigned* bar, unsigned x, unsigned& nloc, unsigned& nx) {
    const unsigned G = gridDim.x * gridDim.y * gridDim.z;
    unsigned sum, cnt, mine, sp = 0u;
    for (;;) {
        sum = 0u; cnt = 0u; mine = 0u;
#pragma unroll
        for (unsigned j = 0; j < 16; ++j) { const unsigned c = xb_ld(&bar[XB_XCNT(j)]); sum += c; cnt += (c > 0u) ? 1u : 0u; mine = (j == x) ? c : mine; }
        if (sum == G) break;
        __builtin_amdgcn_s_sleep(1);
        if ((++sp & 255u) == 0u) { if (xb_ld(&bar[XB_TMO])) break; if (sp > XB_SPIN_CAP) { atomicAdd(&bar[XB_TMO], 1u); break; } }
    }
    nloc = mine > 0u ? mine : 1u; nx = cnt > 0u ? cnt : 1u;
}
__device__ __forceinline__ void xcd_barrier(const XcdBarrier& b) {
    asm volatile("s_waitcnt vmcnt(0)" ::: "memory");
    __syncthreads();
    if (threadIdx.x == 0) {
        unsigned* bar = b.bar;
        __builtin_amdgcn_s_waitcnt(0);
        unsigned nloc = b.st[0], nx = b.st[1];
        if (nloc == 0u) { xcd_barrier_complete(bar, b.x, nloc, nx); b.st[0] = nloc; b.st[1] = nx; }
        const unsigned old = xb_add(&bar[XB_XSUB(b.x)], 1u);
        const unsigned gen = old / nloc;
        if (old + 1u == (gen + 1u) * nloc) {
            __builtin_amdgcn_fence(__ATOMIC_RELEASE, "agent");
            asm volatile("s_waitcnt vmcnt(0)" ::: "memory");
            const unsigned og = xb_add(&bar[XB_TOP], 1u);
            const unsigned tg = og / nx;
            if (og + 1u == (tg + 1u) * nx) xb_add(&bar[XB_TOPGEN], 1u);
            else XB_SPIN(xb_ld(&bar[XB_TOPGEN]) == tg, bar);
            __builtin_amdgcn_fence(__ATOMIC_ACQUIRE, "agent");
            xb_add(&bar[XB_XGEN(b.x)], 1u);
            asm volatile("s_waitcnt vmcnt(0)" ::: "memory");
        } else {
            XB_SPIN(xb_ld(&bar[XB_XGEN(b.x)]) == gen, bar);
            __builtin_amdgcn_fence(__ATOMIC_ACQUIRE, "agent");
            asm volatile("s_waitcnt vmcnt(0)" ::: "memory");
        }
    }
    __syncthreads();
}

__device__ __forceinline__ unsigned cvt_pk_bf16(float lo, float hi) { const f32x2 v = {lo, hi}; const bf16x2_t r = __builtin_convertvector(v, bf16x2_t); return __builtin_bit_cast(unsigned, r); }
__device__ __forceinline__ float bf_lo(unsigned u) { return __uint_as_float(u << 16); }
__device__ __forceinline__ float bf_hi(unsigned u) { return __uint_as_float(u & 0xffff0000u); }
__device__ __forceinline__ float bf2f(bf16_t b) { return __uint_as_float(((unsigned)b) << 16); }
__device__ __forceinline__ u32x2 pack4(f32x4 v) { u32x2 r; r.x = cvt_pk_bf16(v[0], v[1]); r.y = cvt_pk_bf16(v[2], v[3]); return r; }
__device__ __forceinline__ float fast_exp2(float x) { return __builtin_amdgcn_exp2f(x); }
__device__ __forceinline__ float fast_rcp(float x) { return __builtin_amdgcn_rcpf(x); }
__device__ __forceinline__ float silu_f(float x) { return x * fast_rcp(1.0f + fast_exp2(-x * LOG2E)); }
__device__ __forceinline__ float gelu_tanh(float x) {
    const float u = 0.7978845608028654f * (x + 0.044715f * x * x * x);
    return x * fast_rcp(1.0f + fast_exp2(-2.0f * LOG2E * u));
}
__device__ __forceinline__ float wave_sum(float v) {
#pragma unroll
    for (int o = 32; o >= 1; o >>= 1) v += __shfl_xor(v, o);
    return v;
}
__device__ __forceinline__ float cos_rev(float fr) { return __builtin_amdgcn_cosf(fr); }
__device__ __forceinline__ float sin_rev(float fr) { return __builtin_amdgcn_sinf(fr); }
__device__ __forceinline__ float log2_gamma(int h) {
    const float x = __uint_as_float((unsigned)(127 - 5 - h) << 23);
    float s = x * (1.0f + x * (0.5f + x * (0.33333334f + x * (0.25f + x * (0.2f + x * (0.16666667f + x * 0.14285715f))))));
    return -s * LOG2E;
}

__device__ __forceinline__ int tok_batch(int tok) { return tok < TC ? (tok >> 8) : ((tok - TC) >> 14); }

constexpr int GEMM_LDS = 73728;
template <bool TRANS, class AF, class BF>
__device__ __forceinline__ void gemm128(LAS unsigned char* lds, int K, const AF& arow, const BF& brow, f32x4 (&acc)[2][4]) {
    const int tid = threadIdx.x, lane = tid & 63, w = tid >> 6, wm = w >> 1, wn = w & 1;
    const int r0 = tid >> 3, ch = tid & 7;
    const bf16_t* pa0 = arow(r0) + ch * 8; const bf16_t* pa1 = arow(r0 + 64) + ch * 8;
    const bf16_t* pb0 = brow(r0) + ch * 8; const bf16_t* pb1 = brow(r0 + 64) + ch * 8;
    const int woff = r0 * 144 + ch * 16;
#pragma unroll
    for (int mb = 0; mb < 2; ++mb)
#pragma unroll
        for (int nb = 0; nb < 4; ++nb) acc[mb][nb] = (f32x4){0.f, 0.f, 0.f, 0.f};
    u32x4 ra0 = *(const u32x4*)pa0, ra1 = *(const u32x4*)pa1, rb0 = *(const u32x4*)pb0, rb1 = *(const u32x4*)pb1;
    *(LAS u32x4*)(lds + woff) = ra0; *(LAS u32x4*)(lds + woff + 9216) = ra1;
    *(LAS u32x4*)(lds + 36864 + woff) = rb0; *(LAS u32x4*)(lds + 36864 + woff + 9216) = rb1;
    __syncthreads();
    const int nk = K >> 6;
    const int aoff = (32 * wm + (lane & 15)) * 144 + (lane >> 4) * 16;
    const int boff = 36864 + (64 * wn + (lane & 15)) * 144 + (lane >> 4) * 16;
    for (int kt = 0; kt < nk; ++kt) {
        const int buf = (kt & 1) * 18432;
        if (kt + 1 < nk) {
            const int ko = (kt + 1) * 64;
            ra0 = *(const u32x4*)(pa0 + ko); ra1 = *(const u32x4*)(pa1 + ko); rb0 = *(const u32x4*)(pb0 + ko); rb1 = *(const u32x4*)(pb1 + ko);
        }
#pragma unroll
        for (int ks = 0; ks < 2; ++ks) {
            bf16x8 af[2], bfr[4];
#pragma unroll
            for (int mb = 0; mb < 2; ++mb) af[mb] = *(const LAS bf16x8*)(lds + buf + aoff + mb * 2304 + ks * 64);
#pragma unroll
            for (int nb = 0; nb < 4; ++nb) bfr[nb] = *(const LAS bf16x8*)(lds + buf + boff + nb * 2304 + ks * 64);
#pragma unroll
            for (int mb = 0; mb < 2; ++mb)
#pragma unroll
                for (int nb = 0; nb < 4; ++nb)
                    acc[mb][nb] = TRANS ? __builtin_amdgcn_mfma_f32_16x16x32_bf16(bfr[nb], af[mb], acc[mb][nb], 0, 0, 0)
                                        : __builtin_amdgcn_mfma_f32_16x16x32_bf16(af[mb], bfr[nb], acc[mb][nb], 0, 0, 0);
        }
        if (kt + 1 < nk) {
            const int nb2 = ((kt + 1) & 1) * 18432;
            *(LAS u32x4*)(lds + nb2 + woff) = ra0; *(LAS u32x4*)(lds + nb2 + woff + 9216) = ra1;
            *(LAS u32x4*)(lds + 36864 + nb2 + woff) = rb0; *(LAS u32x4*)(lds + 36864 + nb2 + woff + 9216) = rb1;
        }
        __syncthreads();
    }
}
template <bool TRANS, int K, class AF, class BF>
__device__ __forceinline__ void gemm128s(LAS unsigned char* lds, const AF& arow, const BF& brow, f32x4 (&acc)[2][4]) {
    constexpr int NK = K / 64, DEPTH = NK < 4 ? NK : 4;
    const int tid = threadIdx.x, lane = tid & 63, w = tid >> 6, wm = w >> 1, wn = w & 1;
    const int r0 = tid >> 3, ch = tid & 7;
    const bf16_t* pa0 = arow(r0) + ch * 8; const bf16_t* pa1 = arow(r0 + 64) + ch * 8;
    const bf16_t* pb0 = brow(r0) + ch * 8; const bf16_t* pb1 = brow(r0 + 64) + ch * 8;
    const int woff = r0 * 144 + ch * 16;
    u32x4 rg[DEPTH][4];
#pragma unroll
    for (int d = 0; d < DEPTH; ++d) {
        rg[d][0] = *(const u32x4*)(pa0 + d * 64); rg[d][1] = *(const u32x4*)(pa1 + d * 64);
        rg[d][2] = *(const u32x4*)(pb0 + d * 64); rg[d][3] = *(const u32x4*)(pb1 + d * 64);
    }
    __builtin_amdgcn_sched_barrier(0);
#pragma unroll
    for (int mb = 0; mb < 2; ++mb)
#pragma unroll
        for (int nb = 0; nb < 4; ++nb) acc[mb][nb] = (f32x4){0.f, 0.f, 0.f, 0.f};
    *(LAS u32x4*)(lds + woff) = rg[0][0]; *(LAS u32x4*)(lds + woff + 9216) = rg[0][1];
    *(LAS u32x4*)(lds + 36864 + woff) = rg[0][2]; *(LAS u32x4*)(lds + 36864 + woff + 9216) = rg[0][3];
    __syncthreads();
    const int aoff = (32 * wm + (lane & 15)) * 144 + (lane >> 4) * 16;
    const int boff = 36864 + (64 * wn + (lane & 15)) * 144 + (lane >> 4) * 16;
#pragma unroll
    for (int kt = 0; kt < NK; ++kt) {
        const int buf = (kt & 1) * 18432;
        if (kt + DEPTH < NK) {
            const int ko = (kt + DEPTH) * 64;
            rg[kt % DEPTH][0] = *(const u32x4*)(pa0 + ko); rg[kt % DEPTH][1] = *(const u32x4*)(pa1 + ko);
            rg[kt % DEPTH][2] = *(const u32x4*)(pb0 + ko); rg[kt % DEPTH][3] = *(const u32x4*)(pb1 + ko);
            __builtin_amdgcn_sched_barrier(0);
        }
#pragma unroll
        for (int ks = 0; ks < 2; ++ks) {
            bf16x8 af[2], bfr[4];
#pragma unroll
            for (int mb = 0; mb < 2; ++mb) af[mb] = *(const LAS bf16x8*)(lds + buf + aoff + mb * 2304 + ks * 64);
#pragma unroll
            for (int nb = 0; nb < 4; ++nb) bfr[nb] = *(const LAS bf16x8*)(lds + buf + boff + nb * 2304 + ks * 64);
#pragma unroll
            for (int mb = 0; mb < 2; ++mb)
#pragma unroll
                for (int nb = 0; nb < 4; ++nb)
                    acc[mb][nb] = TRANS ? __builtin_amdgcn_mfma_f32_16x16x32_bf16(bfr[nb], af[mb], acc[mb][nb], 0, 0, 0)
                                        : __builtin_amdgcn_mfma_f32_16x16x32_bf16(af[mb], bfr[nb], acc[mb][nb], 0, 0, 0);
        }
        if (kt + 1 < NK) {
            const int nb2 = ((kt + 1) & 1) * 18432; constexpr int dummy = 0; (void)dummy;
            const int s = (kt + 1) % DEPTH;
            *(LAS u32x4*)(lds + nb2 + woff) = rg[s][0]; *(LAS u32x4*)(lds + nb2 + woff + 9216) = rg[s][1];
            *(LAS u32x4*)(lds + 36864 + nb2 + woff) = rg[s][2]; *(LAS u32x4*)(lds + 36864 + nb2 + woff + 9216) = rg[s][3];
        }
        __syncthreads();
    }
}
template <bool TRANS, class AF, class BF>
__device__ __forceinline__ void gemm128r(LAS unsigned char* lds, int K, const AF& arow, const BF& brow, f32x4 (&acc)[2][4]) {
    const int tid = threadIdx.x, lane = tid & 63, w = tid >> 6, wm = w >> 1, wn = w & 1;
    const int r0 = tid >> 3, ch = tid & 7;
    const bf16_t* pa0 = arow(r0) + ch * 8; const bf16_t* pa1 = arow(r0 + 64) + ch * 8;
    const bf16_t* pb0 = brow(r0) + ch * 8; const bf16_t* pb1 = brow(r0 + 64) + ch * 8;
    const int woff = r0 * 144 + ch * 16;
    u32x4 rg[4][4];
#pragma unroll
    for (int d = 0; d < 4; ++d) {
        rg[d][0] = *(const u32x4*)(pa0 + d * 64); rg[d][1] = *(const u32x4*)(pa1 + d * 64);
        rg[d][2] = *(const u32x4*)(pb0 + d * 64); rg[d][3] = *(const u32x4*)(pb1 + d * 64);
    }
    __builtin_amdgcn_sched_barrier(0);
#pragma unroll
    for (int mb = 0; mb < 2; ++mb)
#pragma unroll
        for (int nb = 0; nb < 4; ++nb) acc[mb][nb] = (f32x4){0.f, 0.f, 0.f, 0.f};
    *(LAS u32x4*)(lds + woff) = rg[0][0]; *(LAS u32x4*)(lds + woff + 9216) = rg[0][1];
    *(LAS u32x4*)(lds + 36864 + woff) = rg[0][2]; *(LAS u32x4*)(lds + 36864 + woff + 9216) = rg[0][3];
    __syncthreads();
    const int nk = K >> 6;
    const int aoff = (32 * wm + (lane & 15)) * 144 + (lane >> 4) * 16;
    const int boff = 36864 + (64 * wn + (lane & 15)) * 144 + (lane >> 4) * 16;
#pragma unroll 1
    for (int kt0 = 0; kt0 < nk; kt0 += 4) {
#pragma unroll
        for (int j = 0; j < 4; ++j) {
            const int kt = kt0 + j, buf = (j & 1) * 18432;
            if (kt + 4 < nk) {
                const int ko = (kt + 4) * 64;
                rg[j][0] = *(const u32x4*)(pa0 + ko); rg[j][1] = *(const u32x4*)(pa1 + ko);
                rg[j][2] = *(const u32x4*)(pb0 + ko); rg[j][3] = *(const u32x4*)(pb1 + ko);
            }
            __builtin_amdgcn_sched_barrier(0);
#pragma unroll
            for (int ks = 0; ks < 2; ++ks) {
                bf16x8 af[2], bfr[4];
#pragma unroll
                for (int mb = 0; mb < 2; ++mb) af[mb] = *(const LAS bf16x8*)(lds + buf + aoff + mb * 2304 + ks * 64);
#pragma unroll
                for (int nb = 0; nb < 4; ++nb) bfr[nb] = *(const LAS bf16x8*)(lds + buf + boff + nb * 2304 + ks * 64);
#pragma unroll
                for (int mb = 0; mb < 2; ++mb)
#pragma unroll
                    for (int nb = 0; nb < 4; ++nb)
                        acc[mb][nb] = TRANS ? __builtin_amdgcn_mfma_f32_16x16x32_bf16(bfr[nb], af[mb], acc[mb][nb], 0, 0, 0)
                                            : __builtin_amdgcn_mfma_f32_16x16x32_bf16(af[mb], bfr[nb], acc[mb][nb], 0, 0, 0);
            }
            if (kt + 1 < nk) {
                const int nb2 = ((j + 1) & 1) * 18432, s = (j + 1) & 3;
                *(LAS u32x4*)(lds + nb2 + woff) = rg[s][0]; *(LAS u32x4*)(lds + nb2 + woff + 9216) = rg[s][1];
                *(LAS u32x4*)(lds + 36864 + nb2 + woff) = rg[s][2]; *(LAS u32x4*)(lds + 36864 + nb2 + woff + 9216) = rg[s][3];
            }
            __syncthreads();
        }
    }
}
__device__ __forceinline__ void tile_mn(int t, int MT, int NT, int& mt, int& nt) {
    const int per = 16 * NT; const int g = t / per; const int r = t - g * per; const int rem = MT - g * 16; const int gs = rem < 16 ? rem : 16;
    mt = g * 16 + r % gs; nt = r / gs;
}
struct RowLin { const bf16_t* base; size_t pitch; __device__ __forceinline__ const bf16_t* operator()(int r) const { return base + (size_t)r * pitch; } };

__device__ __forceinline__ s16x4 tr_read(LAS unsigned char* blk, int stride, int lane) {
    const int i = lane & 15;
    return __builtin_amdgcn_ds_read_tr16_b64_v4i16((LAS s16x4*)(blk + (i >> 2) * stride + (i & 3) * 8));
}
__device__ __forceinline__ bf16x8 cat8(s16x4 a, s16x4 b) { bf16x8 r; r[0] = a[0]; r[1] = a[1]; r[2] = a[2]; r[3] = a[3]; r[4] = b[0]; r[5] = b[1]; r[6] = b[2]; r[7] = b[3]; return r; }

namespace pg8 {
#define PG8_LAS __attribute__((address_space(3)))
constexpr int BM = 256, BK = 64, HALF = 128, HTB = HALF * BK * 2  , STAGE_BYTES = 8 * HTB, NXCD = 8, WGM = 8;

__host__ __device__ __forceinline__ int lds_byte(int r, int c) { const int st = (r >> 4) * 2 + (c >> 5), rr = r & 15, cc = c & 31, ob = rr * 64 + cc * 2; return st * 1024 + (ob ^ (((ob >> 9) & 1) << 5)); }
__host__ __device__ __forceinline__ void stage_rc(int b, int& R, int& C) { const int st = b / 1024, sb = b % 1024, swz = sb ^ (((sb >> 9) & 1) << 5); R = (st >> 1) * 16 + swz / 64; C = (st & 1) * 32 + (swz % 64) / 2; }
__host__ __device__ __forceinline__ int perm32(int rho) { const int n = rho >> 4, i = rho & 15; return 8 * (i >> 2) + 4 * n + (i & 3); }

struct Unit { int pm, pn; };
struct Gemm { const bf16_t* A; const bf16_t* Bt; int M, N, K; };

struct StaticOrder {
    int nM, nN, nwg, G, c;
    __host__ __device__ void init(int M, int N, int G_, int c_) { nM = M / BM; nN = N / BM; nwg = nM * nN; G = G_; c = c_; }
    __host__ __device__ bool next(int i, Unit& u) const {
        const long L = (long)i * G + c; if (L >= nwg) return false;
        int wgid = (int)L; { const int q = nwg / NXCD, r = nwg % NXCD, xcd = wgid % NXCD, off = wgid / NXCD; wgid = (xcd < r ? xcd * (q + 1) : r * (q + 1) + (xcd - r) * q) + off; }
        const int nig = WGM * nN, gid = wgid / nig, fm = gid * WGM, gsz = (nM - fm) < WGM ? (nM - fm) : WGM;
        u.pm = fm + ((wgid % nig) % gsz); u.pn = (wgid % nig) / gsz; return true;
    }
    __device__ __forceinline__ void a_ready(const Unit&) const {}
    __device__ __forceinline__ void done(const Unit&) const {}
};
template <class Epi, class Sched>
__device__ __forceinline__ void gemm_phase(PG8_LAS unsigned char* lds, const Gemm g, const Sched& S, const Epi& E) {
    const int tid = threadIdx.x, wid = __builtin_amdgcn_readfirstlane(tid >> 6), lane = tid & 63, wr = wid >> 2, wc = wid & 3, fr = lane & 15, fq = lane >> 4;
    const int K = g.K, nt = K / BK;
    unsigned voffA[2], voffB[2];
#pragma unroll
    for (int i = 0; i < 2; ++i) { int R, C; stage_rc(tid * 16 + i * 8192, R, C); const int Rb = Epi::PERM ? ((R & ~31) + perm32(R & 31)) : R;
        voffA[i] = (unsigned)(R * K + C) * 2u; voffB[i] = (unsigned)(Rb * K + C) * 2u; }
    const size_t kstep = (size_t)(BK * 2);
    const size_t hstep = (size_t)HALF * K * 2;
    const size_t tstep = 2 * hstep;
    const unsigned ldsw = (unsigned)wid * 1024u;
    const int aoff = lds_byte(wr * 64 + fr, fq * 8), boff = lds_byte(wc * 32 + fr, fq * 8);
#define PG8_SA(b, h) (((b) * 2 + (h)) * HTB)
#define PG8_SB(b, h) ((4 + (b) * 2 + (h)) * HTB)
#define PG8_STAGE(bufoff, gbase, voff) do { _Pragma("unroll") for (int _i = 0; _i < 2; ++_i) \
        __builtin_amdgcn_global_load_lds((const unsigned*)((const char*)(gbase) + (voff)[_i]), (PG8_LAS unsigned*)(lds + (bufoff) + ldsw + _i * 8192), 16, 0, 0); } while (0)
#define PG8_LDA(dst, b, h) do { _Pragma("unroll") for (int m = 0; m < 4; ++m) _Pragma("unroll") for (int k = 0; k < 2; ++k) dst[m][k] = *(const PG8_LAS bf16x8*)(lds + PG8_SA(b, h) + aoff + m * 2048 + k * 1024); } while (0)
#define PG8_LDB(dst, b, h) do { _Pragma("unroll") for (int n = 0; n < 2; ++n) _Pragma("unroll") for (int k = 0; k < 2; ++k) dst[n][k] = *(const PG8_LAS bf16x8*)(lds + PG8_SB(b, h) + boff + n * 2048 + k * 1024); } while (0)
#define PG8_MMA(ai, bj, At, Bt) do { __builtin_amdgcn_s_setprio(1); _Pragma("unroll") for (int m = 0; m < 4; ++m) _Pragma("unroll") for (int n = 0; n < 2; ++n) _Pragma("unroll") for (int k = 0; k < 2; ++k) \
        acc[ai][bj][m][n] = __builtin_amdgcn_mfma_f32_16x16x32_bf16(Bt[n][k], At[m][k], acc[ai][bj][m][n], 0, 0, 0); __builtin_amdgcn_s_setprio(0); } while (0)
#define PG8_WAIT_V(n) asm volatile("s_waitcnt vmcnt(" #n ")" ::: "memory")
#define PG8_WAIT_L(n) asm volatile("s_waitcnt lgkmcnt(" #n ")" ::: "memory")
#define PG8_BAR __builtin_amdgcn_s_barrier()
#define PG8_SCHED __builtin_amdgcn_sched_barrier(0)
    Unit cur, nxt; int ui = 0;
    if (!S.next(0, cur)) return;
    f32x4 acc[2][2][4][2];
#pragma unroll
    for (int a = 0; a < 2; ++a)
#pragma unroll
        for (int b = 0; b < 2; ++b)
#pragma unroll
            for (int m = 0; m < 4; ++m)
#pragma unroll
                for (int n = 0; n < 2; ++n) acc[a][b][m][n] = (f32x4){0.f, 0.f, 0.f, 0.f};
    bf16x8 At[4][2], B0[2][2], B1[2][2];
    const char* cA = (const char*)g.A + (size_t)cur.pm * tstep; const char* cB = (const char*)g.Bt + (size_t)cur.pn * tstep;
    S.a_ready(cur);
    PG8_STAGE(PG8_SB(0, 0), cB, voffB); PG8_STAGE(PG8_SA(0, 0), cA, voffA); PG8_STAGE(PG8_SB(0, 1), cB + hstep, voffB); PG8_STAGE(PG8_SA(0, 1), cA + hstep, voffA);
    if (wr == 1) PG8_BAR;
    PG8_WAIT_V(4); PG8_BAR;
    PG8_STAGE(PG8_SB(1, 0), cB + kstep, voffB); PG8_STAGE(PG8_SA(1, 0), cA + kstep, voffA); PG8_STAGE(PG8_SB(1, 1), cB + hstep + kstep, voffB);
    PG8_WAIT_V(6); PG8_BAR;
    for (;;) {
        const bool has_next = S.next(ui + 1, nxt);
        const char* nA = has_next ? (const char*)g.A + (size_t)nxt.pm * tstep : cA; const char* nB = has_next ? (const char*)g.Bt + (size_t)nxt.pn * tstep : cB;
        for (int t = 0; t < nt; t += 2) {
            const bool last = (t == nt - 2);
            const char* a1 = cA + (size_t)(t + 1) * kstep;
            const char* a2 = last ? nA : cA + (size_t)(t + 2) * kstep; const char* b2 = last ? nB : cB + (size_t)(t + 2) * kstep;
            const char* a3 = a2 + kstep; const char* b3 = b2 + kstep;
            if (last && has_next) S.a_ready(nxt);
            PG8_LDB(B0, 0, 0); PG8_SCHED; PG8_LDA(At, 0, 0); PG8_STAGE(PG8_SA(1, 1), a1 + hstep, voffA);
            PG8_WAIT_L(8); PG8_BAR; PG8_WAIT_L(0); PG8_MMA(0, 0, At, B0); PG8_BAR; PG8_SCHED;
            PG8_LDB(B1, 0, 1); PG8_STAGE(PG8_SB(0, 0), b2, voffB);
            PG8_BAR; PG8_WAIT_L(0); PG8_MMA(0, 1, At, B1); PG8_BAR;
            PG8_LDA(At, 0, 1); PG8_STAGE(PG8_SA(0, 0), a2, voffA);
            PG8_BAR; PG8_WAIT_L(0); PG8_MMA(1, 0, At, B0); PG8_BAR; PG8_SCHED;
            PG8_STAGE(PG8_SB(0, 1), b2 + hstep, voffB);
            PG8_WAIT_V(6); PG8_BAR; PG8_MMA(1, 1, At, B1); PG8_BAR;
            PG8_LDB(B0, 1, 0); PG8_SCHED; PG8_LDA(At, 1, 0); PG8_STAGE(PG8_SA(0, 1), a2 + hstep, voffA);
            PG8_WAIT_L(8); PG8_BAR; PG8_WAIT_L(0); PG8_MMA(0, 0, At, B0); PG8_BAR; PG8_SCHED;
            PG8_LDB(B1, 1, 1); PG8_STAGE(PG8_SB(1, 0), b3, voffB);
            PG8_BAR; PG8_WAIT_L(0); PG8_MMA(0, 1, At, B1); PG8_BAR;
            PG8_LDA(At, 1, 1); PG8_STAGE(PG8_SA(1, 0), a3, voffA);
            PG8_BAR; PG8_WAIT_L(0); PG8_MMA(1, 0, At, B0); PG8_BAR; PG8_SCHED;
            PG8_STAGE(PG8_SB(1, 1), b3 + hstep, voffB);
            PG8_WAIT_V(6); PG8_BAR; PG8_MMA(1, 1, At, B1); PG8_BAR;
        }
        if constexpr (!Epi::AFTER_DRAIN) { E(acc, cur, wr, wc, fr, fq); S.done(cur); }
        if (!has_next) break;
#pragma unroll
        for (int a = 0; a < 2; ++a)
#pragma unroll
            for (int b = 0; b < 2; ++b)
#pragma unroll
                for (int m = 0; m < 4; ++m)
#pragma unroll
                    for (int n = 0; n < 2; ++n) acc[a][b][m][n] = (f32x4){0.f, 0.f, 0.f, 0.f};
        cur = nxt; cA = nA; cB = nB; ++ui;
    }
    PG8_WAIT_V(0);
    if (wr == 0) PG8_BAR;
    PG8_BAR;
    if constexpr (Epi::AFTER_DRAIN) { E.fused(acc, cur, wr, wc, fr, fq, lds, wid, lane); S.done(cur); }
#undef PG8_SA
#undef PG8_SB
#undef PG8_STAGE
#undef PG8_LDA
#undef PG8_LDB
#undef PG8_MMA
#undef PG8_WAIT_V
#undef PG8_WAIT_L
#undef PG8_BAR
#undef PG8_SCHED
}
}


struct KArgs { const float* in[23]; float* out; unsigned char* ws; int ph_lo, ph_hi; };
struct Ctx {
    const float* in[23]; float* out; unsigned char* ws; LAS unsigned char* lds; int G, bid, tid, lane, w;
    __device__ __forceinline__ bf16_t* wb(size_t off) const { return (bf16_t*)(ws + off); }
    __device__ __forceinline__ float* wf(size_t off) const { return (float*)(ws + off); }
};

template <bool PERMQK = false>
__device__ __forceinline__ void tconv(const Ctx& c, const float* __restrict__ src, int K, int N, bf16_t* __restrict__ dst) {
    LAS float* tile = (LAS float*)c.lds;
    const int NT = N >> 6, total = (K >> 6) * NT, ngroups = (total + 3) >> 2;
    const int r = c.tid >> 4, c4 = (c.tid & 15) * 4, n = c.tid >> 3, kc = (c.tid & 7) * 8;
    for (int gidx = c.bid; gidx < ngroups; gidx += c.G) {
        f32x4 v[4][2];
#pragma unroll
        for (int q = 0; q < 4; ++q) {
            const int t = gidx * 4 + q;
            if (t < total) { const int kt = t / NT, nt = t - kt * NT;
#pragma unroll
                for (int i = 0; i < 2; ++i) v[q][i] = *(const f32x4*)(src + (size_t)(kt * 64 + r + 32 * i) * N + nt * 64 + c4); }
        }
#pragma unroll
        for (int q = 0; q < 4; ++q)
            if (gidx * 4 + q < total) {
#pragma unroll
                for (int i = 0; i < 2; ++i) { LAS float* p = tile + q * (64 * 65) + (r + 32 * i) * 65 + c4; p[0] = v[q][i][0]; p[1] = v[q][i][1]; p[2] = v[q][i][2]; p[3] = v[q][i][3]; }
            }
        __syncthreads();
#pragma unroll
        for (int q = 0; q < 4; ++q) {
            const int t = gidx * 4 + q;
            if (t < total) {
                const int kt = t / NT, nt = t - kt * NT;
                float f[8];
#pragma unroll
                for (int j = 0; j < 8; ++j) f[j] = tile[q * (64 * 65) + (kc + j) * 65 + n];
                u32x4 o; o.x = cvt_pk_bf16(f[0], f[1]); o.y = cvt_pk_bf16(f[2], f[3]); o.z = cvt_pk_bf16(f[4], f[5]); o.w = cvt_pk_bf16(f[6], f[7]);
                int drow = nt * 64 + n;
                if (PERMQK && drow >= 1024 && drow < 3072) { const int d = drow & 127; drow = (drow & ~127) + 32 * (2 * (d >> 6) + ((d >> 4) & 1)) + 16 * ((d >> 5) & 1) + (d & 15); }
                *(u32x4*)(dst + (size_t)drow * K + kt * 64 + kc) = o;
            }
        }
        __syncthreads();
    }
}
__device__ __forceinline__ void conv_bf16(const Ctx& c, const float* __restrict__ src, bf16_t* __restrict__ dst, size_t n) {
    const size_t nch = n >> 3;
    for (size_t i = (size_t)c.bid * 512 + c.tid; i < nch; i += (size_t)c.G * 512) {
        const f32x4 a = *(const f32x4*)(src + i * 8), b = *(const f32x4*)(src + i * 8 + 4);
        u32x4 o; o.x = cvt_pk_bf16(a[0], a[1]); o.y = cvt_pk_bf16(a[2], a[3]); o.z = cvt_pk_bf16(b[0], b[1]); o.w = cvt_pk_bf16(b[2], b[3]);
        *(u32x4*)(dst + i * 8) = o;
    }
}
__device__ __forceinline__ unsigned enc_fp6(float v) {
    const float a = fminf(fabsf(v), 7.5f);
    float q;
    if (a < 2.0f) q = rintf(a * 8.0f);
    else if (a < 4.0f) q = 16.0f + rintf((a - 2.0f) * 4.0f);
    else q = 24.0f + rintf((a - 4.0f) * 2.0f);
    unsigned c = (unsigned)q; c = c > 31u ? 31u : c;
    return c | (v < 0.f ? 32u : 0u);
}
__device__ __forceinline__ void conv_fp6(const Ctx& c, const float* __restrict__ src, unsigned char* __restrict__ dst, int rows, float scale) {
    const size_t ngroups = (size_t)rows * 64;
    for (size_t gi = (size_t)c.bid * 512 + c.tid; gi < ngroups; gi += (size_t)c.G * 512) {
        const size_t row = gi >> 6; const int l = (int)(gi & 63);
        const float* sp = src + row * 2048 + l * 32;
        unsigned w[6] = {0u, 0u, 0u, 0u, 0u, 0u};
#pragma unroll
        for (int q = 0; q < 8; ++q) {
            const f32x4 v = *(const f32x4*)(sp + q * 4);
#pragma unroll
            for (int e = 0; e < 4; ++e) {
                const int k = q * 4 + e, pos = 6 * k, d = pos >> 5, sh = pos & 31;
                const unsigned code = enc_fp6(v[e] * scale);
                w[d] |= code << sh;
                if (sh > 26) w[d + 1] |= code >> (32 - sh);
            }
        }
        unsigned char* dp = dst + row * 1536 + l * 8;
        *(u32x2*)(dp) = (u32x2){w[0], w[1]}; *(u32x2*)(dp + 512) = (u32x2){w[2], w[3]}; *(u32x2*)(dp + 1024) = (u32x2){w[4], w[5]};
    }
}
__device__ __forceinline__ unsigned enc_fp4(float v) {
    const float a = fabsf(v);
    unsigned c;
    if (a < 2.0f) c = (unsigned)rintf(a * 2.0f);
    else if (a < 4.0f) c = 4u + (unsigned)rintf((a - 2.0f));
    else c = a < 5.0f ? 6u : 7u;
    return c | (v < 0.f ? 8u : 0u);
}
__device__ __forceinline__ void conv_fp4(const Ctx& c, const float* __restrict__ src, unsigned char* __restrict__ dst, int rows, float scale, int part, int nparts) {
    for (int row = part * 8 + c.w; row < rows; row += nparts * 8) {
        const float* sp = src + (size_t)row * 2048 + c.lane * 8;
        f32x4 v[4][2];
#pragma unroll
        for (int q = 0; q < 4; ++q) { v[q][0] = *(const f32x4*)(sp + q * 512); v[q][1] = *(const f32x4*)(sp + q * 512 + 4); }
#pragma unroll
        for (int q = 0; q < 4; ++q) {
            unsigned h = 0u;
#pragma unroll
            for (int e = 0; e < 4; ++e) h |= (enc_fp4(v[q][0][e] * scale) << (4 * e)) | (enc_fp4(v[q][1][e] * scale) << (16 + 4 * e));
            *(unsigned*)(dst + (size_t)row * 1024 + q * 256 + c.lane * 4) = h;
        }
    }
}
__device__ __forceinline__ void conv_fp8(const Ctx& c, const float* __restrict__ src, unsigned char* __restrict__ dst, size_t n, float scale) {
    const size_t nch = n >> 4;
    for (size_t i = (size_t)c.bid * 512 + c.tid; i < nch; i += (size_t)c.G * 512) {
        u32x4 o;
#pragma unroll
        for (int q = 0; q < 4; ++q) {
            const f32x4 a = *(const f32x4*)(src + i * 16 + q * 4);
            int w = 0;
            w = __builtin_amdgcn_cvt_pk_fp8_f32(a[0] * scale, a[1] * scale, w, false);
            w = __builtin_amdgcn_cvt_pk_fp8_f32(a[2] * scale, a[3] * scale, w, true);
            o[q] = (unsigned)w;
        }
        *(u32x4*)(dst + i * 16) = o;
    }
}
__device__ __forceinline__ void phase_prologue(const Ctx& c) {
    tconv<true>(c, c.in[8], 2048, 6144, c.wb(WS_WINE));
    tconv(c, c.in[10], 2048, 2048, c.wb(WS_WOUTE));
    tconv(c, c.in[11], 2048, 2112, c.wb(WS_WINO));
    tconv(c, c.in[15], 512, 1536, c.wb(WS_WUQ));
    tconv(c, c.in[16], 256, 2048, c.wb(WS_WUKV));
    tconv(c, c.in[17], 2048, 2048, c.wb(WS_WOUTO));
    tconv(c, c.in[18], 2048, 2048, c.wb(WS_WQ0));
    tconv(c, c.in[18] + (size_t)2048 * 2048, 2048, 2048, c.wb(WS_WQ1));
    {
        u32x4* p = (u32x4*)(c.wb(WS_WINO) + (size_t)2112 * 2048);
        for (int i = c.bid * 512 + c.tid; i < 192 * 2048 / 8; i += c.G * 512) p[i] = (u32x4){0u, 0u, 0u, 0u};
    }
    conv_bf16(c, c.in[19], c.wb(WS_SKB), (size_t)2 * 16 * 128 * 128);
    {
        const int two = 2 * 32 * 6 - c.G; const bool split = two > 0 && two < c.G; const int r0 = split ? 12288 : 16384;
        conv_fp4(c, c.in[20], c.ws + WS_TABU, r0, U_SCALE, c.bid, c.G);
        conv_fp4(c, c.in[21], c.ws + WS_TABV, r0, V_SCALE, c.bid, c.G);
        if (split && c.bid >= two) {
            conv_fp4(c, c.in[20] + (size_t)r0 * 2048, c.ws + WS_TABU + (size_t)r0 * 1024, 16384 - r0, U_SCALE, c.bid - two, c.G - two);
            conv_fp4(c, c.in[21] + (size_t)r0 * 2048, c.ws + WS_TABV + (size_t)r0 * 1024, 16384 - r0, V_SCALE, c.bid - two, c.G - two);
        }
    }
    const int gt = c.bid * 512 + c.tid, gn = c.G * 512;
    {
        f32x2* r128 = (f32x2*)(c.ws + WS_ROPE); f32x2* r64 = (f32x2*)(c.ws + WS_ROPE + 131072);
        for (int i = gt; i < 256 * 32; i += gn) {
            const int pos = i >> 5, f = i & 31;
            const float inv = exp2f(-(float)f * (13.287712379549449f / 32.0f));
            const float rev = (float)pos * inv * 0.15915494309189535f; const float fr = rev - floorf(rev);
            r128[i] = (f32x2){cos_rev(fr), sin_rev(fr)};
        }
        for (int i = gt; i < 256 * 16; i += gn) {
            const int pos = i >> 4, f = i & 15;
            const float inv = exp2f(-(float)f * (13.287712379549449f / 16.0f));
            const float rev = (float)pos * inv * 0.15915494309189535f; const float fr = rev - floorf(rev);
            r64[i] = (f32x2){cos_rev(fr), sin_rev(fr)};
        }
    }
    {
        bf16_t* MC = c.wb(WS_DFT); bf16_t* M1 = c.wb(WS_DFT + 262144); bf16_t* M2 = c.wb(WS_DFT + 393216); bf16_t* MCX = c.wb(WS_DFT + 458752);
        for (int i = gt; i < 512 * 256; i += gn) {
            const int n = i >> 8, k = i & 255, m = n & 255; const float fr = (float)((m * k) & 255) * (1.0f / 256.0f);
            const float v = (n < 256 ? cos_rev(fr) : -sin_rev(fr)) * 0.0625f;
            MC[i] = (bf16_t)(cvt_pk_bf16(v, 0.f) & 0xffffu);
        }
        for (int i = gt; i < 256 * 256; i += gn) {
            const int j = i >> 8, kk = i & 255, ka = j >> 1, ro = j & 1, ri = kk >> 7, nh = kk & 127;
            const float fr = (float)((ka * nh) & 127) * (1.0f / 128.0f); const float cc = cos_rev(fr), ss = sin_rev(fr);
            const float v = (ro == ri ? cc : (ro == 0 ? ss : -ss)) * 0.08838834764831845f;
            M1[i] = (bf16_t)(cvt_pk_bf16(v, 0.f) & 0xffffu);
        }
        for (int i = gt; i < 128 * 256; i += gn) {
            const int kb = i >> 8, kk = i & 255, ri = kk >> 7, nl = kk & 127;
            const float fr = (float)((kb * nl) & 127) * (1.0f / 128.0f);
            const float v = (ri == 0 ? cos_rev(fr) : sin_rev(fr)) * 0.08838834764831845f;
            M2[i] = (bf16_t)(cvt_pk_bf16(v, 0.f) & 0xffffu);
        }
        for (int i = gt; i < 256 * 512; i += gn) {
            const int k = i >> 9, kk = i & 511, ri = kk >> 8, n = kk & 255;
            const float fr = (float)((k * n) & 255) * (1.0f / 256.0f);
            const float v = (ri == 0 ? cos_rev(fr) : sin_rev(fr)) * 0.0625f;
            MCX[i] = (bf16_t)(cvt_pk_bf16(v, 0.f) & 0xffffu);
        }
    }
    {
        const float* cvec = c.in[1]; const float* cctx = c.in[3]; const float* wmod = c.in[4];
        float* modp = c.wf(WS_MODP);
        for (int u = c.bid; u < 2 * 32 * 6; u += c.G) {
            const int l = u / 192, r = u - l * 192, kc = r / 6, nb = r - kc * 6;
            const int n = nb * 2048 + c.tid * 4;
            f32x4 a0 = {0.f, 0.f, 0.f, 0.f}, a1 = a0, a2 = a0;
            const float* wp = wmod + ((size_t)l * 2048 + kc * 64) * 12288 + n;
#pragma unroll 8
            for (int k = 0; k < 64; ++k) {
                const int kk = kc * 64 + k;
                const f32x4 wv = *(const f32x4*)(wp + (size_t)k * 12288);
                const float s0 = silu_f(cvec[kk]), s1 = silu_f(cvec[2048 + kk]), s2 = silu_f(cctx[kk]);
                a0 += wv * s0; a1 += wv * s1; a2 += wv * s2;
            }
            float* o = modp + ((size_t)(kc * 2 + l) * 3) * 12288 + n;
            *(f32x4*)(o) = a0; *(f32x4*)(o + 12288) = a1; *(f32x4*)(o + 2 * 12288) = a2;
        }
    }
}
__device__ __forceinline__ void phase_mods(const Ctx& c) {
    const float* modp = c.wf(WS_MODP); float* mods = c.wf(WS_MODS); const float* bmod = c.in[5];
    for (int i = c.bid * 512 + c.tid; i < 2 * 3 * 12288; i += c.G * 512) {
        const int l = i / 36864, r = i - l * 36864, n = r % 12288;
        float s = bmod[l * 12288 + n];
        for (int kc = 0; kc < 32; ++kc) s += modp[(size_t)(kc * 2 + l) * 36864 + r];
        mods[i] = s;
    }
}
__device__ __forceinline__ void phase_modnorm(const Ctx& c, int layer, int which, const float* __restrict__ xlat, const float* __restrict__ xctx, int tok_lo, bf16_t* __restrict__ H) {
    const float* mods = c.wf(WS_MODS); const float* nw = c.in[6 + which] + layer * D;
    for (int tok = tok_lo + c.bid * 8 + c.w; tok < TT; tok += c.G * 8) {
        const float* src = tok < TC ? xctx + (size_t)tok * D : xlat + (size_t)(tok - TC) * D;
        const int mw = tok < TC ? 2 : ((tok - TC) >> 14);
        const float* mb = mods + (size_t)(layer * 3 + mw) * 12288 + which * 3 * 2048;
        f32x4 v[8]; float ss = 0.f;
#pragma unroll
        for (int i = 0; i < 8; ++i) { v[i] = *(const f32x4*)(src + i * 256 + c.lane * 4); ss += v[i][0] * v[i][0] + v[i][1] * v[i][1] + v[i][2] * v[i][2] + v[i][3] * v[i][3]; }
        ss = wave_sum(ss);
        const float rstd = rsqrtf(ss * (1.0f / D) + EPS);
#pragma unroll
        for (int i = 0; i < 8; ++i) {
            const int col = i * 256 + c.lane * 4;
            const f32x4 g = *(const f32x4*)(nw + col), sh = *(const f32x4*)(mb + col), sc = *(const f32x4*)(mb + 2048 + col);
            f32x4 o;
#pragma unroll
            for (int j = 0; j < 4; ++j) o[j] = v[i][j] * rstd * g[j] * (1.0f + sc[j]) + sh[j];
            *(u32x2*)(H + (size_t)tok * D + col) = pack4(o);
        }
    }
}

__device__ __forceinline__ void phase_even_proj(const Ctx& c) {
    const bf16_t* H = c.wb(WS_H); const bf16_t* W = c.wb(WS_WINE);
    bf16_t* F = c.wb(WS_A); bf16_t* Q = c.wb(WS_Q); bf16_t* Kb = c.wb(WS_K); bf16_t* V = c.wb(WS_V); bf16_t* Gt = c.wb(WS_G);
    const f32x2* r128 = (const f32x2*)(c.ws + WS_ROPE);
    const int MT = TT / 128, NT = 6144 / 128;
    const int g = c.lane >> 4, wm = c.w >> 1, wn = c.w & 1;
    for (int t = c.bid; t < MT * NT; t += c.G) {
        int mt, nt; tile_mn(t, MT, NT, mt, nt);
        f32x4 acc[2][4];
        gemm128<true>(c.lds, 2048, RowLin{H + (size_t)mt * 128 * D, (size_t)D}, RowLin{W + (size_t)nt * 128 * 2048, 2048}, acc);
        const int region = nt >> 3, cr0 = (nt & 7) * 128 + 64 * wn + 4 * g;
#pragma unroll
        for (int mb = 0; mb < 2; ++mb) {
            const int tok = mt * 128 + 32 * wm + 16 * mb + (c.lane & 15);
            if (region == 0) {
#pragma unroll
                for (int nb = 0; nb < 4; ++nb) *(u32x2*)(F + (size_t)tok * 1024 + cr0 + 16 * nb) = pack4(acc[mb][nb]);
            } else if (region == 1 || region == 2) {
                bf16_t* dst = (region == 1 ? Q : Kb) + (size_t)tok * 1024 + cr0;
                const float sc = region == 2 ? 0.08838834764831845f : 1.0f;
                if (tok >= TC) {
                    const int s = (tok - TC) & (SEQ - 1); const int pos = wn == 0 ? (s >> 6) : (s & 63);
#pragma unroll
                    for (int nb = 0; nb < 2; ++nb) {
                        f32x4 o1, o2;
#pragma unroll
                        for (int r = 0; r < 4; ++r) {
                            const f32x2 cs = r128[pos * 32 + 16 * nb + 4 * g + r];
                            const float a = acc[mb][nb][r] * sc, b = acc[mb][nb + 2][r] * sc;
                            o1[r] = a * cs.x - b * cs.y; o2[r] = b * cs.x + a * cs.y;
                        }
                        *(u32x2*)(dst + 16 * nb) = pack4(o1); *(u32x2*)(dst + 16 * (nb + 2)) = pack4(o2);
                    }
                } else {
#pragma unroll
                    for (int nb = 0; nb < 4; ++nb) *(u32x2*)(dst + 16 * nb) = pack4(acc[mb][nb] * sc);
                }
            } else if (region == 3) {
#pragma unroll
                for (int nb = 0; nb < 4; ++nb) *(u32x2*)(V + (size_t)tok * 1024 + cr0 + 16 * nb) = pack4(acc[mb][nb]);
            } else {
#pragma unroll
                for (int nb = 0; nb < 4; ++nb) {
                    f32x4 o;
#pragma unroll
                    for (int r = 0; r < 4; ++r) o[r] = silu_f(acc[mb][nb][r]);
                    *(u32x2*)(Gt + (size_t)tok * 2048 + (region - 4) * 1024 + cr0 + 16 * nb) = pack4(o);
                }
            }
        }
    }
}
constexpr int FS = 528, F_B = 128 * FS;
template <class RF>
__device__ __forceinline__ void ftile_issue(u32x4 (&r)[8], const RF& row, int tid) {
#pragma unroll
    for (int i = 0; i < 8; ++i) r[i] = *(const u32x4*)(row((tid >> 5) + 16 * i) + (tid & 31) * 8);
}
__device__ __forceinline__ void ftile_write(LAS unsigned char* dst, const u32x4 (&r)[8], int tid) {
#pragma unroll
    for (int i = 0; i < 8; ++i) *(LAS u32x4*)(dst + ((tid >> 5) + 16 * i) * FS + (tid & 31) * 16) = r[i];
}
__device__ __forceinline__ void ftile_mma(LAS unsigned char* lds, f32x4 (&acc)[2][4], int lane, int wm, int wn) {
#pragma unroll
    for (int mb = 0; mb < 2; ++mb)
#pragma unroll
        for (int nb = 0; nb < 4; ++nb) acc[mb][nb] = (f32x4){0.f, 0.f, 0.f, 0.f};
    const int aoff = (32 * wm + (lane & 15)) * FS + (lane >> 4) * 16;
    const int boff = F_B + (64 * wn + (lane & 15)) * FS + (lane >> 4) * 16;
#pragma unroll
    for (int ks = 0; ks < 8; ++ks) {
        bf16x8 af[2], bfr[4];
#pragma unroll
        for (int mb = 0; mb < 2; ++mb) af[mb] = *(const LAS bf16x8*)(lds + aoff + mb * (16 * FS) + ks * 64);
#pragma unroll
        for (int nb = 0; nb < 4; ++nb) bfr[nb] = *(const LAS bf16x8*)(lds + boff + nb * (16 * FS) + ks * 64);
#pragma unroll
        for (int mb = 0; mb < 2; ++mb)
#pragma unroll
            for (int nb = 0; nb < 4; ++nb) acc[mb][nb] = __builtin_amdgcn_mfma_f32_16x16x32_bf16(af[mb], bfr[nb], acc[mb][nb], 0, 0, 0);
    }
}
struct RowStr { const bf16_t* base; size_t pitch; __device__ __forceinline__ const bf16_t* operator()(int r) const { return base + (size_t)r * pitch; } };
__device__ __forceinline__ void phase_chan_dft(const Ctx& c) {
    const bf16_t* F = c.wb(WS_A); const bf16_t* MC = c.wb(WS_DFT);
    bf16_t* Zt = c.wb(WS_ST); bf16_t* Ztc = c.wb(WS_ST + 128 * MiB);
    const int g4 = c.lane >> 4, wm = c.w >> 1, wn = c.w & 1;
    LAS unsigned char* la = c.lds; LAS unsigned char* lb = c.lds + F_B;
    constexpr int NUL = 2 * 4 * 128;
    u32x4 ra[8], rb[8];
    if (c.bid < NUL) {
        const int grp = c.bid & 3, nlo = (c.bid >> 2) & 127, b = c.bid >> 9;
        ftile_issue(ra, RowStr{F + ((size_t)(TC + b * SEQ + nlo)) * 1024 + grp * 256, (size_t)128 * 1024}, c.tid);
        ftile_issue(rb, RowLin{MC, 256}, c.tid);
        ftile_write(la, ra, c.tid); ftile_write(lb, rb, c.tid);
    }
    __syncthreads();
    for (int u = c.bid; u < NUL; u += c.G) {
        const int grp = u & 3, nlo = (u >> 2) & 127, b = u >> 9;
        const bool nxu = u + c.G < NUL;
#pragma unroll 1
        for (int nt = 0; nt < 4; ++nt) {
            if (nt < 3) ftile_issue(rb, RowLin{MC + (size_t)(nt + 1) * 128 * 256, 256}, c.tid);
            else if (nxu) {
                const int un = u + c.G, gn = un & 3, nn = (un >> 2) & 127, bn = un >> 9;
                ftile_issue(ra, RowStr{F + ((size_t)(TC + bn * SEQ + nn)) * 1024 + gn * 256, (size_t)128 * 1024}, c.tid);
                ftile_issue(rb, RowLin{MC, 256}, c.tid);
            }
            __builtin_amdgcn_sched_barrier(0);
            f32x4 acc[2][4];
            ftile_mma(c.lds, acc, c.lane, wm, wn);
#pragma unroll
            for (int mb = 0; mb < 2; ++mb)
#pragma unroll
                for (int nb = 0; nb < 4; ++nb) {
                    const int n = nt * 128 + 64 * wn + 16 * nb + (c.lane & 15), reim = n >> 8, m = n & 255, nhi = 32 * wm + 16 * mb + 4 * g4;
                    *(u32x2*)(Zt + ((((size_t)(b * 4 + grp) * 256 + m) * 128 + nlo) * 2 + reim) * 128 + nhi) = pack4(acc[mb][nb]);
                }
            __syncthreads();
            if (nt < 3) ftile_write(lb, rb, c.tid);
            else if (nxu) { ftile_write(la, ra, c.tid); ftile_write(lb, rb, c.tid); }
            __syncthreads();
        }
    }
    for (int v = c.bid; v < 64; v += c.G) {
        f32x4 acc[2][4];
        const int nt = v & 3, rt = (v >> 2) & 1, grp = (v >> 3) & 3, b = v >> 5;
        gemm128s<false, 256>(c.lds, RowLin{F + ((size_t)(b * NCTX + rt * 128)) * 1024 + grp * 256, 1024}, RowLin{MC + (size_t)nt * 128 * 256, 256}, acc);
#pragma unroll
        for (int mb = 0; mb < 2; ++mb)
#pragma unroll
            for (int nb = 0; nb < 4; ++nb) {
                const int n = nt * 128 + 64 * wn + 16 * nb + (c.lane & 15), reim = n >> 8, m = n & 255, nn = rt * 128 + 32 * wm + 16 * mb + 4 * g4;
                *(u32x2*)(Ztc + (((size_t)(b * 4 + grp) * 256 + m) * 2 + reim) * 256 + nn) = pack4(acc[mb][nb]);
            }
    }
}
__device__ __forceinline__ void phase_dft_stage1(const Ctx& c) {
    const bf16_t* Zt = c.wb(WS_ST); const bf16_t* Ztc = c.wb(WS_ST + 128 * MiB);
    const bf16_t* M1 = c.wb(WS_DFT + 262144); const bf16_t* MCX = c.wb(WS_DFT + 458752);
    bf16_t* Tp = c.wb(WS_H); bf16_t* CAT = c.wb(WS_CAT);
    const int g4 = c.lane >> 4, wm = c.w >> 1, wn = c.w & 1;
    LAS unsigned char* la = c.lds; LAS unsigned char* lb = c.lds + F_B;
    constexpr int NUL = 2048;
    u32x4 ra[8], rb[8];
    if (c.bid < NUL) {
        ftile_issue(ra, RowLin{Zt + (size_t)c.bid * 128 * 256, 256}, c.tid); ftile_issue(rb, RowLin{M1, 256}, c.tid);
        ftile_write(la, ra, c.tid); ftile_write(lb, rb, c.tid);
    }
    __syncthreads();
    for (int rt = c.bid; rt < NUL; rt += c.G) {
        const int bg = rt >> 8, m = rt & 255;
        const bool nxu = rt + c.G < NUL;
#pragma unroll 1
        for (int nt = 0; nt < 2; ++nt) {
            if (nt < 1) ftile_issue(rb, RowLin{M1 + (size_t)(nt + 1) * 128 * 256, 256}, c.tid);
            else if (nxu) { ftile_issue(ra, RowLin{Zt + (size_t)(rt + c.G) * 128 * 256, 256}, c.tid); ftile_issue(rb, RowLin{M1, 256}, c.tid); }
            __builtin_amdgcn_sched_barrier(0);
            f32x4 acc[2][4];
            ftile_mma(c.lds, acc, c.lane, wm, wn);
#pragma unroll
            for (int mb = 0; mb < 2; ++mb)
#pragma unroll
                for (int nb = 0; nb < 4; ++nb) {
                    const int j = nt * 128 + 64 * wn + 16 * nb + (c.lane & 15), ka = j >> 1, ro = j & 1, nlo0 = 32 * wm + 16 * mb + 4 * g4;
                    f32x4 o;
#pragma unroll
                    for (int r = 0; r < 4; ++r) {
                        const float mine = acc[mb][nb][r], other = __shfl_xor(mine, 1);
                        const float fr = (float)((ka * (nlo0 + r)) & 16383) * (1.0f / 16384.0f);
                        const float cc = cos_rev(fr), ss = sin_rev(fr);
                        o[r] = ro == 0 ? (mine * cc + other * ss) : (mine * cc - other * ss);
                    }
                    *(u32x2*)(Tp + ((((size_t)bg * 128 + ka) * 256 + m) * 2 + ro) * 128 + nlo0) = pack4(o);
                }
            __syncthreads();
            if (nt < 1) ftile_write(lb, rb, c.tid);
            else if (nxu) { ftile_write(la, ra, c.tid); ftile_write(lb, rb, c.tid); }
            __syncthreads();
        }
    }
    for (int v = c.bid; v < 32; v += c.G) {
        f32x4 acc[2][4];
        const int nt = v & 1, rt = v >> 1;
        gemm128s<false, 512>(c.lds, RowLin{Ztc + (size_t)rt * 128 * 512, 512}, RowLin{MCX + (size_t)nt * 128 * 512, 512}, acc);
        const int bg = rt >> 1, b = bg >> 2, grp = bg & 3, mh = rt & 1;
#pragma unroll
        for (int mb = 0; mb < 2; ++mb)
#pragma unroll
            for (int nb = 0; nb < 4; ++nb) {
                const int k = nt * 128 + 64 * wn + 16 * nb + (c.lane & 15), m0 = mh * 128 + 32 * wm + 16 * mb + 4 * g4;
                *(u32x2*)(CAT + (size_t)(b * NCTX + k) * 2048 + grp * 256 + m0) = pack4(acc[mb][nb]);
            }
    }
}
__device__ __forceinline__ void phase_dft_stage2(const Ctx& c) {
    const bf16_t* Tp = c.wb(WS_H); const bf16_t* M2 = c.wb(WS_DFT + 393216); bf16_t* CAT = c.wb(WS_CAT);
    const int g4 = c.lane >> 4, wm = c.w >> 1, wn = c.w & 1;
    LAS unsigned char* la = c.lds; LAS unsigned char* lb = c.lds + F_B;
    u32x4 ra[8];
    if (c.bid < 2048) {
        ftile_issue(ra, RowLin{M2, 256}, c.tid);
        ftile_write(lb, ra, c.tid);
        ftile_issue(ra, RowLin{Tp + (size_t)c.bid * 128 * 256, 256}, c.tid);
        ftile_write(la, ra, c.tid);
    }
    __syncthreads();
    for (int u = c.bid; u < 2048; u += c.G) {
        const bool nxu = u + c.G < 2048;
        if (nxu) ftile_issue(ra, RowLin{Tp + (size_t)(u + c.G) * 128 * 256, 256}, c.tid);
        __builtin_amdgcn_sched_barrier(0);
        f32x4 acc[2][4];
        ftile_mma(c.lds, acc, c.lane, wm, wn);
        const int mh = u & 1, ka = (u >> 1) & 127, bg = u >> 8, b = bg >> 2, grp = bg & 3;
#pragma unroll
        for (int mb = 0; mb < 2; ++mb)
#pragma unroll
            for (int nb = 0; nb < 4; ++nb) {
                const int kb = 64 * wn + 16 * nb + (c.lane & 15), m0 = mh * 128 + 32 * wm + 16 * mb + 4 * g4;
                *(u32x2*)(CAT + (size_t)(TC + b * SEQ + ka + 128 * kb) * 2048 + grp * 256 + m0) = pack4(acc[mb][nb]);
            }
        __syncthreads();
        if (nxu) ftile_write(la, ra, c.tid);
        __syncthreads();
    }
}

constexpr int TS = 272;
constexpr int TILE_B = 128 * TS;
constexpr int TSV = 288;
constexpr int TILE_BV = 128 * TSV;
__device__ __forceinline__ int chunk_tok0(int b, int cch) { return cch < 2 ? b * NCTX + cch * 128 : TC + b * SEQ + (cch - 2) * 128; }
template <int STRIDE = TS>
__device__ __forceinline__ void load_tile128(const Ctx& c, LAS unsigned char* dst, const bf16_t* src  , size_t pitch) {
#pragma unroll
    for (int i = 0; i < 4; ++i) {
        const int id = c.tid + 512 * i, row = id >> 4, ch = id & 15;
        *(LAS u32x4*)(dst + row * STRIDE + ch * 16) = *(const u32x4*)(src + (size_t)row * pitch + ch * 8);
    }
}
__device__ __forceinline__ void phase_ret_ds(const Ctx& c) {
    const bf16_t* Kb = c.wb(WS_K); const bf16_t* V = c.wb(WS_V); bf16_t* ST = c.wb(WS_ST);
    LAS unsigned char* kt = c.lds; LAS unsigned char* vf = c.lds + TILE_BV; LAS unsigned char* vb = c.lds + 2 * TILE_BV;
    const int g = c.lane >> 4, wm = c.w >> 1, wn = c.w & 1, d0 = 32 * wm, e0 = 64 * wn;
    u32x4 rk[4], rv[4];
    if (c.bid < NBATCH * 8 * NCH) {
        const int cch = c.bid % NCH, bh = c.bid / NCH; const size_t g0 = (size_t)chunk_tok0(bh >> 3, cch) * 1024 + (bh & 7) * 128;
#pragma unroll
        for (int i = 0; i < 4; ++i) { const int id = c.tid + 512 * i; const size_t go = g0 + (size_t)(id >> 4) * 1024 + (id & 15) * 8; rk[i] = *(const u32x4*)(Kb + go); rv[i] = *(const u32x4*)(V + go); }
    }
    for (int u = c.bid; u < NBATCH * 8 * NCH; u += c.G) {
        const int cch = u % NCH, bh = u / NCH, h = bh & 7, b = bh >> 3;
        const float lg = log2_gamma(h);
#pragma unroll
        for (int i = 0; i < 4; ++i) {
            const int id = c.tid + 512 * i, row = id >> 4, ch = id & 15;
            *(LAS u32x4*)(kt + row * TSV + ch * 16) = rk[i];
            const u32x4 v = rv[i];
            const float zf = fast_exp2(lg * (float)(127 - row)), zb = fast_exp2(lg * (float)row);
            u32x4 of, ob;
            of.x = cvt_pk_bf16(bf_lo(v.x) * zf, bf_hi(v.x) * zf); of.y = cvt_pk_bf16(bf_lo(v.y) * zf, bf_hi(v.y) * zf);
            of.z = cvt_pk_bf16(bf_lo(v.z) * zf, bf_hi(v.z) * zf); of.w = cvt_pk_bf16(bf_lo(v.w) * zf, bf_hi(v.w) * zf);
            ob.x = cvt_pk_bf16(bf_lo(v.x) * zb, bf_hi(v.x) * zb); ob.y = cvt_pk_bf16(bf_lo(v.y) * zb, bf_hi(v.y) * zb);
            ob.z = cvt_pk_bf16(bf_lo(v.z) * zb, bf_hi(v.z) * zb); ob.w = cvt_pk_bf16(bf_lo(v.w) * zb, bf_hi(v.w) * zb);
            *(LAS u32x4*)(vf + row * TSV + ch * 16) = of; *(LAS u32x4*)(vb + row * TSV + ch * 16) = ob;
        }
        __syncthreads();
        if (u + c.G < NBATCH * 8 * NCH) {
            const int un = u + c.G, cn = un % NCH, bn = un / NCH; const size_t g0 = (size_t)chunk_tok0(bn >> 3, cn) * 1024 + (bn & 7) * 128;
#pragma unroll
            for (int i = 0; i < 4; ++i) { const int id = c.tid + 512 * i; const size_t go = g0 + (size_t)(id >> 4) * 1024 + (id & 15) * 8; rk[i] = *(const u32x4*)(Kb + go); rv[i] = *(const u32x4*)(V + go); }
        }
        __builtin_amdgcn_sched_barrier(0);
        f32x4 accf[2][4], accb[2][4];
#pragma unroll
        for (int mb = 0; mb < 2; ++mb)
#pragma unroll
            for (int nb = 0; nb < 4; ++nb) { accf[mb][nb] = (f32x4){0.f, 0.f, 0.f, 0.f}; accb[mb][nb] = (f32x4){0.f, 0.f, 0.f, 0.f}; }
#pragma unroll
        for (int ks = 0; ks < 4; ++ks) {
            const int j0 = 32 * ks + 8 * g;
            bf16x8 af[2];
#pragma unroll
            for (int mb = 0; mb < 2; ++mb)
                af[mb] = cat8(tr_read(kt + j0 * TSV + (d0 + 16 * mb) * 2, TSV, c.lane), tr_read(kt + (j0 + 4) * TSV + (d0 + 16 * mb) * 2, TSV, c.lane));
#pragma unroll
            for (int nb = 0; nb < 4; ++nb) {
                const bf16x8 bf = cat8(tr_read(vf + j0 * TSV + (e0 + 16 * nb) * 2, TSV, c.lane), tr_read(vf + (j0 + 4) * TSV + (e0 + 16 * nb) * 2, TSV, c.lane));
                const bf16x8 bb = cat8(tr_read(vb + j0 * TSV + (e0 + 16 * nb) * 2, TSV, c.lane), tr_read(vb + (j0 + 4) * TSV + (e0 + 16 * nb) * 2, TSV, c.lane));
#pragma unroll
                for (int mb = 0; mb < 2; ++mb) {
                    accf[mb][nb] = __builtin_amdgcn_mfma_f32_16x16x32_bf16(af[mb], bf, accf[mb][nb], 0, 0, 0);
                    accb[mb][nb] = __builtin_amdgcn_mfma_f32_16x16x32_bf16(af[mb], bb, accb[mb][nb], 0, 0, 0);
                }
            }
        }
        bf16_t* sf = ST + ((size_t)((0 * 2 + b) * 8 + h) * NCH + cch) * 16384;
        bf16_t* sb = ST + ((size_t)((1 * 2 + b) * 8 + h) * NCH + cch) * 16384;
#pragma unroll
        for (int mb = 0; mb < 2; ++mb)
#pragma unroll
            for (int nb = 0; nb < 4; ++nb) {
                const int e = e0 + 16 * nb + (c.lane & 15), d = d0 + 16 * mb + 4 * g;
                *(u32x2*)(sf + e * 128 + d) = pack4(accf[mb][nb]);
                *(u32x2*)(sb + e * 128 + d) = pack4(accb[mb][nb]);
            }
        __syncthreads();
    }
}
__device__ __forceinline__ void phase_ret_scan(const Ctx& c) {
    bf16_t* ST = c.wb(WS_ST);
    for (int gid = c.bid * 512 + c.tid; gid < 2 * 16 * 2048; gid += c.G * 512) {
        const int dir = gid >> 15, rem = gid & 32767, bh = rem >> 11, e8 = rem & 2047, h = bh & 7;
        bf16_t* base = ST + (size_t)(dir * 16 + bh) * NCH * 16384 + e8 * 8;
        const float decay = fast_exp2(log2_gamma(h) * 128.0f);
        float st[8];
#pragma unroll
        for (int j = 0; j < 8; ++j) st[j] = 0.f;
        for (int s0 = 0; s0 < NCH; s0 += 26) {
            u32x4 ds[26];
#pragma unroll
            for (int i = 0; i < 26; ++i) {
                const int s = s0 + i; const int cch = dir == 0 ? s : (s < 2 ? 1 - s : 131 - s);
                ds[i] = *(const u32x4*)(base + (size_t)cch * 16384);
            }
            __builtin_amdgcn_sched_barrier(0);
#pragma unroll
            for (int i = 0; i < 26; ++i) {
                const int s = s0 + i; const int cch = dir == 0 ? s : (s < 2 ? 1 - s : 131 - s);
                u32x4 o; o.x = cvt_pk_bf16(st[0], st[1]); o.y = cvt_pk_bf16(st[2], st[3]); o.z = cvt_pk_bf16(st[4], st[5]); o.w = cvt_pk_bf16(st[6], st[7]);
                *(u32x4*)(base + (size_t)cch * 16384) = o;
                st[0] = st[0] * decay + bf_lo(ds[i].x); st[1] = st[1] * decay + bf_hi(ds[i].x);
                st[2] = st[2] * decay + bf_lo(ds[i].y); st[3] = st[3] * decay + bf_hi(ds[i].y);
                st[4] = st[4] * decay + bf_lo(ds[i].z); st[5] = st[5] * decay + bf_hi(ds[i].z);
                st[6] = st[6] * decay + bf_lo(ds[i].w); st[7] = st[7] * decay + bf_hi(ds[i].w);
            }
        }
    }
}
__device__ __forceinline__ void phase_ret_out(const Ctx& c) {
    const bf16_t* Q = c.wb(WS_Q); const bf16_t* Kb = c.wb(WS_K); const bf16_t* V = c.wb(WS_V); const bf16_t* Gt = c.wb(WS_G);
    const bf16_t* ST = c.wb(WS_ST); bf16_t* CAT = c.wb(WS_CAT); const float* gn = c.in[9];
    LAS unsigned char* qt = c.lds; LAS unsigned char* kt = c.lds + TILE_B; LAS unsigned char* vt = c.lds + 2 * TILE_B;
    LAS unsigned char* pw = c.lds + 2 * TILE_B + TILE_BV + c.w * (16 * TS);
    LAS float* gws = (LAS float*)(c.lds + 2 * TILE_B + TILE_BV + 8 * (16 * TS));
    const int g = c.lane >> 4, il = c.lane & 15, i0 = 16 * c.w;
    for (int u = c.bid; u < NBATCH * 8 * NCH; u += c.G) {
        const int cch = u % NCH, bh = u / NCH, h = bh & 7, b = bh >> 3;
        const int tok0 = chunk_tok0(b, cch);
        const float lg = log2_gamma(h);
        const bf16_t* st0 = ST + ((size_t)((0 * 2 + b) * 8 + h) * NCH + cch) * 16384;
        u32x4 rq[4], rk[4], rv[4], rs[4];
#pragma unroll
        for (int i = 0; i < 4; ++i) {
            const int id = c.tid + 512 * i, row = id >> 4, ch = id & 15;
            const size_t go = (size_t)(tok0 + row) * 1024 + h * 128 + ch * 8;
            rq[i] = *(const u32x4*)(Q + go); rk[i] = *(const u32x4*)(Kb + go); rv[i] = *(const u32x4*)(V + go);
            rs[i] = *(const u32x4*)(st0 + row * 128 + ch * 8);
        }
        const float gwv = gn[h * 128 + (c.tid & 127)];
        __builtin_amdgcn_sched_barrier(0);
#pragma unroll
        for (int i = 0; i < 4; ++i) {
            const int id = c.tid + 512 * i, row = id >> 4, ch = id & 15;
            *(LAS u32x4*)(qt + row * TS + ch * 16) = rq[i]; *(LAS u32x4*)(kt + row * TS + ch * 16) = rk[i];
            *(LAS u32x4*)(vt + row * TSV + ch * 16) = rv[i];
        }
        if (c.tid < 128) gws[c.tid] = gwv;
        __syncthreads();
        f32x4 sT[8];
#pragma unroll
        for (int jb = 0; jb < 8; ++jb) sT[jb] = (f32x4){0.f, 0.f, 0.f, 0.f};
#pragma unroll 1
        for (int ks = 0; ks < 4; ++ks) {
            const bf16x8 qk = *(const LAS bf16x8*)(qt + (i0 + il) * TS + (32 * ks + 8 * g) * 2);
#pragma unroll
            for (int jb = 0; jb < 8; ++jb) {
                const bf16x8 kf = *(const LAS bf16x8*)(kt + (16 * jb + il) * TS + (32 * ks + 8 * g) * 2);
                sT[jb] = __builtin_amdgcn_mfma_f32_16x16x32_bf16(kf, qk, sT[jb], 0, 0, 0);
            }
        }
        __syncthreads();
        f32x4 ret[8];
#pragma unroll
        for (int eb = 0; eb < 8; ++eb) ret[eb] = (f32x4){0.f, 0.f, 0.f, 0.f};
        const int ii = i0 + il;
        const int tok = tok0 + ii;
#pragma unroll 1
        for (int dir = 0; dir < 2; ++dir) {
#pragma unroll
            for (int i = 0; i < 4; ++i) {
                const int id = c.tid + 512 * i, row = id >> 4, ch = id & 15;
                *(LAS u32x4*)(kt + row * TS + ch * 16) = rs[i];
            }
            if (dir == 0) {
                const bf16_t* st1 = ST + ((size_t)((1 * 2 + b) * 8 + h) * NCH + cch) * 16384;
#pragma unroll
                for (int i = 0; i < 4; ++i) {
                    const int id = c.tid + 512 * i, row = id >> 4, ch = id & 15;
                    rs[i] = *(const u32x4*)(st1 + row * 128 + ch * 8);
                }
            }
            u32x2 gg[8];
#pragma unroll
            for (int eb = 0; eb < 8; ++eb) gg[eb] = *(const u32x2*)(Gt + (size_t)tok * 2048 + dir * 1024 + h * 128 + 16 * eb + 4 * g);
            __builtin_amdgcn_sched_barrier(0);
#pragma unroll
            for (int jb = 0; jb < 8; ++jb) {
                f32x4 p;
#pragma unroll
                for (int r = 0; r < 4; ++r) {
                    const int j = 16 * jb + 4 * g + r; const int dl = dir == 0 ? ii - j : j - ii;
                    p[r] = dl >= 0 ? sT[jb][r] * fast_exp2(lg * (float)dl) : 0.f;
                }
                *(LAS u32x2*)(pw + il * TS + (16 * jb + 4 * g) * 2) = pack4(p);
            }
            __syncthreads();
            f32x4 o[8];
#pragma unroll
            for (int eb = 0; eb < 8; ++eb) o[eb] = (f32x4){0.f, 0.f, 0.f, 0.f};
#pragma unroll 1
            for (int ks = 0; ks < 4; ++ks) {
                const bf16x8 qk = *(const LAS bf16x8*)(qt + (i0 + il) * TS + (32 * ks + 8 * g) * 2);
#pragma unroll
                for (int eb = 0; eb < 8; ++eb) {
                    const bf16x8 sfr = *(const LAS bf16x8*)(kt + (16 * eb + il) * TS + (32 * ks + 8 * g) * 2);
                    o[eb] = __builtin_amdgcn_mfma_f32_16x16x32_bf16(sfr, qk, o[eb], 0, 0, 0);
                }
            }
            const float xi = dir == 0 ? fast_exp2(lg * (float)(ii + 1)) : fast_exp2(lg * (float)(128 - ii));
#pragma unroll
            for (int eb = 0; eb < 8; ++eb) o[eb] = o[eb] * xi;
#pragma unroll 1
            for (int ks = 0; ks < 4; ++ks) {
                const bf16x8 pf = *(const LAS bf16x8*)(pw + il * TS + (32 * ks + 8 * g) * 2);
                const int j0 = 32 * ks + 8 * g;
#pragma unroll
                for (int eb = 0; eb < 8; ++eb) {
                    const bf16x8 vfr = cat8(tr_read(vt + j0 * TSV + (16 * eb) * 2, TSV, c.lane), tr_read(vt + (j0 + 4) * TSV + (16 * eb) * 2, TSV, c.lane));
                    o[eb] = __builtin_amdgcn_mfma_f32_16x16x32_bf16(vfr, pf, o[eb], 0, 0, 0);
                }
            }
            float ss = 0.f;
#pragma unroll
            for (int eb = 0; eb < 8; ++eb) ss += o[eb][0] * o[eb][0] + o[eb][1] * o[eb][1] + o[eb][2] * o[eb][2] + o[eb][3] * o[eb][3];
            ss += __shfl_xor(ss, 16); ss += __shfl_xor(ss, 32);
            const float rstd = rsqrtf(ss * (1.0f / 128.0f) + EPS);
#pragma unroll
            for (int eb = 0; eb < 8; ++eb) {
                const f32x4 gw = *(const LAS f32x4*)(gws + 16 * eb + 4 * g);
                ret[eb][0] += o[eb][0] * rstd * gw[0] * bf_lo(gg[eb].x); ret[eb][1] += o[eb][1] * rstd * gw[1] * bf_hi(gg[eb].x);
                ret[eb][2] += o[eb][2] * rstd * gw[2] * bf_lo(gg[eb].y); ret[eb][3] += o[eb][3] * rstd * gw[3] * bf_hi(gg[eb].y);
            }
            __syncthreads();
        }
#pragma unroll
        for (int eb = 0; eb < 8; ++eb) *(u32x2*)(CAT + (size_t)tok * 2048 + 1024 + h * 128 + 16 * eb + 4 * g) = pack4(ret[eb]);
    }
}
__device__ __forceinline__ void phase_wout(const Ctx& c, const bf16_t* W, int layer, const float* xlat_old, const float* xctx_old, int mt_lo, int MTn) {
    const bf16_t* CAT = c.wb(WS_CAT); const float* mods = c.wf(WS_MODS); float* xctx_new = c.wf(WS_XCTX);
    const int NT = 16;
    const int g = c.lane >> 4, wm = c.w >> 1, wn = c.w & 1;
    for (int t = c.bid; t < MTn * NT; t += c.G) {
        int mt, nt; tile_mn(t, MTn, NT, mt, nt); mt += mt_lo;
        f32x4 acc[2][4];
#if DBG_CAT_PART == 0
        gemm128r<true>(c.lds, 2048, RowLin{CAT + (size_t)mt * 128 * 2048, 2048}, RowLin{W + (size_t)nt * 128 * 2048, 2048}, acc);
#else
        gemm128<true>(c.lds, 1024, RowLin{CAT + (size_t)mt * 128 * 2048 + (DBG_CAT_PART - 1) * 1024, 2048}, RowLin{W + (size_t)nt * 128 * 2048 + (DBG_CAT_PART - 1) * 1024, 2048}, acc);
#endif
#pragma unroll
        for (int mb = 0; mb < 2; ++mb) {
            const int tok = mt * 128 + 32 * wm + 16 * mb + (c.lane & 15);
            const int mw = tok < TC ? 2 : ((tok - TC) >> 14);
            const float* g1 = mods + (size_t)(layer * 3 + mw) * 12288 + 2 * 2048;
            const float* xo = tok < TC ? xctx_old + (size_t)tok * D : xlat_old + (size_t)(tok - TC) * D;
            float* xn = tok < TC ? xctx_new + (size_t)tok * D : c.out + (size_t)(tok - TC) * D;
#pragma unroll
            for (int nb = 0; nb < 4; ++nb) {
                const int col = nt * 128 + 64 * wn + 16 * nb + 4 * g;
                const f32x4 gv = *(const f32x4*)(g1 + col), xv = *(const f32x4*)(xo + col);
                *(f32x4*)(xn + col) = xv + gv * acc[mb][nb];
            }
        }
    }
}
__device__ __forceinline__ void phase_peer_q(const Ctx& c, const bf16_t* W, int mt_lo, int MTn) {
    const bf16_t* H = c.wb(WS_H); bf16_t* Qp = c.wb(WS_G);
    const int NT = 16;
    const int g = c.lane >> 4, wm = c.w >> 1, wn = c.w & 1;
    for (int t = c.bid; t < MTn * NT; t += c.G) {
        int mt, nt; tile_mn(t, MTn, NT, mt, nt); mt += mt_lo;
        f32x4 acc[2][4];
        gemm128r<true>(c.lds, 2048, RowLin{H + (size_t)mt * 128 * 2048, 2048}, RowLin{W + (size_t)nt * 128 * 2048, 2048}, acc);
#pragma unroll
        for (int mb = 0; mb < 2; ++mb) {
            const int tok = mt * 128 + 32 * wm + 16 * mb + (c.lane & 15);
#pragma unroll
            for (int nb = 0; nb < 4; ++nb) *(u32x2*)(Qp + (size_t)tok * 2048 + nt * 128 + 64 * wn + 16 * nb + 4 * g) = pack4(acc[mb][nb]);
        }
    }
}

__device__ __forceinline__ unsigned enc_key(float v) { const unsigned u = __float_as_uint(v); return (u & 0x80000000u) ? ~u : (u | 0x80000000u); }
__device__ __forceinline__ float dec_key(unsigned k) { return __uint_as_float((k & 0x80000000u) ? (k & 0x7fffffffu) : ~k); }
__device__ __forceinline__ void ins16(unsigned (&L)[16], unsigned x) {
#pragma unroll
    for (int i = 0; i < 16; ++i) { const unsigned hi = L[i] > x ? L[i] : x; x = L[i] > x ? x : L[i]; L[i] = hi; }
}
__device__ __forceinline__ void merge16(unsigned (&A)[16], const unsigned (&B)[16]) {
#pragma unroll
    for (int i = 0; i < 16; ++i) A[i] = A[i] > B[15 - i] ? A[i] : B[15 - i];
#pragma unroll
    for (int s = 8; s >= 1; s >>= 1) {
#pragma unroll
        for (int i = 0; i < 16; ++i)
            if ((i & s) == 0) { const unsigned x = A[i], y = A[i + s]; A[i] = x > y ? x : y; A[i + s] = x > y ? y : x; }
    }
}
__device__ __forceinline__ void sort16(unsigned (&A)[16]) {
#pragma unroll
    for (int k = 2; k <= 16; k <<= 1) {
#pragma unroll
        for (int j = k >> 1; j > 0; j >>= 1) {
#pragma unroll
            for (int i = 0; i < 16; ++i) {
                const int l = i ^ j;
                if (l > i) {
                    const unsigned x = A[i], y = A[l]; const unsigned hi = x > y ? x : y, lo = x > y ? y : x;
                    if ((i & k) == 0) { A[i] = hi; A[l] = lo; } else { A[i] = lo; A[l] = hi; }
                }
            }
        }
    }
}
__device__ __forceinline__ unsigned sel16(const unsigned (&L)[16], int a) {
    unsigned r = L[0];
#pragma unroll
    for (int i = 1; i < 16; ++i) r = (a == i) ? L[i] : r;
    return r;
}
__device__ __forceinline__ void topk_issue(const Ctx& c, u32x4 (&ra)[2][2][2], u32x4 (&rb)[2][2][2], const bf16_t* qbase, const bf16_t* kbase) {
    const int r0 = c.tid >> 3, ch = c.tid & 7;
#pragma unroll
    for (int p = 0; p < 2; ++p)
#pragma unroll
        for (int kt = 0; kt < 2; ++kt)
#pragma unroll
            for (int hf = 0; hf < 2; ++hf) {
                ra[p][kt][hf] = *(const u32x4*)(qbase + (size_t)(r0 + 64 * hf) * 2048 + p * 128 + kt * 64 + ch * 8);
                rb[p][kt][hf] = *(const u32x4*)(kbase + (size_t)p * 128 * 128 + (r0 + 64 * hf) * 128 + kt * 64 + ch * 8);
            }
}
__device__ __forceinline__ void topk_scores_pair(const Ctx& c, LAS float* S0, LAS float* S1, const u32x4 (&ra)[2][2][2], const u32x4 (&rb)[2][2][2]) {
    const int lane = c.lane, g = lane >> 4, wm = c.w >> 1, wn = c.w & 1;
    const int r0 = c.tid >> 3, ch = c.tid & 7, woff = r0 * 144 + ch * 16;
    const int aoff = (32 * wm + (lane & 15)) * 144 + (lane >> 4) * 16;
    const int boff = 36864 + (64 * wn + (lane & 15)) * 144 + (lane >> 4) * 16;
#pragma unroll
    for (int p = 0; p < 2; ++p) {
        if (p == 1) __syncthreads();
#pragma unroll
        for (int kt = 0; kt < 2; ++kt)
#pragma unroll
            for (int hf = 0; hf < 2; ++hf) {
                *(LAS u32x4*)(c.lds + kt * 18432 + woff + hf * 9216) = ra[p][kt][hf];
                *(LAS u32x4*)(c.lds + 36864 + kt * 18432 + woff + hf * 9216) = rb[p][kt][hf];
            }
        __syncthreads();
        f32x4 acc[2][4];
#pragma unroll
        for (int mb = 0; mb < 2; ++mb)
#pragma unroll
            for (int nb = 0; nb < 4; ++nb) acc[mb][nb] = (f32x4){0.f, 0.f, 0.f, 0.f};
#pragma unroll
        for (int kt = 0; kt < 2; ++kt)
#pragma unroll
            for (int ks = 0; ks < 2; ++ks) {
                bf16x8 af[2], bfr[4];
#pragma unroll
                for (int mb = 0; mb < 2; ++mb) af[mb] = *(const LAS bf16x8*)(c.lds + kt * 18432 + aoff + mb * 2304 + ks * 64);
#pragma unroll
                for (int nb = 0; nb < 4; ++nb) bfr[nb] = *(const LAS bf16x8*)(c.lds + kt * 18432 + boff + nb * 2304 + ks * 64);
#pragma unroll
                for (int mb = 0; mb < 2; ++mb)
#pragma unroll
                    for (int nb = 0; nb < 4; ++nb) acc[mb][nb] = __builtin_amdgcn_mfma_f32_16x16x32_bf16(af[mb], bfr[nb], acc[mb][nb], 0, 0, 0);
            }
        if (p == 1) __syncthreads();
        LAS float* S = p == 0 ? S0 : S1;
#pragma unroll
        for (int mb = 0; mb < 2; ++mb)
#pragma unroll
            for (int nb = 0; nb < 4; ++nb)
#pragma unroll
                for (int r = 0; r < 4; ++r) S[(32 * wm + 16 * mb + 4 * g + r) * 129 + 64 * wn + 16 * nb + (lane & 15)] = acc[mb][nb][r];
    }
}
__device__ __forceinline__ void phase_peer_topk(const Ctx& c, int layer, int mt_lo) {
    const bf16_t* Qp = c.wb(WS_G); const bf16_t* SK = c.wb(WS_SKB) + (size_t)layer * 16 * 128 * 128;
    int* IDX = (int*)(c.ws + WS_IDX); float* GATE = c.wf(WS_GATE);
    LAS float* S0 = (LAS float*)(c.lds + GEMM_LDS);
    LAS float* S1 = (LAS float*)c.lds;
    const int MT = TT / 128, NU = (MT - mt_lo) * 8;
    u32x4 ra[2][2][2], rb[2][2][2];
    if (c.bid < NU) topk_issue(c, ra, rb, Qp + (size_t)(mt_lo + (c.bid >> 3)) * 128 * 2048 + ((c.bid & 7) * 2) * 128, SK + (size_t)((c.bid & 7) * 2) * 128 * 128);
    for (int u = c.bid; u < NU; u += c.G) {
        const int mt = mt_lo + (u >> 3), h = u & 7;
        topk_scores_pair(c, S0, S1, ra, rb);
        if (u + c.G < NU) {
            const int un = u + c.G;
            topk_issue(c, ra, rb, Qp + (size_t)(mt_lo + (un >> 3)) * 128 * 2048 + ((un & 7) * 2) * 128, SK + (size_t)((un & 7) * 2) * 128 * 128);
        }
        __builtin_amdgcn_sched_barrier(0);
        __syncthreads();
        unsigned La[16], Lb[16];
#pragma unroll
        for (int i = 0; i < 16; ++i) { La[i] = 0u; Lb[i] = 0u; }
        if (c.tid < 256) {
            LAS float* row = (c.tid < 128 ? S0 : S1) + (c.tid & 127) * 129;
#pragma unroll
            for (int i = 0; i < 16; ++i) La[i] = (enc_key(row[i]) & ~127u) | (unsigned)i;
            sort16(La);
#pragma unroll 1
            for (int j0 = 16; j0 < 128; j0 += 16) {
#pragma unroll
                for (int i = 0; i < 16; ++i) Lb[i] = (enc_key(row[j0 + i]) & ~127u) | (unsigned)(j0 + i);
                sort16(Lb);
                merge16(La, Lb);
            }
        }
        __syncthreads();
        if (c.tid >= 128 && c.tid < 256) { LAS unsigned* lst = (LAS unsigned*)S1 + (c.tid - 128) * 129;
#pragma unroll
            for (int i = 0; i < 16; ++i) lst[i] = La[i]; }
        __syncthreads();
        if (c.tid < 128) {
            LAS unsigned* l1 = (LAS unsigned*)S1 + c.tid * 129;
#pragma unroll
            for (int i = 0; i < 16; ++i) Lb[i] = l1[i];
            unsigned M[16], T[16];
#define CK(a, b) ((enc_key(dec_key(La[a] & ~127u) + dec_key(Lb[b] & ~127u)) & ~255u) | (unsigned)(255 - ((a) * 16 + (b))))
#pragma unroll
            for (int b = 0; b < 16; ++b) M[b] = CK(0, b);
#pragma unroll
            for (int a = 1; a < 8; ++a) {
#pragma unroll
                for (int b = 0; b < 16; ++b) T[b] = ((a + 1) * (b + 1) <= 16) ? CK(a, b) : 0u;
                merge16(M, T);
            }
#pragma unroll
            for (int a = 8; a < 16; ++a) T[a - 8] = CK(a, 0);
#pragma unroll
            for (int i = 8; i < 16; ++i) T[i] = 0u;
            merge16(M, T);
#undef CK
            const int tok = mt * 128 + c.tid;
            float sv[16]; const float smax = dec_key(M[0] & ~255u); float sum = 0.f;
#pragma unroll
            for (int k = 0; k < 16; ++k) { sv[k] = fast_exp2((dec_key(M[k] & ~255u) - smax) * LOG2E); sum += sv[k]; }
            const float inv = 1.0f / sum;
            int* ip = IDX + ((size_t)tok * 8 + h) * 16; float* gp = GATE + ((size_t)tok * 8 + h) * 16;
            LAS unsigned* lst = (LAS unsigned*)S0 + c.tid * 129;
#pragma unroll
            for (int i = 0; i < 16; ++i) { lst[i] = La[i]; lst[16 + i] = Lb[i]; }
#pragma unroll
            for (int k = 0; k < 16; ++k) {
                const int ab = 255 - (int)(M[k] & 255u), a = ab >> 4, b = ab & 15;
                const int i0 = (int)(lst[a] & 127u), i1 = (int)(lst[16 + b] & 127u);
                ip[k] = i0 * 128 + i1; gp[k] = sv[k] * inv;
            }
        }
        __syncthreads();
    }
}
typedef unsigned u32x6 __attribute__((ext_vector_type(6)));
typedef float f32x32 __attribute__((ext_vector_type(32)));
__device__ __forceinline__ void gather_experts(const Ctx& c, int layer, const unsigned char* TU, const unsigned char* TV, const float (&xf)[32], int idA, int idB, float gA, float gB,
                                               int e_lo, int e_hi, float (&acc)[32]) {
    for (int e = e_lo; e < (((DBG_SKIP_GATHER >> layer) & 1) ? 0 : e_hi); e += 4) {
        const int sl = e & 63;
        int rr[4]; float gg[4];
#pragma unroll
        for (int k = 0; k < 4; ++k) { rr[k] = __shfl(e < 64 ? idA : idB, sl + k); gg[k] = __shfl(e < 64 ? gA : gB, sl + k); }
        u32x4 uu[4]; u32x4 vv[4];
#pragma unroll
        for (int k = 0; k < 4; ++k) {
            uu[k] = *(const u32x4*)(TU + (size_t)rr[k] * 1024 + c.lane * 16);
            vv[k] = *(const u32x4*)(TV + (size_t)rr[k] * 1024 + c.lane * 16);
        }
        __builtin_amdgcn_sched_barrier(0);
        float dd[4];
#pragma unroll
        for (int k = 0; k < 4; ++k) {
            float d0 = 0.f, d1 = 0.f;
#pragma unroll
            for (int q = 0; q < 4; ++q) {
                const f32x2 f0 = __builtin_amdgcn_cvt_scalef32_pk_f32_fp4(uu[k][q], 1.0f, 0), f1 = __builtin_amdgcn_cvt_scalef32_pk_f32_fp4(uu[k][q], 1.0f, 1);
                const f32x2 f2 = __builtin_amdgcn_cvt_scalef32_pk_f32_fp4(uu[k][q], 1.0f, 2), f3 = __builtin_amdgcn_cvt_scalef32_pk_f32_fp4(uu[k][q], 1.0f, 3);
                d0 += f0.x * xf[q * 8 + 0] + f1.x * xf[q * 8 + 2] + f2.x * xf[q * 8 + 4] + f3.x * xf[q * 8 + 6];
                d1 += f0.y * xf[q * 8 + 1] + f1.y * xf[q * 8 + 3] + f2.y * xf[q * 8 + 5] + f3.y * xf[q * 8 + 7];
            }
            dd[k] = d0 + d1;
        }
#pragma unroll
        for (int o = 32; o >= 1; o >>= 1) {
#pragma unroll
            for (int k = 0; k < 4; ++k) dd[k] += __shfl_xor(dd[k], o);
        }
#pragma unroll
        for (int k = 0; k < 4; ++k) {
            const float w = gg[k] * gelu_tanh(dd[k] * (1.0f / U_SCALE)) * (1.0f / V_SCALE);
#pragma unroll
            for (int q = 0; q < 4; ++q) {
                const f32x2 f0 = __builtin_amdgcn_cvt_scalef32_pk_f32_fp4(vv[k][q], 1.0f, 0), f1 = __builtin_amdgcn_cvt_scalef32_pk_f32_fp4(vv[k][q], 1.0f, 1);
                const f32x2 f2 = __builtin_amdgcn_cvt_scalef32_pk_f32_fp4(vv[k][q], 1.0f, 2), f3 = __builtin_amdgcn_cvt_scalef32_pk_f32_fp4(vv[k][q], 1.0f, 3);
                acc[q * 8 + 0] += w * f0.x; acc[q * 8 + 1] += w * f0.y; acc[q * 8 + 2] += w * f1.x; acc[q * 8 + 3] += w * f1.y;
                acc[q * 8 + 4] += w * f2.x; acc[q * 8 + 5] += w * f2.y; acc[q * 8 + 6] += w * f3.x; acc[q * 8 + 7] += w * f3.y;
            }
        }
    }
}
__device__ __forceinline__ void gather_load_x(const Ctx& c, const bf16_t* H, int tok, float (&xf)[32]) {
#pragma unroll
    for (int q = 0; q < 4; ++q) {
        const u32x4 v = *(const u32x4*)(H + (size_t)tok * D + c.lane * 32 + q * 8);
#pragma unroll
        for (int e = 0; e < 4; ++e) { xf[q * 8 + e * 2] = bf_lo(v[e]); xf[q * 8 + e * 2 + 1] = bf_hi(v[e]); }
    }
}
template <bool FINAL>
__device__ __forceinline__ void gather_epilogue(const Ctx& c, int layer, int tok, float (&acc)[32]) {
    const float* mods = c.wf(WS_MODS); float* xctx = c.wf(WS_XCTX); const float* fnorm = c.in[22];
    const int mw = tok < TC ? 2 : ((tok - TC) >> 14);
    const float* g2 = mods + (size_t)(layer * 3 + mw) * 12288 + 5 * 2048;
    float* xp = tok < TC ? xctx + (size_t)tok * D : c.out + (size_t)(tok - TC) * D;
    float ss = 0.f;
    f32x4 xa[8], ga[8];
#pragma unroll
    for (int q = 0; q < 8; ++q) { xa[q] = *(const f32x4*)(xp + c.lane * 32 + q * 4); ga[q] = *(const f32x4*)(g2 + c.lane * 32 + q * 4); }
    __builtin_amdgcn_sched_barrier(0);
#pragma unroll
    for (int q = 0; q < 8; ++q) {
        const int col = c.lane * 32 + q * 4;
        const f32x4 xv = xa[q], gv = ga[q];
        f32x4 o;
#pragma unroll
        for (int j = 0; j < 4; ++j) { o[j] = xv[j] + gv[j] * acc[q * 4 + j]; ss += o[j] * o[j]; }
        if (!FINAL) *(f32x4*)(xp + col) = o;
        else { acc[q * 4 + 0] = o[0]; acc[q * 4 + 1] = o[1]; acc[q * 4 + 2] = o[2]; acc[q * 4 + 3] = o[3]; }
    }
    if (FINAL) {
        f32x4 fwa[8];
#pragma unroll
        for (int q = 0; q < 8; ++q) fwa[q] = *(const f32x4*)(fnorm + c.lane * 32 + q * 4);
        __builtin_amdgcn_sched_barrier(0);
        ss = wave_sum(ss);
        const float rstd = rsqrtf(ss * (1.0f / D) + EPS);
#pragma unroll
        for (int q = 0; q < 8; ++q) {
            const int col = c.lane * 32 + q * 4;
            const f32x4 fw = fwa[q];
            f32x4 o;
#pragma unroll
            for (int j = 0; j < 4; ++j) o[j] = acc[q * 4 + j] * rstd * fw[j];
#if defined(DBG_ATTN_CHECK) || defined(DBG_TOPK_CHECK) || defined(DBG_TSEL) || defined(DBG_FOURIER_CHECK) || defined(DBG_RET_CHECK)
            for (int j = 0; j < 4; ++j) o[j] += 10000.0f * (float)(*(volatile unsigned*)(c.ws + WS_CTL + 32768));
#endif
            *(f32x4*)(xp + col) = o;
        }
    }
}
template <bool FINAL>
__device__ __forceinline__ void phase_peer_gather(const Ctx& c, int layer, int tok_lo) {
    const bf16_t* H = c.wb(WS_H); const unsigned char* TU = c.ws + WS_TABU + (size_t)layer * (32 * MiB); const unsigned char* TV = c.ws + WS_TABV + (size_t)layer * (32 * MiB);
    const int* IDX = (const int*)(c.ws + WS_IDX); const float* GATE = c.wf(WS_GATE);
    const int W = c.G * 8, nTok = TT - tok_lo, R = nTok / W, rem = nTok - R * W;
    u32x4 xr[4]; int idA = 0, idB = 0; float gA = 0.f, gB = 0.f;
    if (R > 0) {
        const int tok = tok_lo + c.bid * 8 + c.w;
#pragma unroll
        for (int q = 0; q < 4; ++q) xr[q] = *(const u32x4*)(H + (size_t)tok * D + c.lane * 32 + q * 8);
        idA = IDX[(size_t)tok * 128 + c.lane]; idB = IDX[(size_t)tok * 128 + 64 + c.lane];
        gA = GATE[(size_t)tok * 128 + c.lane]; gB = GATE[(size_t)tok * 128 + 64 + c.lane];
    }
    for (int r = 0; r < R; ++r) {
        const int tok = tok_lo + r * W + c.bid * 8 + c.w;
        float xf[32];
#pragma unroll
        for (int q = 0; q < 4; ++q)
#pragma unroll
            for (int e = 0; e < 4; ++e) { xf[q * 8 + e * 2] = bf_lo(xr[q][e]); xf[q * 8 + e * 2 + 1] = bf_hi(xr[q][e]); }
        const int cA = idA, cB = idB; const float cgA = gA, cgB = gB;
        if (r + 1 < R) {
            const int tn = tok + W;
#pragma unroll
            for (int q = 0; q < 4; ++q) xr[q] = *(const u32x4*)(H + (size_t)tn * D + c.lane * 32 + q * 8);
            idA = IDX[(size_t)tn * 128 + c.lane]; idB = IDX[(size_t)tn * 128 + 64 + c.lane];
            gA = GATE[(size_t)tn * 128 + c.lane]; gB = GATE[(size_t)tn * 128 + 64 + c.lane];
        }
        __builtin_amdgcn_sched_barrier(0);
        float acc[32];
#pragma unroll
        for (int j = 0; j < 32; ++j) acc[j] = 0.f;
        gather_experts(c, layer, TU, TV, xf, cA, cB, cgA, cgB, 0, 128, acc);
        gather_epilogue<FINAL>(c, layer, tok, acc);
    }
    if (rem > 0) {
        int S = 1; if (W % rem == 0) { const int q = W / rem; S = q >= 8 ? 8 : (q >= 4 ? 4 : (q >= 2 ? 2 : 1)); }
        const int per = 8 / S, ti = c.bid * per + c.w / S, part = c.w % S, ne = 128 / S;
        const bool act = ti < rem; const int tok = tok_lo + R * W + (act ? ti : 0);
        float acc[32];
#pragma unroll
        for (int j = 0; j < 32; ++j) acc[j] = 0.f;
        if (act) {
            float xf[32];
            gather_load_x(c, H, tok, xf);
            const int idA = IDX[(size_t)tok * 128 + c.lane], idB = IDX[(size_t)tok * 128 + 64 + c.lane];
            const float gA = GATE[(size_t)tok * 128 + c.lane], gB = GATE[(size_t)tok * 128 + 64 + c.lane];
            gather_experts(c, layer, TU, TV, xf, idA, idB, gA, gB, part * ne, part * ne + ne, acc);
        }
        if (S > 1) {
            LAS float* red = (LAS float*)c.lds;
            __syncthreads();
#pragma unroll
            for (int j = 0; j < 32; ++j) red[(c.w * 32 + j) * 64 + c.lane] = acc[j];
            __syncthreads();
            if (act && part == 0)
                for (int p = 1; p < S; ++p) {
#pragma unroll
                    for (int j = 0; j < 32; ++j) acc[j] += red[((c.w + p) * 32 + j) * 64 + c.lane];
                }
        }
        if (act && part == 0) gather_epilogue<FINAL>(c, layer, tok, acc);
    }
}

__device__ __forceinline__ void rope64_store(const f32x4 (&a)[4], bool rotate, int s, int g, float sc, const f32x2* r64, bf16_t* dst) {
    if (rotate) {
        const int prow = s >> 6, pcol = s & 63;
#pragma unroll
        for (int hlf = 0; hlf < 2; ++hlf) {
            const int pos = hlf == 0 ? prow : pcol;
            f32x4 o1, o2;
#pragma unroll
            for (int r = 0; r < 4; ++r) {
                const f32x2 cs = r64[pos * 16 + 4 * g + r];
                const float x1 = a[2 * hlf][r] * sc, x2 = a[2 * hlf + 1][r] * sc;
                o1[r] = x1 * cs.x - x2 * cs.y; o2[r] = x2 * cs.x + x1 * cs.y;
            }
            *(u32x2*)(dst + 32 * hlf) = pack4(o1); *(u32x2*)(dst + 32 * hlf + 16) = pack4(o2);
        }
    } else {
#pragma unroll
        for (int nb = 0; nb < 4; ++nb) *(u32x2*)(dst + 16 * nb) = pack4(a[nb] * sc);
    }
}
__device__ __forceinline__ void phase_odd_proj(const Ctx& c) {
    const bf16_t* H = c.wb(WS_H); const bf16_t* W = c.wb(WS_WINO);
    bf16_t* SQ = c.wb(WS_A); bf16_t* SK = c.wb(WS_Q); bf16_t* SV = c.wb(WS_Q + 9 * MiB); bf16_t* CQ = c.wb(WS_Q + 18 * MiB);
    bf16_t* CKV = c.wb(WS_K); bf16_t* KR = c.wb(WS_K + 17 * MiB);
    const f32x2* r64 = (const f32x2*)(c.ws + WS_ROPE + 131072);
    const int MT = TT / 128, NT = 17;
    const int g = c.lane >> 4, wm = c.w >> 1, wn = c.w & 1;
    for (int t = c.bid; t < MT * NT; t += c.G) {
        int mt, nt; tile_mn(t, MT, NT, mt, nt);
        f32x4 acc[2][4];
        gemm128<true>(c.lds, 2048, RowLin{H + (size_t)mt * 128 * D, (size_t)D}, RowLin{W + (size_t)nt * 128 * 2048, 2048}, acc);
#pragma unroll
        for (int mb = 0; mb < 2; ++mb) {
            const int tok = mt * 128 + 32 * wm + 16 * mb + (c.lane & 15);
            const bool lat = tok >= TC; const int s = (tok - TC) & (SEQ - 1);
            const int cw = 64 * wn + 4 * g;
            if (nt < 8) rope64_store(acc[mb], lat, s, g, 0.125f, r64, SQ + (size_t)tok * 1024 + nt * 128 + cw);
            else if (nt == 8) rope64_store(acc[mb], lat, s, g, 1.0f, r64, SK + (size_t)tok * 128 + cw);
            else if (nt == 9) rope64_store(acc[mb], false, s, g, 1.0f, r64, SV + (size_t)tok * 128 + cw);
            else if (nt < 14) rope64_store(acc[mb], false, s, g, 1.0f, r64, CQ + (size_t)tok * 512 + (nt - 10) * 128 + cw);
            else if (nt < 16) rope64_store(acc[mb], false, s, g, 1.0f, r64, CKV + (size_t)tok * 256 + (nt - 14) * 128 + cw);
            else if (wn == 0) rope64_store(acc[mb], lat, s, g, 1.0f, r64, KR + (size_t)tok * 64 + 4 * g);
        }
    }
}
__device__ __forceinline__ void phase_odd_local(const Ctx& c) {
    bf16_t* CQ = c.wb(WS_Q + 18 * MiB); bf16_t* CKV = c.wb(WS_K); const bf16_t* KR = c.wb(WS_K + 17 * MiB); bf16_t* MK = c.wb(WS_ST);
    const float* qn = c.in[13]; const float* kvn = c.in[14];
    const int l32 = c.lane & 31, hh = c.lane >> 3, part = c.lane & 7, W = c.G * 8;
    const f32x4 qw0 = *(const f32x4*)(qn + c.lane * 8), qw1 = *(const f32x4*)(qn + c.lane * 8 + 4);
    const f32x4 kw0 = *(const f32x4*)(kvn + l32 * 8), kw1 = *(const f32x4*)(kvn + l32 * 8 + 4);
    for (int t0 = c.bid * 8 + c.w; t0 < TT; t0 += 4 * W) {
        u32x4 vq[4], vk[4], vr[4];
#pragma unroll
        for (int k = 0; k < 4; ++k) {
            const int tok = t0 + k * W;
            if (tok < TT) {
                vq[k] = *(const u32x4*)(CQ + (size_t)tok * 512 + c.lane * 8);
                vk[k] = *(const u32x4*)(CKV + (size_t)tok * 256 + l32 * 8);
                vr[k] = *(const u32x4*)(KR + (size_t)tok * 64 + part * 8);
            }
        }
        __builtin_amdgcn_sched_barrier(0);
#pragma unroll
        for (int k = 0; k < 4; ++k) {
            const int tok = t0 + k * W;
            if (tok < TT) {
                {
                    const u32x4 v = vq[k];
                    float f[8] = {bf_lo(v.x), bf_hi(v.x), bf_lo(v.y), bf_hi(v.y), bf_lo(v.z), bf_hi(v.z), bf_lo(v.w), bf_hi(v.w)};
                    float ss = 0.f;
#pragma unroll
                    for (int j = 0; j < 8; ++j) ss += f[j] * f[j];
                    ss = wave_sum(ss);
                    const float rstd = rsqrtf(ss * (1.0f / 512.0f) + EPS);
                    u32x4 o; o.x = cvt_pk_bf16(f[0] * rstd * qw0[0], f[1] * rstd * qw0[1]); o.y = cvt_pk_bf16(f[2] * rstd * qw0[2], f[3] * rstd * qw0[3]);
                    o.z = cvt_pk_bf16(f[4] * rstd * qw1[0], f[5] * rstd * qw1[1]); o.w = cvt_pk_bf16(f[6] * rstd * qw1[2], f[7] * rstd * qw1[3]);
                    *(u32x4*)(CQ + (size_t)tok * 512 + c.lane * 8) = o;
                }
                {
                    const u32x4 v = vk[k];
                    float f[8] = {bf_lo(v.x), bf_hi(v.x), bf_lo(v.y), bf_hi(v.y), bf_lo(v.z), bf_hi(v.z), bf_lo(v.w), bf_hi(v.w)};
                    float ss = 0.f;
#pragma unroll
                    for (int j = 0; j < 8; ++j) ss += f[j] * f[j];
                    ss = wave_sum(ss) * 0.5f;
                    const float rstd = rsqrtf(ss * (1.0f / 256.0f) + EPS);
                    u32x4 o; o.x = cvt_pk_bf16(f[0] * rstd * kw0[0], f[1] * rstd * kw0[1]); o.y = cvt_pk_bf16(f[2] * rstd * kw0[2], f[3] * rstd * kw0[3]);
                    o.z = cvt_pk_bf16(f[4] * rstd * kw1[0], f[5] * rstd * kw1[1]); o.w = cvt_pk_bf16(f[6] * rstd * kw1[2], f[7] * rstd * kw1[3]);
                    if (c.lane < 32) *(u32x4*)(CKV + (size_t)tok * 256 + l32 * 8) = o;
                }
                *(u32x4*)(MK + ((size_t)tok * 8 + hh) * 192 + 128 + part * 8) = vr[k];
            }
        }
    }
}
__device__ __forceinline__ void phase_mla_up(const Ctx& c) {
    const bf16_t* CQ = c.wb(WS_Q + 18 * MiB); const bf16_t* CKV = c.wb(WS_K);
    const bf16_t* Wuq = c.wb(WS_WUQ); const bf16_t* Wukv = c.wb(WS_WUKV);
    bf16_t* MQ = c.wb(WS_G); bf16_t* MK = c.wb(WS_ST); bf16_t* MV = c.wb(WS_V);
    const f32x2* r64 = (const f32x2*)(c.ws + WS_ROPE + 131072);
    const int g = c.lane >> 4, wm = c.w >> 1, wn = c.w & 1;
    const int NUQ = 256 * 12, NUKV = 260 * 16;
    for (int u = c.bid; u < NUQ + NUKV; u += c.G) {
        f32x4 acc[2][4];
        if (u < NUQ) {
            int mt, nt; tile_mn(u, 256, 12, mt, nt); mt += 4;
            gemm128<true>(c.lds, 512, RowLin{CQ + (size_t)mt * 128 * 512, 512}, RowLin{Wuq + (size_t)nt * 128 * 512, 512}, acc);
            const int rr = nt * 2 + wn, part = rr % 3;
#pragma unroll
            for (int mb = 0; mb < 2; ++mb) {
                const int tok = mt * 128 + 32 * wm + 16 * mb + (c.lane & 15); const int s = (tok - TC) & (SEQ - 1);
                rope64_store(acc[mb], part == 2, s, g, 0.07216878364870322f, r64, MQ + (size_t)tok * 1536 + rr * 64 + 4 * g);
            }
        } else {
            int mt, nt; tile_mn(u - NUQ, 260, 16, mt, nt);
            gemm128<true>(c.lds, 256, RowLin{CKV + (size_t)mt * 128 * 256, 256}, RowLin{Wukv + (size_t)nt * 128 * 256, 256}, acc);
            const int head = nt >> 1;
#pragma unroll
            for (int mb = 0; mb < 2; ++mb) {
                const int tok = mt * 128 + 32 * wm + 16 * mb + (c.lane & 15);
                bf16_t* dst = (nt & 1) ? MV + ((size_t)tok * 8 + head) * 128 + 64 * wn + 4 * g : MK + ((size_t)tok * 8 + head) * 192 + 64 * wn + 4 * g;
#pragma unroll
                for (int nb = 0; nb < 4; ++nb) *(u32x2*)(dst + 16 * nb) = pack4(acc[mb][nb]);
            }
        }
    }
}

__device__ __forceinline__ int fresh_lane() { int l = __builtin_amdgcn_mbcnt_hi(~0u, __builtin_amdgcn_mbcnt_lo(~0u, 0u)); asm volatile("" : "+v"(l)); return l; }
__device__ __forceinline__ void half_pair(float v, float& a, float& b) {
    const auto rr = __builtin_amdgcn_permlane32_swap(__float_as_uint(v), __float_as_uint(v), false, false);
    a = __uint_as_float(rr[0]); b = __uint_as_float(rr[1]);
}
template <int DQK, int DV, bool SWA, bool YOUNG>
__device__ __forceinline__ void attn_body(const Ctx& c0, const bf16_t* __restrict__ qptr, int qpitch, const bf16_t* __restrict__ kptr, int kpitch,
                                          const bf16_t* __restrict__ vptr, int vpitch, bf16_t* __restrict__ optr, int opitch, int b, int q0, float sink) {
    constexpr int KS = DQK * 2 + 16, VS = DV * 2 + (DV == 128 ? 32 : 16);
    constexpr int KCPR = DQK / 8, VCPR = DV / 8, KPT = DQK / 64, VPT = DV / 64, NKS = DQK / 16, NDB = DV / 32;
    constexpr int KB = 64 * KS;
    const int lane = fresh_lane(), tid = c0.w * 64 + lane;
    LAS unsigned char* kbuf = c0.lds; LAS unsigned char* vt = c0.lds + 2 * KB;
    const int hh = lane >> 5, l31 = lane & 31, blk = (lane >> 4) & 1;
    const int wq = SWA ? (c0.w & 3) : c0.w;
    int ntiles, kt_lo = 0;
    if (SWA) { kt_lo = (q0 - 128) >> 6; if (kt_lo < 0) kt_lo = 0; int kt_hi = (q0 + 127 + 128) >> 6; if (kt_hi > 255) kt_hi = 255; ntiles = 4 + kt_hi - kt_lo + 1; }
    else ntiles = 4 + 256;
    bf16x8 qf[NKS];
    {
        const bf16_t* qr = qptr + (size_t)(32 * wq + l31) * qpitch + 8 * hh;
#pragma unroll
        for (int ks = 0; ks < NKS; ++ks) qf[ks] = *(const bf16x8*)(qr + 16 * ks);
    }
    f32x16 o[NDB];
#pragma unroll
    for (int db = 0; db < NDB; ++db)
#pragma unroll
        for (int r = 0; r < 16; ++r) o[db][r] = 0.f;
    float m = SWA ? sink * LOG2E : 0.0f, l = (SWA && hh == 0) ? 1.0f : 0.0f;

    const int qpos = q0 + 32 * wq + l31;
    u32x4 kr[KPT], vr[VPT];
#define ATT_TK(tt) ((tt) < 4 ? b * NCTX + 64 * (tt) : TC + b * SEQ + 64 * (kt_lo + (tt) - 4))
#define ATT_LOADK(tt) do { const char* _kb = (const char*)(kptr + (size_t)ATT_TK(tt) * kpitch); \
        _Pragma("unroll") for (int i = 0; i < KPT; ++i) { const int id = tid + 512 * i, row = id / KCPR, ch = id % KCPR; kr[i] = *(const u32x4*)(_kb + (unsigned)((row * kpitch + ch * 8) * 2)); } } while (0)
#define ATT_LOADV(tt) do { const char* _vb = (const char*)(vptr + (size_t)ATT_TK(tt) * vpitch); \
        _Pragma("unroll") for (int i = 0; i < VPT; ++i) { const int id = tid + 512 * i, row = id / VCPR, ch = id % VCPR; vr[i] = *(const u32x4*)(_vb + (unsigned)((row * vpitch + ch * 8) * 2)); } } while (0)
#define ATT_WRITE_K(buf) do { _Pragma("unroll") for (int i = 0; i < KPT; ++i) { const int id = tid + 512 * i, row = id / KCPR, ch = id % KCPR; *(LAS u32x4*)(kbuf + (buf) * KB + row * KS + ch * 16) = kr[i]; } } while (0)
#define ATT_WRITE_V() do { _Pragma("unroll") for (int i = 0; i < VPT; ++i) { const int id = tid + 512 * i, row = id / VCPR, ch = id % VCPR; *(LAS u32x4*)(vt + row * VS + ch * 16) = vr[i]; } } while (0)
#define ATT_QK(buf) do { f32x16 negm; _Pragma("unroll") for (int r = 0; r < 16; ++r) negm[r] = -m; \
        _Pragma("unroll") for (int ks = 0; ks < NKS; ++ks) _Pragma("unroll") for (int kb = 0; kb < 2; ++kb) { \
            const bf16x8 kf = *(const LAS bf16x8*)(kbuf + (buf) * KB + (32 * kb + l31) * KS + (16 * ks + 8 * hh) * 2); \
            s[kb] = __builtin_amdgcn_mfma_f32_32x32x16_bf16(kf, qf[ks], ks == 0 ? negm : s[kb], 0, 0, 0); } } while (0)
    f32x16 s[2];
    const int qw0 = q0 + 32 * wq;
#define ATT_DMAX(tt) (qw0 + 31 - 64 * (kt_lo + (tt) - 4))
#define ATT_DMIN(tt) (qw0 - 63 - 64 * (kt_lo + (tt) - 4))
#define ATT_LIVE(tt) (!SWA || (tt) < 4 || (ATT_DMIN(tt) <= 128 && ATT_DMAX(tt) >= -128))
    ATT_LOADK(0); ATT_WRITE_K(0); ATT_LOADV(0);
    if (ntiles > 1) ATT_LOADK(1);
    __syncthreads();
    if (YOUNG) ATT_QK(0);
    for (int t = 0; t < ntiles; ++t) {
        __syncthreads();
        ATT_WRITE_V();
        if (t + 1 < ntiles) ATT_WRITE_K((t + 1) & 1);
        __syncthreads();
        if (t + 1 < ntiles) ATT_LOADV(t + 1);
        if (t + 2 < ntiles) ATT_LOADK(t + 2);
        const bool live = ATT_LIVE(t);
        if (live) {
        if (!YOUNG) ATT_QK(t & 1);
        if (SWA && t >= 4 && (ATT_DMAX(t) > 128 || ATT_DMIN(t) < -128)) {
            const int kpos0 = 64 * (kt_lo + t - 4);
#pragma unroll
            for (int kb = 0; kb < 2; ++kb)
#pragma unroll
                for (int r = 0; r < 16; ++r) {
                    const int kpos = kpos0 + 32 * kb + (r & 3) + 8 * (r >> 2) + 4 * hh; const int dd = qpos - kpos;
                    if (dd > 128 || dd < -128) s[kb][r] = -INFINITY;
                }
        }
        float tm = s[0][0];
#pragma unroll
        for (int kb = 0; kb < 2; ++kb)
#pragma unroll
            for (int r = 0; r < 16; ++r) tm = fmaxf(tm, s[kb][r]);
        { float ta, tb; half_pair(tm, ta, tb); tm = fmaxf(ta, tb); }
        const bool upd = tm > 8.0f || (!SWA && t == 0);
        if (!__all(!upd)) {
            const float d = upd ? tm : 0.f;
#pragma unroll
            for (int kb = 0; kb < 2; ++kb)
#pragma unroll
                for (int r = 0; r < 16; ++r) s[kb][r] -= d;
            m += d;
            const float alpha = d > 0.f ? fast_exp2(-d) : 1.0f;
            l *= alpha;
#pragma unroll
            for (int db = 0; db < NDB; ++db)
#pragma unroll
                for (int r = 0; r < 16; ++r) o[db][r] *= alpha;
        }
        float ps = 0.f;
#pragma unroll
        for (int kb = 0; kb < 2; ++kb)
#pragma unroll
            for (int r = 0; r < 16; ++r) { const float p = fast_exp2(s[kb][r]); s[kb][r] = p; ps += p; }
        l += ps;
#pragma unroll
        for (int kb = 0; kb < 2; ++kb)
#pragma unroll
            for (int s2 = 0; s2 < 2; ++s2) {
                u32x4 pk;
                pk.x = cvt_pk_bf16(s[kb][8 * s2 + 0], s[kb][8 * s2 + 1]); pk.y = cvt_pk_bf16(s[kb][8 * s2 + 2], s[kb][8 * s2 + 3]);
                pk.z = cvt_pk_bf16(s[kb][8 * s2 + 4], s[kb][8 * s2 + 5]); pk.w = cvt_pk_bf16(s[kb][8 * s2 + 6], s[kb][8 * s2 + 7]);
                const bf16x8 pf = __builtin_bit_cast(bf16x8, pk);
                const int r0 = 32 * kb + 16 * s2 + 4 * hh;
#pragma unroll
                for (int db = 0; db < NDB; ++db) {
                    const bf16x8 vf = cat8(tr_read(vt + r0 * VS + (32 * db + 16 * blk) * 2, VS, lane), tr_read(vt + (r0 + 8) * VS + (32 * db + 16 * blk) * 2, VS, lane));
                    o[db] = __builtin_amdgcn_mfma_f32_32x32x16_bf16(vf, pf, o[db], 0, 0, 0);
                }
            }
        }
        if (YOUNG && t + 1 < ntiles && ATT_LIVE(t + 1)) ATT_QK((t + 1) & 1);
    }
#undef ATT_DMAX
#undef ATT_DMIN
#undef ATT_LIVE
#undef ATT_TK
#undef ATT_LOADK
#undef ATT_LOADV
#undef ATT_WRITE_K
#undef ATT_WRITE_V
#undef ATT_QK
    { float la, lb; half_pair(l, la, lb); l = la + lb; }
    const float inv = 1.0f / l;
    const int le = fresh_lane();
    bf16_t* orow = optr + (size_t)(32 * wq + (le & 31)) * opitch + 4 * (le >> 5);
#pragma unroll
    for (int db = 0; db < NDB; ++db)
#pragma unroll
        for (int rg = 0; rg < 4; ++rg) {
            f32x4 v = {o[db][4 * rg] * inv, o[db][4 * rg + 1] * inv, o[db][4 * rg + 2] * inv, o[db][4 * rg + 3] * inv};
            *(u32x2*)(orow + 32 * db + 8 * rg) = pack4(v);
        }
    __syncthreads();
}
template <int DQK, int DV, bool SWA>
__device__ __forceinline__ void attn_unit(const Ctx& c, const bf16_t* __restrict__ qptr, int qpitch, const bf16_t* __restrict__ kptr, int kpitch,
                                          const bf16_t* __restrict__ vptr, int vpitch, bf16_t* __restrict__ optr, int opitch, int b, int q0, float sink, float sink2) {
    if (c.w < 4) attn_body<DQK, DV, SWA, false>(c, qptr, qpitch, kptr, kpitch, vptr, vpitch, optr, opitch, b, q0, sink);
    else attn_body<DQK, DV, SWA, true>(c, SWA ? qptr + DQK : qptr, qpitch, kptr, kpitch, vptr, vpitch, SWA ? optr + DV : optr, opitch, b, q0, SWA ? sink2 : sink);
}
__device__ __forceinline__ void phase_attention(const Ctx& c) {
    const bf16_t* MQ = c.wb(WS_G); const bf16_t* MK = c.wb(WS_ST); const bf16_t* MV = c.wb(WS_V);
    const bf16_t* SQ = c.wb(WS_A); const bf16_t* SK = c.wb(WS_Q); const bf16_t* SV = c.wb(WS_Q + 9 * MiB);
    bf16_t* CAT = c.wb(WS_CAT); const float* sink = c.in[12];
    for (int u = c.bid; u < 1024; u += c.G) {
        const int b = u >> 9, h = (u >> 6) & 7, qb = u & 63; const size_t tok0 = (size_t)TC + (size_t)b * SEQ + qb * 256;
        attn_unit<192, 128, false>(c, MQ + tok0 * 1536 + h * 192, 1536, MK + h * 192, 1536, MV + h * 128, 1024, CAT + tok0 * 2048 + 1024 + h * 128, 2048, b, qb * 256, 0.f, 0.f);
    }
    for (int u = c.bid; u < 2048; u += c.G) {
        const int b = u >> 10, hq = ((u >> 7) & 7) * 2, qb = u & 127; const size_t tok0 = (size_t)TC + (size_t)b * SEQ + qb * 128;
        attn_unit<64, 64, true>(c, SQ + tok0 * 1024 + hq * 64, 1024, SK + (hq >> 3) * 64, 128, SV + (hq >> 3) * 64, 128, CAT + tok0 * 2048 + hq * 64, 2048, b, qb * 128, sink[hq], sink[hq + 1]);
    }
}


#ifdef DBG_TOPK_CHECK

__device__ __forceinline__ void dbg_gather_save(const Ctx& c) {
    if (c.bid >= 64) return;
    const int tok = 512 + 509 * c.bid + (c.bid & 1 ? 0 : 7);
    float* sv = (float*)(c.ws + WS_CTL + 65536) + (size_t)c.bid * 2048;
    for (int i = c.tid; i < 2048; i += 512) sv[i] = c.out[(size_t)(tok - TC) * D + i];
}
__device__ __forceinline__ void dbg_gather_check(const Ctx& c) {
    if (c.bid >= 64) return;
    const int tok = 512 + 509 * c.bid + (c.bid & 1 ? 0 : 7);
    const bf16_t* H = c.wb(WS_H); const bf16_t* TU = c.wb(WS_TABU); const bf16_t* TV = c.wb(WS_TABV);
    const int* IDX = (const int*)(c.ws + WS_IDX); const float* GATE = c.wf(WS_GATE);
    const float* sv = (const float*)(c.ws + WS_CTL + 65536) + (size_t)c.bid * 2048;
    const float* g2 = c.wf(WS_MODS) + (size_t)(0 * 3 + ((tok - TC) >> 14)) * 12288 + 5 * 2048;
    LAS float* red = (LAS float*)c.lds;
    float f0 = 0.f, f1 = 0.f, f2 = 0.f, f3 = 0.f;
    const int d0 = c.tid * 4;
    for (int e = 0; e < 128; ++e) {
        const int id = IDX[(size_t)tok * 128 + e]; const float gt = GATE[(size_t)tok * 128 + e];
        float p = 0.f;
        for (int j = 0; j < 4; ++j) p += bf2f(H[(size_t)tok * D + d0 + j]) * bf2f(TU[(size_t)id * D + d0 + j]);
        p = wave_sum(p);
        __syncthreads();
        if (c.lane == 0) red[c.w] = p;
        __syncthreads();
        float a = 0.f; for (int w = 0; w < 8; ++w) a += red[w];
        const float wgt = gt * gelu_tanh(a);
        f0 += wgt * bf2f(TV[(size_t)id * D + d0]); f1 += wgt * bf2f(TV[(size_t)id * D + d0 + 1]); f2 += wgt * bf2f(TV[(size_t)id * D + d0 + 2]); f3 += wgt * bf2f(TV[(size_t)id * D + d0 + 3]);
    }
    const float* xo = c.out + (size_t)(tok - TC) * D + d0;
    int bad = 0;
    if (fabsf(sv[d0] + g2[d0] * f0 - xo[0]) > 0.02f) bad = 16;
    if (fabsf(sv[d0 + 1] + g2[d0 + 1] * f1 - xo[1]) > 0.02f) bad = 16;
    if (fabsf(sv[d0 + 2] + g2[d0 + 2] * f2 - xo[2]) > 0.02f) bad = 16;
    if (fabsf(sv[d0 + 3] + g2[d0 + 3] * f3 - xo[3]) > 0.02f) bad = 16;
    if (bad) atomicOr((unsigned*)(c.ws + WS_CTL + 32768), (unsigned)bad);
}
__device__ __forceinline__ void dbg_topk_check(const Ctx& c) {
    const bf16_t* Qp = c.wb(WS_G); const bf16_t* SK = c.wb(WS_SKB);
    const int* IDX = (const int*)(c.ws + WS_IDX); const float* GATE = c.wf(WS_GATE);
    LAS float* sc = (LAS float*)c.lds;
    LAS int* cnt = (LAS int*)(c.lds + 2048);
    if (c.bid >= 64) return;
    const int tok = 512 + 509 * c.bid + (c.bid & 1 ? 0 : 7);
    int bad = 0;
    for (int h = 0; h < 8; ++h) {
        if (c.tid < 256) {
            const int p = c.tid >> 7, key = c.tid & 127, hp = h * 2 + p;
            float s = 0.f;
            for (int cc = 0; cc < 128; ++cc) s += bf2f(Qp[(size_t)tok * 2048 + hp * 128 + cc]) * bf2f(SK[((size_t)hp * 128 + key) * 128 + cc]);
            sc[p * 128 + key] = s;
        }
        if (c.tid == 0) cnt[0] = 0;
        __syncthreads();
        LAS float* ls = (LAS float*)(c.lds + 4096);
        if (c.tid < 16) { const int id = IDX[((size_t)tok * 8 + h) * 16 + c.tid]; ls[c.tid] = sc[(id >> 7) & 127] + sc[128 + (id & 127)]; if (id < 0 || id >= 16384) bad |= 1; }
        __syncthreads();
        float smin = 1e30f, smax = -1e30f;
        for (int k = 0; k < 16; ++k) { smin = fminf(smin, ls[k]); smax = fmaxf(smax, ls[k]); }
        for (int k = 0; k < 16; ++k) for (int k2 = k + 1; k2 < 16; ++k2) if (IDX[((size_t)tok * 8 + h) * 16 + k] == IDX[((size_t)tok * 8 + h) * 16 + k2]) bad |= 2;
        int n = 0;
        for (int i = c.tid; i < 16384; i += 512) { const float v = sc[i >> 7] + sc[128 + (i & 127)]; if (v > smin + 2e-2f) ++n; }
        atomicAdd((int*)cnt, n);
        __syncthreads();
        if (cnt[0] > 15) bad |= 4;
        float den = 0.f; for (int k = 0; k < 16; ++k) den += fast_exp2((ls[k] - smax) * LOG2E);
        for (int k = 0; k < 16; ++k) { const float gref = fast_exp2((ls[k] - smax) * LOG2E) / den; if (fabsf(gref - GATE[((size_t)tok * 8 + h) * 16 + k]) > 2e-2f) bad |= 8; }
        __syncthreads();
    }
    if (bad && c.tid == 0) atomicOr((unsigned*)(c.ws + WS_CTL + 32768), (unsigned)bad);
}
#endif

#ifdef DBG_ATTN_CHECK
__device__ __forceinline__ void dbg_attn_check(const Ctx& c) {
    if (c.bid >= 64) return;
    LAS float* sc = (LAS float*)c.lds;
    LAS float* red = (LAS float*)(c.lds + 80000);
    const bf16_t* CAT = c.wb(WS_CAT);
    int bad = 0;
    if (c.bid < 32) {
        const bf16_t* MQ = c.wb(WS_G); const bf16_t* MK = c.wb(WS_ST); const bf16_t* MV = c.wb(WS_V);
        const int b = c.bid & 1, h = (c.bid >> 1) & 7, s = (c.bid * 523 + 77) & 16383;
        const size_t tok = (size_t)TC + (size_t)b * SEQ + s;
        float lmax = -1e30f;
        for (int k = c.tid; k < 16640; k += 512) {
            const size_t kt = k < 256 ? (size_t)b * 256 + k : (size_t)TC + (size_t)b * SEQ + (k - 256);
            float a = 0.f;
            for (int d = 0; d < 192; ++d) a += bf2f(MQ[tok * 1536 + h * 192 + d]) * bf2f(MK[(kt * 8 + h) * 192 + d]);
            sc[k] = a; lmax = fmaxf(lmax, a);
        }
#pragma unroll
        for (int o = 32; o >= 1; o >>= 1) lmax = fmaxf(lmax, __shfl_xor(lmax, o));
        if (c.lane == 0) red[c.w] = lmax;
        __syncthreads();
        float mx = red[0]; for (int w = 1; w < 8; ++w) mx = fmaxf(mx, red[w]);
        __syncthreads();
        float ls = 0.f;
        for (int k = c.tid; k < 16640; k += 512) { float p = fast_exp2((sc[k] - mx) * LOG2E);
#if defined(DBG_ATTN_MODE) && DBG_ATTN_MODE == 1
            p = 1.f;
#endif
            sc[k] = p; ls += p; }
        ls = wave_sum(ls);
        if (c.lane == 0) red[c.w] = ls;
        __syncthreads();
        float den = 0.f; for (int w = 0; w < 8; ++w) den += red[w];
        if (c.tid < 128) {
            float o = 0.f;
            for (int k = 0; k < 16640; ++k) { const size_t kt = k < 256 ? (size_t)b * 256 + k : (size_t)TC + (size_t)b * SEQ + (k - 256);
#ifdef DBG_ATTN_SYNV
                o += sc[k] * (float)((((int)kt) * 3 + c.tid) & 31);
#else
                o += sc[k] * bf2f(MV[(kt * 8 + h) * 128 + c.tid]);
#endif
            }
            o /= den;
            const float got = bf2f(CAT[tok * 2048 + 1024 + h * 128 + c.tid]);
            if (fabsf(got - o) > 0.002f + 0.03f * fabsf(o)) bad = 1;

        }
    } else {
        const bf16_t* SQ = c.wb(WS_A); const bf16_t* SK = c.wb(WS_Q); const bf16_t* SV = c.wb(WS_Q + 9 * MiB);
        const int i = c.bid - 32; const int b = i & 1, hq = (i >> 1) & 15;
        const int s = i < 4 ? (i == 0 ? 0 : (i == 1 ? 16383 : (i == 2 ? 100 : 16300))) : ((i * 1021 + 333) & 16383);
        const size_t tok = (size_t)TC + (size_t)b * SEQ + s; const int hk = hq >> 3;
        const float sink = c.in[12][hq];
        const int lo = s - 128 < 0 ? 0 : s - 128, hi = s + 128 > 16383 ? 16383 : s + 128, nk = 256 + hi - lo + 1;
        float lmax = sink;
        for (int k = c.tid; k < nk; k += 512) {
            const size_t kt = k < 256 ? (size_t)b * 256 + k : (size_t)TC + (size_t)b * SEQ + lo + (k - 256);
            float a = 0.f;
            for (int d = 0; d < 64; ++d) a += bf2f(SQ[tok * 1024 + hq * 64 + d]) * bf2f(SK[kt * 128 + hk * 64 + d]);
            sc[k] = a; lmax = fmaxf(lmax, a);
        }
#pragma unroll
        for (int o = 32; o >= 1; o >>= 1) lmax = fmaxf(lmax, __shfl_xor(lmax, o));
        if (c.lane == 0) red[c.w] = lmax;
        __syncthreads();
        float mx = red[0]; for (int w = 1; w < 8; ++w) mx = fmaxf(mx, red[w]);
        __syncthreads();
        float ls = 0.f;
        for (int k = c.tid; k < nk; k += 512) { float p = fast_exp2((sc[k] - mx) * LOG2E);
#if defined(DBG_ATTN_MODE) && DBG_ATTN_MODE == 1
            p = 1.f;
#endif
            sc[k] = p; ls += p; }
        ls = wave_sum(ls);
        if (c.lane == 0) red[c.w] = ls;
        __syncthreads();
#if defined(DBG_ATTN_MODE) && DBG_ATTN_MODE == 1
        float den = 1.f;
#else
        float den = fast_exp2((sink - mx) * LOG2E);
#endif
        for (int w = 0; w < 8; ++w) den += red[w];
        if (c.tid < 64) {
            float o = 0.f;
            for (int k = 0; k < nk; ++k) { const size_t kt = k < 256 ? (size_t)b * 256 + k : (size_t)TC + (size_t)b * SEQ + lo + (k - 256); o += sc[k] * bf2f(SV[kt * 128 + hk * 64 + c.tid]); }
            o /= den;
            const float got = bf2f(CAT[tok * 2048 + hq * 64 + c.tid]);
            if (fabsf(got - o) > 0.002f + 0.03f * fabsf(o)) bad = 2;

        }
    }
    if (bad) atomicOr((unsigned*)(c.ws + WS_CTL + 32768), (unsigned)bad);
    __syncthreads();
}
#endif

typedef const f32x4 (&Acc8)[2][2][4][2];
__device__ __forceinline__ void rope64_pair(const f32x4 a, const f32x4 b, bool rotate, const f32x4 (&cs)[2], float sc, bf16_t* dst) {
    if (rotate) {
        f32x4 o1, o2;
#pragma unroll
        for (int r = 0; r < 4; ++r) { const float cx = cs[r >> 1][(r & 1) * 2], sx = cs[r >> 1][(r & 1) * 2 + 1]; const float x1 = a[r] * sc, x2 = b[r] * sc; o1[r] = x1 * cx - x2 * sx; o2[r] = x2 * cx + x1 * sx; }
        *(u32x2*)dst = pack4(o1); *(u32x2*)(dst + 16) = pack4(o2);
    } else { *(u32x2*)dst = pack4(a * sc); *(u32x2*)(dst + 16) = pack4(b * sc); }
}
__device__ __forceinline__ void rope64_load(f32x4 (&cs)[2], const f32x2* r64, int tok, int wc, int fq) {
    const int s = (tok - TC) & (SEQ - 1), pos = (wc & 1) == 0 ? (s >> 6) : (s & 63);
    const f32x4* p = (const f32x4*)(r64 + pos * 16 + 4 * fq);
    if (tok >= TC) { cs[0] = p[0]; cs[1] = p[1]; }
}
struct EpiEvenProj {
    static constexpr bool PERM = false, AFTER_DRAIN = false;
    bf16_t* F; bf16_t* Q; bf16_t* Kb; bf16_t* V; bf16_t* Gt; const f32x2* r128;
    __device__ __forceinline__ void ld_cs(f32x4 (&cs)[2], int tok, int wc, int fq) const {
        const int s = (tok - TC) & (SEQ - 1), pos = (wc >> 1) == 0 ? (s >> 6) : (s & 63);
        const f32x4* p = (const f32x4*)(r128 + pos * 32 + 16 * (wc & 1) + 4 * fq);
        if (tok >= TC) { cs[0] = p[0]; cs[1] = p[1]; }
    }
    __device__ __forceinline__ void operator()(Acc8 acc, const pg8::Unit& u, int wr, int wc, int fr, int fq) const {
        const int region = u.pn >> 2, ct = (u.pn & 3) * 256;
        const bool qk = region == 1 || region == 2;
        const int tok0 = u.pm * 256 + wr * 64 + fr;
        f32x4 cur[2], nxt[2];
        if (qk) ld_cs(cur, tok0, wc, fq);
#pragma unroll
        for (int ai = 0; ai < 2; ++ai)
#pragma unroll
            for (int m = 0; m < 4; ++m) {
                const int tok = tok0 + ai * 128 + m * 16, gi = ai * 4 + m;
                if (qk && gi + 1 < 8) ld_cs(nxt, tok0 + ((gi + 1) >> 2) * 128 + ((gi + 1) & 3) * 16, wc, fq);
#pragma unroll
                for (int bj = 0; bj < 2; ++bj) {
                    const int col = ct + bj * 128 + wc * 32 + 4 * fq;
                    if (region == 0) { *(u32x2*)(F + (size_t)tok * 1024 + col) = pack4(acc[ai][bj][m][0]); *(u32x2*)(F + (size_t)tok * 1024 + col + 16) = pack4(acc[ai][bj][m][1]); }
                    else if (region == 3) { *(u32x2*)(V + (size_t)tok * 1024 + col) = pack4(acc[ai][bj][m][0]); *(u32x2*)(V + (size_t)tok * 1024 + col + 16) = pack4(acc[ai][bj][m][1]); }
                    else if (region >= 4) {
#pragma unroll
                        for (int n = 0; n < 2; ++n) { f32x4 o;
#pragma unroll
                            for (int r = 0; r < 4; ++r) o[r] = silu_f(acc[ai][bj][m][n][r]);
                            *(u32x2*)(Gt + (size_t)tok * 2048 + (region - 4) * 1024 + col + 16 * n) = pack4(o); }
                    } else {
                        const int head = (u.pn & 3) * 2 + bj, d0 = 64 * (wc >> 1) + 16 * (wc & 1) + 4 * fq;
                        bf16_t* dst = (region == 1 ? Q : Kb) + (size_t)tok * 1024 + head * 128 + d0;
                        const float sc = region == 2 ? 0.08838834764831845f : 1.0f;
                        if (tok >= TC) {
                            f32x4 o1, o2;
#pragma unroll
                            for (int r = 0; r < 4; ++r) { const float cx = cur[r >> 1][(r & 1) * 2], sx = cur[r >> 1][(r & 1) * 2 + 1]; const float a = acc[ai][bj][m][0][r] * sc, b = acc[ai][bj][m][1][r] * sc; o1[r] = a * cx - b * sx; o2[r] = b * cx + a * sx; }
                            *(u32x2*)dst = pack4(o1); *(u32x2*)(dst + 32) = pack4(o2);
                        } else { *(u32x2*)dst = pack4(acc[ai][bj][m][0] * sc); *(u32x2*)(dst + 32) = pack4(acc[ai][bj][m][1] * sc); }
                    }
                }
                if (qk && gi + 1 < 8) { cur[0] = nxt[0]; cur[1] = nxt[1]; }
            }
    }
};
struct EpiOddProj {
    static constexpr bool PERM = false, AFTER_DRAIN = false;
    bf16_t* SQ; bf16_t* SK; bf16_t* SV; bf16_t* CQ; bf16_t* CKV; bf16_t* KR; const f32x2* r64;
    __device__ __forceinline__ void operator()(Acc8 acc, const pg8::Unit& u, int wr, int wc, int fr, int fq) const {
        const bool rot = u.pn <= 4 || u.pn == 8;
        const int tok0 = u.pm * 256 + wr * 64 + fr;
        f32x4 cur[2], nxt[2];
        if (rot) rope64_load(cur, r64, tok0, wc, fq);
#pragma unroll
        for (int ai = 0; ai < 2; ++ai)
#pragma unroll
            for (int m = 0; m < 4; ++m) {
                const int tok = tok0 + ai * 128 + m * 16, gi = ai * 4 + m;
                if (rot && gi + 1 < 8) rope64_load(nxt, r64, tok0 + ((gi + 1) >> 2) * 128 + ((gi + 1) & 3) * 16, wc, fq);
                const bool lat = tok >= TC;
#pragma unroll
                for (int bj = 0; bj < 2; ++bj) {
                    const int c0 = u.pn * 256 + bj * 128 + wc * 32 + 4 * fq;
                    const f32x4 a = acc[ai][bj][m][0], b = acc[ai][bj][m][1];
                    if (u.pn < 4) rope64_pair(a, b, lat, cur, 0.125f * LOG2E, SQ + (size_t)tok * 1024 + c0);
                    else if (u.pn == 4) { if (bj == 0) rope64_pair(a, b, lat, cur, 1.0f, SK + (size_t)tok * 128 + (c0 - 1024)); else rope64_pair(a, b, false, cur, 1.0f, SV + (size_t)tok * 128 + (c0 - 1152)); }
                    else if (u.pn < 7) rope64_pair(a, b, false, cur, 1.0f, CQ + (size_t)tok * 512 + (c0 - 1280));
                    else if (u.pn == 7) rope64_pair(a, b, false, cur, 1.0f, CKV + (size_t)tok * 256 + (c0 - 1792));
                    else if (bj == 0 && wc < 2) rope64_pair(a, b, lat, cur, 1.0f, KR + (size_t)tok * 64 + (c0 - 2048));
                }
                if (rot && gi + 1 < 8) { cur[0] = nxt[0]; cur[1] = nxt[1]; }
            }
    }
};
struct EpiMlaQ {
    static constexpr bool PERM = false, AFTER_DRAIN = false;
    bf16_t* MQ; const f32x2* r64;
    __device__ __forceinline__ void operator()(Acc8 acc, const pg8::Unit& u, int wr, int wc, int fr, int fq) const {
        const int tok0 = TC + u.pm * 256 + wr * 64 + fr;
        f32x4 cur[2], nxt[2];
        rope64_load(cur, r64, tok0, wc, fq);
#pragma unroll
        for (int ai = 0; ai < 2; ++ai)
#pragma unroll
            for (int m = 0; m < 4; ++m) {
                const int tok = tok0 + ai * 128 + m * 16, gi = ai * 4 + m;
                if (gi + 1 < 8) rope64_load(nxt, r64, tok0 + ((gi + 1) >> 2) * 128 + ((gi + 1) & 3) * 16, wc, fq);
#pragma unroll
                for (int bj = 0; bj < 2; ++bj) {
                    const int c0 = u.pn * 256 + bj * 128 + wc * 32 + 4 * fq; const int rr = c0 >> 6;
                    rope64_pair(acc[ai][bj][m][0], acc[ai][bj][m][1], (rr % 3) == 2, cur, 0.07216878364870322f * LOG2E, MQ + (size_t)tok * 1536 + c0);
                }
                if (gi + 1 < 8) { cur[0] = nxt[0]; cur[1] = nxt[1]; }
            }
    }
};
struct EpiMlaKV {
    static constexpr bool PERM = false, AFTER_DRAIN = false;
    bf16_t* MK; bf16_t* MV;
    __device__ __forceinline__ void operator()(Acc8 acc, const pg8::Unit& u, int wr, int wc, int fr, int fq) const {
#pragma unroll
        for (int ai = 0; ai < 2; ++ai)
#pragma unroll
            for (int m = 0; m < 4; ++m) {
                const int tok = u.pm * 256 + ai * 128 + wr * 64 + m * 16 + fr;
                bf16_t* k = MK + ((size_t)tok * 8 + u.pn) * 192 + wc * 32 + 4 * fq; bf16_t* v = MV + ((size_t)tok * 8 + u.pn) * 128 + wc * 32 + 4 * fq;
                *(u32x2*)k = pack4(acc[ai][0][m][0]); *(u32x2*)(k + 16) = pack4(acc[ai][0][m][1]);
                *(u32x2*)v = pack4(acc[ai][1][m][0]); *(u32x2*)(v + 16) = pack4(acc[ai][1][m][1]);
            }
    }
};
struct EpiWout {
    static constexpr bool PERM = false, AFTER_DRAIN = false;
    const float* mods; const float* xlat_old; const float* xctx_old; float* out; float* xctx_new; int layer, tok_off;
    struct Grp { f32x4 gv[2][2], xv[2][2]; float* xn; };
    __device__ __forceinline__ void load_grp(Grp& G, const pg8::Unit& u, int ai, int m, int wr, int wc, int fr, int fq) const {
        const int tok = tok_off + u.pm * 256 + ai * 128 + wr * 64 + m * 16 + fr;
        const int mw = tok < TC ? 2 : ((tok - TC) >> 14);
        const float* g1 = mods + (size_t)(layer * 3 + mw) * 12288 + 2 * 2048;
        const float* xo = tok < TC ? xctx_old + (size_t)tok * D : xlat_old + (size_t)(tok - TC) * D;
        G.xn = tok < TC ? xctx_new + (size_t)tok * D : out + (size_t)(tok - TC) * D;
#pragma unroll
        for (int bj = 0; bj < 2; ++bj)
#pragma unroll
            for (int n = 0; n < 2; ++n) {
                const int col = u.pn * 256 + bj * 128 + wc * 32 + n * 16 + 4 * fq;
                G.gv[bj][n] = *(const f32x4*)(g1 + col); G.xv[bj][n] = *(const f32x4*)(xo + col);
            }
    }
    __device__ __forceinline__ void operator()(Acc8 acc, const pg8::Unit& u, int wr, int wc, int fr, int fq) const {
        Grp cur, nxt;
        load_grp(cur, u, 0, 0, wr, wc, fr, fq);
#pragma unroll
        for (int ai = 0; ai < 2; ++ai)
#pragma unroll
            for (int m = 0; m < 4; ++m) {
                const int gi = ai * 4 + m;
                if (gi + 1 < 8) load_grp(nxt, u, (gi + 1) >> 2, (gi + 1) & 3, wr, wc, fr, fq);
#pragma unroll
                for (int bj = 0; bj < 2; ++bj)
#pragma unroll
                    for (int n = 0; n < 2; ++n) {
                        const int col = u.pn * 256 + bj * 128 + wc * 32 + n * 16 + 4 * fq;
                        __builtin_nontemporal_store(cur.xv[bj][n] + cur.gv[bj][n] * acc[ai][bj][m][n], (f32x4*)(cur.xn + col));
                    }
                if (gi + 1 < 8) cur = nxt;
            }
    }
};
struct EpiStoreBf16 {
    static constexpr bool PERM = false, AFTER_DRAIN = false;
    bf16_t* O; int ldc;
    __device__ __forceinline__ void operator()(Acc8 acc, const pg8::Unit& u, int wr, int wc, int fr, int fq) const {
#pragma unroll
        for (int ai = 0; ai < 2; ++ai)
#pragma unroll
            for (int m = 0; m < 4; ++m) {
                bf16_t* rp = O + (size_t)(u.pm * 256 + ai * 128 + wr * 64 + m * 16 + fr) * ldc + u.pn * 256 + wc * 32 + 4 * fq;
#pragma unroll
                for (int bj = 0; bj < 2; ++bj)
#pragma unroll
                    for (int n = 0; n < 2; ++n) *(u32x2*)(rp + bj * 128 + n * 16) = pack4(acc[ai][bj][m][n]);
            }
    }
};
template <class Epi>
__device__ __forceinline__ void big_gemm(const Ctx& c, const bf16_t* A, const bf16_t* Bt, int M, int N, int K, const Epi& E) {
    pg8::Gemm g{A, Bt, M, N, K}; pg8::StaticOrder S; S.init(M, N, c.G, c.bid);
    pg8::gemm_phase<Epi, pg8::StaticOrder>((PG8_LAS unsigned char*)c.lds, g, S, E);
}
__device__ __forceinline__ void phase_even_proj2(const Ctx& c) {
    EpiEvenProj E{c.wb(WS_A), c.wb(WS_Q), c.wb(WS_K), c.wb(WS_V), c.wb(WS_G), (const f32x2*)(c.ws + WS_ROPE)};
    big_gemm(c, c.wb(WS_H), c.wb(WS_WINE), TT, 6144, 2048, E);
    const int busy = (TT / 256) * 24 - 12 * c.G;
    if (busy > 0 && busy < c.G && c.bid >= busy) {
        conv_fp4(c, c.in[20] + (size_t)16384 * 2048, c.ws + WS_TABU + 32 * MiB, 16384, U_SCALE, c.bid - busy, c.G - busy);
        conv_fp4(c, c.in[21] + (size_t)16384 * 2048, c.ws + WS_TABV + 32 * MiB, 16384, V_SCALE, c.bid - busy, c.G - busy);
    } else if (!(busy > 0 && busy < c.G)) {
        conv_fp4(c, c.in[20] + (size_t)16384 * 2048, c.ws + WS_TABU + 32 * MiB, 16384, U_SCALE, c.bid, c.G);
        conv_fp4(c, c.in[21] + (size_t)16384 * 2048, c.ws + WS_TABV + 32 * MiB, 16384, V_SCALE, c.bid, c.G);
    }
}
__device__ __forceinline__ void phase_odd_proj2(const Ctx& c) {
    EpiOddProj E{c.wb(WS_A), c.wb(WS_Q), c.wb(WS_Q + 9 * MiB), c.wb(WS_Q + 18 * MiB), c.wb(WS_K), c.wb(WS_K + 17 * MiB), (const f32x2*)(c.ws + WS_ROPE + 131072)};
    big_gemm(c, c.wb(WS_H), c.wb(WS_WINO), TT, 2304, 2048, E);
}
__device__ __forceinline__ void phase_mla_up2(const Ctx& c) {
    EpiMlaQ EQ{c.wb(WS_G), (const f32x2*)(c.ws + WS_ROPE + 131072)};
    big_gemm(c, c.wb(WS_Q + 18 * MiB) + (size_t)TC * 512, c.wb(WS_WUQ), TL, 1536, 512, EQ);
    EpiMlaKV EK{c.wb(WS_ST), c.wb(WS_V)};
    big_gemm(c, c.wb(WS_K), c.wb(WS_WUKV), TT, 2048, 256, EK);
}
__device__ __forceinline__ void phase_wout2(const Ctx& c, const bf16_t* W, int layer, const float* xlat_old, const float* xctx_old, int tok_off) {
    EpiWout E{c.wf(WS_MODS), xlat_old, xctx_old, c.out, c.wf(WS_XCTX), layer, tok_off};
    big_gemm(c, c.wb(WS_CAT) + (size_t)tok_off * 2048, W, TT - tok_off, 2048, 2048, E);
}
__device__ __forceinline__ void phase_peer_q2(const Ctx& c, const bf16_t* W, int tok_off) {
    EpiStoreBf16 E{c.wb(WS_G) + (size_t)tok_off * 2048, 2048};
    big_gemm(c, c.wb(WS_H) + (size_t)tok_off * 2048, W, TT - tok_off, 2048, 2048, E);
}

#ifdef DBG_FOURIER_CHECK
__device__ __forceinline__ void dbg_fourier_check(const Ctx& c) {
    if (c.bid >= 48) return;
    const bf16_t* F = c.wb(WS_A); const bf16_t* CAT = c.wb(WS_CAT);
    LAS float* red = (LAS float*)c.lds;
    const int i = c.bid;
    const bool lat = i >= 32;
    const int b = i & 1, g = (i >> 1) & 3, m = (i * 53 + 7) & 255;
    const int L = lat ? 16384 : 256;
    const int k = lat ? ((i * 2731 + 11) & 16383) : ((i * 37 + 3) & 255);
    const size_t tok0 = lat ? (size_t)TC + (size_t)b * SEQ : (size_t)b * NCTX;
    float acc = 0.f;
    for (int n = c.tid; n < L; n += 512) {
        const float fa = (float)(((long long)k * n) % L) / (float)L;
        float rs = 0.f;
        for (int cc = 0; cc < 256; ++cc) {
            const float fb = (float)((m * cc) & 255) * (1.0f / 256.0f);
            float fr = fa + fb; fr = fr - floorf(fr);
            rs += bf2f(F[(tok0 + n) * 1024 + g * 256 + cc]) * cos_rev(fr);
        }
        acc += rs;
    }
    acc = wave_sum(acc);
    if (c.lane == 0) red[c.w] = acc;
    __syncthreads();
    float tot = 0.f; for (int w = 0; w < 8; ++w) tot += red[w];
    tot *= lat ? (1.0f / 2048.0f) : (1.0f / 256.0f);
    const float got = bf2f(CAT[(tok0 + k) * 2048 + g * 256 + m]);
    if (c.tid == 0 && fabsf(got - tot) > 0.03f + 0.03f * fabsf(tot)) atomicOr((unsigned*)(c.ws + WS_CTL + 32768), lat ? 2u : 1u);
    __syncthreads();
}
#endif
#ifdef DBG_RET_CHECK
__device__ __forceinline__ void dbg_ret_check(const Ctx& c) {
    if (c.bid >= 32) return;
    const bf16_t* Q = c.wb(WS_Q); const bf16_t* Kb = c.wb(WS_K); const bf16_t* V = c.wb(WS_V); const bf16_t* Gt = c.wb(WS_G); const bf16_t* CAT = c.wb(WS_CAT);
    const float* gn = c.in[9];
    LAS float* wgt = (LAS float*)c.lds;
    LAS float* red = (LAS float*)(c.lds + 80000);
    const int i = c.bid, b = i & 1, h = (i >> 1) & 7;
    const bool isctx = i >= 26;
    const int pos = isctx ? (i == 26 ? 5 : (i == 27 ? 130 : (i == 28 ? 255 : (i == 29 ? 0 : (i * 41) & 255))))
                          : (i == 0 ? 0 : (i == 1 ? 16383 : (i == 2 ? 127 : (i == 3 ? 128 : (i * 1637 + 29) & 16383))));
    const size_t tokT = isctx ? (size_t)b * NCTX + pos : (size_t)TC + (size_t)b * SEQ + pos;
    const float lg = log2_gamma(h);
    float yacc = 0.f;
    for (int dir = 0; dir < 2; ++dir) {
        const int nkeys = isctx ? 256 : 256 + 16384;
        for (int j = c.tid; j < nkeys; j += 512) {
            const bool kc = j < 256; const int kp = kc ? j : j - 256;
            const size_t tokK = kc ? (size_t)b * NCTX + kp : (size_t)TC + (size_t)b * SEQ + kp;
            int dist;
            if (isctx) dist = dir == 0 ? pos - kp : kp - pos;
            else if (kc) dist = dir == 0 ? 256 + pos - kp : 16384 - pos + kp;
            else dist = dir == 0 ? pos - kp : kp - pos;
            float w = 0.f;
            if (dist >= 0) {
                float d = 0.f;
                for (int x = 0; x < 128; ++x) d += bf2f(Q[tokT * 1024 + h * 128 + x]) * bf2f(Kb[tokK * 1024 + h * 128 + x]);
                w = d * fast_exp2(lg * (float)dist);
            }
            wgt[j] = w;
        }
        __syncthreads();
        float o = 0.f;
        if (c.tid < 128) {
            for (int j = 0; j < nkeys; ++j) {
                const float w = wgt[j];
                if (w != 0.f) { const bool kc = j < 256; const int kp = kc ? j : j - 256; const size_t tokK = kc ? (size_t)b * NCTX + kp : (size_t)TC + (size_t)b * SEQ + kp;
                    o += w * bf2f(V[tokK * 1024 + h * 128 + c.tid]); }
            }
        }
        float ss = (c.tid < 128) ? o * o : 0.f;
        ss = wave_sum(ss);
        if (c.lane == 0) red[c.w] = ss;
        __syncthreads();
        const float tot = red[0] + red[1];
        const float rstd = rsqrtf(tot * (1.0f / 128.0f) + EPS);
        if (c.tid < 128) yacc += o * rstd * gn[h * 128 + c.tid] * bf2f(Gt[tokT * 2048 + dir * 1024 + h * 128 + c.tid]);
        __syncthreads();
    }
    if (c.tid < 128) {
        const float got = bf2f(CAT[tokT * 2048 + 1024 + h * 128 + c.tid]);
        if (fabsf(got - yacc) > 0.04f + 0.05f * fabsf(yacc)) atomicOr((unsigned*)(c.ws + WS_CTL + 32768), isctx ? 8u : 4u);
    }
    __syncthreads();
}
#endif
__global__ void __launch_bounds__(512, 2) fwd_kernel(KArgs a) {
    extern __shared__ __attribute__((aligned(16))) unsigned char shm[];
    Ctx c;
#pragma unroll
    for (int i = 0; i < 23; ++i) c.in[i] = a.in[i];
    c.out = a.out; c.ws = a.ws; c.lds = (LAS unsigned char*)shm; c.G = gridDim.x; c.bid = blockIdx.x; c.tid = threadIdx.x; c.lane = threadIdx.x & 63;
    c.w = __builtin_amdgcn_readfirstlane(threadIdx.x >> 6);
    const int lo = a.ph_lo, hi = a.ph_hi;
    volatile LAS unsigned* bw = (volatile LAS unsigned*)(c.lds + LDS_BYTES - 16);
    XcdBarrier bar; bar.bar = (unsigned*)(a.ws + WS_CTL); bar.x = 0; bar.st = bw;
    if (hi - lo > 1) {
        if (threadIdx.x == 0) { bw[0] = 0u; bw[1] = 0u; bw[2] = 0u; bw[3] = 0u; }
        __syncthreads();
        bar = xcd_barrier_post((unsigned*)(a.ws + WS_CTL), bw);
    }
#define IN(k) (((PHASE_MASK >> (k)) & 1u) && lo <= (k) && (k) < hi)
#define SEAM(k) do { if (IN(k) && IN((k) + 1)) xcd_barrier(bar); } while (0)
    float* XCTX = c.wf(WS_XCTX); bf16_t* H = c.wb(WS_H);
    if (IN(0)) phase_prologue(c);
    SEAM(0);
    if (IN(1)) phase_mods(c);
    SEAM(1);
    if (IN(2)) phase_modnorm(c, 0, 0, c.in[0], c.in[2], 0, H);
    SEAM(2);
    if (IN(3)) phase_even_proj2(c);
    SEAM(3);
    if (IN(4)) phase_chan_dft(c);
    SEAM(4);
    if (IN(5)) phase_dft_stage1(c);
    SEAM(5);
    if (IN(6)) { phase_dft_stage2(c); phase_ret_ds(c); }
    SEAM(6);
    if (IN(7)) phase_ret_scan(c);
    SEAM(7);
    if (IN(8)) phase_ret_out(c);
    SEAM(8);
#ifdef DBG_FOURIER_CHECK
    if (IN(9)) dbg_fourier_check(c);
#endif
#ifdef DBG_RET_CHECK
    if (IN(9)) dbg_ret_check(c);
#endif
    if (IN(9)) { phase_wout2(c, c.wb(WS_WOUTE), 0, c.in[0], c.in[2], TC); phase_wout(c, c.wb(WS_WOUTE), 0, c.in[0], c.in[2], 0, TC / 128); }
    SEAM(9);
    if (IN(10)) phase_modnorm(c, 0, 1, c.out, XCTX, 0, H);
    SEAM(10);
    if (IN(11)) { phase_peer_q2(c, c.wb(WS_WQ0), TC); phase_peer_q(c, c.wb(WS_WQ0), 0, TC / 128); }
    SEAM(11);
    if (IN(12)) phase_peer_topk(c, 0, 0);
    SEAM(12);
#ifdef DBG_TOPK_CHECK
    if (lo == 12) dbg_gather_save(c);
#endif
    if (IN(13)) phase_peer_gather<false>(c, 0, 0);
    SEAM(13);
#ifdef DBG_TOPK_CHECK
    if (lo == 13) dbg_topk_check(c);
    if (lo == 14) dbg_gather_check(c);
#endif
    if (IN(14)) {
        phase_modnorm(c, 1, 0, c.out, XCTX, 0, H);
    }
    SEAM(14);
    if (IN(15)) phase_odd_proj2(c);
    SEAM(15);
    if (IN(16)) phase_odd_local(c);
    SEAM(16);
    if (IN(17)) phase_mla_up2(c);
    SEAM(17);
    if (IN(18)) phase_attention(c);
    SEAM(18);
#ifdef DBG_ATTN_CHECK
    if (IN(19)) dbg_attn_check(c);
#endif
    if (IN(19)) phase_wout2(c, c.wb(WS_WOUTO), 1, c.out, XCTX, TC);
    SEAM(19);
    if (IN(20)) phase_modnorm(c, 1, 1, c.out, XCTX, TC, H);
    SEAM(20);
    if (IN(21)) phase_peer_q2(c, c.wb(WS_WQ1), TC);
    SEAM(21);
    if (IN(22)) phase_peer_topk(c, 1, 4);
    SEAM(22);
    if (IN(23)) phase_peer_gather<true>(c, 1, TC);
#ifdef DUMP_OFF
    if (lo == NPH - 1) { const bf16_t* src = c.wb(DUMP_OFF); for (size_t i = (size_t)c.bid * 512 + c.tid; i < (size_t)TL * D; i += (size_t)c.G * 512) { float v = bf2f(src[i]); c.out[i] = (v == v && fabsf(v) < 1e30f) ? v : 777.0f; } }
#endif
#undef IN
#undef SEAM
}

extern "C" void kernel_launch(void* const* d_in, const int* in_sizes, int n_in, void* d_out, int out_size, void* d_ws, size_t ws_size, hipStream_t stream) {
    static int grid = 0;
    if (grid == 0) {
        if (n_in != 23 || ws_size < WS_END) { fprintf(stderr, "kernel_launch: unexpected n_in %d / ws %zu\n", n_in, ws_size); grid = -1; return; }
        int dev = 0, cus = 0, per_cu = 0;
        hipGetDevice(&dev);
        hipDeviceGetAttribute(&cus, hipDeviceAttributeMultiprocessorCount, dev);
        if (hipFuncSetAttribute((const void*)fwd_kernel, hipFuncAttributeMaxDynamicSharedMemorySize, LDS_BYTES) != hipSuccess) { fprintf(stderr, "hipFuncSetAttribute failed\n"); grid = -1; return; }
        if (hipOccupancyMaxActiveBlocksPerMultiprocessor(&per_cu, (const void*)fwd_kernel, 512, LDS_BYTES) != hipSuccess || per_cu < 1) { fprintf(stderr, "occupancy query: %d\n", per_cu); }
        (void)hipGetLastError();
        grid = cus > 0 ? cus : 256;
    }
    if (grid < 0) return;
    hipMemsetAsync((char*)d_ws + WS_CTL, 0, 65536, stream);
    KArgs a{};
    for (int i = 0; i < 23; ++i) a.in[i] = (const float*)d_in[i];
    a.out = (float*)d_out; a.ws = (unsigned char*)d_ws;
#if N_LAUNCHES == 1
    a.ph_lo = 0; a.ph_hi = NPH;
    hipLaunchKernelGGL(fwd_kernel, dim3(grid), dim3(512), LDS_BYTES, stream, a);
#else
    { static const int order[NPH] = {0,1,2,3,4,5,6,7,8,9,10,11,12,13,14,15,16,17,18,19,20,21,22,23};
      for (int i = 0; i < NPH; ++i) { const int k = order[i]; a.ph_lo = k; a.ph_hi = k + 1; hipLaunchKernelGGL(fwd_kernel, dim3(grid), dim3(512), LDS_BYTES, stream, a); } }
#endif
}
```
